# Optimizing an MI355X kernel written in HIP

```python
import math
import jax
import jax.numpy as jnp
from jax import lax
import numpy as np

D_MODEL = 1024
BATCH = 16
SEQ = 2048
DEPTH = 2

CTX_LEN = 256
GRID_W = 64
EPS = 1e-6

HY_WIDTH = 256
HY_HEADS = 4
HY_SHORT = 3
HY_EMB = 33
HY_BANDS = (HY_EMB - 1) // 2
HY_HIDDEN = 64
HY_DECAY_TARGET = 1e-2
HY_SHORT_DECAY_PCT = 0.3
HY_LONG_DECAY_PCT = 1.5

SSD_HEADS = 8
SSD_HEAD_DIM = 64
SSD_INNER = SSD_HEADS * SSD_HEAD_DIM
SSD_GROUPS = 2
SSD_STATE = 128
SSD_CONV = 3
SSD_CHUNK = 128
SSD_XBC = SSD_INNER + 2 * SSD_GROUPS * SSD_STATE

FN_WIDTH = 256
FN_GROUPS = 4
FN_GROUP_DIM = FN_WIDTH // FN_GROUPS

D_MIX = HY_WIDTH + SSD_INNER + FN_WIDTH

OFF_HY = 0
OFF_Z = OFF_HY + 3 * HY_WIDTH
OFF_XBC = OFF_Z + SSD_INNER
OFF_DT = OFF_XBC + SSD_XBC
OFF_FN = OFF_DT + 2 * SSD_HEADS
D_IN_PROJ = OFF_FN + FN_WIDTH

PEER_HEADS = 8
PEER_TOPK = 16
N_KEYS = 128
N_EXPERTS = N_KEYS * N_KEYS
PEER_QDIM = 256
PEER_HALF = PEER_QDIM // 2
PEER_BLOCK = 128

kernel_name = 'hybrid_hyena_ssd_fnet_peer_dit'


def rmsnorm(x, g):
    xf = x.astype(jnp.float32)
    y = xf * lax.rsqrt(jnp.mean(xf * xf, axis=-1, keepdims=True) + EPS)
    return y.astype(x.dtype) * g


def modulate(h, shift, scale):
    return h * (1 + scale) + shift


def dwconv(u, w, b):
    k_w, ch = w.shape
    y = lax.conv_general_dilated(u, w.astype(u.dtype)[:, None, :], window_strides=(1,),
                                 padding=[(k_w // 2, k_w // 2)],
                                 dimension_numbers=('NWC', 'WIO', 'NWC'), feature_group_count=ch)
    return y + b


def hyena_filter(seq_len, w1, b1, w2, b2, w3, freq):
    f32 = jnp.float32
    t = jnp.linspace(0.0, 1.0, seq_len, dtype=f32)[:, None]
    w = 2.0 * math.pi * jnp.arange(seq_len, dtype=f32)[:, None] / seq_len
    f = jnp.linspace(1e-4, HY_BANDS - 1, HY_BANDS, dtype=f32)[None, :]
    z = jnp.concatenate([t, jnp.cos(f * w), -jnp.sin(f * w)], axis=-1)
    fr = freq.astype(f32)
    h = jnp.sin(fr * (z @ w1.astype(f32) + b1.astype(f32)))
    h = jnp.sin(fr * (h @ w2.astype(f32) + b2.astype(f32)))
    h = h @ w3.astype(f32)
    max_decay = math.log(HY_DECAY_TARGET) / HY_SHORT_DECAY_PCT
    min_decay = math.log(HY_DECAY_TARGET) / HY_LONG_DECAY_PCT
    deltas = jnp.abs(jnp.linspace(min_decay, max_decay, HY_WIDTH, dtype=f32))
    window = jnp.exp(-t * deltas)
    h_fwd = h[:, :HY_WIDTH] * window
    h_bwd = h[:, HY_WIDTH:] * window
    k = jnp.concatenate([h_fwd, jnp.zeros((1, HY_WIDTH), f32), jnp.flip(h_bwd[1:], axis=0)], axis=0)
    return k * lax.rsqrt(jnp.sum(k * k, axis=0, keepdims=True) + EPS)


def long_conv(u, k, bias):
    seq_len = u.shape[1]
    uf = u.astype(jnp.float32)
    u_hat = jnp.fft.rfft(uf, n=2 * seq_len, axis=1)
    k_hat = jnp.fft.rfft(k, n=2 * seq_len, axis=0)
    y = jnp.fft.irfft(u_hat * k_hat[None], n=2 * seq_len, axis=1)[:, :seq_len]
    return (y + uf * bias.astype(jnp.float32)).astype(u.dtype)


def hyena_mixer(u, conv_w, conv_b, w1, b1, w2, b2, w3, freq, bias):
    u = dwconv(u, conv_w, conv_b)
    v, x1, x2 = jnp.split(u, 3, axis=-1)
    k = hyena_filter(u.shape[1], w1, b1, w2, b2, w3, freq)
    return x1 * long_conv(x2 * v, k, bias)


def fourier_mixer(u):
    b, seq_len, _ = u.shape
    uf = u.astype(jnp.float32).reshape(b, seq_len, FN_GROUPS, FN_GROUP_DIM)
    y = jnp.fft.fft2(uf, axes=(1, 3), norm='ortho').real
    return y.reshape(b, seq_len, FN_WIDTH).astype(u.dtype)


def ssd_scan(x, dt, a, bm, cm, h0, with_output):
    f32 = jnp.float32
    b, seq_len, n_heads, hd = x.shape
    n_groups, n_state = bm.shape[2], bm.shape[3]
    hg = n_heads // n_groups
    q = SSD_CHUNK
    nc = seq_len // q
    xdt = (x.astype(f32) * dt[..., None]).reshape(b, nc, q, n_groups, hg, hd)
    a_cum = jnp.cumsum((dt * a).reshape(b, nc, q, n_groups, hg), axis=2)
    bc = bm.astype(f32).reshape(b, nc, q, n_groups, n_state)
    decay_end = jnp.exp(a_cum[:, :, -1:] - a_cum)
    states = jnp.einsum('bcjgn,bcjgkp->bcgkpn', bc, decay_end[..., None] * xdt)
    chunk_decay = jnp.exp(a_cum[:, :, -1])

    def step(h, inp):
        s, d = inp
        return h * d[..., None, None] + s, h

    h_last, h_in = lax.scan(step, h0, (jnp.moveaxis(states, 1, 0), jnp.moveaxis(chunk_decay, 1, 0)))
    if not with_output:
        return h_last
    h_in = jnp.moveaxis(h_in, 0, 1)
    cc = cm.astype(f32).reshape(b, nc, q, n_groups, n_state)
    lower = jnp.tril(jnp.ones((q, q), dtype=bool))[:, :, None, None]
    seg = a_cum[:, :, :, None] - a_cum[:, :, None, :]
    lmat = jnp.where(lower, jnp.exp(jnp.where(lower, seg, 0.0)), 0.0)
    cb = jnp.einsum('bcign,bcjgn->bcijg', cc, bc)
    y_diag = jnp.einsum('bcijgk,bcjgkp->bcigkp', cb[..., None] * lmat, xdt)
    y_off = jnp.einsum('bcign,bcgkpn->bcigkp', cc, h_in) * jnp.exp(a_cum)[..., None]
    return (y_diag + y_off).reshape(b, seq_len, n_heads, hd), h_last


def gated_group_rmsnorm(y, z, g):
    b, seq_len, _ = y.shape
    yf = (y * jax.nn.silu(z.astype(jnp.float32))).reshape(b, seq_len, SSD_GROUPS, SSD_INNER // SSD_GROUPS)
    yf = yf * lax.rsqrt(jnp.mean(yf * yf, axis=-1, keepdims=True) + EPS)
    return yf.reshape(b, seq_len, SSD_INNER).astype(z.dtype) * g


def ssd_mixer(z, xbc, dt_raw, conv_w, conv_b, dt_bias, a_log, d_skip, norm_g, h0_fwd, h0_bwd, with_output):
    f32 = jnp.float32
    b, seq_len, _ = xbc.shape
    gn = SSD_GROUPS * SSD_STATE
    xbc = jax.nn.silu(dwconv(xbc, conv_w, conv_b))
    x = xbc[..., :SSD_INNER].reshape(b, seq_len, SSD_HEADS, SSD_HEAD_DIM)
    bm = xbc[..., SSD_INNER:SSD_INNER + gn].reshape(b, seq_len, SSD_GROUPS, SSD_STATE)
    cm = xbc[..., SSD_INNER + gn:].reshape(b, seq_len, SSD_GROUPS, SSD_STATE)
    dt = jax.nn.softplus(dt_raw.astype(f32).reshape(b, seq_len, 2, SSD_HEADS) + dt_bias.astype(f32))
    a = -jnp.exp(a_log.astype(f32))
    flip = lambda arr: jnp.flip(arr, axis=1)
    out_f = ssd_scan(x, dt[:, :, 0], a[0], bm, cm, h0_fwd, with_output)
    out_b = ssd_scan(flip(x), flip(dt[:, :, 1]), a[1], flip(bm), flip(cm), h0_bwd, with_output)
    if not with_output:
        return None, out_f, out_b
    y_f, h_f = out_f
    y_b, h_b = out_b
    y = y_f + flip(y_b) + d_skip.astype(f32)[:, None] * x.astype(f32)
    y = gated_group_rmsnorm(y.reshape(b, seq_len, SSD_INNER), z, norm_g)
    return y, h_f, h_b


def peer_ffn(h, wq, k1, k2, u_tab, v_tab):
    f32 = jnp.float32
    b, seq_len, d = h.shape
    n_tok = b * seq_len
    hf = h.reshape(n_tok, d)
    q = (hf @ wq).reshape(n_tok, PEER_HEADS, 2, PEER_HALF).astype(f32)
    s1 = jnp.einsum('thd,nd->thn', q[:, :, 0], k1.astype(f32))
    s2 = jnp.einsum('thd,nd->thn', q[:, :, 1], k2.astype(f32))
    v1, i1 = lax.top_k(s1, PEER_TOPK)
    v2, i2 = lax.top_k(s2, PEER_TOPK)
    cand = (v1[..., :, None] + v2[..., None, :]).reshape(n_tok, PEER_HEADS, PEER_TOPK * PEER_TOPK)
    sc, ci = lax.top_k(cand, PEER_TOPK)
    e1 = jnp.take_along_axis(i1, ci // PEER_TOPK, axis=-1)
    e2 = jnp.take_along_axis(i2, ci % PEER_TOPK, axis=-1)
    idx = (e1 * N_KEYS + e2).reshape(n_tok, PEER_HEADS * PEER_TOPK)
    gates = jax.nn.softmax(sc, axis=-1).reshape(n_tok, PEER_HEADS * PEER_TOPK)
    nb = n_tok // PEER_BLOCK

    def block(args):
        hb, ib, gb = args
        us = jnp.take(u_tab, ib, axis=0)
        act = jax.nn.gelu(jnp.einsum('td,tkd->tk', hb, us).astype(f32)) * gb
        vs = jnp.take(v_tab, ib, axis=0)
        return jnp.einsum('tk,tkd->td', act.astype(hb.dtype), vs)

    out = lax.map(block, (hf.reshape(nb, PEER_BLOCK, d), idx.reshape(nb, PEER_BLOCK, -1),
                          gates.reshape(nb, PEER_BLOCK, -1)))
    return out.reshape(b, seq_len, d).astype(h.dtype)


def trunk_layer(xl, xc, c, c_ctx, p, ctx_out):
    f32 = jnp.float32
    mod_l = (jax.nn.silu(c) @ p['w_ada'] + p['b_ada'])[:, None, :]
    mod_c = jax.nn.silu(c_ctx) @ p['w_ada'] + p['b_ada']
    sh1, sc1, ga1, sh2, sc2, ga2 = jnp.split(mod_l, 6, axis=-1)
    csh1, csc1, cga1, csh2, csc2, cga2 = jnp.split(mod_c, 6, axis=-1)
    pl = modulate(rmsnorm(xl, p['g_norm1']), sh1, sc1) @ p['w_in']
    pc = modulate(rmsnorm(xc, p['g_norm1']), csh1, csc1) @ p['w_in']
    ssd_w = (p['ssd_conv_w'], p['ssd_conv_b'], p['ssd_dt_bias'], p['ssd_a_log'], p['ssd_d'], p['ssd_norm_g'])

    def ssd_cols(proj):
        return proj[..., OFF_Z:OFF_XBC], proj[..., OFF_XBC:OFF_DT], proj[..., OFF_DT:OFF_FN]

    h0 = jnp.zeros((xl.shape[0], SSD_GROUPS, SSD_HEADS // SSD_GROUPS, SSD_HEAD_DIM, SSD_STATE), f32)
    yc_ssd, hc_fwd, hc_bwd = ssd_mixer(*ssd_cols(pc), *ssd_w, h0, h0, ctx_out)
    yl_ssd, _, _ = ssd_mixer(*ssd_cols(pl), *ssd_w, hc_fwd, hc_bwd, True)

    def token_mix(proj, y_ssd):
        y_hy = hyena_mixer(proj[..., OFF_HY:OFF_Z], p['hy_conv_w'], p['hy_conv_b'], p['hf_w1'], p['hf_b1'],
                           p['hf_w2'], p['hf_b2'], p['hf_w3'], p['hf_freq'], p['hy_bias'])
        y_fn = fourier_mixer(proj[..., OFF_FN:D_IN_PROJ])
        return jnp.concatenate([y_hy, y_ssd.astype(y_hy.dtype), y_fn], axis=-1) @ p['w_out']

    def channel_mix(h_in, shift, scale):
        return peer_ffn(modulate(rmsnorm(h_in, p['g_norm2']), shift, scale),
                        p['peer_wq'], p['peer_k1'], p['peer_k2'], p['peer_u'], p['peer_v'])

    xl = xl + ga1 * token_mix(pl, yl_ssd)
    xl = xl + ga2 * channel_mix(xl, sh2, sc2)
    if ctx_out:
        xc = xc + cga1 * token_mix(pc, yc_ssd)
        xc = xc + cga2 * channel_mix(xc, csh2, csc2)
    return xl, xc


def setup_inputs(seed: int = 0) -> dict:
    key = jax.random.key(seed)
    ks = list(jax.random.split(key, 40))
    f32 = jnp.float32

    def nrm(shape, scale):
        return jax.random.normal(ks.pop(), shape, f32) * scale

    nl = DEPTH
    x = nrm((BATCH, SEQ, D_MODEL), 1.0)
    c = nrm((BATCH, D_MODEL), 1.0)
    ctx = nrm((BATCH, CTX_LEN, D_MODEL), 1.0)
    c_ctx = nrm((D_MODEL,), 1.0)
    w_ada = nrm((nl, D_MODEL, 6 * D_MODEL), D_MODEL ** -0.5)
    b_ada = nrm((nl, 6 * D_MODEL), 0.02)
    g_norm1 = 1.0 + nrm((nl, D_MODEL), 0.02)
    g_norm2 = 1.0 + nrm((nl, D_MODEL), 0.02)
    w_in = nrm((nl, D_MODEL, D_IN_PROJ), D_MODEL ** -0.5)
    hy_conv_w = nrm((nl, HY_SHORT, 3 * HY_WIDTH), HY_SHORT ** -0.5)
    hy_conv_b = nrm((nl, 3 * HY_WIDTH), 0.02)
    hf_w1 = nrm((nl, HY_EMB, HY_HIDDEN), HY_EMB ** -0.5)
    hf_b1 = nrm((nl, HY_HIDDEN), 0.1)
    hf_w2 = nrm((nl, HY_HIDDEN, HY_HIDDEN), HY_HIDDEN ** -0.5)
    hf_b2 = nrm((nl, HY_HIDDEN), 0.1)
    hf_w3 = nrm((nl, HY_HIDDEN, 2 * HY_WIDTH), HY_HIDDEN ** -0.5)
    hf_freq = 1.0 + nrm((nl, HY_HIDDEN), 0.1)
    hy_bias = nrm((nl, HY_WIDTH), 0.5)
    ssd_conv_w = nrm((nl, SSD_CONV, SSD_XBC), SSD_CONV ** -0.5)
    ssd_conv_b = nrm((nl, SSD_XBC), 0.02)
    dt0 = jnp.exp(jax.random.uniform(ks.pop(), (nl, 2, SSD_HEADS), f32, math.log(1e-3), math.log(1e-1)))
    ssd_dt_bias = dt0 + jnp.log(-jnp.expm1(-dt0))
    ssd_a_log = jnp.log(jax.random.uniform(ks.pop(), (nl, 2, SSD_HEADS), f32, 1.0, 16.0))
    ssd_d = 1.0 + nrm((nl, SSD_HEADS), 0.1)
    ssd_norm_g = 1.0 + nrm((nl, SSD_INNER), 0.02)
    w_out = nrm((nl, D_MIX, D_MODEL), D_MIX ** -0.5)
    peer_wq = nrm((nl, D_MODEL, PEER_HEADS * PEER_QDIM), D_MODEL ** -0.5)
    peer_k1 = nrm((nl, N_KEYS, PEER_HALF), PEER_HALF ** -0.5)
    peer_k2 = nrm((nl, N_KEYS, PEER_HALF), PEER_HALF ** -0.5)
    peer_u = nrm((nl, N_EXPERTS, D_MODEL), D_MODEL ** -0.5)
    peer_v = nrm((nl, N_EXPERTS, D_MODEL), PEER_HEADS ** -0.5)
    g_final = 1.0 + nrm((D_MODEL,), 0.02)
    return {'x': x, 'c': c, 'ctx': ctx, 'c_ctx': c_ctx, 'w_ada': w_ada, 'b_ada': b_ada,
            'g_norm1': g_norm1, 'g_norm2': g_norm2, 'w_in': w_in, 'hy_conv_w': hy_conv_w,
            'hy_conv_b': hy_conv_b, 'hf_w1': hf_w1, 'hf_b1': hf_b1, 'hf_w2': hf_w2, 'hf_b2': hf_b2,
            'hf_w3': hf_w3, 'hf_freq': hf_freq, 'hy_bias': hy_bias, 'ssd_conv_w': ssd_conv_w,
            'ssd_conv_b': ssd_conv_b, 'ssd_dt_bias': ssd_dt_bias, 'ssd_a_log': ssd_a_log, 'ssd_d': ssd_d,
            'ssd_norm_g': ssd_norm_g, 'w_out': w_out, 'peer_wq': peer_wq, 'peer_k1': peer_k1,
            'peer_k2': peer_k2, 'peer_u': peer_u, 'peer_v': peer_v, 'g_final': g_final}


def reference(x, c, ctx, c_ctx, w_ada, b_ada, g_norm1, g_norm2, w_in, hy_conv_w, hy_conv_b, hf_w1, hf_b1,
              hf_w2, hf_b2, hf_w3, hf_freq, hy_bias, ssd_conv_w, ssd_conv_b, ssd_dt_bias, ssd_a_log, ssd_d,
              ssd_norm_g, w_out, peer_wq, peer_k1, peer_k2, peer_u, peer_v, g_final):
    xl, xc = x, ctx
    for i in range(DEPTH):
        p = {'w_ada': w_ada[i], 'b_ada': b_ada[i], 'g_norm1': g_norm1[i], 'g_norm2': g_norm2[i],
             'w_in': w_in[i], 'hy_conv_w': hy_conv_w[i], 'hy_conv_b': hy_conv_b[i], 'hf_w1': hf_w1[i],
             'hf_b1': hf_b1[i], 'hf_w2': hf_w2[i], 'hf_b2': hf_b2[i], 'hf_w3': hf_w3[i], 'hf_freq': hf_freq[i],
             'hy_bias': hy_bias[i], 'ssd_conv_w': ssd_conv_w[i], 'ssd_conv_b': ssd_conv_b[i],
             'ssd_dt_bias': ssd_dt_bias[i], 'ssd_a_log': ssd_a_log[i], 'ssd_d': ssd_d[i],
             'ssd_norm_g': ssd_norm_g[i], 'w_out': w_out[i], 'peer_wq': peer_wq[i], 'peer_k1': peer_k1[i],
             'peer_k2': peer_k2[i], 'peer_u': peer_u[i], 'peer_v': peer_v[i]}
        xl, xc = trunk_layer(xl, xc, c, c_ctx, p, i < DEPTH - 1)
    return rmsnorm(xl, g_final)
```

```cpp
#include <hip/hip_runtime.h>
#include <hip/hip_cooperative_groups.h>
#include <cstdio>
namespace cg = cooperative_groups;

#ifndef PH_MASK
#define PH_MASK 0xFFFF
#endif
#ifndef PEER_REPS
#define PEER_REPS 1
#endif
#ifndef EXTRA_SYNCS
#define EXTRA_SYNCS 0
#endif
#ifndef REP_MASK
#define REP_MASK 0
#endif
#ifndef ONE_LAUNCH
#define ONE_LAUNCH 1
#endif

typedef unsigned short u16;
typedef unsigned int u32;
typedef __attribute__((ext_vector_type(8))) short bf16x8;
typedef __attribute__((ext_vector_type(16))) float f32x16;
typedef __attribute__((ext_vector_type(4))) float f32x4;
typedef __attribute__((ext_vector_type(2))) float f32x2;
typedef __attribute__((ext_vector_type(4))) unsigned int u32x4;
#define DI __device__ __forceinline__
DI int TID() { int t = threadIdx.x; asm volatile("" : "+v"(t)); return t; }

DI u16 f2bf(float x) { u32 u = __float_as_uint(x); u += 0x7fffu + ((u >> 16) & 1u); return (u16)(u >> 16); }
DI float bf2f(u16 v) { return __uint_as_float(((u32)v) << 16); }
DI u32 pack2(float a, float b) { return (u32)f2bf(a) | ((u32)f2bf(b) << 16); }
DI float bflo(u32 v) { return __uint_as_float(v << 16); }
DI float bfhi(u32 v) { return __uint_as_float(v & 0xffff0000u); }

constexpr int D = 1024, NB = 16, SEQ = 2048, CTXL = 256, TPB = 2304, ROWS = NB * TPB;
constexpr int NIN = 2944;
constexpr int RSTR = 4112;
constexpr int NTHR = 256;
constexpr int LDS_BYTES = 73728;
constexpr float EPSF = 1e-6f;

constexpr size_t SZ_PHY = (size_t)ROWS * 768 * 2, SZ_PZ = (size_t)ROWS * 512 * 2, SZ_PXBC = (size_t)ROWS * 1024 * 2;
constexpr size_t OFF_PHY = 0;
constexpr size_t OFF_PZ = OFF_PHY + SZ_PHY;
constexpr size_t OFF_PXBC = OFF_PZ + SZ_PZ;
constexpr size_t OFF_Q = OFF_PHY;
constexpr size_t OFF_ACT = OFF_PXBC + SZ_PXBC;
constexpr size_t OFF_XBCA = OFF_ACT + (size_t)ROWS * 1024 * 2;
constexpr size_t OFF_DREG = OFF_XBCA + (size_t)ROWS * 1024 * 2;
constexpr size_t OFF_PQT = OFF_DREG;
constexpr size_t OFF_UT = OFF_PQT + (size_t)NB * 512 * TPB * 2;
constexpr size_t OFF_X1C = OFF_UT + (size_t)256 * 16 * TPB * 2;
constexpr size_t OFF_TV = OFF_DREG;
constexpr size_t OFF_TI = OFF_TV + (size_t)ROWS * 256 * 4;
constexpr size_t OFF_XC = OFF_DREG + (size_t)ROWS * 256 * 8;
constexpr size_t OFF_WIN = OFF_XC + (size_t)NB * CTXL * D * 4;
constexpr size_t OFF_WOUT = OFF_WIN + (size_t)2 * NIN * 1024 * 2;
constexpr size_t OFF_WQ = OFF_WOUT + (size_t)2 * 1024 * 1024 * 2;
constexpr size_t OFF_K12 = OFF_WQ + (size_t)2 * 2048 * 1024 * 2;
constexpr size_t OFF_DFT = OFF_K12 + (size_t)2 * 2 * 128 * 128 * 2;
constexpr size_t OFF_DFTC = OFF_DFT + (size_t)2048 * 4096 * 2;
constexpr size_t OFF_RF = OFF_DFTC + (size_t)256 * 512 * 2;
constexpr size_t OFF_PART = OFF_RF + (size_t)3 * 256 * 2 * RSTR * 2;
constexpr size_t OFF_MOD = OFF_PART + (size_t)3 * 32 * 256 * 4;
constexpr size_t OFF_DT = OFF_MOD + (size_t)2 * 17 * 6144 * 4;
constexpr size_t OFF_CTR = OFF_DT + (size_t)ROWS * 16 * 4;
constexpr size_t OFF_BAR = OFF_CTR + 256;
constexpr size_t OFF_TX = OFF_BAR + 3456 * 4;
constexpr size_t WS_END = OFF_TX + (size_t)NB * 768 * TPB * 2;

struct Params {
  const float* in[31];
  float* out;
  unsigned char* ws;
  int pad0, pad1;
};

enum { I_X = 0, I_C, I_CTX, I_CCTX, I_WADA, I_BADA, I_G1, I_G2, I_WIN, I_HYCW, I_HYCB, I_HFW1, I_HFB1, I_HFW2, I_HFB2,
       I_HFW3, I_HFFREQ, I_HYBIAS, I_SCW, I_SCB, I_SDTB, I_SALOG, I_SD, I_SNG, I_WOUT, I_WQ, I_K1, I_K2, I_PU, I_PV, I_GF };

__device__ const unsigned char CAND_A[56] = {0, 0, 0, 0, 0, 0, 0, 0, 0, 0, 0, 0, 0, 0, 0, 0, 1, 1, 1, 1, 1, 1, 1, 1, 2, 2, 2, 2, 2, 3, 3, 3, 3, 4, 4, 4, 5, 5, 6, 6, 7, 7, 8, 9, 10, 11, 12, 13, 14, 15, 0, 0, 0, 0, 0, 0};
__device__ const unsigned char CAND_B[56] = {0, 1, 2, 3, 4, 5, 6, 7, 8, 9, 10, 11, 12, 13, 14, 15, 0, 1, 2, 3, 4, 5, 6, 7, 0, 1, 2, 3, 4, 0, 1, 2, 3, 0, 1, 2, 0, 1, 0, 1, 0, 1, 0, 0, 0, 0, 0, 0, 0, 0, 0, 0, 0, 0, 0, 0};

#define WSP(T, off) ((T*)(p.ws + (off)))

#define XB_TMO      128
#define XB_XCNT(j)  (256  + 64 * (j))
#define XB_XSUB(j)  (1280 + 64 * (j))
#define XB_XGEN(j)  (2304 + 64 * (j))
#define XB_TOP      3328
#define XB_TOPGEN   3392
#define XCD_BAR_WORDS 3456
#define XB_SPIN_CAP (1u << 18)
#define LAS __attribute__((address_space(3)))
DI unsigned xb_ld(unsigned* p) { return __hip_atomic_load(p, __ATOMIC_RELAXED, __HIP_MEMORY_SCOPE_AGENT); }
DI unsigned xb_add(unsigned* p, unsigned v) { return __hip_atomic_fetch_add(p, v, __ATOMIC_RELAXED, __HIP_MEMORY_SCOPE_AGENT); }
DI unsigned xb_xcc_id() { return (unsigned)__builtin_amdgcn_s_getreg((3 << 11) | 20) & 0xFu; }
#define XB_SPIN(cond, bar) do { unsigned _sp = 0; while (cond) { __builtin_amdgcn_s_sleep(1); \
    if ((++_sp & 255u) == 0u) { if (xb_ld(&(bar)[XB_TMO])) break; if (_sp > XB_SPIN_CAP) { atomicAdd(&(bar)[XB_TMO], 1u); break; } } } } while (0)
struct XcdBarrier { unsigned* bar; unsigned x; volatile LAS unsigned* st; };
DI XcdBarrier xcd_barrier_post(unsigned* bar, volatile LAS unsigned* st) {
  XcdBarrier b; b.bar = bar; b.x = xb_xcc_id(); b.st = st;
  if (threadIdx.x == 0) (void)xb_add(&bar[XB_XCNT(b.x)], 1u);
  return b;
}
DI void xcd_barrier_complete(unsigned* bar, unsigned x, unsigned& nloc, unsigned& nx) {
  const unsigned G = gridDim.x * gridDim.y * gridDim.z;
  unsigned sum, cnt, mine, sp = 0u;
  for (;;) {
    sum = 0u; cnt = 0u; mine = 0u;
#pragma unroll
    for (unsigned j = 0; j < 16; ++j) { const unsigned c = xb_ld(&bar[XB_XCNT(j)]); sum += c; cnt += (c > 0u) ? 1u : 0u; mine = (j == x) ? c : mine; }
    if (sum == G) break;
    __builtin_amdgcn_s_sleep(1);
    if ((++sp & 255u) == 0u) { if (xb_ld(&bar[XB_TMO])) break; if (sp > XB_SPIN_CAP) { atomicAdd(&bar[XB_TMO], 1u); break; } }
  }
  nloc = mine > 0u ? mine : 1u; nx = cnt > 0u ? cnt : 1u;
}
DI void xcd_barrier(const XcdBarrier& b) {
  asm volatile("s_waitcnt vmcnt(0)" ::: "memory");
  __syncthreads();
  if (threadIdx.x == 0) {
    unsigned* bar = b.bar;
    __builtin_amdgcn_s_waitcnt(0);
    unsigned nloc = b.st[0], nx = b.st[1];
    if (nloc == 0u) { xcd_barrier_complete(bar, b.x, nloc, nx); b.st[0] = nloc; b.st[1] = nx; }
    const unsigned old = xb_add(&bar[XB_XSUB(b.x)], 1u);
    const unsigned gen = old / nloc;
    if (old + 1u == (gen + 1u) * nloc) {
      __builtin_amdgcn_fence(__ATOMIC_RELEASE, "agent");
      asm volatile("s_waitcnt vmcnt(0)" ::: "memory");
      const unsigned og = xb_add(&bar[XB_TOP], 1u);
      const unsigned tg = og / nx;
      if (og + 1u == (tg + 1u) * nx) xb_add(&bar[XB_TOPGEN], 1u);
      else XB_SPIN(xb_ld(&bar[XB_TOPGEN]) == tg, bar);
      __builtin_amdgcn_fence(__ATOMIC_ACQUIRE, "agent");
      xb_add(&bar[XB_XGEN(b.x)], 1u);
      asm volatile("s_waitcnt vmcnt(0)" ::: "memory");
    } else {
      XB_SPIN(xb_ld(&bar[XB_XGEN(b.x)]) == gen, bar);
      __builtin_amdgcn_fence(__ATOMIC_ACQUIRE, "agent");
      asm volatile("s_waitcnt vmcnt(0)" ::: "memory");
    }
  }
  __syncthreads();
}


template <bool SWAP, class AF, class BF, class EF>
DI void gemm_tile(const AF& af, const BF& bfn, const EF& ef, int m0, int n0, int K, char* smem) {
  u16* As = (u16*)smem;
  u16* Bs = As + 2 * 128 * 40;
  const int tid = TID(), lane = tid & 63, w = tid >> 6;
  const int wm = w >> 1, wn = w & 1, l32 = lane & 31, h = lane >> 5;
  const int lrow = (tid >> 6) * 16 + ((tid >> 5) & 1) * 8 + ((tid >> 2) & 1) * 4 + ((tid >> 3) & 3), lk = (tid & 3) * 8;
  f32x16 acc[2][2];
#pragma unroll
  for (int i = 0; i < 2; ++i)
#pragma unroll
    for (int j = 0; j < 2; ++j)
#pragma unroll
      for (int r = 0; r < 16; ++r) acc[i][j][r] = 0.f;
  u32x4 ra0, ra1, rb0, rb1;
  const int nk = K >> 5;
  ra0 = *(const u32x4*)af(m0 + lrow, lk);
  ra1 = *(const u32x4*)af(m0 + lrow + 64, lk);
  rb0 = *(const u32x4*)bfn(n0 + lrow, lk);
  rb1 = *(const u32x4*)bfn(n0 + lrow + 64, lk);
  *(u32x4*)&As[(lrow) * 40 + lk] = ra0;
  *(u32x4*)&As[(lrow + 64) * 40 + lk] = ra1;
  *(u32x4*)&Bs[(lrow) * 40 + lk] = rb0;
  *(u32x4*)&Bs[(lrow + 64) * 40 + lk] = rb1;
  {
    const int k1 = (nk > 1) ? 32 + lk : lk;
    ra0 = *(const u32x4*)af(m0 + lrow, k1);
    ra1 = *(const u32x4*)af(m0 + lrow + 64, k1);
    rb0 = *(const u32x4*)bfn(n0 + lrow, k1);
    rb1 = *(const u32x4*)bfn(n0 + lrow + 64, k1);
  }
  __syncthreads();
  for (int kt = 0; kt < nk; ++kt) {
    const int cur = kt & 1;
    const u16* Ab = As + cur * 128 * 40;
    const u16* Bb = Bs + cur * 128 * 40;
#pragma unroll
    for (int ks = 0; ks < 2; ++ks) {
      bf16x8 a[2], b[2];
#pragma unroll
      for (int i = 0; i < 2; ++i) {
        a[i] = *(const bf16x8*)&Ab[(wm * 64 + i * 32 + l32) * 40 + ks * 16 + h * 8];
        b[i] = *(const bf16x8*)&Bb[(wn * 64 + i * 32 + l32) * 40 + ks * 16 + h * 8];
      }
#pragma unroll
      for (int i = 0; i < 2; ++i)
#pragma unroll
        for (int j = 0; j < 2; ++j)
          acc[i][j] = SWAP ? __builtin_amdgcn_mfma_f32_32x32x16_bf16(b[j], a[i], acc[i][j], 0, 0, 0)
                           : __builtin_amdgcn_mfma_f32_32x32x16_bf16(a[i], b[j], acc[i][j], 0, 0, 0);
    }
    {
      u16* An = As + (cur ^ 1) * 128 * 40;
      u16* Bn = Bs + (cur ^ 1) * 128 * 40;
      *(u32x4*)&An[(lrow) * 40 + lk] = ra0;
      *(u32x4*)&An[(lrow + 64) * 40 + lk] = ra1;
      *(u32x4*)&Bn[(lrow) * 40 + lk] = rb0;
      *(u32x4*)&Bn[(lrow + 64) * 40 + lk] = rb1;
      const int kn = (kt + 2 < nk) ? kt + 2 : nk - 1;
      const int k0 = kn * 32 + lk;
      ra0 = *(const u32x4*)af(m0 + lrow, k0);
      ra1 = *(const u32x4*)af(m0 + lrow + 64, k0);
      rb0 = *(const u32x4*)bfn(n0 + lrow, k0);
      rb1 = *(const u32x4*)bfn(n0 + lrow + 64, k0);
    }
    __syncthreads();
  }
#pragma unroll
  for (int i = 0; i < 2; ++i)
#pragma unroll
    for (int j = 0; j < 2; ++j)
#pragma unroll
      for (int rg = 0; rg < 4; ++rg) {
        const int m = SWAP ? (m0 + wm * 64 + i * 32 + l32) : (m0 + wm * 64 + i * 32 + rg * 8 + h * 4);
        const int n = SWAP ? (n0 + wn * 64 + j * 32 + rg * 8 + h * 4) : (n0 + wn * 64 + j * 32 + l32);
        ef(m, n, acc[i][j][rg * 4 + 0], acc[i][j][rg * 4 + 1], acc[i][j][rg * 4 + 2], acc[i][j][rg * 4 + 3]);
      }
}

DI float wave_sum(float v) {
#pragma unroll
  for (int o = 32; o >= 1; o >>= 1) v += __shfl_xor(v, o);
  return v;
}
DI float silu_f(float x) { return x / (1.f + __expf(-x)); }
DI float gelu_tanh(float x) {
  const float u = 0.7978845608028654f * (x + 0.044715f * x * x * x);
  return 0.5f * x * (1.f + tanhf(u));
}

DI const float* xrow_ptr(const Params& p, bool from_input, int b, int pos) {
  if (pos < CTXL) return (from_input ? p.in[I_CTX] : WSP(const float, OFF_XC)) + ((size_t)b * CTXL + pos) * D;
  return (from_input ? p.in[I_X] : (const float*)p.out) + ((size_t)b * SEQ + (pos - CTXL)) * D;
}
DI float* xrow_wptr(const Params& p, int b, int pos) {
  if (pos < CTXL) return WSP(float, OFF_XC) + ((size_t)b * CTXL + pos) * D;
  return p.out + ((size_t)b * SEQ + (pos - CTXL)) * D;
}

DI void phase_prologue(const Params& p, int bid, int nblk, char* smem) {
  const int tid = TID();
  const int gtid = bid * NTHR + tid, gn = nblk * NTHR;
  {
    float* scs = (float*)smem;
    for (int it = bid; it < 192; it += nblk) {
      const int l = it / 96, col0 = (it % 96) * 64;
      for (int e = tid; e < 17 * 1024; e += NTHR) {
        const int j = e >> 10, k = e & 1023;
        const float v = (j < 16) ? p.in[I_C][j * 1024 + k] : p.in[I_CCTX][k];
        scs[e] = v / (1.f + expf(-v));
      }
      __syncthreads();
      const int col = tid & 63, kq = tid >> 6;
      float acc[17];
#pragma unroll
      for (int j = 0; j < 17; ++j) acc[j] = 0.f;
      const float* wa = p.in[I_WADA] + (size_t)l * 1024 * 6144 + col0 + col;
      for (int k0 = kq * 256; k0 < kq * 256 + 256; k0 += 8) {
        float wv[8];
#pragma unroll
        for (int kk = 0; kk < 8; ++kk) wv[kk] = wa[(size_t)(k0 + kk) * 6144];
#pragma unroll
        for (int kk = 0; kk < 8; ++kk)
#pragma unroll
          for (int j = 0; j < 17; ++j) acc[j] += scs[j * 1024 + k0 + kk] * wv[kk];
      }
      __syncthreads();
#pragma unroll
      for (int j = 0; j < 17; ++j) scs[(kq * 17 + j) * 64 + col] = acc[j];
      __syncthreads();
      for (int e = tid; e < 17 * 64; e += NTHR) {
        const int j = e >> 6, cc = e & 63;
        float s = p.in[I_BADA][l * 6144 + col0 + cc];
#pragma unroll
        for (int q = 0; q < 4; ++q) s += scs[(q * 17 + j) * 64 + cc];
        WSP(float, OFF_MOD)[(size_t)(l * 17 + j) * 6144 + col0 + cc] = s;
      }
      __syncthreads();
    }
  }
  {
    float* zs = (float*)smem;
    float* h1s = zs + 64 * 33;
    float* h2s = h1s + 64 * 64;
    for (int it = (nblk >= 260 ? (bid >= 192 ? bid - 192 : 1 << 20) : bid); it < 68; it += nblk) {
      const int f = it < 32 ? 0 : (it < 64 ? 1 : 2);
      const int tile = it - (f == 0 ? 0 : (f == 1 ? 32 : 64));
      const int L = (f == 2) ? 256 : 2048;
      const int lyr = (f == 1) ? 1 : 0;
      const int pos0 = tile * 64;
      const float* w1 = p.in[I_HFW1] + lyr * 33 * 64;
      const float* b1 = p.in[I_HFB1] + lyr * 64;
      const float* w2 = p.in[I_HFW2] + lyr * 64 * 64;
      const float* b2 = p.in[I_HFB2] + lyr * 64;
      const float* w3 = p.in[I_HFW3] + lyr * 64 * 512;
      const float* fq = p.in[I_HFFREQ] + lyr * 64;
      for (int e = tid; e < 64 * 33; e += NTHR) {
        const int pi = e / 33, q = e % 33;
        const int pos = pos0 + pi;
        const float tt = (float)pos / (float)(L - 1);
        const float wv = 6.283185307179586f * (float)pos / (float)L;
        float z;
        if (q == 0) z = tt;
        else if (q <= 16) { const float fi = 1e-4f + (float)(q - 1) * ((15.f - 1e-4f) / 15.f); z = cosf(fi * wv); }
        else { const float fi = 1e-4f + (float)(q - 17) * ((15.f - 1e-4f) / 15.f); z = -sinf(fi * wv); }
        zs[e] = z;
      }
      __syncthreads();
      for (int e = tid; e < 64 * 64; e += NTHR) {
        const int pi = e >> 6, j = e & 63;
        float s = b1[j];
        for (int q = 0; q < 33; ++q) s += zs[pi * 33 + q] * w1[q * 64 + j];
        h1s[e] = sinf(fq[j] * s);
      }
      __syncthreads();
      for (int e = tid; e < 64 * 64; e += NTHR) {
        const int pi = e >> 6, j = e & 63;
        float s = b2[j];
        for (int k = 0; k < 64; ++k) s += h1s[pi * 64 + k] * w2[k * 64 + j];
        h2s[e] = sinf(fq[j] * s);
      }
      __syncthreads();
      {
        const int c = tid;
        const float mind = logf(1e-2f) / 1.5f, maxd = logf(1e-2f) / 0.3f;
        const float delta = fabsf(mind + (float)c * ((maxd - mind) / 255.f));
        u16* R0 = WSP(u16, OFF_RF) + ((size_t)(f * 256 + c) * 2 + 0) * RSTR;
        u16* R1 = R0 + RSTR;
        float ssq = 0.f;
        for (int pb = 0; pb < 4; ++pb) {
          float af_[16], ab_[16];
#pragma unroll
          for (int i = 0; i < 16; ++i) { af_[i] = 0.f; ab_[i] = 0.f; }
          for (int k = 0; k < 64; ++k) {
            const float wf = w3[k * 512 + c], wb = w3[k * 512 + 256 + c];
#pragma unroll
            for (int i = 0; i < 16; ++i) {
              const float hv = h2s[(pb * 16 + i) * 64 + k];
              af_[i] += hv * wf;
              ab_[i] += hv * wb;
            }
          }
#pragma unroll
          for (int i = 0; i < 16; ++i) {
            const int pos = pos0 + pb * 16 + i;
            const float tt = (float)pos / (float)(L - 1);
            const float win = expf(-tt * delta);
            const float vf = af_[i] * win, vb = ab_[i] * win;
            const u16 bfv = f2bf(vf), bbv = f2bf(vb);
            R0[L - pos] = bfv;
            R1[L - pos - 1] = bfv;
            ssq += vf * vf;
            if (pos >= 1) {
              R0[L + pos] = bbv;
              R1[L + pos - 1] = bbv;
              ssq += vb * vb;
            }
          }
        }
        WSP(float, OFF_PART)[(size_t)(f * 32 + tile) * 256 + c] = ssq;
      }
      __syncthreads();
    }
  }
  for (int e = gtid; e < 2 * NIN * 128; e += gn) {
    const int l = e / (NIN * 128);
    const int r = e % (NIN * 128);
    const int kc = r / NIN, n = r % NIN;
    const int k0 = kc * 8;
    const float* wsrc = p.in[I_WIN] + (size_t)l * 1024 * 2576;
    float v[8];
    if (n < 2304) {
#pragma unroll
      for (int j = 0; j < 8; ++j) v[j] = wsrc[(size_t)(k0 + j) * 2576 + n];
    } else if (n < 2816) {
      const int np = n - 2304, g = np >> 7, rr = np & 127, pq = rr >> 6, kk = rr & 63;
#pragma unroll
      for (int j = 0; j < 8; ++j) v[j] = 0.f;
      for (int jj = 0; jj < 64; ++jj) {
        const float ang = 6.283185307179586f * (float)((jj * kk) & 63) / 64.f;
        const float tr = pq ? sinf(ang) : cosf(ang);
#pragma unroll
        for (int j = 0; j < 8; ++j) v[j] += wsrc[(size_t)(k0 + j) * 2576 + 2320 + g * 64 + jj] * tr;
      }
    } else if (n < 2832) {
#pragma unroll
      for (int j = 0; j < 8; ++j) v[j] = wsrc[(size_t)(k0 + j) * 2576 + 2304 + (n - 2816)];
    } else {
#pragma unroll
      for (int j = 0; j < 8; ++j) v[j] = 0.f;
    }
    uint4 o = {pack2(v[0], v[1]), pack2(v[2], v[3]), pack2(v[4], v[5]), pack2(v[6], v[7])};
    *(uint4*)&WSP(u16, OFF_WIN)[((size_t)l * NIN + n) * 1024 + k0] = o;
  }
  for (int e = gtid; e < 2 * 1024 * 128; e += gn) {
    const int l = e / (1024 * 128), r = e % (1024 * 128), kc = r / 1024, n = r % 1024, k0 = kc * 8;
    const float* wsrc = p.in[I_WOUT] + (size_t)l * 1024 * 1024;
    float v[8];
#pragma unroll
    for (int j = 0; j < 8; ++j) v[j] = wsrc[(size_t)(k0 + j) * 1024 + n];
    uint4 o = {pack2(v[0], v[1]), pack2(v[2], v[3]), pack2(v[4], v[5]), pack2(v[6], v[7])};
    *(uint4*)&WSP(u16, OFF_WOUT)[((size_t)l * 1024 + n) * 1024 + k0] = o;
  }
  for (int e = gtid; e < 2 * 2048 * 128; e += gn) {
    const int l = e / (2048 * 128), r = e % (2048 * 128), kc = r / 2048, n = r % 2048, k0 = kc * 8;
    const float* wsrc = p.in[I_WQ] + (size_t)l * 1024 * 2048;
    float v[8];
#pragma unroll
    for (int j = 0; j < 8; ++j) v[j] = wsrc[(size_t)(k0 + j) * 2048 + n];
    uint4 o = {pack2(v[0], v[1]), pack2(v[2], v[3]), pack2(v[4], v[5]), pack2(v[6], v[7])};
    *(uint4*)&WSP(u16, OFF_WQ)[((size_t)l * 2048 + n) * 1024 + k0] = o;
  }
  for (int e = gtid; e < 2 * 2 * 128 * 128; e += gn) {
    const int l = e / (2 * 16384), r = e % (2 * 16384), which = r / 16384, i = r % 16384;
    const float v = (which ? p.in[I_K2] : p.in[I_K1])[l * 16384 + i];
    WSP(u16, OFF_K12)[e] = f2bf(v);
  }
  for (int e = gtid; e < 2048 * 512; e += gn) {
    const int tp = e >> 9, k0 = (e & 511) * 8;
    const float s = 1.f / sqrtf(2048.f * 64.f);
    float v[8];
#pragma unroll
    for (int j = 0; j < 8; ++j) {
      const int k = k0 + j, t = k & 2047;
      const float ang = 6.283185307179586f * (float)((tp * t) & 2047) / 2048.f;
      v[j] = (k < 2048) ? cosf(ang) * s : -sinf(ang) * s;
    }
    uint4 o = {pack2(v[0], v[1]), pack2(v[2], v[3]), pack2(v[4], v[5]), pack2(v[6], v[7])};
    *(uint4*)&WSP(u16, OFF_DFT)[(size_t)tp * 4096 + k0] = o;
  }
  for (int e = gtid; e < 256 * 64; e += gn) {
    const int tp = e >> 6, k0 = (e & 63) * 8;
    const float s = 1.f / sqrtf(256.f * 64.f);
    float v[8];
#pragma unroll
    for (int j = 0; j < 8; ++j) {
      const int k = k0 + j, t = k & 255;
      const float ang = 6.283185307179586f * (float)((tp * t) & 255) / 256.f;
      v[j] = (k < 256) ? cosf(ang) * s : -sinf(ang) * s;
    }
    uint4 o = {pack2(v[0], v[1]), pack2(v[2], v[3]), pack2(v[4], v[5]), pack2(v[6], v[7])};
    *(uint4*)&WSP(u16, OFF_DFTC)[(size_t)tp * 512 + k0] = o;
  }
}

DI void phase_norm(const Params& p, int l, int which, int bid, int nblk) {
  const int lane = TID() & 63, w = TID() >> 6;
  const float* g = (which ? p.in[I_G2] : p.in[I_G1]) + l * 1024;
  const bool from_input = (which == 0 && l == 0);
  for (int row = bid * 4 + w; row < ROWS; row += nblk * 4) {
    const int b = row / TPB, pos = row % TPB;
    if (which == 1 && l == 1 && pos < CTXL) continue;
    const float* xr = xrow_ptr(p, from_input, b, pos);
    const float* mod = WSP(const float, OFF_MOD) + (size_t)(l * 17 + (pos < CTXL ? 16 : b)) * 6144 + which * 3072;
    float x[16];
#pragma unroll
    for (int hh = 0; hh < 2; ++hh) {
      const float4 a = *(const float4*)(xr + hh * 512 + lane * 8);
      const float4 c = *(const float4*)(xr + hh * 512 + lane * 8 + 4);
      x[hh * 8 + 0] = a.x; x[hh * 8 + 1] = a.y; x[hh * 8 + 2] = a.z; x[hh * 8 + 3] = a.w;
      x[hh * 8 + 4] = c.x; x[hh * 8 + 5] = c.y; x[hh * 8 + 6] = c.z; x[hh * 8 + 7] = c.w;
    }
    float ss = 0.f;
#pragma unroll
    for (int i = 0; i < 16; ++i) ss += x[i] * x[i];
    ss = wave_sum(ss);
    const float rs = rsqrtf(ss * (1.f / 1024.f) + EPSF);
#pragma unroll
    for (int hh = 0; hh < 2; ++hh) {
      const int c0 = hh * 512 + lane * 8;
      float y[8];
#pragma unroll
      for (int i = 0; i < 8; ++i) {
        const float yn = x[hh * 8 + i] * rs * g[c0 + i];
        y[i] = yn * (1.f + mod[1024 + c0 + i]) + mod[c0 + i];
      }
      uint4 o = {pack2(y[0], y[1]), pack2(y[2], y[3]), pack2(y[4], y[5]), pack2(y[6], y[7])};
      *(uint4*)&WSP(u16, OFF_ACT)[(size_t)row * 1024 + c0] = o;
    }
  }
}

constexpr float U_SCALE = 64.f, V_SCALE = 4.f;
DI void phase_tables(const Params& p, int l, int bid, int nblk) {
  const int gtid = bid * NTHR + TID(), gn = nblk * NTHR;
  unsigned char* dst = WSP(unsigned char, OFF_XBCA);
  for (int e = gtid; e < 2 * 16384 * 64; e += gn) {
    const int which = e / (16384 * 64), r = e % (16384 * 64);
    const float sc = which ? V_SCALE : U_SCALE;
    const float* src = (which ? p.in[I_PV] : p.in[I_PU]) + (size_t)l * 16384 * 1024 + (size_t)r * 16;
    u32 o[4];
#pragma unroll
    for (int q = 0; q < 4; ++q) {
      const float4 a = *(const float4*)(src + q * 4);
      int v = __builtin_amdgcn_cvt_pk_fp8_f32(a.x * sc, a.y * sc, 0, false);
      v = __builtin_amdgcn_cvt_pk_fp8_f32(a.z * sc, a.w * sc, v, true);
      o[q] = (u32)v;
    }
    uint4 ov = {o[0], o[1], o[2], o[3]};
    *(uint4*)&dst[(size_t)e * 16] = ov;
  }
}

DI void phase_inproj(const Params& p, int l, int bid, int nblk, char* smem) {
  const u16* A = WSP(const u16, OFF_ACT);
  const u16* B = WSP(const u16, OFF_WIN) + (size_t)l * NIN * 1024;
  u16* PHY = WSP(u16, OFF_PHY);
  u16* PZ = WSP(u16, OFF_PZ);
  u16* PXBC = WSP(u16, OFF_PXBC);
  u16* PQT = WSP(u16, OFF_PQT);
  float* DT = WSP(float, OFF_DT);
  auto af = [=](int m, int k) { return A + (size_t)m * 1024 + k; };
  auto bfn = [=](int n, int k) { return B + (size_t)n * 1024 + k; };
  auto efT = [=](int m, int n, float v0, float v1, float v2, float v3) {
    const uint2 o = {pack2(v0, v1), pack2(v2, v3)};
    if (n < 768) *(uint2*)&PHY[(size_t)m * 768 + n] = o;
    else if (n < 1280) *(uint2*)&PZ[(size_t)m * 512 + (n - 768)] = o;
    else if (n < 2304) *(uint2*)&PXBC[(size_t)m * 1024 + (n - 1280)] = o;
    else if (n >= 2816 && n < 2832) { float4 f = {v0, v1, v2, v3}; *(float4*)&DT[(size_t)m * 16 + (n - 2816)] = f; }
  };
  auto efN = [=](int m, int n, float v0, float v1, float v2, float v3) {
    const int b = m / TPB, pos = m % TPB, np = n - 2304;
    uint2 o = {pack2(v0, v1), pack2(v2, v3)};
    *(uint2*)&PQT[((size_t)(b * 512 + np)) * TPB + pos] = o;
  };
  const int ntile = (ROWS / 128) * (NIN / 128);
  const int vb = (nblk % 8 == 0) ? (bid & 7) * (nblk >> 3) + (bid >> 3) : bid;
  for (int t = vb; t < ntile; t += nblk) {
    const int mt = t / (NIN / 128), nt = t % (NIN / 128);
    if (nt >= 18 && nt < 22) gemm_tile<false>(af, bfn, efN, mt * 128, nt * 128, 1024, smem);
    else gemm_tile<true>(af, bfn, efT, mt * 128, nt * 128, 1024, smem);
  }
}

DI void unpack8(const uint4& v, float* f) {
  f[0] = bflo(v.x); f[1] = bfhi(v.x); f[2] = bflo(v.y); f[3] = bfhi(v.y);
  f[4] = bflo(v.z); f[5] = bfhi(v.z); f[6] = bflo(v.w); f[7] = bfhi(v.w);
}
DI void phase_prep(const Params& p, int l, int bid, int nblk, char* smem) {
  const int tid = TID();
  u16* tile = (u16*)smem;
  const u16* PHY = WSP(const u16, OFF_PHY);
  const u16* PXBC = WSP(const u16, OFF_PXBC);
  u16* UT = WSP(u16, OFF_UT);
  u16* X1C = WSP(u16, OFF_X1C);
  u16* XBCA = WSP(u16, OFF_XBCA);
  u16* TX = WSP(u16, OFF_TX);
  const float* hw = p.in[I_HYCW] + l * 3 * 768;
  const float* hb = p.in[I_HYCB] + l * 768;
  const float* sw = p.in[I_SCW] + l * 3 * 1024;
  const float* sb = p.in[I_SCB] + l * 1024;
  const int cg8 = (tid & 31) * 8, pg = tid >> 5;
  for (int it = bid; it < NB * 36 * 6; it += nblk) {
    const int pass = it % 6, bt = it / 6;
    const int b = bt / 36, pt = bt % 36, pos0 = pt * 64;
    const int seg_lo = (pos0 < CTXL) ? 0 : CTXL, seg_hi = (pos0 < CTXL) ? CTXL : TPB;
    const size_t rbase = (size_t)b * TPB;
    const int pfirst = pos0 + pg * 8;
    bool transposed = false;
    if (pass <= 1) {
      if (l == 1 && pos0 < CTXL) continue;
      float cv0[8][8];
#pragma unroll
      for (int sg = 0; sg < 2; ++sg) {
        if (pass == 0 && sg == 1) break;
        const int sgrp = (pass == 0) ? 1 : (sg == 0 ? 0 : 2);
        const int col = sgrp * 256 + cg8;
        float w0[8], w1[8], w2[8], bb[8];
#pragma unroll
        for (int e = 0; e < 8; ++e) { w0[e] = hw[col + e]; w1[e] = hw[768 + col + e]; w2[e] = hw[1536 + col + e]; bb[e] = hb[col + e]; }
        uint4 raw[10];
#pragma unroll
        for (int k = 0; k < 10; ++k) {
          const int pn = pfirst + k - 1;
          raw[k] = (pn >= seg_lo && pn < seg_hi) ? *(const uint4*)&PHY[(rbase + pn) * 768 + col] : make_uint4(0u, 0u, 0u, 0u);
        }
        float xm[8], x0[8], xp[8];
        unpack8(raw[0], xm);
        unpack8(raw[1], x0);
#pragma unroll
        for (int k = 0; k < 8; ++k) {
          unpack8(raw[k + 2], xp);
          float o[8];
#pragma unroll
          for (int e = 0; e < 8; ++e) {
            o[e] = w0[e] * xm[e] + w1[e] * x0[e] + w2[e] * xp[e] + bb[e];
            xm[e] = x0[e]; x0[e] = xp[e];
          }
          if (pass == 0) {
            uint4 o1 = {pack2(o[0], o[1]), pack2(o[2], o[3]), pack2(o[4], o[5]), pack2(o[6], o[7])};
            *(uint4*)&X1C[(rbase + pfirst + k) * 256 + cg8] = o1;
          } else if (sg == 0) {
#pragma unroll
            for (int e = 0; e < 8; ++e) cv0[k][e] = o[e];
          } else {
            uint4 ou = {pack2(o[0] * cv0[k][0], o[1] * cv0[k][1]), pack2(o[2] * cv0[k][2], o[3] * cv0[k][3]),
                        pack2(o[4] * cv0[k][4], o[5] * cv0[k][5]), pack2(o[6] * cv0[k][6], o[7] * cv0[k][7])};
            *(uint4*)&tile[(pg * 8 + k) * 264 + cg8] = ou;
          }
        }
      }
      transposed = (pass == 1);
    } else {
      const int col = (pass - 2) * 256 + cg8;
      float w0[8], w1[8], w2[8], bb[8];
#pragma unroll
      for (int e = 0; e < 8; ++e) { w0[e] = sw[col + e]; w1[e] = sw[1024 + col + e]; w2[e] = sw[2048 + col + e]; bb[e] = sb[col + e]; }
      uint4 raw[10];
#pragma unroll
      for (int k = 0; k < 10; ++k) {
        const int pn = pfirst + k - 1;
        raw[k] = (pn >= seg_lo && pn < seg_hi) ? *(const uint4*)&PXBC[(rbase + pn) * 1024 + col] : make_uint4(0u, 0u, 0u, 0u);
      }
      float xm[8], x0[8], xp[8];
      unpack8(raw[0], xm);
      unpack8(raw[1], x0);
#pragma unroll
      for (int k = 0; k < 8; ++k) {
        unpack8(raw[k + 2], xp);
        float o[8];
#pragma unroll
        for (int e = 0; e < 8; ++e) {
          o[e] = silu_f(w0[e] * xm[e] + w1[e] * x0[e] + w2[e] * xp[e] + bb[e]);
          xm[e] = x0[e]; x0[e] = xp[e];
        }
        uint4 ov = {pack2(o[0], o[1]), pack2(o[2], o[3]), pack2(o[4], o[5]), pack2(o[6], o[7])};
        *(uint4*)&XBCA[(rbase + pfirst + k) * 1024 + col] = ov;
        if (pass < 5) *(uint4*)&tile[(pg * 8 + k) * 264 + cg8] = ov;
      }
      transposed = pass < 5;
    }
    if (transposed) {
      __syncthreads();
      u16* dst = (pass == 1) ? (UT + ((size_t)(tid * 16 + b)) * TPB + pos0) : (TX + ((size_t)(b * 768 + (pass - 2) * 256 + tid)) * TPB + pos0);
#pragma unroll
      for (int pc = 0; pc < 8; ++pc) {
        u32 wv[4];
#pragma unroll
        for (int e = 0; e < 4; ++e)
          wv[e] = (u32)tile[(pc * 8 + 2 * e) * 264 + tid] | ((u32)tile[(pc * 8 + 2 * e + 1) * 264 + tid] << 16);
        uint4 o = {wv[0], wv[1], wv[2], wv[3]};
        *(uint4*)&dst[pc * 8] = o;
      }
      __syncthreads();
    }
  }
}

DI void ssd_item(const Params& p, int l, int it, char* smem) {
  const int tid = TID(), lane = tid & 63, w = tid >> 6, l32 = lane & 31, h = lane >> 5;
  const int b = it >> 4, hd = (it >> 1) & 7, dir = it & 1, g = hd >> 2;
  u16* BG = (u16*)smem;
  u16* HL = BG + 128 * 136;
  float* fa = (float*)(HL + 64 * 136);
  float* fdt = fa + 128;
  float* fsw = fdt + 128;
  float* fea = fsw + 128;
  float* ftot = fea + 128;
  const u16* XBCA = WSP(const u16, OFF_XBCA);
  const u16* TX = WSP(const u16, OFF_TX);
  const float* DT = WSP(const float, OFF_DT);
  u16* Y = WSP(u16, OFF_PXBC) + (dir ? (size_t)ROWS * 512 : 0);
  const float dtb = p.in[I_SDTB][l * 16 + dir * 8 + hd];
  const float a = -expf(p.in[I_SALOG][l * 16 + dir * 8 + hd]);
  const size_t rbase = (size_t)b * TPB;
  f32x16 Hacc[2];
#pragma unroll
  for (int i = 0; i < 2; ++i)
#pragma unroll
    for (int r = 0; r < 16; ++r) Hacc[i][r] = 0.f;
  for (int e = tid; e < 64 * 136; e += NTHR) HL[e] = 0;
  for (int ci = 0; ci < 18; ++ci) {
    const int pos0 = dir ? ((ci < 2) ? (1 - ci) * 128 : (CTXL + (17 - ci) * 128)) : ci * 128;
#pragma unroll
    for (int i = 0; i < 8; ++i) {
      const int q = tid + 256 * i, j = q >> 4, ch = q & 15;
      *(uint4*)&BG[j * 136 + ch * 8] = *(const uint4*)&XBCA[(rbase + pos0 + j) * 1024 + 512 + g * 128 + ch * 8];
    }
    if (w == 0) {
      const float r0 = DT[(rbase + pos0 + 2 * lane) * 16 + dir * 8 + hd] + dtb;
      const float r1 = DT[(rbase + pos0 + 2 * lane + 1) * 16 + dir * 8 + hd] + dtb;
      const float dt0 = (r0 > 20.f) ? r0 : log1pf(expf(r0));
      const float dt1 = (r1 > 20.f) ? r1 : log1pf(expf(r1));
      const float a0 = dt0 * a, a1 = dt1 * a;
      const float sm = a0 + a1;
      float incl = sm;
#pragma unroll
      for (int o = 1; o < 64; o <<= 1) {
        const float t = __shfl_up(incl, o);
        if (lane >= o) incl += t;
      }
      const float excl = incl - sm;
      const float total = __shfl(incl, 63);
      float ac0, ac1;
      if (!dir) { ac0 = excl + a0; ac1 = excl + sm; }
      else { ac0 = total - excl; ac1 = total - excl - a0; }
      fa[2 * lane] = ac0; fa[2 * lane + 1] = ac1;
      fdt[2 * lane] = dt0; fdt[2 * lane + 1] = dt1;
      fsw[2 * lane] = dt0 * __expf(total - ac0); fsw[2 * lane + 1] = dt1 * __expf(total - ac1);
      fea[2 * lane] = __expf(ac0); fea[2 * lane + 1] = __expf(ac1);
      if (lane == 0) ftot[0] = __expf(total);
    }
    __syncthreads();
    const u16* cr = XBCA + (rbase + pos0 + w * 32 + l32) * 1024 + 768 + g * 128 + h * 8;
    f32x16 acc[4], yd[2];
#pragma unroll
    for (int i = 0; i < 4; ++i)
#pragma unroll
      for (int r = 0; r < 16; ++r) acc[i][r] = 0.f;
#pragma unroll
    for (int i = 0; i < 2; ++i)
#pragma unroll
      for (int r = 0; r < 16; ++r) yd[i][r] = 0.f;
#pragma unroll
    for (int ks = 0; ks < 8; ++ks) {
      const bf16x8 areg = *(const bf16x8*)(cr + ks * 16);
#pragma unroll
      for (int jb = 0; jb < 4; ++jb) {
        const bf16x8 bb = *(const bf16x8*)&BG[(jb * 32 + l32) * 136 + ks * 16 + h * 8];
        acc[jb] = __builtin_amdgcn_mfma_f32_32x32x16_bf16(areg, bb, acc[jb], 0, 0, 0);
      }
    }
    {
      const float eai = fea[w * 32 + l32];
#pragma unroll
      for (int ks = 0; ks < 8; ++ks) {
        union { u32 u[4]; bf16x8 v; } t;
        t.v = *(const bf16x8*)(cr + ks * 16);
#pragma unroll
        for (int q = 0; q < 4; ++q) t.u[q] = pack2(bflo(t.u[q]) * eai, bfhi(t.u[q]) * eai);
#pragma unroll
        for (int pb = 0; pb < 2; ++pb) {
          const bf16x8 bb = *(const bf16x8*)&HL[(pb * 32 + l32) * 136 + ks * 16 + h * 8];
          yd[pb] = __builtin_amdgcn_mfma_f32_32x32x16_bf16(t.v, bb, yd[pb], 0, 0, 0);
        }
      }
    }
    __syncthreads();
    int l32v = l32, hv_ = h;
    asm volatile("" : "+v"(l32v), "+v"(hv_));
#pragma unroll
    for (int jb = 0; jb < 4; ++jb) {
      const int j = jb * 32 + l32v;
      const float aj = fa[j], dtj = fdt[j];
#pragma unroll
      for (int r = 0; r < 16; ++r) {
        const int i = w * 32 + (r & 3) + 8 * (r >> 2) + 4 * hv_;
        const float ai = fa[i];
        const bool valid = dir ? (j >= i) : (j <= i);
        const float v = valid ? acc[jb][r] * __expf(ai - aj) * dtj : 0.f;
        BG[i * 136 + j] = f2bf(v);
      }
    }
    asm volatile("" ::: "memory");
    bf16x8 xf[2][8];
    {
      const u16* xt = TX + ((size_t)(b * 768 + hd * 64 + l32v)) * TPB + pos0 + hv_ * 8;
#pragma unroll
      for (int pb = 0; pb < 2; ++pb)
#pragma unroll
        for (int ks = 0; ks < 8; ++ks) xf[pb][ks] = *(const bf16x8*)(xt + (size_t)pb * 32 * TPB + ks * 16);
    }
#pragma unroll
    for (int ks = 0; ks < 8; ++ks) {
      const bf16x8 aa = *(const bf16x8*)&BG[(w * 32 + l32v) * 136 + ks * 16 + hv_ * 8];
#pragma unroll
      for (int pb = 0; pb < 2; ++pb) yd[pb] = __builtin_amdgcn_mfma_f32_32x32x16_bf16(aa, xf[pb][ks], yd[pb], 0, 0, 0);
    }
#pragma unroll
    for (int pb = 0; pb < 2; ++pb)
#pragma unroll
      for (int r = 0; r < 16; ++r) {
        const int i = w * 32 + (r & 3) + 8 * (r >> 2) + 4 * hv_;
        Y[(rbase + pos0 + i) * 512 + hd * 64 + pb * 32 + l32v] = f2bf(yd[pb][r]);
      }
    {
      const float eend = ftot[0];
#pragma unroll
      for (int pm = 0; pm < 2; ++pm)
#pragma unroll
        for (int r = 0; r < 16; ++r) Hacc[pm][r] *= eend;
      const u16* bt = TX + ((size_t)(b * 768 + 512 + g * 128 + w * 32 + l32v)) * TPB + pos0 + hv_ * 8;
#pragma unroll
      for (int ks = 0; ks < 8; ++ks) {
        const uint4 raw = *(const uint4*)(bt + ks * 16);
        const float4 s0 = *(const float4*)&fsw[ks * 16 + hv_ * 8];
        const float4 s1 = *(const float4*)&fsw[ks * 16 + hv_ * 8 + 4];
        union { u32 u[4]; bf16x8 v; } bs;
        bs.u[0] = pack2(bflo(raw.x) * s0.x, bfhi(raw.x) * s0.y);
        bs.u[1] = pack2(bflo(raw.y) * s0.z, bfhi(raw.y) * s0.w);
        bs.u[2] = pack2(bflo(raw.z) * s1.x, bfhi(raw.z) * s1.y);
        bs.u[3] = pack2(bflo(raw.w) * s1.z, bfhi(raw.w) * s1.w);
#pragma unroll
        for (int pm = 0; pm < 2; ++pm) Hacc[pm] = __builtin_amdgcn_mfma_f32_32x32x16_bf16(xf[pm][ks], bs.v, Hacc[pm], 0, 0, 0);
      }
#pragma unroll
      for (int pm = 0; pm < 2; ++pm)
#pragma unroll
        for (int r = 0; r < 16; ++r) {
          const int pp = pm * 32 + (r & 3) + 8 * (r >> 2) + 4 * hv_;
          HL[pp * 136 + w * 32 + l32v] = f2bf(Hacc[pm][r]);
        }
    }
    __syncthreads();
  }
}

DI void hyena_item(const Params& p, int l, int it) {
  const int lane = TID() & 63, w = TID() >> 6;
  int c, f, L, posoff, tt0, ntile;
  if (it < 2048) { c = it >> 3; f = l; L = 2048; posoff = CTXL; tt0 = (it & 7) * 256 + w * 64; ntile = 32; }
  else { c = it - 2048; f = 2; L = 256; posoff = 0; tt0 = w * 64; ntile = 4; }
  const u16* R0 = WSP(const u16, OFF_RF) + ((size_t)(f * 256 + c) * 2) * RSTR;
  const u16* R1 = R0 + RSTR;
  const u16* UT = WSP(const u16, OFF_UT);
  const int l16 = lane & 15, kg = lane >> 4;
  f32x4 acc[4];
#pragma unroll
  for (int i = 0; i < 4; ++i) acc[i] = (f32x4){0.f, 0.f, 0.f, 0.f};
  const u16* ub = UT + ((size_t)(c * 16 + l16)) * TPB + posoff + kg * 8;
  const u16* rsel = (l16 & 1) ? (R1 - 1) : R0;
  const int nb = L - (tt0 + l16) + kg * 8;
  for (int s0 = 0; s0 < L; s0 += 32) {
    const bf16x8 bfrag = *(const bf16x8*)(ub + s0);
#pragma unroll
    for (int i = 0; i < 4; ++i) {
      const u32* ap = (const u32*)(rsel + (nb - 16 * i + s0));
      union { u32 u[4]; bf16x8 v; } au;
      au.u[0] = ap[0]; au.u[1] = ap[1]; au.u[2] = ap[2]; au.u[3] = ap[3];
      acc[i] = __builtin_amdgcn_mfma_f32_16x16x32_bf16(au.v, bfrag, acc[i], 0, 0, 0);
    }
  }
  float ssq = 0.f;
  for (int t = 0; t < ntile; ++t) ssq += WSP(const float, OFF_PART)[(size_t)(f * 32 + t) * 256 + c];
  const float scale = rsqrtf(ssq + EPSF);
  const float bias = p.in[I_HYBIAS][l * 256 + c];
  const u16* X1C = WSP(const u16, OFF_X1C);
  u16* YM = WSP(u16, OFF_ACT);
  const int b = l16;
#pragma unroll
  for (int i = 0; i < 4; ++i)
#pragma unroll
    for (int r = 0; r < 4; ++r) {
      const int t = tt0 + 16 * i + kg * 4 + r;
      const size_t row = (size_t)b * TPB + posoff + t;
      const float u = bf2f(UT[((size_t)(c * 16 + b)) * TPB + posoff + t]);
      const float x1 = bf2f(X1C[row * 256 + c]);
      YM[row * 1024 + c] = f2bf(x1 * (scale * acc[i][r] + bias * u));
    }
}

DI void hyena_item_lat(const Params& p, int l, int it) {
  const int lane = TID() & 63, w = TID() >> 6;
  const int c = it >> 2, f = l, L = 2048, posoff = CTXL;
  const int tt0 = (it & 3) * 512 + w * 128;
  const u16* R0 = WSP(const u16, OFF_RF) + ((size_t)(f * 256 + c) * 2) * RSTR;
  const u16* R1 = R0 + RSTR;
  const u16* UT = WSP(const u16, OFF_UT);
  const int l16 = lane & 15, kg = lane >> 4;
  asm volatile("s_waitcnt vmcnt(0)" ::: "memory");
  f32x4 acc[8];
#pragma unroll
  for (int i = 0; i < 8; ++i) acc[i] = (f32x4){0.f, 0.f, 0.f, 0.f};
  const u16* ub = UT + ((size_t)(c * 16 + l16)) * TPB + posoff + kg * 8;
  const u16* rsel = (l16 & 1) ? (R1 - 1) : R0;
  const int nb = L - (tt0 + l16) + kg * 8;
  union AF { u32 u[4]; bf16x8 v; };
  AF a[16];
  bf16x8 bq[8];
#define HY_LOADA(dst, off) { const u32* ap_ = (const u32*)(rsel + (off)); dst.u[0] = ap_[0]; dst.u[1] = ap_[1]; dst.u[2] = ap_[2]; dst.u[3] = ap_[3]; }
#pragma unroll
  for (int i = 0; i < 8; ++i) HY_LOADA(a[i], nb - 16 * i)
#pragma unroll
  for (int v = 1; v < 4; ++v) {
    HY_LOADA(a[(0 - 2 * v) & 15], nb + 32 * v)
    HY_LOADA(a[(1 - 2 * v) & 15], nb - 16 + 32 * v)
  }
#pragma unroll
  for (int v = 0; v < 4; ++v) bq[v] = *(const bf16x8*)(ub + 32 * v);
#pragma unroll 1
  for (int sb = 0; sb < L; sb += 256) {
#pragma unroll
    for (int u = 0; u < 8; ++u) {
      const int s0 = sb + 32 * u;
      const int spf = (s0 + 128 < L) ? s0 + 128 : L - 32;
      HY_LOADA(a[(8 - 2 * u) & 15], nb + spf)
      HY_LOADA(a[(9 - 2 * u) & 15], nb - 16 + spf)
      bq[(u + 4) & 7] = *(const bf16x8*)(ub + spf);
      __builtin_amdgcn_sched_barrier(0);
#pragma unroll
      for (int i = 0; i < 8; ++i) acc[i] = __builtin_amdgcn_mfma_f32_16x16x32_bf16(a[(i - 2 * u) & 15].v, bq[u & 7], acc[i], 0, 0, 0);
      __builtin_amdgcn_sched_barrier(0);
    }
  }
#undef HY_LOADA
  float ssq = 0.f;
  for (int t = 0; t < 32; ++t) ssq += WSP(const float, OFF_PART)[(size_t)(f * 32 + t) * 256 + c];
  const float scale = rsqrtf(ssq + EPSF);
  const float bias = p.in[I_HYBIAS][l * 256 + c];
  const u16* X1C = WSP(const u16, OFF_X1C);
  u16* YM = WSP(u16, OFF_ACT);
  const int b = l16;
#pragma unroll
  for (int i = 0; i < 8; ++i)
#pragma unroll
    for (int r = 0; r < 4; ++r) {
      const int t = tt0 + 16 * i + kg * 4 + r;
      const size_t row = (size_t)b * TPB + posoff + t;
      const float uu = bf2f(UT[((size_t)(c * 16 + b)) * TPB + posoff + t]);
      const float x1 = bf2f(X1C[row * 256 + c]);
      YM[row * 1024 + c] = f2bf(x1 * (scale * acc[i][r] + bias * uu));
    }
}

DI void fnet_item(const Params& p, int it, char* smem) {
  const u16* PQT = WSP(const u16, OFF_PQT);
  u16* YM = WSP(u16, OFF_ACT);
  if (it < 512) {
    const int mt = it >> 5, nt = it & 31;
    const u16* A = WSP(const u16, OFF_DFT);
    auto af = [=](int m, int k) { return A + (size_t)m * 4096 + k; };
    auto bfn = [=](int n, int k) {
      const int b = n >> 8, n2 = n & 255, g = n2 >> 6, kk = n2 & 63, pq = k >> 11, t = k & 2047;
      return PQT + ((size_t)(b * 512 + g * 128 + pq * 64 + kk)) * TPB + CTXL + t;
    };
    auto ef = [=](int m, int n, float v0, float v1, float v2, float v3) {
      const int b = n >> 8, n2 = n & 255;
      const uint2 o = {pack2(v0, v1), pack2(v2, v3)};
      *(uint2*)&YM[((size_t)b * TPB + CTXL + m) * 1024 + 768 + n2] = o;
    };
    gemm_tile<true>(af, bfn, ef, mt * 128, nt * 128, 4096, smem);
  } else {
    const int i2 = it - 512, mt = i2 >> 5, nt = i2 & 31;
    const u16* A = WSP(const u16, OFF_DFTC);
    auto af = [=](int m, int k) { return A + (size_t)m * 512 + k; };
    auto bfn = [=](int n, int k) {
      const int b = n >> 8, n2 = n & 255, g = n2 >> 6, kk = n2 & 63, pq = k >> 8, t = k & 255;
      return PQT + ((size_t)(b * 512 + g * 128 + pq * 64 + kk)) * TPB + t;
    };
    auto ef = [=](int m, int n, float v0, float v1, float v2, float v3) {
      const int b = n >> 8, n2 = n & 255;
      const uint2 o = {pack2(v0, v1), pack2(v2, v3)};
      *(uint2*)&YM[((size_t)b * TPB + m) * 1024 + 768 + n2] = o;
    };
    gemm_tile<true>(af, bfn, ef, mt * 128, nt * 128, 512, smem);
  }
}

DI void phase_mixers(const Params& p, int l, int bid, int nblk, char* smem, int rep = 0) {
  for (int it = bid; it < 256; it += nblk) ssd_item(p, l, it, smem);
  const int nf = (l == 0) ? 576 : 512;
  const int nh = (l == 0) ? 1280 : 1024;
  int* ctr = WSP(int, OFF_CTR) + l + 2 * rep;
  int* sitem = (int*)(smem + LDS_BYTES - 16);
  for (;;) {
    if (TID() == 0) *sitem = atomicAdd(ctr, 1);
    __syncthreads();
    const int it = *sitem;
    __syncthreads();
    if (it >= nf + nh) break;
    if (it < nf) fnet_item(p, it, smem);
    else if (it - nf < 1024) hyena_item_lat(p, l, it - nf);
    else hyena_item(p, l, it - nf + 1024);
  }
}

DI void phase_ssd_combine(const Params& p, int l, int bid, int nblk) {
  const int lane = TID() & 63, w = TID() >> 6;
  const u16* YF = WSP(const u16, OFF_PXBC);
  const u16* YB = YF + (size_t)ROWS * 512;
  const u16* XBCA = WSP(const u16, OFF_XBCA);
  const u16* PZ = WSP(const u16, OFF_PZ);
  u16* YM = WSP(u16, OFF_ACT);
  const float* ng = p.in[I_SNG] + l * 512;
  const int c0 = lane * 8;
  const float dsk = p.in[I_SD][l * 8 + (c0 >> 6)];
  for (int row = bid * 4 + w; row < ROWS; row += nblk * 4) {
    const int pos = row % TPB;
    if (l == 1 && pos < CTXL) continue;
    const uint4 vf = *(const uint4*)(YF + (size_t)row * 512 + c0);
    const uint4 vb = *(const uint4*)(YB + (size_t)row * 512 + c0);
    const uint4 vx = *(const uint4*)(XBCA + (size_t)row * 1024 + c0);
    const uint4 vz = *(const uint4*)(PZ + (size_t)row * 512 + c0);
    const u32 af_[4] = {vf.x, vf.y, vf.z, vf.w}, ab_[4] = {vb.x, vb.y, vb.z, vb.w};
    const u32 ax_[4] = {vx.x, vx.y, vx.z, vx.w}, az_[4] = {vz.x, vz.y, vz.z, vz.w};
    float y[8];
    float ss = 0.f;
#pragma unroll
    for (int i = 0; i < 4; ++i) {
      const float y0 = bflo(af_[i]) + bflo(ab_[i]) + dsk * bflo(ax_[i]);
      const float y1 = bfhi(af_[i]) + bfhi(ab_[i]) + dsk * bfhi(ax_[i]);
      y[2 * i] = y0 * silu_f(bflo(az_[i]));
      y[2 * i + 1] = y1 * silu_f(bfhi(az_[i]));
      ss += y[2 * i] * y[2 * i] + y[2 * i + 1] * y[2 * i + 1];
    }
#pragma unroll
    for (int o = 16; o >= 1; o >>= 1) ss += __shfl_xor(ss, o);
    const float rs = rsqrtf(ss * (1.f / 256.f) + EPSF);
    float o8[8];
#pragma unroll
    for (int i = 0; i < 8; ++i) o8[i] = y[i] * rs * ng[c0 + i];
    uint4 o = {pack2(o8[0], o8[1]), pack2(o8[2], o8[3]), pack2(o8[4], o8[5]), pack2(o8[6], o8[7])};
    *(uint4*)&YM[(size_t)row * 1024 + 256 + c0] = o;
  }
}

DI void phase_outproj(const Params& p, int l, int bid, int nblk, char* smem) {
  const u16* A = WSP(const u16, OFF_ACT);
  const u16* B = WSP(const u16, OFF_WOUT) + (size_t)l * 1024 * 1024;
  const float* MOD = WSP(const float, OFF_MOD);
  const Params pp = p;
  auto af = [=](int m, int k) { return A + (size_t)m * 1024 + k; };
  auto bfn = [=](int n, int k) { return B + (size_t)n * 1024 + k; };
  auto ef = [=](int m, int n, float v0, float v1, float v2, float v3) {
    const int b = m / TPB, pos = m % TPB;
    const float4 ga = *(const float4*)&MOD[(size_t)(l * 17 + (pos < CTXL ? 16 : b)) * 6144 + 2048 + n];
    const float4 xo = *(const float4*)(xrow_ptr(pp, l == 0, b, pos) + n);
    const float4 o = {xo.x + ga.x * v0, xo.y + ga.y * v1, xo.z + ga.z * v2, xo.w + ga.w * v3};
    *(float4*)(xrow_wptr(pp, b, pos) + n) = o;
  };
  const int ntile = (ROWS / 128) * 8;
  const int vb = (nblk % 8 == 0) ? (bid & 7) * (nblk >> 3) + (bid >> 3) : bid;
  for (int t = vb; t < ntile; t += nblk) {
    const int mt = t >> 3, nt = t & 7;
    if (l == 1 && (mt % 18) < 2) continue;
    gemm_tile<true>(af, bfn, ef, mt * 128, nt * 128, 1024, smem);
  }
}

DI void phase_q(const Params& p, int l, int bid, int nblk, char* smem) {
  const u16* A = WSP(const u16, OFF_ACT);
  const u16* B = WSP(const u16, OFF_WQ) + (size_t)l * 2048 * 1024;
  u16* Q = WSP(u16, OFF_Q);
  auto af = [=](int m, int k) { return A + (size_t)m * 1024 + k; };
  auto bfn = [=](int n, int k) { return B + (size_t)n * 1024 + k; };
  auto ef = [=](int m, int n, float v0, float v1, float v2, float v3) {
    const uint2 o = {pack2(v0, v1), pack2(v2, v3)};
    *(uint2*)&Q[(size_t)m * 2048 + n] = o;
  };
  const int ntile = (ROWS / 128) * 16;
  const int vb = (nblk % 8 == 0) ? (bid & 7) * (nblk >> 3) + (bid >> 3) : bid;
  for (int t = vb; t < ntile; t += nblk) {
    const int mt = t >> 4, nt = t & 15;
    if (l == 1 && (mt % 18) < 2) continue;
    gemm_tile<true>(af, bfn, ef, mt * 128, nt * 128, 1024, smem);
  }
}

DI void phase_topk(const Params& p, int l, int bid, int nblk, char* smem) {
  const int tid = TID(), lane = tid & 63, w = tid >> 6, l32 = lane & 31, h = lane >> 5;
  u16* qs = (u16*)smem;
  float* sc = (float*)(smem + 64 * 136 * 2);
  const u16* Q = WSP(const u16, OFF_Q);
  float* TV = WSP(float, OFF_TV);
  int* TI = WSP(int, OFF_TI);
  for (int it = bid; it < (ROWS / 64) * 16; it += nblk) {
    const int hh = it & 15, rt = it >> 4;
    if (l == 1 && (rt % 36) < 4) continue;
    const int row0 = rt * 64;
#pragma unroll
    for (int i = 0; i < 4; ++i) {
      const int q = tid + 256 * i, r = q >> 4, ch = q & 15;
      *(uint4*)&qs[r * 136 + ch * 8] = *(const uint4*)&Q[(size_t)(row0 + r) * 2048 + hh * 128 + ch * 8];
    }
    __syncthreads();
    const u16* kb = WSP(const u16, OFF_K12) + (size_t)(l * 2 + (hh & 1)) * 16384;
    f32x16 acc[2];
#pragma unroll
    for (int i = 0; i < 2; ++i)
#pragma unroll
      for (int r = 0; r < 16; ++r) acc[i][r] = 0.f;
#pragma unroll
    for (int ks = 0; ks < 8; ++ks) {
      const bf16x8 bq = *(const bf16x8*)&kb[(w * 32 + l32) * 128 + ks * 16 + h * 8];
      const bf16x8 a0 = *(const bf16x8*)&qs[(l32) * 136 + ks * 16 + h * 8];
      const bf16x8 a1 = *(const bf16x8*)&qs[(32 + l32) * 136 + ks * 16 + h * 8];
      acc[0] = __builtin_amdgcn_mfma_f32_32x32x16_bf16(a0, bq, acc[0], 0, 0, 0);
      acc[1] = __builtin_amdgcn_mfma_f32_32x32x16_bf16(a1, bq, acc[1], 0, 0, 0);
    }
#pragma unroll
    for (int mt = 0; mt < 2; ++mt)
#pragma unroll
      for (int i = 0; i < 16; ++i) {
        const int r = mt * 32 + (i & 3) + 8 * (i >> 2) + 4 * h;
        sc[r * 133 + w * 33 + l32] = acc[mt][i];
      }
    __syncthreads();
    {
      const int r = tid >> 2, part = tid & 3;
      u32 key[32];
#pragma unroll
      for (int j = 0; j < 32; ++j) {
        const u32 u = __float_as_uint(sc[r * 133 + part * 33 + j]);
        const u32 ord = (u & 0x80000000u) ? ~u : (u | 0x80000000u);
        key[j] = (ord & ~127u) | (u32)(127 - (part * 32 + j));
      }
      float* tv = TV + ((size_t)(row0 + r) * 16 + hh) * 16;
      int* ti = TI + ((size_t)(row0 + r) * 16 + hh) * 16;
      u32 prev = 0xFFFFFFFFu;
#pragma unroll
      for (int rd = 0; rd < 16; ++rd) {
        u32 m = 0u;
#pragma unroll
        for (int j = 0; j < 32; ++j) { const u32 d = key[j] - prev; m = d > m ? d : m; }
        { const u32 o = (u32)__shfl_xor((int)m, 1); m = o > m ? o : m; }
        { const u32 o = (u32)__shfl_xor((int)m, 2); m = o > m ? o : m; }
        const u32 best = prev + m;
        prev = best;
        if (part == 0) {
          const u32 ordv = best & ~127u;
          const u32 uu = (ordv & 0x80000000u) ? (ordv & 0x7FFFFFFFu) : ~ordv;
          tv[rd] = __uint_as_float(uu);
          ti[rd] = 127 - (int)(best & 127u);
        }
      }
    }
    __syncthreads();
  }
}

DI void phase_peer(const Params& p, int l, int bid, int nblk) {
  const int w = TID() >> 6;
  const float* TV = WSP(const float, OFF_TV);
  const int* TI = WSP(const int, OFF_TI);
  const u16* H2 = WSP(const u16, OFF_ACT);
  const unsigned char* UB = WSP(const unsigned char, OFF_XBCA);
  const unsigned char* VB = UB + (size_t)16384 * 1024;
  const float* gfin = p.in[I_GF];
  for (int row = bid * 4 + w; row < ROWS; row += nblk * 4) {
    const int b = row / TPB, pos = row % TPB;
    if (l == 1 && pos < CTXL) continue;
    const int lane = TID() & 63;
    const int head = lane >> 3, sub = lane & 7;
    const float* tv1 = TV + ((size_t)row * 16 + head * 2) * 16;
    const float* tv2 = tv1 + 16;
    const int* ti1 = TI + ((size_t)row * 16 + head * 2) * 16;
    const int* ti2 = ti1 + 16;
    u32 ck[7];
#pragma unroll
    for (int s = 0; s < 7; ++s) {
      const int c = sub + 8 * s;
      if (c < 50) {
        const u32 u = __float_as_uint(tv1[CAND_A[c]] + tv2[CAND_B[c]]);
        const u32 ord = (u & 0x80000000u) ? ~u : (u | 0x80000000u);
        ck[s] = (ord & ~63u) | (u32)(63 - c);
      } else ck[s] = 0u;
    }
    float w0v = 0.f, w1v = 0.f, mx = 0.f;
    int w0c = 0, w1c = 0;
    u32 prevk = 0xFFFFFFFFu;
#pragma unroll
    for (int r = 0; r < 16; ++r) {
      u32 m = 0u;
#pragma unroll
      for (int s = 0; s < 7; ++s) { const u32 d = ck[s] - prevk; m = d > m ? d : m; }
#pragma unroll
      for (int o = 1; o <= 4; o <<= 1) { const u32 ov = (u32)__shfl_xor((int)m, o); m = ov > m ? ov : m; }
      const u32 best = prevk + m;
      prevk = best;
      const u32 ordv = best & ~63u;
      const float bv = __uint_as_float((ordv & 0x80000000u) ? (ordv & 0x7FFFFFFFu) : ~ordv);
      const int bc = 63 - (int)(best & 63u);
      if (r == 0) mx = bv;
      if (sub == (r & 7)) {
        if (r < 8) { w0v = bv; w0c = bc; } else { w1v = bv; w1c = bc; }
      }
    }
    const float e0 = expf(w0v - mx), e1 = expf(w1v - mx);
    float es = e0 + e1;
#pragma unroll
    for (int o = 1; o <= 4; o <<= 1) es += __shfl_xor(es, o);
    const float g0 = e0 / es, g1 = e1 / es;
    const int idx0 = ti1[CAND_A[w0c]] * 128 + ti2[CAND_B[w0c]];
    const int idx1 = ti1[CAND_A[w1c]] * 128 + ti2[CAND_B[w1c]];
    const u16* hrow = H2 + (size_t)row * 1024;
    float hv[16];
    {
      const uint4 ha = *(const uint4*)(hrow + lane * 16), hb = *(const uint4*)(hrow + lane * 16 + 8);
      hv[0] = bflo(ha.x); hv[1] = bfhi(ha.x); hv[2] = bflo(ha.y); hv[3] = bfhi(ha.y);
      hv[4] = bflo(ha.z); hv[5] = bfhi(ha.z); hv[6] = bflo(ha.w); hv[7] = bfhi(ha.w);
      hv[8] = bflo(hb.x); hv[9] = bfhi(hb.x); hv[10] = bflo(hb.y); hv[11] = bfhi(hb.y);
      hv[12] = bflo(hb.z); hv[13] = bfhi(hb.z); hv[14] = bflo(hb.w); hv[15] = bfhi(hb.w);
    }
    float acc[16];
#pragma unroll 1
    for (int prep_ = 0; prep_ < PEER_REPS; ++prep_) {
    const bool b0 = lane & 1, b1 = lane & 2, b2 = lane & 4;
    float act0 = 0.f, act1 = 0.f;
    u32x4 rb[2][8];
#define PEER_LOAD(buf, k, TAB)                                                                     \
  _Pragma("unroll") for (int j = 0; j < 8; ++j) {                                                  \
    const int e = (k) * 8 + j;                                                                     \
    const int id = __builtin_amdgcn_readlane(((k) < 8) ? idx0 : idx1, e & 63);                     \
    rb[buf][j] = *(const u32x4*)(TAB + (size_t)id * 1024 + lane * 16);                             \
  }
#define PEER_DOT(buf, k)                                                                           \
  {                                                                                                \
    float d[8];                                                                                    \
    _Pragma("unroll") for (int j = 0; j < 8; ++j) {                                                \
      const u32 uw[4] = {rb[buf][j][0], rb[buf][j][1], rb[buf][j][2], rb[buf][j][3]};              \
      float sd = 0.f;                                                                              \
      _Pragma("unroll") for (int q = 0; q < 4; ++q) {                                              \
        const f32x2 lo = __builtin_amdgcn_cvt_pk_f32_fp8((int)uw[q], false);                       \
        const f32x2 hi = __builtin_amdgcn_cvt_pk_f32_fp8((int)uw[q], true);                        \
        sd += hv[q * 4 + 0] * lo.x + hv[q * 4 + 1] * lo.y + hv[q * 4 + 2] * hi.x + hv[q * 4 + 3] * hi.y; \
      }                                                                                            \
      d[j] = sd;                                                                                   \
    }                                                                                              \
    float a4[4];                                                                                   \
    _Pragma("unroll") for (int q = 0; q < 4; ++q) {                                                \
      const float keep = b0 ? d[2 * q + 1] : d[2 * q], send = b0 ? d[2 * q] : d[2 * q + 1];        \
      a4[q] = keep + __shfl_xor(send, 1);                                                          \
    }                                                                                              \
    float a2[2];                                                                                   \
    _Pragma("unroll") for (int q = 0; q < 2; ++q) {                                                \
      const float keep = b1 ? a4[2 * q + 1] : a4[2 * q], send = b1 ? a4[2 * q] : a4[2 * q + 1];    \
      a2[q] = keep + __shfl_xor(send, 2);                                                          \
    }                                                                                              \
    const float keep = b2 ? a2[1] : a2[0], send = b2 ? a2[0] : a2[1];                              \
    float c1 = keep + __shfl_xor(send, 4);                                                         \
    c1 += __shfl_xor(c1, 8);                                                                       \
    c1 += __shfl_xor(c1, 16);                                                                      \
    c1 += __shfl_xor(c1, 32);                                                                      \
    if ((lane >> 3) == ((k) & 7)) { if ((k) < 8) act0 = c1; else act1 = c1; }                      \
  }
    PEER_LOAD(0, 0, UB)
#pragma unroll 1
    for (int k = 0; k < 16; k += 2) {
      PEER_LOAD(1, k + 1, UB)
      __builtin_amdgcn_sched_barrier(0);
      PEER_DOT(0, k)
      { const int kn = (k + 2 < 16) ? k + 2 : 15; PEER_LOAD(0, kn, UB) }
      __builtin_amdgcn_sched_barrier(0);
      PEER_DOT(1, k + 1)
    }
    const float ga0 = gelu_tanh(act0 * (1.f / U_SCALE)) * g0 * (1.f / V_SCALE);
    const float ga1 = gelu_tanh(act1 * (1.f / U_SCALE)) * g1 * (1.f / V_SCALE);
#pragma unroll
    for (int i = 0; i < 16; ++i) acc[i] = 0.f;
#define PEER_ACC(buf, k)                                                                           \
  _Pragma("unroll") for (int j = 0; j < 8; ++j) {                                                  \
    const int e = (k) * 8 + j;                                                                     \
    const int ai = __builtin_amdgcn_readlane(__builtin_bit_cast(int, ((k) < 8) ? ga0 : ga1), e & 63); \
    const float a = __builtin_bit_cast(float, ai);                                                 \
    const u32 vw[4] = {rb[buf][j][0], rb[buf][j][1], rb[buf][j][2], rb[buf][j][3]};                \
    _Pragma("unroll") for (int q = 0; q < 4; ++q) {                                                \
      const f32x2 lo = __builtin_amdgcn_cvt_pk_f32_fp8((int)vw[q], false);                         \
      const f32x2 hi = __builtin_amdgcn_cvt_pk_f32_fp8((int)vw[q], true);                          \
      acc[q * 4 + 0] += a * lo.x; acc[q * 4 + 1] += a * lo.y; acc[q * 4 + 2] += a * hi.x; acc[q * 4 + 3] += a * hi.y; \
    }                                                                                              \
  }
    PEER_LOAD(0, 0, VB)
#pragma unroll 1
    for (int k = 0; k < 16; k += 2) {
      PEER_LOAD(1, k + 1, VB)
      __builtin_amdgcn_sched_barrier(0);
      PEER_ACC(0, k)
      { const int kn = (k + 2 < 16) ? k + 2 : 15; PEER_LOAD(0, kn, VB) }
      __builtin_amdgcn_sched_barrier(0);
      PEER_ACC(1, k + 1)
    }
#undef PEER_LOAD
#undef PEER_DOT
#undef PEER_ACC
      if (prep_ + 1 < PEER_REPS) { _Pragma("unroll") for (int i = 0; i < 16; ++i) asm volatile("" :: "v"(acc[i])); }
    }
    int row2 = row;
    asm volatile("" : "+v"(row2));
    const int lane2 = TID() & 63;
    const int b2 = row2 / TPB, pos2 = row2 % TPB;
    const float* xr = xrow_ptr(p, false, b2, pos2);
    float* xw = xrow_wptr(p, b2, pos2);
    const float* ga = WSP(const float, OFF_MOD) + (size_t)(l * 17 + (pos2 < CTXL ? 16 : b2)) * 6144 + 5120;
    float xn[16];
    float ss = 0.f;
#pragma unroll
    for (int q = 0; q < 4; ++q) {
      const float4 xv = *(const float4*)(xr + lane2 * 16 + q * 4);
      const float4 gv = *(const float4*)(ga + lane2 * 16 + q * 4);
      xn[q * 4 + 0] = xv.x + gv.x * acc[q * 4 + 0];
      xn[q * 4 + 1] = xv.y + gv.y * acc[q * 4 + 1];
      xn[q * 4 + 2] = xv.z + gv.z * acc[q * 4 + 2];
      xn[q * 4 + 3] = xv.w + gv.w * acc[q * 4 + 3];
    }
    if (l == 1) {
#pragma unroll
      for (int i = 0; i < 16; ++i) ss += xn[i] * xn[i];
      ss = wave_sum(ss);
      const float rs = rsqrtf(ss * (1.f / 1024.f) + EPSF);
#pragma unroll
      for (int i = 0; i < 16; ++i) xn[i] = xn[i] * rs * gfin[lane2 * 16 + i];
    }
#pragma unroll
    for (int q = 0; q < 4; ++q) {
      float4 o = {xn[q * 4 + 0], xn[q * 4 + 1], xn[q * 4 + 2], xn[q * 4 + 3]};
      *(float4*)(xw + lane2 * 16 + q * 4) = o;
    }
  }
}

template <int S>
DI void run_stage(const Params& p, int l, int bid, int nblk, char* smem) {
  for (int rep = 0; rep < 1 + ((REP_MASK >> (S + 1)) & 1); ++rep) {
  if (S == 0) { if (PH_MASK & 2) phase_norm(p, l, 0, bid, nblk); }
  else if (S == 1) { if (PH_MASK & 4) phase_inproj(p, l, bid, nblk, smem); }
  else if (S == 2) { if (PH_MASK & 8) phase_prep(p, l, bid, nblk, smem); }
  else if (S == 3) { if (PH_MASK & 16) phase_mixers(p, l, bid, nblk, smem, rep); }
  else if (S == 4) { if (PH_MASK & 32) phase_ssd_combine(p, l, bid, nblk); }
  else if (S == 5) { if (PH_MASK & 64) phase_outproj(p, l, bid, nblk, smem); }
  else if (S == 6) { if (PH_MASK & 128) { phase_norm(p, l, 1, bid, nblk); phase_tables(p, l, bid, nblk); } }
  else if (S == 7) { if (PH_MASK & 256) phase_q(p, l, bid, nblk, smem); }
  else if (S == 8) { if (PH_MASK & 512) phase_topk(p, l, bid, nblk, smem); }
  else { if (PH_MASK & 1024) phase_peer(p, l, bid, nblk); }
  }
}

#if ONE_LAUNCH
__global__ void __launch_bounds__(NTHR, 2) mega(Params p) {
  extern __shared__ __attribute__((aligned(16))) char smem[];
  const int bid = blockIdx.x, nblk = gridDim.x;
  cg::grid_group grid = cg::this_grid();
  volatile LAS unsigned* bst = (volatile LAS unsigned*)(smem + LDS_BYTES - 32);
  if (threadIdx.x == 0) { bst[0] = 0u; bst[1] = 0u; }
  __syncthreads();
  const XcdBarrier bar = xcd_barrier_post(WSP(unsigned, OFF_BAR), bst);
  for (int rep = 0; rep < 1 + (REP_MASK & 1); ++rep) { if (PH_MASK & 1) phase_prologue(p, bid, nblk, smem); }
  grid.sync();
#define GBAR() xcd_barrier(bar)
#pragma nounroll
  for (int l = 0; l < 2; ++l) {
    for (int xs = 0; xs < EXTRA_SYNCS; ++xs) GBAR();
    run_stage<0>(p, l, bid, nblk, smem); GBAR();
    run_stage<1>(p, l, bid, nblk, smem); GBAR();
    run_stage<2>(p, l, bid, nblk, smem); GBAR();
    run_stage<3>(p, l, bid, nblk, smem); GBAR();
    run_stage<4>(p, l, bid, nblk, smem); GBAR();
    run_stage<5>(p, l, bid, nblk, smem); GBAR();
    run_stage<6>(p, l, bid, nblk, smem); GBAR();
    run_stage<7>(p, l, bid, nblk, smem); GBAR();
    run_stage<8>(p, l, bid, nblk, smem); GBAR();
    run_stage<9>(p, l, bid, nblk, smem);
    if (l == 0) GBAR();
  }
}
#else
template <int S>
__global__ void __launch_bounds__(NTHR, 2) stage_kernel(Params p, int l) {
  extern __shared__ __attribute__((aligned(16))) char smem[];
  if (S < 0) phase_prologue(p, blockIdx.x, gridDim.x, smem);
  else run_stage<(S < 0 ? 0 : S)>(p, l, blockIdx.x, gridDim.x, smem);
}

template <int S>
static void launch_stage(const Params& p, int l, int grid, hipStream_t stream) {
  (void)hipFuncSetAttribute((const void*)stage_kernel<S>, hipFuncAttributeMaxDynamicSharedMemorySize, LDS_BYTES);
  hipLaunchKernelGGL(stage_kernel<S>, dim3(grid), dim3(NTHR), LDS_BYTES, stream, p, l);
}

#endif

extern "C" void kernel_launch(void* const* d_in, const int* in_sizes, int n_in, void* d_out, int out_size, void* d_ws,
                              size_t ws_size, hipStream_t stream) {
  static int grid = 0;
  if (grid == 0) {
    if (ws_size < WS_END || n_in != 31) { fprintf(stderr, "kernel_launch: ws %zu < %zu or n_in %d\n", ws_size, (size_t)WS_END, n_in); grid = -1; return; }
    int dev = 0, cus = 0, per_cu = 0;
    (void)hipGetDevice(&dev);
    (void)hipDeviceGetAttribute(&cus, hipDeviceAttributeMultiprocessorCount, dev);
#if ONE_LAUNCH
    (void)hipFuncSetAttribute((const void*)mega, hipFuncAttributeMaxDynamicSharedMemorySize, LDS_BYTES);
    (void)hipOccupancyMaxActiveBlocksPerMultiprocessor(&per_cu, (const void*)mega, NTHR, LDS_BYTES);
#else
    (void)hipFuncSetAttribute((const void*)stage_kernel<3>, hipFuncAttributeMaxDynamicSharedMemorySize, LDS_BYTES);
    (void)hipOccupancyMaxActiveBlocksPerMultiprocessor(&per_cu, (const void*)stage_kernel<3>, NTHR, LDS_BYTES);
#endif
    if (per_cu < 1) per_cu = 1;
    if (per_cu > 2) per_cu = 2;
    grid = cus * per_cu;
  }
  if (grid < 0) return;
  (void)hipMemsetAsync((char*)d_ws + OFF_CTR, 0, 256 + 3456 * 4, stream);
  Params p{};
  for (int i = 0; i < 31; ++i) p.in[i] = (const float*)d_in[i];
  p.out = (float*)d_out;
  p.ws = (unsigned char*)d_ws;
#if ONE_LAUNCH
  void* args[] = {&p};
  hipError_t e = hipLaunchCooperativeKernel((const void*)mega, dim3(grid), dim3(NTHR), args, LDS_BYTES, stream);
  if (e != hipSuccess) fprintf(stderr, "cooperative launch failed: %s (grid %d)\n", hipGetErrorString(e), grid);
#else
  launch_stage<-1>(p, 0, grid, stream);
  for (int l = 0; l < 2; ++l) {
    launch_stage<0>(p, l, grid, stream);
    launch_stage<1>(p, l, grid, stream);
    launch_stage<2>(p, l, grid, stream);
    launch_stage<3>(p, l, grid, stream);
    launch_stage<4>(p, l, grid, stream);
    launch_stage<5>(p, l, grid, stream);
    launch_stage<6>(p, l, grid, stream);
    launch_stage<7>(p, l, grid, stream);
    launch_stage<8>(p, l, grid, stream);
    launch_stage<9>(p, l, grid, stream);
  }
#endif
}
```

```cpp
#include <hip/hip_runtime.h>
#include <hip/hip_cooperative_groups.h>
#include <cstdio>
namespace cg = cooperative_groups;

#ifndef PH_MASK
#define PH_MASK 0xFFFF
#endif
#ifndef PEER_REPS
#define PEER_REPS 1
#endif
#ifndef EXTRA_SYNCS
#define EXTRA_SYNCS 0
#endif
#ifndef REP_MASK
#define REP_MASK 0
#endif
#ifndef ONE_LAUNCH
#define ONE_LAUNCH 1
#endif

typedef unsigned short u16;
typedef unsigned int u32;
typedef __attribute__((ext_vector_type(8))) short bf16x8;
typedef __attribute__((ext_vector_type(16))) float f32x16;
typedef __attribute__((ext_vector_type(4))) float f32x4;
typedef __attribute__((ext_vector_type(2))) float f32x2;
typedef __attribute__((ext_vector_type(4))) unsigned int u32x4;
#define DI __device__ __forceinline__
DI int TID() { int t = threadIdx.x; asm volatile("" : "+v"(t)); return t; }

DI u16 f2bf(float x) { u32 u = __float_as_uint(x); u += 0x7fffu + ((u >> 16) & 1u); return (u16)(u >> 16); }
DI float bf2f(u16 v) { return __uint_as_float(((u32)v) << 16); }
DI u32 pack2(float a, float b) { return (u32)f2bf(a) | ((u32)f2bf(b) << 16); }
DI float bflo(u32 v) { return __uint_as_float(v << 16); }
DI float bfhi(u32 v) { return __uint_as_float(v & 0xffff0000u); }

constexpr int D = 1024, NB = 16, SEQ = 2048, CTXL = 256, TPB = 2304, ROWS = NB * TPB;
constexpr int NIN = 2944;
constexpr int RSTR = 4112;
constexpr int NTHR = 256;
constexpr int LDS_BYTES = 73728;
constexpr float EPSF = 1e-6f;

constexpr size_t SZ_PHY = (size_t)ROWS * 768 * 2, SZ_PZ = (size_t)ROWS * 512 * 2, SZ_PXBC = (size_t)ROWS * 1024 * 2;
constexpr size_t OFF_PHY = 0;
constexpr size_t OFF_PZ = OFF_PHY + SZ_PHY;
constexpr size_t OFF_PXBC = OFF_PZ + SZ_PZ;
constexpr size_t OFF_Q = OFF_PHY;
constexpr size_t OFF_ACT = OFF_PXBC + SZ_PXBC;
constexpr size_t OFF_XBCA = OFF_ACT + (size_t)ROWS * 1024 * 2;
constexpr size_t OFF_DREG = OFF_XBCA + (size_t)ROWS * 1024 * 2;
constexpr size_t OFF_PQT = OFF_DREG;
constexpr size_t OFF_UT = OFF_PQT + (size_t)NB * 512 * TPB * 2;
constexpr size_t OFF_X1C = OFF_UT + (size_t)256 * 16 * TPB * 2;
constexpr size_t OFF_TV = OFF_DREG;
constexpr size_t OFF_TI = OFF_TV + (size_t)ROWS * 256 * 4;
constexpr size_t OFF_XC = OFF_DREG + (size_t)ROWS * 256 * 8;
constexpr size_t OFF_WIN = OFF_XC + (size_t)NB * CTXL * D * 4;
constexpr size_t OFF_WOUT = OFF_WIN + (size_t)2 * NIN * 1024 * 2;
constexpr size_t OFF_WQ = OFF_WOUT + (size_t)2 * 1024 * 1024 * 2;
constexpr size_t OFF_K12 = OFF_WQ + (size_t)2 * 2048 * 1024 * 2;
constexpr size_t OFF_DFT = OFF_K12 + (size_t)2 * 2 * 128 * 128 * 2;
constexpr size_t OFF_DFTC = OFF_DFT + (size_t)2048 * 4096 * 2;
constexpr size_t OFF_RF = OFF_DFTC + (size_t)256 * 512 * 2;
constexpr size_t OFF_PART = OFF_RF + (size_t)3 * 256 * 2 * RSTR * 2;
constexpr size_t OFF_MOD = OFF_PART + (size_t)3 * 32 * 256 * 4;
constexpr size_t OFF_DT = OFF_MOD + (size_t)2 * 17 * 6144 * 4;
constexpr size_t OFF_CTR = OFF_DT + (size_t)ROWS * 16 * 4;
constexpr size_t OFF_BAR = OFF_CTR + 256;
constexpr size_t OFF_TX = OFF_BAR + 3456 * 4;
constexpr size_t WS_END = OFF_TX + (size_t)NB * 768 * TPB * 2;

struct Params {
  const float* in[31];
  float* out;
  unsigned char* ws;
  int pad0, pad1;
};

enum { I_X = 0, I_C, I_CTX, I_CCTX, I_WADA, I_BADA, I_G1, I_G2, I_WIN, I_HYCW, I_HYCB, I_HFW1, I_HFB1, I_HFW2, I_HFB2,
       I_HFW3, I_HFFREQ, I_HYBIAS, I_SCW, I_SCB, I_SDTB, I_SALOG, I_SD, I_SNG, I_WOUT, I_WQ, I_K1, I_K2, I_PU, I_PV, I_GF };

__device__ const unsigned char CAND_A[56] = {0, 0, 0, 0, 0, 0, 0, 0, 0, 0, 0, 0, 0, 0, 0, 0, 1, 1, 1, 1, 1, 1, 1, 1, 2, 2, 2, 2, 2, 3, 3, 3, 3, 4, 4, 4, 5, 5, 6, 6, 7, 7, 8, 9, 10, 11, 12, 13, 14, 15, 0, 0, 0, 0, 0, 0};
__device__ const unsigned char CAND_B[56] = {0, 1, 2, 3, 4, 5, 6, 7, 8, 9, 10, 11, 12, 13, 14, 15, 0, 1, 2, 3, 4, 5, 6, 7, 0, 1, 2, 3, 4, 0, 1, 2, 3, 0, 1, 2, 0, 1, 0, 1, 0, 1, 0, 0, 0, 0, 0, 0, 0, 0, 0, 0, 0, 0, 0, 0};

#define WSP(T, off) ((T*)(p.ws + (off)))

#define XB_TMO      128
#define XB_XCNT(j)  (256  + 64 * (j))
#define XB_XSUB(j)  (1280 + 64 * (j))
#define XB_XGEN(j)  (2304 + 64 * (j))
#define XB_TOP      3328
#define XB_TOPGEN   3392
#define XCD_BAR_WORDS 3456
#define XB_SPIN_CAP (1u << 18)
#define LAS __attribute__((address_space(3)))
DI unsigned xb_ld(unsigned* p) { return __hip_atomic_load(p, __ATOMIC_RELAXED, __HIP_MEMORY_SCOPE_AGENT); }
DI unsigned xb_add(unsigned* p, unsigned v) { return __hip_atomic_fetch_add(p, v, __ATOMIC_RELAXED, __HIP_MEMORY_SCOPE_AGENT); }
DI unsigned xb_xcc_id() { return (unsigned)__builtin_amdgcn_s_getreg((3 << 11) | 20) & 0xFu; }
#define XB_SPIN(cond, bar) do { unsigned _sp = 0; while (cond) { __builtin_amdgcn_s_sleep(1); \
    if ((++_sp & 255u) == 0u) { if (xb_ld(&(bar)[XB_TMO])) break; if (_sp > XB_SPIN_CAP) { atomicAdd(&(bar)[XB_TMO], 1u); break; } } } } while (0)
struct XcdBarrier { unsigned* bar; unsigned x; volatile LAS unsigned* st; };
DI XcdBarrier xcd_barrier_post(unsigned* bar, volatile LAS unsigned* st) {
  XcdBarrier b; b.bar = bar; b.x = xb_xcc_id(); b.st = st;
  if (threadIdx.x == 0) (void)xb_add(&bar[XB_XCNT(b.x)], 1u);
  return b;
}
DI void xcd_barrier_complete(unsigned* bar, unsigned x, unsigned& nloc, unsigned& nx) {
  const unsigned G = gridDim.x * gridDim.y * gridDim.z;
  unsigned sum, cnt, mine, sp = 0u;
  for (;;) {
    sum = 0u; cnt = 0u; mine = 0u;
#pragma unroll
    for (unsigned j = 0; j < 16; ++j) { const unsigned c = xb_ld(&bar[XB_XCNT(j)]); sum += c; cnt += (c > 0u) ? 1u : 0u; mine = (j == x) ? c : mine; }
    if (sum == G) break;
    __builtin_amdgcn_s_sleep(1);
    if ((++sp & 255u) == 0u) { if (xb_ld(&bar[XB_TMO])) break; if (sp > XB_SPIN_CAP) { atomicAdd(&bar[XB_TMO], 1u); break; } }
  }
  nloc = mine > 0u ? mine : 1u; nx = cnt > 0u ? cnt : 1u;
}
DI void xcd_barrier(const XcdBarrier& b) {
  asm volatile("s_waitcnt vmcnt(0)" ::: "memory");
  __syncthreads();
  if (threadIdx.x == 0) {
    unsigned* bar = b.bar;
    __builtin_amdgcn_s_waitcnt(0);
    unsigned nloc = b.st[0], nx = b.st[1];
    if (nloc == 0u) { xcd_barrier_complete(bar, b.x, nloc, nx); b.st[0] = nloc; b.st[1] = nx; }
    const unsigned old = xb_add(&bar[XB_XSUB(b.x)], 1u);
    const unsigned gen = old / nloc;
    if (old + 1u == (gen + 1u) * nloc) {
      __builtin_amdgcn_fence(__ATOMIC_RELEASE, "agent");
      asm volatile("s_waitcnt vmcnt(0)" ::: "memory");
      const unsigned og = xb_add(&bar[XB_TOP], 1u);
      const unsigned tg = og / nx;
      if (og + 1u == (tg + 1u) * nx) xb_add(&bar[XB_TOPGEN], 1u);
      else XB_SPIN(xb_ld(&bar[XB_TOPGEN]) == tg, bar);
      __builtin_amdgcn_fence(__ATOMIC_ACQUIRE, "agent");
      xb_add(&bar[XB_XGEN(b.x)], 1u);
      asm volatile("s_waitcnt vmcnt(0)" ::: "memory");
    } else {
      XB_SPIN(xb_ld(&bar[XB_XGEN(b.x)]) == gen, bar);
      __builtin_amdgcn_fence(__ATOMIC_ACQUIRE, "agent");
      asm volatile("s_waitcnt vmcnt(0)" ::: "memory");
    }
  }
  __syncthreads();
}


template <bool SWAP, int MI, class AF, class BF, class EF>
DI void gemm_tile(const AF& af, const BF& bfn, const EF& ef, int m0, int n0, int K, char* smem) {
  constexpr int AROWS = MI * 64;
  u16* As = (u16*)smem;
  u16* Bs = As + 2 * AROWS * 40;
  const int tid = TID(), lane = tid & 63, w = tid >> 6;
  const int wm = w >> 1, wn = w & 1, l32 = lane & 31, h = lane >> 5;
  const int lrow = (tid >> 6) * 16 + ((tid >> 5) & 1) * 8 + ((tid >> 2) & 1) * 4 + ((tid >> 3) & 3), lk = (tid & 3) * 8;
  f32x16 acc[MI][2];
#pragma unroll
  for (int i = 0; i < MI; ++i)
#pragma unroll
    for (int j = 0; j < 2; ++j)
#pragma unroll
      for (int r = 0; r < 16; ++r) acc[i][j][r] = 0.f;
  u32x4 ra[MI], rb[2];
  const int nk = K >> 5;
#pragma unroll
  for (int i = 0; i < MI; ++i) ra[i] = *(const u32x4*)af(m0 + lrow + 64 * i, lk);
#pragma unroll
  for (int i = 0; i < 2; ++i) rb[i] = *(const u32x4*)bfn(n0 + lrow + 64 * i, lk);
#pragma unroll
  for (int i = 0; i < MI; ++i) *(u32x4*)&As[(lrow + 64 * i) * 40 + lk] = ra[i];
#pragma unroll
  for (int i = 0; i < 2; ++i) *(u32x4*)&Bs[(lrow + 64 * i) * 40 + lk] = rb[i];
  {
    const int k1 = (nk > 1) ? 32 + lk : lk;
#pragma unroll
    for (int i = 0; i < MI; ++i) ra[i] = *(const u32x4*)af(m0 + lrow + 64 * i, k1);
#pragma unroll
    for (int i = 0; i < 2; ++i) rb[i] = *(const u32x4*)bfn(n0 + lrow + 64 * i, k1);
  }
  __syncthreads();
  for (int kt = 0; kt < nk; ++kt) {
    const int cur = kt & 1;
    const u16* Ab = As + cur * AROWS * 40;
    const u16* Bb = Bs + cur * 128 * 40;
#pragma unroll
    for (int ks = 0; ks < 2; ++ks) {
      bf16x8 a[MI], b[2];
#pragma unroll
      for (int i = 0; i < MI; ++i) a[i] = *(const bf16x8*)&Ab[(wm * (MI * 32) + i * 32 + l32) * 40 + ks * 16 + h * 8];
#pragma unroll
      for (int i = 0; i < 2; ++i) b[i] = *(const bf16x8*)&Bb[(wn * 64 + i * 32 + l32) * 40 + ks * 16 + h * 8];
#pragma unroll
      for (int i = 0; i < MI; ++i)
#pragma unroll
        for (int j = 0; j < 2; ++j)
          acc[i][j] = SWAP ? __builtin_amdgcn_mfma_f32_32x32x16_bf16(b[j], a[i], acc[i][j], 0, 0, 0)
                           : __builtin_amdgcn_mfma_f32_32x32x16_bf16(a[i], b[j], acc[i][j], 0, 0, 0);
    }
    {
      u16* An = As + (cur ^ 1) * AROWS * 40;
      u16* Bn = Bs + (cur ^ 1) * 128 * 40;
#pragma unroll
      for (int i = 0; i < MI; ++i) *(u32x4*)&An[(lrow + 64 * i) * 40 + lk] = ra[i];
#pragma unroll
      for (int i = 0; i < 2; ++i) *(u32x4*)&Bn[(lrow + 64 * i) * 40 + lk] = rb[i];
      const int kn = (kt + 2 < nk) ? kt + 2 : nk - 1;
      const int k0 = kn * 32 + lk;
#pragma unroll
      for (int i = 0; i < MI; ++i) ra[i] = *(const u32x4*)af(m0 + lrow + 64 * i, k0);
#pragma unroll
      for (int i = 0; i < 2; ++i) rb[i] = *(const u32x4*)bfn(n0 + lrow + 64 * i, k0);
    }
    __syncthreads();
  }
#pragma unroll
  for (int i = 0; i < MI; ++i)
#pragma unroll
    for (int j = 0; j < 2; ++j)
#pragma unroll
      for (int rg = 0; rg < 4; ++rg) {
        const int m = SWAP ? (m0 + wm * (MI * 32) + i * 32 + l32) : (m0 + wm * (MI * 32) + i * 32 + rg * 8 + h * 4);
        const int n = SWAP ? (n0 + wn * 64 + j * 32 + rg * 8 + h * 4) : (n0 + wn * 64 + j * 32 + l32);
        ef(m, n, acc[i][j][rg * 4 + 0], acc[i][j][rg * 4 + 1], acc[i][j][rg * 4 + 2], acc[i][j][rg * 4 + 3]);
      }
}

DI float wave_sum(float v) {
#pragma unroll
  for (int o = 32; o >= 1; o >>= 1) v += __shfl_xor(v, o);
  return v;
}
DI float silu_f(float x) { return x / (1.f + __expf(-x)); }
DI float gelu_tanh(float x) {
  const float u = 0.7978845608028654f * (x + 0.044715f * x * x * x);
  return 0.5f * x * (1.f + tanhf(u));
}

DI const float* xrow_ptr(const Params& p, bool from_input, int b, int pos) {
  if (pos < CTXL) return (from_input ? p.in[I_CTX] : WSP(const float, OFF_XC)) + ((size_t)b * CTXL + pos) * D;
  return (from_input ? p.in[I_X] : (const float*)p.out) + ((size_t)b * SEQ + (pos - CTXL)) * D;
}
DI float* xrow_wptr(const Params& p, int b, int pos) {
  if (pos < CTXL) return WSP(float, OFF_XC) + ((size_t)b * CTXL + pos) * D;
  return p.out + ((size_t)b * SEQ + (pos - CTXL)) * D;
}

DI void phase_prologue(const Params& p, int bid, int nblk, char* smem) {
  const int tid = TID();
  const int gtid = bid * NTHR + tid, gn = nblk * NTHR;
  {
    float* scs = (float*)smem;
    for (int it = bid; it < 192; it += nblk) {
      const int l = it / 96, col0 = (it % 96) * 64;
      for (int e = tid; e < 17 * 1024; e += NTHR) {
        const int j = e >> 10, k = e & 1023;
        const float v = (j < 16) ? p.in[I_C][j * 1024 + k] : p.in[I_CCTX][k];
        scs[e] = v / (1.f + expf(-v));
      }
      __syncthreads();
      const int col = tid & 63, kq = tid >> 6;
      float acc[17];
#pragma unroll
      for (int j = 0; j < 17; ++j) acc[j] = 0.f;
      const float* wa = p.in[I_WADA] + (size_t)l * 1024 * 6144 + col0 + col;
      for (int k0 = kq * 256; k0 < kq * 256 + 256; k0 += 8) {
        float wv[8];
#pragma unroll
        for (int kk = 0; kk < 8; ++kk) wv[kk] = wa[(size_t)(k0 + kk) * 6144];
#pragma unroll
        for (int kk = 0; kk < 8; ++kk)
#pragma unroll
          for (int j = 0; j < 17; ++j) acc[j] += scs[j * 1024 + k0 + kk] * wv[kk];
      }
      __syncthreads();
#pragma unroll
      for (int j = 0; j < 17; ++j) scs[(kq * 17 + j) * 64 + col] = acc[j];
      __syncthreads();
      for (int e = tid; e < 17 * 64; e += NTHR) {
        const int j = e >> 6, cc = e & 63;
        float s = p.in[I_BADA][l * 6144 + col0 + cc];
#pragma unroll
        for (int q = 0; q < 4; ++q) s += scs[(q * 17 + j) * 64 + cc];
        WSP(float, OFF_MOD)[(size_t)(l * 17 + j) * 6144 + col0 + cc] = s;
      }
      __syncthreads();
    }
  }
  {
    float* zs = (float*)smem;
    float* h1s = zs + 64 * 33;
    float* h2s = h1s + 64 * 64;
    for (int it = (nblk >= 260 ? (bid >= 192 ? bid - 192 : 1 << 20) : bid); it < 68; it += nblk) {
      const int f = it < 32 ? 0 : (it < 64 ? 1 : 2);
      const int tile = it - (f == 0 ? 0 : (f == 1 ? 32 : 64));
      const int L = (f == 2) ? 256 : 2048;
      const int lyr = (f == 1) ? 1 : 0;
      const int pos0 = tile * 64;
      const float* w1 = p.in[I_HFW1] + lyr * 33 * 64;
      const float* b1 = p.in[I_HFB1] + lyr * 64;
      const float* w2 = p.in[I_HFW2] + lyr * 64 * 64;
      const float* b2 = p.in[I_HFB2] + lyr * 64;
      const float* w3 = p.in[I_HFW3] + lyr * 64 * 512;
      const float* fq = p.in[I_HFFREQ] + lyr * 64;
      for (int e = tid; e < 64 * 33; e += NTHR) {
        const int pi = e / 33, q = e % 33;
        const int pos = pos0 + pi;
        const float tt = (float)pos / (float)(L - 1);
        const float wv = 6.283185307179586f * (float)pos / (float)L;
        float z;
        if (q == 0) z = tt;
        else if (q <= 16) { const float fi = 1e-4f + (float)(q - 1) * ((15.f - 1e-4f) / 15.f); z = cosf(fi * wv); }
        else { const float fi = 1e-4f + (float)(q - 17) * ((15.f - 1e-4f) / 15.f); z = -sinf(fi * wv); }
        zs[e] = z;
      }
      __syncthreads();
      for (int e = tid; e < 64 * 64; e += NTHR) {
        const int pi = e >> 6, j = e & 63;
        float s = b1[j];
        for (int q = 0; q < 33; ++q) s += zs[pi * 33 + q] * w1[q * 64 + j];
        h1s[e] = sinf(fq[j] * s);
      }
      __syncthreads();
      for (int e = tid; e < 64 * 64; e += NTHR) {
        const int pi = e >> 6, j = e & 63;
        float s = b2[j];
        for (int k = 0; k < 64; ++k) s += h1s[pi * 64 + k] * w2[k * 64 + j];
        h2s[e] = sinf(fq[j] * s);
      }
      __syncthreads();
      {
        const int c = tid;
        const float mind = logf(1e-2f) / 1.5f, maxd = logf(1e-2f) / 0.3f;
        const float delta = fabsf(mind + (float)c * ((maxd - mind) / 255.f));
        u16* R0 = WSP(u16, OFF_RF) + ((size_t)(f * 256 + c) * 2 + 0) * RSTR;
        u16* R1 = R0 + RSTR;
        float ssq = 0.f;
        for (int pb = 0; pb < 4; ++pb) {
          float af_[16], ab_[16];
#pragma unroll
          for (int i = 0; i < 16; ++i) { af_[i] = 0.f; ab_[i] = 0.f; }
          for (int k = 0; k < 64; ++k) {
            const float wf = w3[k * 512 + c], wb = w3[k * 512 + 256 + c];
#pragma unroll
            for (int i = 0; i < 16; ++i) {
              const float hv = h2s[(pb * 16 + i) * 64 + k];
              af_[i] += hv * wf;
              ab_[i] += hv * wb;
            }
          }
#pragma unroll
          for (int i = 0; i < 16; ++i) {
            const int pos = pos0 + pb * 16 + i;
            const float tt = (float)pos / (float)(L - 1);
            const float win = expf(-tt * delta);
            const float vf = af_[i] * win, vb = ab_[i] * win;
            const u16 bfv = f2bf(vf), bbv = f2bf(vb);
            R0[L - pos] = bfv;
            R1[L - pos - 1] = bfv;
            ssq += vf * vf;
            if (pos >= 1) {
              R0[L + pos] = bbv;
              R1[L + pos - 1] = bbv;
              ssq += vb * vb;
            }
          }
        }
        WSP(float, OFF_PART)[(size_t)(f * 32 + tile) * 256 + c] = ssq;
      }
      __syncthreads();
    }
  }
  for (int e = gtid; e < 2 * NIN * 128; e += gn) {
    const int l = e / (NIN * 128);
    const int r = e % (NIN * 128);
    const int kc = r / NIN, n = r % NIN;
    const int k0 = kc * 8;
    const float* wsrc = p.in[I_WIN] + (size_t)l * 1024 * 2576;
    float v[8];
    if (n < 2304) {
#pragma unroll
      for (int j = 0; j < 8; ++j) v[j] = wsrc[(size_t)(k0 + j) * 2576 + n];
    } else if (n < 2816) {
      const int np = n - 2304, g = np >> 7, rr = np & 127, pq = rr >> 6, kk = rr & 63;
#pragma unroll
      for (int j = 0; j < 8; ++j) v[j] = 0.f;
      for (int jj = 0; jj < 64; ++jj) {
        const float ang = 6.283185307179586f * (float)((jj * kk) & 63) / 64.f;
        const float tr = pq ? sinf(ang) : cosf(ang);
#pragma unroll
        for (int j = 0; j < 8; ++j) v[j] += wsrc[(size_t)(k0 + j) * 2576 + 2320 + g * 64 + jj] * tr;
      }
    } else if (n < 2832) {
#pragma unroll
      for (int j = 0; j < 8; ++j) v[j] = wsrc[(size_t)(k0 + j) * 2576 + 2304 + (n - 2816)];
    } else {
#pragma unroll
      for (int j = 0; j < 8; ++j) v[j] = 0.f;
    }
    uint4 o = {pack2(v[0], v[1]), pack2(v[2], v[3]), pack2(v[4], v[5]), pack2(v[6], v[7])};
    *(uint4*)&WSP(u16, OFF_WIN)[((size_t)l * NIN + n) * 1024 + k0] = o;
  }
  for (int e = gtid; e < 2 * 1024 * 128; e += gn) {
    const int l = e / (1024 * 128), r = e % (1024 * 128), kc = r / 1024, n = r % 1024, k0 = kc * 8;
    const float* wsrc = p.in[I_WOUT] + (size_t)l * 1024 * 1024;
    float v[8];
#pragma unroll
    for (int j = 0; j < 8; ++j) v[j] = wsrc[(size_t)(k0 + j) * 1024 + n];
    uint4 o = {pack2(v[0], v[1]), pack2(v[2], v[3]), pack2(v[4], v[5]), pack2(v[6], v[7])};
    *(uint4*)&WSP(u16, OFF_WOUT)[((size_t)l * 1024 + n) * 1024 + k0] = o;
  }
  for (int e = gtid; e < 2 * 2048 * 128; e += gn) {
    const int l = e / (2048 * 128), r = e % (2048 * 128), kc = r / 2048, n = r % 2048, k0 = kc * 8;
    const float* wsrc = p.in[I_WQ] + (size_t)l * 1024 * 2048;
    float v[8];
#pragma unroll
    for (int j = 0; j < 8; ++j) v[j] = wsrc[(size_t)(k0 + j) * 2048 + n];
    uint4 o = {pack2(v[0], v[1]), pack2(v[2], v[3]), pack2(v[4], v[5]), pack2(v[6], v[7])};
    *(uint4*)&WSP(u16, OFF_WQ)[((size_t)l * 2048 + n) * 1024 + k0] = o;
  }
  for (int e = gtid; e < 2 * 2 * 128 * 128; e += gn) {
    const int l = e / (2 * 16384), r = e % (2 * 16384), which = r / 16384, i = r % 16384;
    const float v = (which ? p.in[I_K2] : p.in[I_K1])[l * 16384 + i];
    WSP(u16, OFF_K12)[e] = f2bf(v);
  }
  for (int e = gtid; e < 2048 * 512; e += gn) {
    const int tp = e >> 9, k0 = (e & 511) * 8;
    const float s = 1.f / sqrtf(2048.f * 64.f);
    float v[8];
#pragma unroll
    for (int j = 0; j < 8; ++j) {
      const int k = k0 + j, t = k & 2047;
      const float ang = 6.283185307179586f * (float)((tp * t) & 2047) / 2048.f;
      v[j] = (k < 2048) ? cosf(ang) * s : -sinf(ang) * s;
    }
    uint4 o = {pack2(v[0], v[1]), pack2(v[2], v[3]), pack2(v[4], v[5]), pack2(v[6], v[7])};
    *(uint4*)&WSP(u16, OFF_DFT)[(size_t)tp * 4096 + k0] = o;
  }
  for (int e = gtid; e < 256 * 64; e += gn) {
    const int tp = e >> 6, k0 = (e & 63) * 8;
    const float s = 1.f / sqrtf(256.f * 64.f);
    float v[8];
#pragma unroll
    for (int j = 0; j < 8; ++j) {
      const int k = k0 + j, t = k & 255;
      const float ang = 6.283185307179586f * (float)((tp * t) & 255) / 256.f;
      v[j] = (k < 256) ? cosf(ang) * s : -sinf(ang) * s;
    }
    uint4 o = {pack2(v[0], v[1]), pack2(v[2], v[3]), pack2(v[4], v[5]), pack2(v[6], v[7])};
    *(uint4*)&WSP(u16, OFF_DFTC)[(size_t)tp * 512 + k0] = o;
  }
}

DI void phase_norm(const Params& p, int l, int which, int bid, int nblk) {
  const int lane = TID() & 63, w = TID() >> 6;
  const float* g = (which ? p.in[I_G2] : p.in[I_G1]) + l * 1024;
  const bool from_input = (which == 0 && l == 0);
  for (int row = bid * 4 + w; row < ROWS; row += nblk * 4) {
    const int b = row / TPB, pos = row % TPB;
    if (which == 1 && l == 1 && pos < CTXL) continue;
    const float* xr = xrow_ptr(p, from_input, b, pos);
    const float* mod = WSP(const float, OFF_MOD) + (size_t)(l * 17 + (pos < CTXL ? 16 : b)) * 6144 + which * 3072;
    float x[16];
#pragma unroll
    for (int hh = 0; hh < 2; ++hh) {
      const float4 a = *(const float4*)(xr + hh * 512 + lane * 8);
      const float4 c = *(const float4*)(xr + hh * 512 + lane * 8 + 4);
      x[hh * 8 + 0] = a.x; x[hh * 8 + 1] = a.y; x[hh * 8 + 2] = a.z; x[hh * 8 + 3] = a.w;
      x[hh * 8 + 4] = c.x; x[hh * 8 + 5] = c.y; x[hh * 8 + 6] = c.z; x[hh * 8 + 7] = c.w;
    }
    float ss = 0.f;
#pragma unroll
    for (int i = 0; i < 16; ++i) ss += x[i] * x[i];
    ss = wave_sum(ss);
    const float rs = rsqrtf(ss * (1.f / 1024.f) + EPSF);
#pragma unroll
    for (int hh = 0; hh < 2; ++hh) {
      const int c0 = hh * 512 + lane * 8;
      float y[8];
#pragma unroll
      for (int i = 0; i < 8; ++i) {
        const float yn = x[hh * 8 + i] * rs * g[c0 + i];
        y[i] = yn * (1.f + mod[1024 + c0 + i]) + mod[c0 + i];
      }
      uint4 o = {pack2(y[0], y[1]), pack2(y[2], y[3]), pack2(y[4], y[5]), pack2(y[6], y[7])};
      *(uint4*)&WSP(u16, OFF_ACT)[(size_t)row * 1024 + c0] = o;
    }
  }
}

constexpr float U_SCALE = 64.f, V_SCALE = 4.f;
DI void phase_tables(const Params& p, int l, int bid, int nblk) {
  const int gtid = bid * NTHR + TID(), gn = nblk * NTHR;
  unsigned char* dst = WSP(unsigned char, OFF_XBCA);
  for (int e = gtid; e < 2 * 16384 * 64; e += gn) {
    const int which = e / (16384 * 64), r = e % (16384 * 64);
    const float sc = which ? V_SCALE : U_SCALE;
    const float* src = (which ? p.in[I_PV] : p.in[I_PU]) + (size_t)l * 16384 * 1024 + (size_t)r * 16;
    u32 o[4];
#pragma unroll
    for (int q = 0; q < 4; ++q) {
      const float4 a = *(const float4*)(src + q * 4);
      int v = __builtin_amdgcn_cvt_pk_fp8_f32(a.x * sc, a.y * sc, 0, false);
      v = __builtin_amdgcn_cvt_pk_fp8_f32(a.z * sc, a.w * sc, v, true);
      o[q] = (u32)v;
    }
    uint4 ov = {o[0], o[1], o[2], o[3]};
    *(uint4*)&dst[(size_t)e * 16] = ov;
  }
}

DI void phase_inproj(const Params& p, int l, int bid, int nblk, char* smem) {
  const u16* A = WSP(const u16, OFF_ACT);
  const u16* B = WSP(const u16, OFF_WIN) + (size_t)l * NIN * 1024;
  u16* PHY = WSP(u16, OFF_PHY);
  u16* PZ = WSP(u16, OFF_PZ);
  u16* PXBC = WSP(u16, OFF_PXBC);
  u16* PQT = WSP(u16, OFF_PQT);
  float* DT = WSP(float, OFF_DT);
  auto af = [=](int m, int k) { return A + (size_t)m * 1024 + k; };
  auto bfn = [=](int n, int k) { return B + (size_t)n * 1024 + k; };
  auto efT = [=](int m, int n, float v0, float v1, float v2, float v3) {
    const uint2 o = {pack2(v0, v1), pack2(v2, v3)};
    if (n < 768) *(uint2*)&PHY[(size_t)m * 768 + n] = o;
    else if (n < 1280) *(uint2*)&PZ[(size_t)m * 512 + (n - 768)] = o;
    else if (n < 2304) *(uint2*)&PXBC[(size_t)m * 1024 + (n - 1280)] = o;
    else if (n >= 2816 && n < 2832) { float4 f = {v0, v1, v2, v3}; *(float4*)&DT[(size_t)m * 16 + (n - 2816)] = f; }
  };
  auto efN = [=](int m, int n, float v0, float v1, float v2, float v3) {
    const int b = m / TPB, pos = m % TPB, np = n - 2304;
    uint2 o = {pack2(v0, v1), pack2(v2, v3)};
    *(uint2*)&PQT[((size_t)(b * 512 + np)) * TPB + pos] = o;
  };
  const int ntile = (ROWS / 256) * (NIN / 128);
  const int vb = (nblk % 8 == 0) ? (bid & 7) * (nblk >> 3) + (bid >> 3) : bid;
  for (int t = vb; t < ntile; t += nblk) {
    const int mt = t / (NIN / 128), nt = t % (NIN / 128);
    if (nt >= 18 && nt < 22) gemm_tile<false, 4>(af, bfn, efN, mt * 256, nt * 128, 1024, smem);
    else gemm_tile<true, 4>(af, bfn, efT, mt * 256, nt * 128, 1024, smem);
  }
}

DI void unpack8(const uint4& v, float* f) {
  f[0] = bflo(v.x); f[1] = bfhi(v.x); f[2] = bflo(v.y); f[3] = bfhi(v.y);
  f[4] = bflo(v.z); f[5] = bfhi(v.z); f[6] = bflo(v.w); f[7] = bfhi(v.w);
}
DI void phase_prep(const Params& p, int l, int bid, int nblk, char* smem) {
  const int tid = TID();
  u16* tile = (u16*)smem;
  const u16* PHY = WSP(const u16, OFF_PHY);
  const u16* PXBC = WSP(const u16, OFF_PXBC);
  u16* UT = WSP(u16, OFF_UT);
  u16* X1C = WSP(u16, OFF_X1C);
  u16* XBCA = WSP(u16, OFF_XBCA);
  u16* TX = WSP(u16, OFF_TX);
  const float* hw = p.in[I_HYCW] + l * 3 * 768;
  const float* hb = p.in[I_HYCB] + l * 768;
  const float* sw = p.in[I_SCW] + l * 3 * 1024;
  const float* sb = p.in[I_SCB] + l * 1024;
  const int cg8 = (tid & 31) * 8, pg = tid >> 5;
  for (int it = bid; it < NB * 36 * 6; it += nblk) {
    const int pass = it % 6, bt = it / 6;
    const int b = bt / 36, pt = bt % 36, pos0 = pt * 64;
    const int seg_lo = (pos0 < CTXL) ? 0 : CTXL, seg_hi = (pos0 < CTXL) ? CTXL : TPB;
    const size_t rbase = (size_t)b * TPB;
    const int pfirst = pos0 + pg * 8;
    bool transposed = false;
    if (pass <= 1) {
      if (l == 1 && pos0 < CTXL) continue;
      float cv0[8][8];
#pragma unroll
      for (int sg = 0; sg < 2; ++sg) {
        if (pass == 0 && sg == 1) break;
        const int sgrp = (pass == 0) ? 1 : (sg == 0 ? 0 : 2);
        const int col = sgrp * 256 + cg8;
        float w0[8], w1[8], w2[8], bb[8];
#pragma unroll
        for (int e = 0; e < 8; ++e) { w0[e] = hw[col + e]; w1[e] = hw[768 + col + e]; w2[e] = hw[1536 + col + e]; bb[e] = hb[col + e]; }
        uint4 raw[10];
#pragma unroll
        for (int k = 0; k < 10; ++k) {
          const int pn = pfirst + k - 1;
          raw[k] = (pn >= seg_lo && pn < seg_hi) ? *(const uint4*)&PHY[(rbase + pn) * 768 + col] : make_uint4(0u, 0u, 0u, 0u);
        }
        float xm[8], x0[8], xp[8];
        unpack8(raw[0], xm);
        unpack8(raw[1], x0);
#pragma unroll
        for (int k = 0; k < 8; ++k) {
          unpack8(raw[k + 2], xp);
          float o[8];
#pragma unroll
          for (int e = 0; e < 8; ++e) {
            o[e] = w0[e] * xm[e] + w1[e] * x0[e] + w2[e] * xp[e] + bb[e];
            xm[e] = x0[e]; x0[e] = xp[e];
          }
          if (pass == 0) {
            uint4 o1 = {pack2(o[0], o[1]), pack2(o[2], o[3]), pack2(o[4], o[5]), pack2(o[6], o[7])};
            *(uint4*)&X1C[(rbase + pfirst + k) * 256 + cg8] = o1;
          } else if (sg == 0) {
#pragma unroll
            for (int e = 0; e < 8; ++e) cv0[k][e] = o[e];
          } else {
            uint4 ou = {pack2(o[0] * cv0[k][0], o[1] * cv0[k][1]), pack2(o[2] * cv0[k][2], o[3] * cv0[k][3]),
                        pack2(o[4] * cv0[k][4], o[5] * cv0[k][5]), pack2(o[6] * cv0[k][6], o[7] * cv0[k][7])};
            *(uint4*)&tile[(pg * 8 + k) * 264 + cg8] = ou;
          }
        }
      }
      transposed = (pass == 1);
    } else {
      const int col = (pass - 2) * 256 + cg8;
      float w0[8], w1[8], w2[8], bb[8];
#pragma unroll
      for (int e = 0; e < 8; ++e) { w0[e] = sw[col + e]; w1[e] = sw[1024 + col + e]; w2[e] = sw[2048 + col + e]; bb[e] = sb[col + e]; }
      uint4 raw[10];
#pragma unroll
      for (int k = 0; k < 10; ++k) {
        const int pn = pfirst + k - 1;
        raw[k] = (pn >= seg_lo && pn < seg_hi) ? *(const uint4*)&PXBC[(rbase + pn) * 1024 + col] : make_uint4(0u, 0u, 0u, 0u);
      }
      float xm[8], x0[8], xp[8];
      unpack8(raw[0], xm);
      unpack8(raw[1], x0);
#pragma unroll
      for (int k = 0; k < 8; ++k) {
        unpack8(raw[k + 2], xp);
        float o[8];
#pragma unroll
        for (int e = 0; e < 8; ++e) {
          o[e] = silu_f(w0[e] * xm[e] + w1[e] * x0[e] + w2[e] * xp[e] + bb[e]);
          xm[e] = x0[e]; x0[e] = xp[e];
        }
        uint4 ov = {pack2(o[0], o[1]), pack2(o[2], o[3]), pack2(o[4], o[5]), pack2(o[6], o[7])};
        *(uint4*)&XBCA[(rbase + pfirst + k) * 1024 + col] = ov;
        if (pass < 5) *(uint4*)&tile[(pg * 8 + k) * 264 + cg8] = ov;
      }
      transposed = pass < 5;
    }
    if (transposed) {
      __syncthreads();
      u16* dst = (pass == 1) ? (UT + ((size_t)(tid * 16 + b)) * TPB + pos0) : (TX + ((size_t)(b * 768 + (pass - 2) * 256 + tid)) * TPB + pos0);
#pragma unroll
      for (int pc = 0; pc < 8; ++pc) {
        u32 wv[4];
#pragma unroll
        for (int e = 0; e < 4; ++e)
          wv[e] = (u32)tile[(pc * 8 + 2 * e) * 264 + tid] | ((u32)tile[(pc * 8 + 2 * e + 1) * 264 + tid] << 16);
        uint4 o = {wv[0], wv[1], wv[2], wv[3]};
        *(uint4*)&dst[pc * 8] = o;
      }
      __syncthreads();
    }
  }
}

DI void ssd_item(const Params& p, int l, int it, char* smem) {
  const int tid = TID(), lane = tid & 63, w = tid >> 6, l32 = lane & 31, h = lane >> 5;
  const int b = it >> 4, hd = (it >> 1) & 7, dir = it & 1, g = hd >> 2;
  u16* BG = (u16*)smem;
  u16* HL = BG + 128 * 136;
  float* fa = (float*)(HL + 64 * 136);
  float* fdt = fa + 128;
  float* fsw = fdt + 128;
  float* fea = fsw + 128;
  float* ftot = fea + 128;
  const u16* XBCA = WSP(const u16, OFF_XBCA);
  const u16* TX = WSP(const u16, OFF_TX);
  const float* DT = WSP(const float, OFF_DT);
  u16* Y = WSP(u16, OFF_PXBC) + (dir ? (size_t)ROWS * 512 : 0);
  const float dtb = p.in[I_SDTB][l * 16 + dir * 8 + hd];
  const float a = -expf(p.in[I_SALOG][l * 16 + dir * 8 + hd]);
  const size_t rbase = (size_t)b * TPB;
  f32x16 Hacc[2];
#pragma unroll
  for (int i = 0; i < 2; ++i)
#pragma unroll
    for (int r = 0; r < 16; ++r) Hacc[i][r] = 0.f;
  for (int e = tid; e < 64 * 136; e += NTHR) HL[e] = 0;
  for (int ci = 0; ci < 18; ++ci) {
    const int pos0 = dir ? ((ci < 2) ? (1 - ci) * 128 : (CTXL + (17 - ci) * 128)) : ci * 128;
#pragma unroll
    for (int i = 0; i < 8; ++i) {
      const int q = tid + 256 * i, j = q >> 4, ch = q & 15;
      *(uint4*)&BG[j * 136 + ch * 8] = *(const uint4*)&XBCA[(rbase + pos0 + j) * 1024 + 512 + g * 128 + ch * 8];
    }
    if (w == 0) {
      const float r0 = DT[(rbase + pos0 + 2 * lane) * 16 + dir * 8 + hd] + dtb;
      const float r1 = DT[(rbase + pos0 + 2 * lane + 1) * 16 + dir * 8 + hd] + dtb;
      const float dt0 = (r0 > 20.f) ? r0 : log1pf(expf(r0));
      const float dt1 = (r1 > 20.f) ? r1 : log1pf(expf(r1));
      const float a0 = dt0 * a, a1 = dt1 * a;
      const float sm = a0 + a1;
      float incl = sm;
#pragma unroll
      for (int o = 1; o < 64; o <<= 1) {
        const float t = __shfl_up(incl, o);
        if (lane >= o) incl += t;
      }
      const float excl = incl - sm;
      const float total = __shfl(incl, 63);
      float ac0, ac1;
      if (!dir) { ac0 = excl + a0; ac1 = excl + sm; }
      else { ac0 = total - excl; ac1 = total - excl - a0; }
      fa[2 * lane] = ac0; fa[2 * lane + 1] = ac1;
      fdt[2 * lane] = dt0; fdt[2 * lane + 1] = dt1;
      fsw[2 * lane] = dt0 * __expf(total - ac0); fsw[2 * lane + 1] = dt1 * __expf(total - ac1);
      fea[2 * lane] = __expf(ac0); fea[2 * lane + 1] = __expf(ac1);
      if (lane == 0) ftot[0] = __expf(total);
    }
    __syncthreads();
    const u16* cr = XBCA + (rbase + pos0 + w * 32 + l32) * 1024 + 768 + g * 128 + h * 8;
    f32x16 acc[4], yd[2];
#pragma unroll
    for (int i = 0; i < 4; ++i)
#pragma unroll
      for (int r = 0; r < 16; ++r) acc[i][r] = 0.f;
#pragma unroll
    for (int i = 0; i < 2; ++i)
#pragma unroll
      for (int r = 0; r < 16; ++r) yd[i][r] = 0.f;
#pragma unroll
    for (int ks = 0; ks < 8; ++ks) {
      const bf16x8 areg = *(const bf16x8*)(cr + ks * 16);
#pragma unroll
      for (int jb = 0; jb < 4; ++jb) {
        const bf16x8 bb = *(const bf16x8*)&BG[(jb * 32 + l32) * 136 + ks * 16 + h * 8];
        acc[jb] = __builtin_amdgcn_mfma_f32_32x32x16_bf16(areg, bb, acc[jb], 0, 0, 0);
      }
    }
    {
      const float eai = fea[w * 32 + l32];
#pragma unroll
      for (int ks = 0; ks < 8; ++ks) {
        union { u32 u[4]; bf16x8 v; } t;
        t.v = *(const bf16x8*)(cr + ks * 16);
#pragma unroll
        for (int q = 0; q < 4; ++q) t.u[q] = pack2(bflo(t.u[q]) * eai, bfhi(t.u[q]) * eai);
#pragma unroll
        for (int pb = 0; pb < 2; ++pb) {
          const bf16x8 bb = *(const bf16x8*)&HL[(pb * 32 + l32) * 136 + ks * 16 + h * 8];
          yd[pb] = __builtin_amdgcn_mfma_f32_32x32x16_bf16(t.v, bb, yd[pb], 0, 0, 0);
        }
      }
    }
    __syncthreads();
    int l32v = l32, hv_ = h;
    asm volatile("" : "+v"(l32v), "+v"(hv_));
#pragma unroll
    for (int jb = 0; jb < 4; ++jb) {
      const int j = jb * 32 + l32v;
      const float aj = fa[j], dtj = fdt[j];
#pragma unroll
      for (int r = 0; r < 16; ++r) {
        const int i = w * 32 + (r & 3) + 8 * (r >> 2) + 4 * hv_;
        const float ai = fa[i];
        const bool valid = dir ? (j >= i) : (j <= i);
        const float v = valid ? acc[jb][r] * __expf(ai - aj) * dtj : 0.f;
        BG[i * 136 + j] = f2bf(v);
      }
    }
    asm volatile("" ::: "memory");
    bf16x8 xf[2][8];
    {
      const u16* xt = TX + ((size_t)(b * 768 + hd * 64 + l32v)) * TPB + pos0 + hv_ * 8;
#pragma unroll
      for (int pb = 0; pb < 2; ++pb)
#pragma unroll
        for (int ks = 0; ks < 8; ++ks) xf[pb][ks] = *(const bf16x8*)(xt + (size_t)pb * 32 * TPB + ks * 16);
    }
#pragma unroll
    for (int ks = 0; ks < 8; ++ks) {
      const bf16x8 aa = *(const bf16x8*)&BG[(w * 32 + l32v) * 136 + ks * 16 + hv_ * 8];
#pragma unroll
      for (int pb = 0; pb < 2; ++pb) yd[pb] = __builtin_amdgcn_mfma_f32_32x32x16_bf16(aa, xf[pb][ks], yd[pb], 0, 0, 0);
    }
#pragma unroll
    for (int pb = 0; pb < 2; ++pb)
#pragma unroll
      for (int r = 0; r < 16; ++r) {
        const int i = w * 32 + (r & 3) + 8 * (r >> 2) + 4 * hv_;
        Y[(rbase + pos0 + i) * 512 + hd * 64 + pb * 32 + l32v] = f2bf(yd[pb][r]);
      }
    {
      const float eend = ftot[0];
#pragma unroll
      for (int pm = 0; pm < 2; ++pm)
#pragma unroll
        for (int r = 0; r < 16; ++r) Hacc[pm][r] *= eend;
      const u16* bt = TX + ((size_t)(b * 768 + 512 + g * 128 + w * 32 + l32v)) * TPB + pos0 + hv_ * 8;
#pragma unroll
      for (int ks = 0; ks < 8; ++ks) {
        const uint4 raw = *(const uint4*)(bt + ks * 16);
        const float4 s0 = *(const float4*)&fsw[ks * 16 + hv_ * 8];
        const float4 s1 = *(const float4*)&fsw[ks * 16 + hv_ * 8 + 4];
        union { u32 u[4]; bf16x8 v; } bs;
        bs.u[0] = pack2(bflo(raw.x) * s0.x, bfhi(raw.x) * s0.y);
        bs.u[1] = pack2(bflo(raw.y) * s0.z, bfhi(raw.y) * s0.w);
        bs.u[2] = pack2(bflo(raw.z) * s1.x, bfhi(raw.z) * s1.y);
        bs.u[3] = pack2(bflo(raw.w) * s1.z, bfhi(raw.w) * s1.w);
#pragma unroll
        for (int pm = 0; pm < 2; ++pm) Hacc[pm] = __builtin_amdgcn_mfma_f32_32x32x16_bf16(xf[pm][ks], bs.v, Hacc[pm], 0, 0, 0);
      }
#pragma unroll
      for (int pm = 0; pm < 2; ++pm)
#pragma unroll
        for (int r = 0; r < 16; ++r) {
          const int pp = pm * 32 + (r & 3) + 8 * (r >> 2) + 4 * hv_;
          HL[pp * 136 + w * 32 + l32v] = f2bf(Hacc[pm][r]);
        }
    }
    __syncthreads();
  }
}

DI void hyena_item(const Params& p, int l, int it) {
  const int lane = TID() & 63, w = TID() >> 6;
  int c, f, L, posoff, tt0, ntile;
  if (it < 2048) { c = it >> 3; f = l; L = 2048; posoff = CTXL; tt0 = (it & 7) * 256 + w * 64; ntile = 32; }
  else { c = it - 2048; f = 2; L = 256; posoff = 0; tt0 = w * 64; ntile = 4; }
  const u16* R0 = WSP(const u16, OFF_RF) + ((size_t)(f * 256 + c) * 2) * RSTR;
  const u16* R1 = R0 + RSTR;
  const u16* UT = WSP(const u16, OFF_UT);
  const int l16 = lane & 15, kg = lane >> 4;
  f32x4 acc[4];
#pragma unroll
  for (int i = 0; i < 4; ++i) acc[i] = (f32x4){0.f, 0.f, 0.f, 0.f};
  const u16* ub = UT + ((size_t)(c * 16 + l16)) * TPB + posoff + kg * 8;
  const u16* rsel = (l16 & 1) ? (R1 - 1) : R0;
  const int nb = L - (tt0 + l16) + kg * 8;
  for (int s0 = 0; s0 < L; s0 += 32) {
    const bf16x8 bfrag = *(const bf16x8*)(ub + s0);
#pragma unroll
    for (int i = 0; i < 4; ++i) {
      const u32* ap = (const u32*)(rsel + (nb - 16 * i + s0));
      union { u32 u[4]; bf16x8 v; } au;
      au.u[0] = ap[0]; au.u[1] = ap[1]; au.u[2] = ap[2]; au.u[3] = ap[3];
      acc[i] = __builtin_amdgcn_mfma_f32_16x16x32_bf16(au.v, bfrag, acc[i], 0, 0, 0);
    }
  }
  float ssq = 0.f;
  for (int t = 0; t < ntile; ++t) ssq += WSP(const float, OFF_PART)[(size_t)(f * 32 + t) * 256 + c];
  const float scale = rsqrtf(ssq + EPSF);
  const float bias = p.in[I_HYBIAS][l * 256 + c];
  const u16* X1C = WSP(const u16, OFF_X1C);
  u16* YM = WSP(u16, OFF_ACT);
  const int b = l16;
#pragma unroll
  for (int i = 0; i < 4; ++i)
#pragma unroll
    for (int r = 0; r < 4; ++r) {
      const int t = tt0 + 16 * i + kg * 4 + r;
      const size_t row = (size_t)b * TPB + posoff + t;
      const float u = bf2f(UT[((size_t)(c * 16 + b)) * TPB + posoff + t]);
      const float x1 = bf2f(X1C[row * 256 + c]);
      YM[row * 1024 + c] = f2bf(x1 * (scale * acc[i][r] + bias * u));
    }
}

DI void hyena_item_lat(const Params& p, int l, int it) {
  const int lane = TID() & 63, w = TID() >> 6;
  const int c = it >> 2, f = l, L = 2048, posoff = CTXL;
  const int tt0 = (it & 3) * 512 + w * 128;
  const u16* R0 = WSP(const u16, OFF_RF) + ((size_t)(f * 256 + c) * 2) * RSTR;
  const u16* R1 = R0 + RSTR;
  const u16* UT = WSP(const u16, OFF_UT);
  const int l16 = lane & 15, kg = lane >> 4;
  f32x4 acc[8];
#pragma unroll
  for (int i = 0; i < 8; ++i) acc[i] = (f32x4){0.f, 0.f, 0.f, 0.f};
  const u16* ub = UT + ((size_t)(c * 16 + l16)) * TPB + posoff + kg * 8;
  const u16* rsel = (l16 & 1) ? (R1 - 1) : R0;
  const int nb = L - (tt0 + l16) + kg * 8;
  union AF { u32 u[4]; bf16x8 v; };
  AF a[8];
#define HY_LOADA(dst, off) { const u32* ap_ = (const u32*)(rsel + (off)); dst.u[0] = ap_[0]; dst.u[1] = ap_[1]; dst.u[2] = ap_[2]; dst.u[3] = ap_[3]; }
#pragma unroll
  for (int i = 2; i < 8; ++i) HY_LOADA(a[i], nb - 16 * i)
#pragma unroll 1
  for (int sb = 0; sb < L; sb += 128) {
#pragma unroll
    for (int u = 0; u < 4; ++u) {
      const int s0 = sb + 32 * u;
      HY_LOADA(a[(0 - 2 * u) & 7], nb + s0)
      HY_LOADA(a[(1 - 2 * u) & 7], nb - 16 + s0)
      const bf16x8 bfrag = *(const bf16x8*)(ub + s0);
#pragma unroll
      for (int i = 0; i < 8; ++i) acc[i] = __builtin_amdgcn_mfma_f32_16x16x32_bf16(a[(i - 2 * u) & 7].v, bfrag, acc[i], 0, 0, 0);
    }
  }
#undef HY_LOADA
  float ssq = 0.f;
  for (int t = 0; t < 32; ++t) ssq += WSP(const float, OFF_PART)[(size_t)(f * 32 + t) * 256 + c];
  const float scale = rsqrtf(ssq + EPSF);
  const float bias = p.in[I_HYBIAS][l * 256 + c];
  const u16* X1C = WSP(const u16, OFF_X1C);
  u16* YM = WSP(u16, OFF_ACT);
  const int b = l16;
#pragma unroll
  for (int i = 0; i < 8; ++i)
#pragma unroll
    for (int r = 0; r < 4; ++r) {
      const int t = tt0 + 16 * i + kg * 4 + r;
      const size_t row = (size_t)b * TPB + posoff + t;
      const float uu = bf2f(UT[((size_t)(c * 16 + b)) * TPB + posoff + t]);
      const float x1 = bf2f(X1C[row * 256 + c]);
      YM[row * 1024 + c] = f2bf(x1 * (scale * acc[i][r] + bias * uu));
    }
}

DI void fnet_item(const Params& p, int it, char* smem) {
  const u16* PQT = WSP(const u16, OFF_PQT);
  u16* YM = WSP(u16, OFF_ACT);
  if (it < 256) {
    const int mt = it >> 5, nt = it & 31;
    const u16* A = WSP(const u16, OFF_DFT);
    auto af = [=](int m, int k) { return A + (size_t)m * 4096 + k; };
    auto bfn = [=](int n, int k) {
      const int b = n >> 8, n2 = n & 255, g = n2 >> 6, kk = n2 & 63, pq = k >> 11, t = k & 2047;
      return PQT + ((size_t)(b * 512 + g * 128 + pq * 64 + kk)) * TPB + CTXL + t;
    };
    auto ef = [=](int m, int n, float v0, float v1, float v2, float v3) {
      const int b = n >> 8, n2 = n & 255;
      const uint2 o = {pack2(v0, v1), pack2(v2, v3)};
      *(uint2*)&YM[((size_t)b * TPB + CTXL + m) * 1024 + 768 + n2] = o;
    };
    gemm_tile<true, 4>(af, bfn, ef, mt * 256, nt * 128, 4096, smem);
  } else {
    const int i2 = it - 256, mt = i2 >> 5, nt = i2 & 31;
    const u16* A = WSP(const u16, OFF_DFTC);
    auto af = [=](int m, int k) { return A + (size_t)m * 512 + k; };
    auto bfn = [=](int n, int k) {
      const int b = n >> 8, n2 = n & 255, g = n2 >> 6, kk = n2 & 63, pq = k >> 8, t = k & 255;
      return PQT + ((size_t)(b * 512 + g * 128 + pq * 64 + kk)) * TPB + t;
    };
    auto ef = [=](int m, int n, float v0, float v1, float v2, float v3) {
      const int b = n >> 8, n2 = n & 255;
      const uint2 o = {pack2(v0, v1), pack2(v2, v3)};
      *(uint2*)&YM[((size_t)b * TPB + m) * 1024 + 768 + n2] = o;
    };
    gemm_tile<true, 4>(af, bfn, ef, mt * 256, nt * 128, 512, smem);
  }
}

DI void phase_mixers(const Params& p, int l, int bid, int nblk, char* smem, int rep = 0) {
  for (int it = bid; it < 256; it += nblk) ssd_item(p, l, it, smem);
  const int nf = (l == 0) ? 288 : 256;
  const int nh = (l == 0) ? 1280 : 1024;
  int* ctr = WSP(int, OFF_CTR) + l + 2 * rep;
  int* sitem = (int*)(smem + LDS_BYTES - 16);
  for (;;) {
    if (TID() == 0) *sitem = atomicAdd(ctr, 1);
    __syncthreads();
    const int it = *sitem;
    __syncthreads();
    if (it >= nf + nh) break;
    if (it < nf) fnet_item(p, it, smem);
    else if (it - nf < 1024) hyena_item_lat(p, l, it - nf);
    else hyena_item(p, l, it - nf + 1024);
  }
}

DI void phase_ssd_combine(const Params& p, int l, int bid, int nblk) {
  const int lane = TID() & 63, w = TID() >> 6;
  const u16* YF = WSP(const u16, OFF_PXBC);
  const u16* YB = YF + (size_t)ROWS * 512;
  const u16* XBCA = WSP(const u16, OFF_XBCA);
  const u16* PZ = WSP(const u16, OFF_PZ);
  u16* YM = WSP(u16, OFF_ACT);
  const float* ng = p.in[I_SNG] + l * 512;
  const int c0 = lane * 8;
  const float dsk = p.in[I_SD][l * 8 + (c0 >> 6)];
  for (int row = bid * 4 + w; row < ROWS; row += nblk * 4) {
    const int pos = row % TPB;
    if (l == 1 && pos < CTXL) continue;
    const uint4 vf = *(const uint4*)(YF + (size_t)row * 512 + c0);
    const uint4 vb = *(const uint4*)(YB + (size_t)row * 512 + c0);
    const uint4 vx = *(const uint4*)(XBCA + (size_t)row * 1024 + c0);
    const uint4 vz = *(const uint4*)(PZ + (size_t)row * 512 + c0);
    const u32 af_[4] = {vf.x, vf.y, vf.z, vf.w}, ab_[4] = {vb.x, vb.y, vb.z, vb.w};
    const u32 ax_[4] = {vx.x, vx.y, vx.z, vx.w}, az_[4] = {vz.x, vz.y, vz.z, vz.w};
    float y[8];
    float ss = 0.f;
#pragma unroll
    for (int i = 0; i < 4; ++i) {
      const float y0 = bflo(af_[i]) + bflo(ab_[i]) + dsk * bflo(ax_[i]);
      const float y1 = bfhi(af_[i]) + bfhi(ab_[i]) + dsk * bfhi(ax_[i]);
      y[2 * i] = y0 * silu_f(bflo(az_[i]));
      y[2 * i + 1] = y1 * silu_f(bfhi(az_[i]));
      ss += y[2 * i] * y[2 * i] + y[2 * i + 1] * y[2 * i + 1];
    }
#pragma unroll
    for (int o = 16; o >= 1; o >>= 1) ss += __shfl_xor(ss, o);
    const float rs = rsqrtf(ss * (1.f / 256.f) + EPSF);
    float o8[8];
#pragma unroll
    for (int i = 0; i < 8; ++i) o8[i] = y[i] * rs * ng[c0 + i];
    uint4 o = {pack2(o8[0], o8[1]), pack2(o8[2], o8[3]), pack2(o8[4], o8[5]), pack2(o8[6], o8[7])};
    *(uint4*)&YM[(size_t)row * 1024 + 256 + c0] = o;
  }
}

DI void phase_outproj(const Params& p, int l, int bid, int nblk, char* smem) {
  const u16* A = WSP(const u16, OFF_ACT);
  const u16* B = WSP(const u16, OFF_WOUT) + (size_t)l * 1024 * 1024;
  const float* MOD = WSP(const float, OFF_MOD);
  const Params pp = p;
  auto af = [=](int m, int k) { return A + (size_t)m * 1024 + k; };
  auto bfn = [=](int n, int k) { return B + (size_t)n * 1024 + k; };
  auto ef = [=](int m, int n, float v0, float v1, float v2, float v3) {
    const int b = m / TPB, pos = m % TPB;
    const float4 ga = *(const float4*)&MOD[(size_t)(l * 17 + (pos < CTXL ? 16 : b)) * 6144 + 2048 + n];
    const float4 xo = *(const float4*)(xrow_ptr(pp, l == 0, b, pos) + n);
    const float4 o = {xo.x + ga.x * v0, xo.y + ga.y * v1, xo.z + ga.z * v2, xo.w + ga.w * v3};
    *(float4*)(xrow_wptr(pp, b, pos) + n) = o;
  };
  const int ntile = (ROWS / 128) * 8;
  const int vb = (nblk % 8 == 0) ? (bid & 7) * (nblk >> 3) + (bid >> 3) : bid;
  for (int t = vb; t < ntile; t += nblk) {
    const int mt = t >> 3, nt = t & 7;
    if (l == 1 && (mt % 18) < 2) continue;
    gemm_tile<true, 2>(af, bfn, ef, mt * 128, nt * 128, 1024, smem);
  }
}

DI void phase_q(const Params& p, int l, int bid, int nblk, char* smem) {
  const u16* A = WSP(const u16, OFF_ACT);
  const u16* B = WSP(const u16, OFF_WQ) + (size_t)l * 2048 * 1024;
  u16* Q = WSP(u16, OFF_Q);
  auto af = [=](int m, int k) { return A + (size_t)m * 1024 + k; };
  auto bfn = [=](int n, int k) { return B + (size_t)n * 1024 + k; };
  auto ef = [=](int m, int n, float v0, float v1, float v2, float v3) {
    const uint2 o = {pack2(v0, v1), pack2(v2, v3)};
    *(uint2*)&Q[(size_t)m * 2048 + n] = o;
  };
  const int ntile = (ROWS / 256) * 16;
  const int vb = (nblk % 8 == 0) ? (bid & 7) * (nblk >> 3) + (bid >> 3) : bid;
  for (int t = vb; t < ntile; t += nblk) {
    const int mt = t >> 4, nt = t & 15;
    if (l == 1 && (mt % 9) < 1) continue;
    gemm_tile<true, 4>(af, bfn, ef, mt * 256, nt * 128, 1024, smem);
  }
}

DI void phase_topk(const Params& p, int l, int bid, int nblk, char* smem) {
  const int tid = TID(), lane = tid & 63, w = tid >> 6, l32 = lane & 31, h = lane >> 5;
  u16* qs = (u16*)smem;
  float* sc = (float*)(smem + 64 * 136 * 2);
  const u16* Q = WSP(const u16, OFF_Q);
  float* TV = WSP(float, OFF_TV);
  int* TI = WSP(int, OFF_TI);
  for (int it = bid; it < (ROWS / 64) * 16; it += nblk) {
    const int hh = it & 15, rt = it >> 4;
    if (l == 1 && (rt % 36) < 4) continue;
    const int row0 = rt * 64;
#pragma unroll
    for (int i = 0; i < 4; ++i) {
      const int q = tid + 256 * i, r = q >> 4, ch = q & 15;
      *(uint4*)&qs[r * 136 + ch * 8] = *(const uint4*)&Q[(size_t)(row0 + r) * 2048 + hh * 128 + ch * 8];
    }
    __syncthreads();
    const u16* kb = WSP(const u16, OFF_K12) + (size_t)(l * 2 + (hh & 1)) * 16384;
    f32x16 acc[2];
#pragma unroll
    for (int i = 0; i < 2; ++i)
#pragma unroll
      for (int r = 0; r < 16; ++r) acc[i][r] = 0.f;
#pragma unroll
    for (int ks = 0; ks < 8; ++ks) {
      const bf16x8 bq = *(const bf16x8*)&kb[(w * 32 + l32) * 128 + ks * 16 + h * 8];
      const bf16x8 a0 = *(const bf16x8*)&qs[(l32) * 136 + ks * 16 + h * 8];
      const bf16x8 a1 = *(const bf16x8*)&qs[(32 + l32) * 136 + ks * 16 + h * 8];
      acc[0] = __builtin_amdgcn_mfma_f32_32x32x16_bf16(a0, bq, acc[0], 0, 0, 0);
      acc[1] = __builtin_amdgcn_mfma_f32_32x32x16_bf16(a1, bq, acc[1], 0, 0, 0);
    }
#pragma unroll
    for (int mt = 0; mt < 2; ++mt)
#pragma unroll
      for (int i = 0; i < 16; ++i) {
        const int r = mt * 32 + (i & 3) + 8 * (i >> 2) + 4 * h;
        sc[r * 133 + w * 33 + l32] = acc[mt][i];
      }
    __syncthreads();
    {
      const int r = tid >> 2, part = tid & 3;
      u32 key[32];
#pragma unroll
      for (int j = 0; j < 32; ++j) {
        const u32 u = __float_as_uint(sc[r * 133 + part * 33 + j]);
        const u32 ord = (u & 0x80000000u) ? ~u : (u | 0x80000000u);
        key[j] = (ord & ~127u) | (u32)(127 - (part * 32 + j));
      }
      float* tv = TV + ((size_t)(row0 + r) * 16 + hh) * 16;
      int* ti = TI + ((size_t)(row0 + r) * 16 + hh) * 16;
      u32 prev = 0xFFFFFFFFu;
#pragma unroll
      for (int rd = 0; rd < 16; ++rd) {
        u32 m = 0u;
#pragma unroll
        for (int j = 0; j < 32; ++j) { const u32 d = key[j] - prev; m = d > m ? d : m; }
        { const u32 o = (u32)__shfl_xor((int)m, 1); m = o > m ? o : m; }
        { const u32 o = (u32)__shfl_xor((int)m, 2); m = o > m ? o : m; }
        const u32 best = prev + m;
        prev = best;
        if (part == 0) {
          const u32 ordv = best & ~127u;
          const u32 uu = (ordv & 0x80000000u) ? (ordv & 0x7FFFFFFFu) : ~ordv;
          tv[rd] = __uint_as_float(uu);
          ti[rd] = 127 - (int)(best & 127u);
        }
      }
    }
    __syncthreads();
  }
}

DI void phase_peer(const Params& p, int l, int bid, int nblk) {
  const int w = TID() >> 6;
  const float* TV = WSP(const float, OFF_TV);
  const int* TI = WSP(const int, OFF_TI);
  const u16* H2 = WSP(const u16, OFF_ACT);
  const unsigned char* UB = WSP(const unsigned char, OFF_XBCA);
  const unsigned char* VB = UB + (size_t)16384 * 1024;
  const float* gfin = p.in[I_GF];
  for (int row = bid * 4 + w; row < ROWS; row += nblk * 4) {
    const int b = row / TPB, pos = row % TPB;
    if (l == 1 && pos < CTXL) continue;
    const int lane = TID() & 63;
    const int head = lane >> 3, sub = lane & 7;
    const float* tv1 = TV + ((size_t)row * 16 + head * 2) * 16;
    const float* tv2 = tv1 + 16;
    const int* ti1 = TI + ((size_t)row * 16 + head * 2) * 16;
    const int* ti2 = ti1 + 16;
    u32 ck[7];
#pragma unroll
    for (int s = 0; s < 7; ++s) {
      const int c = sub + 8 * s;
      if (c < 50) {
        const u32 u = __float_as_uint(tv1[CAND_A[c]] + tv2[CAND_B[c]]);
        const u32 ord = (u & 0x80000000u) ? ~u : (u | 0x80000000u);
        ck[s] = (ord & ~63u) | (u32)(63 - c);
      } else ck[s] = 0u;
    }
    float w0v = 0.f, w1v = 0.f, mx = 0.f;
    int w0c = 0, w1c = 0;
    u32 prevk = 0xFFFFFFFFu;
#pragma unroll
    for (int r = 0; r < 16; ++r) {
      u32 m = 0u;
#pragma unroll
      for (int s = 0; s < 7; ++s) { const u32 d = ck[s] - prevk; m = d > m ? d : m; }
#pragma unroll
      for (int o = 1; o <= 4; o <<= 1) { const u32 ov = (u32)__shfl_xor((int)m, o); m = ov > m ? ov : m; }
      const u32 best = prevk + m;
      prevk = best;
      const u32 ordv = best & ~63u;
      const float bv = __uint_as_float((ordv & 0x80000000u) ? (ordv & 0x7FFFFFFFu) : ~ordv);
      const int bc = 63 - (int)(best & 63u);
      if (r == 0) mx = bv;
      if (sub == (r & 7)) {
        if (r < 8) { w0v = bv; w0c = bc; } else { w1v = bv; w1c = bc; }
      }
    }
    const float e0 = expf(w0v - mx), e1 = expf(w1v - mx);
    float es = e0 + e1;
#pragma unroll
    for (int o = 1; o <= 4; o <<= 1) es += __shfl_xor(es, o);
    const float g0 = e0 / es, g1 = e1 / es;
    const int idx0 = ti1[CAND_A[w0c]] * 128 + ti2[CAND_B[w0c]];
    const int idx1 = ti1[CAND_A[w1c]] * 128 + ti2[CAND_B[w1c]];
    const u16* hrow = H2 + (size_t)row * 1024;
    float hv[16];
    {
      const uint4 ha = *(const uint4*)(hrow + lane * 16), hb = *(const uint4*)(hrow + lane * 16 + 8);
      hv[0] = bflo(ha.x); hv[1] = bfhi(ha.x); hv[2] = bflo(ha.y); hv[3] = bfhi(ha.y);
      hv[4] = bflo(ha.z); hv[5] = bfhi(ha.z); hv[6] = bflo(ha.w); hv[7] = bfhi(ha.w);
      hv[8] = bflo(hb.x); hv[9] = bfhi(hb.x); hv[10] = bflo(hb.y); hv[11] = bfhi(hb.y);
      hv[12] = bflo(hb.z); hv[13] = bfhi(hb.z); hv[14] = bflo(hb.w); hv[15] = bfhi(hb.w);
    }
    float acc[16];
#pragma unroll 1
    for (int prep_ = 0; prep_ < PEER_REPS; ++prep_) {
    const bool b0 = lane & 1, b1 = lane & 2, b2 = lane & 4;
    float act0 = 0.f, act1 = 0.f;
    u32x4 rb[2][8];
#define PEER_LOAD(buf, k, TAB)                                                                     \
  _Pragma("unroll") for (int j = 0; j < 8; ++j) {                                                  \
    const int e = (k) * 8 + j;                                                                     \
    const int id = __builtin_amdgcn_readlane(((k) < 8) ? idx0 : idx1, e & 63);                     \
    rb[buf][j] = *(const u32x4*)(TAB + (size_t)id * 1024 + lane * 16);                             \
  }
#define PEER_DOT(buf, k)                                                                           \
  {                                                                                                \
    float d[8];                                                                                    \
    _Pragma("unroll") for (int j = 0; j < 8; ++j) {                                                \
      const u32 uw[4] = {rb[buf][j][0], rb[buf][j][1], rb[buf][j][2], rb[buf][j][3]};              \
      float sd = 0.f;                                                                              \
      _Pragma("unroll") for (int q = 0; q < 4; ++q) {                                              \
        const f32x2 lo = __builtin_amdgcn_cvt_pk_f32_fp8((int)uw[q], false);                       \
        const f32x2 hi = __builtin_amdgcn_cvt_pk_f32_fp8((int)uw[q], true);                        \
        sd += hv[q * 4 + 0] * lo.x + hv[q * 4 + 1] * lo.y + hv[q * 4 + 2] * hi.x + hv[q * 4 + 3] * hi.y; \
      }                                                                                            \
      d[j] = sd;                                                                                   \
    }                                                                                              \
    float a4[4];                                                                                   \
    _Pragma("unroll") for (int q = 0; q < 4; ++q) {                                                \
      const float keep = b0 ? d[2 * q + 1] : d[2 * q], send = b0 ? d[2 * q] : d[2 * q + 1];        \
      a4[q] = keep + __shfl_xor(send, 1);                                                          \
    }                                                                                              \
    float a2[2];                                                                                   \
    _Pragma("unroll") for (int q = 0; q < 2; ++q) {                                                \
      const float keep = b1 ? a4[2 * q + 1] : a4[2 * q], send = b1 ? a4[2 * q] : a4[2 * q + 1];    \
      a2[q] = keep + __shfl_xor(send, 2);                                                          \
    }                                                                                              \
    const float keep = b2 ? a2[1] : a2[0], send = b2 ? a2[0] : a2[1];                              \
    float c1 = keep + __shfl_xor(send, 4);                                                         \
    c1 += __shfl_xor(c1, 8);                                                                       \
    c1 += __shfl_xor(c1, 16);                                                                      \
    c1 += __shfl_xor(c1, 32);                                                                      \
    if ((lane >> 3) == ((k) & 7)) { if ((k) < 8) act0 = c1; else act1 = c1; }                      \
  }
    PEER_LOAD(0, 0, UB)
#pragma unroll 1
    for (int k = 0; k < 16; k += 2) {
      PEER_LOAD(1, k + 1, UB)
      __builtin_amdgcn_sched_barrier(0);
      PEER_DOT(0, k)
      { const int kn = (k + 2 < 16) ? k + 2 : 15; PEER_LOAD(0, kn, UB) }
      __builtin_amdgcn_sched_barrier(0);
      PEER_DOT(1, k + 1)
    }
    const float ga0 = gelu_tanh(act0 * (1.f / U_SCALE)) * g0 * (1.f / V_SCALE);
    const float ga1 = gelu_tanh(act1 * (1.f / U_SCALE)) * g1 * (1.f / V_SCALE);
#pragma unroll
    for (int i = 0; i < 16; ++i) acc[i] = 0.f;
#define PEER_ACC(buf, k)                                                                           \
  _Pragma("unroll") for (int j = 0; j < 8; ++j) {                                                  \
    const int e = (k) * 8 + j;                                                                     \
    const int ai = __builtin_amdgcn_readlane(__builtin_bit_cast(int, ((k) < 8) ? ga0 : ga1), e & 63); \
    const float a = __builtin_bit_cast(float, ai);                                                 \
    const u32 vw[4] = {rb[buf][j][0], rb[buf][j][1], rb[buf][j][2], rb[buf][j][3]};                \
    _Pragma("unroll") for (int q = 0; q < 4; ++q) {                                                \
      const f32x2 lo = __builtin_amdgcn_cvt_pk_f32_fp8((int)vw[q], false);                         \
      const f32x2 hi = __builtin_amdgcn_cvt_pk_f32_fp8((int)vw[q], true);                          \
      acc[q * 4 + 0] += a * lo.x; acc[q * 4 + 1] += a * lo.y; acc[q * 4 + 2] += a * hi.x; acc[q * 4 + 3] += a * hi.y; \
    }                                                                                              \
  }
    PEER_LOAD(0, 0, VB)
#pragma unroll 1
    for (int k = 0; k < 16; k += 2) {
      PEER_LOAD(1, k + 1, VB)
      __builtin_amdgcn_sched_barrier(0);
      PEER_ACC(0, k)
      { const int kn = (k + 2 < 16) ? k + 2 : 15; PEER_LOAD(0, kn, VB) }
      __builtin_amdgcn_sched_barrier(0);
      PEER_ACC(1, k + 1)
    }
#undef PEER_LOAD
#undef PEER_DOT
#undef PEER_ACC
      if (prep_ + 1 < PEER_REPS) { _Pragma("unroll") for (int i = 0; i < 16; ++i) asm volatile("" :: "v"(acc[i])); }
    }
    int row2 = row;
    asm volatile("" : "+v"(row2));
    const int lane2 = TID() & 63;
    const int b2 = row2 / TPB, pos2 = row2 % TPB;
    const float* xr = xrow_ptr(p, false, b2, pos2);
    float* xw = xrow_wptr(p, b2, pos2);
    const float* ga = WSP(const float, OFF_MOD) + (size_t)(l * 17 + (pos2 < CTXL ? 16 : b2)) * 6144 + 5120;
    float xn[16];
    float ss = 0.f;
#pragma unroll
    for (int q = 0; q < 4; ++q) {
      const float4 xv = *(const float4*)(xr + lane2 * 16 + q * 4);
      const float4 gv = *(const float4*)(ga + lane2 * 16 + q * 4);
      xn[q * 4 + 0] = xv.x + gv.x * acc[q * 4 + 0];
      xn[q * 4 + 1] = xv.y + gv.y * acc[q * 4 + 1];
      xn[q * 4 + 2] = xv.z + gv.z * acc[q * 4 + 2];
      xn[q * 4 + 3] = xv.w + gv.w * acc[q * 4 + 3];
    }
    if (l == 1) {
#pragma unroll
      for (int i = 0; i < 16; ++i) ss += xn[i] * xn[i];
      ss = wave_sum(ss);
      const float rs = rsqrtf(ss * (1.f / 1024.f) + EPSF);
#pragma unroll
      for (int i = 0; i < 16; ++i) xn[i] = xn[i] * rs * gfin[lane2 * 16 + i];
    }
#pragma unroll
    for (int q = 0; q < 4; ++q) {
      float4 o = {xn[q * 4 + 0], xn[q * 4 + 1], xn[q * 4 + 2], xn[q * 4 + 3]};
      *(float4*)(xw + lane2 * 16 + q * 4) = o;
    }
  }
}

template <int S>
DI void run_stage(const Params& p, int l, int bid, int nblk, char* smem) {
  for (int rep = 0; rep < 1 + ((REP_MASK >> (S + 1)) & 1); ++rep) {
  if (S == 0) { if (PH_MASK & 2) phase_norm(p, l, 0, bid, nblk); }
  else if (S == 1) { if (PH_MASK & 4) phase_inproj(p, l, bid, nblk, smem); }
  else if (S == 2) { if (PH_MASK & 8) phase_prep(p, l, bid, nblk, smem); }
  else if (S == 3) { if (PH_MASK & 16) phase_mixers(p, l, bid, nblk, smem, rep); }
  else if (S == 4) { if (PH_MASK & 32) phase_ssd_combine(p, l, bid, nblk); }
  else if (S == 5) { if (PH_MASK & 64) phase_outproj(p, l, bid, nblk, smem); }
  else if (S == 6) { if (PH_MASK & 128) { phase_norm(p, l, 1, bid, nblk); phase_tables(p, l, bid, nblk); } }
  else if (S == 7) { if (PH_MASK & 256) phase_q(p, l, bid, nblk, smem); }
  else if (S == 8) { if (PH_MASK & 512) phase_topk(p, l, bid, nblk, smem); }
  else { if (PH_MASK & 1024) phase_peer(p, l, bid, nblk); }
  }
}

#if ONE_LAUNCH
__global__ void __launch_bounds__(NTHR, 2) mega(Params p) {
  extern __shared__ __attribute__((aligned(16))) char smem[];
  const int bid = blockIdx.x, nblk = gridDim.x;
  cg::grid_group grid = cg::this_grid();
  volatile LAS unsigned* bst = (volatile LAS unsigned*)(smem + LDS_BYTES - 32);
  if (threadIdx.x == 0) { bst[0] = 0u; bst[1] = 0u; }
  __syncthreads();
  const XcdBarrier bar = xcd_barrier_post(WSP(unsigned, OFF_BAR), bst);
  for (int rep = 0; rep < 1 + (REP_MASK & 1); ++rep) { if (PH_MASK & 1) phase_prologue(p, bid, nblk, smem); }
  grid.sync();
#define GBAR() xcd_barrier(bar)
#pragma nounroll
  for (int l = 0; l < 2; ++l) {
    for (int xs = 0; xs < EXTRA_SYNCS; ++xs) GBAR();
    run_stage<0>(p, l, bid, nblk, smem); GBAR();
    run_stage<1>(p, l, bid, nblk, smem); GBAR();
    run_stage<2>(p, l, bid, nblk, smem); GBAR();
    run_stage<3>(p, l, bid, nblk, smem); GBAR();
    run_stage<4>(p, l, bid, nblk, smem); GBAR();
    run_stage<5>(p, l, bid, nblk, smem); GBAR();
    run_stage<6>(p, l, bid, nblk, smem); GBAR();
    run_stage<7>(p, l, bid, nblk, smem); GBAR();
    run_stage<8>(p, l, bid, nblk, smem); GBAR();
    run_stage<9>(p, l, bid, nblk, smem);
    if (l == 0) GBAR();
  }
}
#else
template <int S>
__global__ void __launch_bounds__(NTHR, 2) stage_kernel(Params p, int l) {
  extern __shared__ __attribute__((aligned(16))) char smem[];
  if (S < 0) phase_prologue(p, blockIdx.x, gridDim.x, smem);
  else run_stage<(S < 0 ? 0 : S)>(p, l, blockIdx.x, gridDim.x, smem);
}

template <int S>
static void launch_stage(const Params& p, int l, int grid, hipStream_t stream) {
  (void)hipFuncSetAttribute((const void*)stage_kernel<S>, hipFuncAttributeMaxDynamicSharedMemorySize, LDS_BYTES);
  hipLaunchKernelGGL(stage_kernel<S>, dim3(grid), dim3(NTHR), LDS_BYTES, stream, p, l);
}

#endif

extern "C" void kernel_launch(void* const* d_in, const int* in_sizes, int n_in, void* d_out, int out_size, void* d_ws,
                              size_t ws_size, hipStream_t stream) {
  static int grid = 0;
  if (grid == 0) {
    if (ws_size < WS_END || n_in != 31) { fprintf(stderr, "kernel_launch: ws %zu < %zu or n_in %d\n", ws_size, (size_t)WS_END, n_in); grid = -1; return; }
    int dev = 0, cus = 0, per_cu = 0;
    (void)hipGetDevice(&dev);
    (void)hipDeviceGetAttribute(&cus, hipDeviceAttributeMultiprocessorCount, dev);
#if ONE_LAUNCH
    (void)hipFuncSetAttribute((const void*)mega, hipFuncAttributeMaxDynamicSharedMemorySize, LDS_BYTES);
    (void)hipOccupancyMaxActiveBlocksPerMultiprocessor(&per_cu, (const void*)mega, NTHR, LDS_BYTES);
#else
    (void)hipFuncSetAttribute((const void*)stage_kernel<3>, hipFuncAttributeMaxDynamicSharedMemorySize, LDS_BYTES);
    (void)hipOccupancyMaxActiveBlocksPerMultiprocessor(&per_cu, (const void*)stage_kernel<3>, NTHR, LDS_BYTES);
#endif
    if (per_cu < 1) per_cu = 1;
    if (per_cu > 2) per_cu = 2;
    grid = cus * per_cu;
  }
  if (grid < 0) return;
  (void)hipMemsetAsync((char*)d_ws + OFF_CTR, 0, 256 + 3456 * 4, stream);
  Params p{};
  for (int i = 0; i < 31; ++i) p.in[i] = (const float*)d_in[i];
  p.out = (float*)d_out;
  p.ws = (unsigned char*)d_ws;
#if ONE_LAUNCH
  void* args[] = {&p};
  hipError_t e = hipLaunchCooperativeKernel((const void*)mega, dim3(grid), dim3(NTHR), args, LDS_BYTES, stream);
  if (e != hipSuccess) fprintf(stderr, "cooperative launch failed: %s (grid %d)\n", hipGetErrorString(e), grid);
#else
  launch_stage<-1>(p, 0, grid, stream);
  for (int l = 0; l < 2; ++l) {
    launch_stage<0>(p, l, grid, stream);
    launch_stage<1>(p, l, grid, stream);
    launch_stage<2>(p, l, grid, stream);
    launch_stage<3>(p, l, grid, stream);
    launch_stage<4>(p, l, grid, stream);
    launch_stage<5>(p, l, grid, stream);
    launch_stage<6>(p, l, grid, stream);
    launch_stage<7>(p, l, grid, stream);
    launch_stage<8>(p, l, grid, stream);
    launch_stage<9>(p, l, grid, stream);
  }
#endif
}
```

```cpp
#include <hip/hip_runtime.h>
#include <hip/hip_cooperative_groups.h>
#include <cstdio>
namespace cg = cooperative_groups;

#ifndef PH_MASK
#define PH_MASK 0xFFFF
#endif
#ifndef PEER_REPS
#define PEER_REPS 1
#endif
#ifndef EXTRA_SYNCS
#define EXTRA_SYNCS 0
#endif
#ifndef REP_MASK
#define REP_MASK 0
#endif
#ifndef ONE_LAUNCH
#define ONE_LAUNCH 1
#endif

typedef unsigned short u16;
typedef unsigned int u32;
typedef __attribute__((ext_vector_type(8))) short bf16x8;
typedef __attribute__((ext_vector_type(16))) float f32x16;
typedef __attribute__((ext_vector_type(4))) float f32x4;
typedef __attribute__((ext_vector_type(2))) float f32x2;
typedef __attribute__((ext_vector_type(4))) unsigned int u32x4;
#define DI __device__ __forceinline__
DI int TID() { int t = threadIdx.x; asm volatile("" : "+v"(t)); return t; }

DI u16 f2bf(float x) { u32 u = __float_as_uint(x); u += 0x7fffu + ((u >> 16) & 1u); return (u16)(u >> 16); }
DI float bf2f(u16 v) { return __uint_as_float(((u32)v) << 16); }
DI u32 pack2(float a, float b) { return (u32)f2bf(a) | ((u32)f2bf(b) << 16); }
DI float bflo(u32 v) { return __uint_as_float(v << 16); }
DI float bfhi(u32 v) { return __uint_as_float(v & 0xffff0000u); }

constexpr int D = 1024, NB = 16, SEQ = 2048, CTXL = 256, TPB = 2304, ROWS = NB * TPB;
constexpr int NIN = 2944;
constexpr int RSTR = 4112;
constexpr int NTHR = 256;
constexpr int LDS_BYTES = 73728;
constexpr float EPSF = 1e-6f;

constexpr size_t SZ_PHY = (size_t)ROWS * 768 * 2, SZ_PZ = (size_t)ROWS * 512 * 2, SZ_PXBC = (size_t)ROWS * 1024 * 2;
constexpr size_t OFF_PHY = 0;
constexpr size_t OFF_PZ = OFF_PHY + SZ_PHY;
constexpr size_t OFF_PXBC = OFF_PZ + SZ_PZ;
constexpr size_t OFF_Q = OFF_PHY;
constexpr size_t OFF_ACT = OFF_PXBC + SZ_PXBC;
constexpr size_t OFF_XBCA = OFF_ACT + (size_t)ROWS * 1024 * 2;
constexpr size_t OFF_DREG = OFF_XBCA + (size_t)ROWS * 1024 * 2;
constexpr size_t OFF_PQT = OFF_DREG;
constexpr size_t OFF_UT = OFF_PQT + (size_t)NB * 512 * TPB * 2;
constexpr size_t OFF_X1C = OFF_UT + (size_t)256 * 16 * TPB * 2;
constexpr size_t OFF_TV = OFF_DREG;
constexpr size_t OFF_TI = OFF_TV + (size_t)ROWS * 256 * 4;
constexpr size_t OFF_XC = OFF_DREG + (size_t)ROWS * 256 * 8;
constexpr size_t OFF_WIN = OFF_XC + (size_t)NB * CTXL * D * 4;
constexpr size_t OFF_WOUT = OFF_WIN + (size_t)2 * NIN * 1024 * 2;
constexpr size_t OFF_WQ = OFF_WOUT + (size_t)2 * 1024 * 1024 * 2;
constexpr size_t OFF_K12 = OFF_WQ + (size_t)2 * 2048 * 1024 * 2;
constexpr size_t OFF_DFT = OFF_K12 + (size_t)2 * 2 * 128 * 128 * 2;
constexpr size_t OFF_DFTC = OFF_DFT + (size_t)2048 * 4096 * 2;
constexpr size_t OFF_RF = OFF_DFTC + (size_t)256 * 512 * 2;
constexpr size_t OFF_PART = OFF_RF + (size_t)3 * 256 * 2 * RSTR * 2;
constexpr size_t OFF_MOD = OFF_PART + (size_t)3 * 32 * 256 * 4;
constexpr size_t OFF_DT = OFF_MOD + (size_t)2 * 17 * 6144 * 4;
constexpr size_t OFF_CTR = OFF_DT + (size_t)ROWS * 16 * 4;
constexpr size_t OFF_BAR = OFF_CTR + 256;
constexpr size_t OFF_TX = OFF_BAR + 3456 * 4;
constexpr size_t WS_END = OFF_TX + (size_t)NB * 768 * TPB * 2;

struct Params {
  const float* in[31];
  float* out;
  unsigned char* ws;
  int pad0, pad1;
};

enum { I_X = 0, I_C, I_CTX, I_CCTX, I_WADA, I_BADA, I_G1, I_G2, I_WIN, I_HYCW, I_HYCB, I_HFW1, I_HFB1, I_HFW2, I_HFB2,
       I_HFW3, I_HFFREQ, I_HYBIAS, I_SCW, I_SCB, I_SDTB, I_SALOG, I_SD, I_SNG, I_WOUT, I_WQ, I_K1, I_K2, I_PU, I_PV, I_GF };

__device__ const unsigned char CAND_A[56] = {0, 0, 0, 0, 0, 0, 0, 0, 0, 0, 0, 0, 0, 0, 0, 0, 1, 1, 1, 1, 1, 1, 1, 1, 2, 2, 2, 2, 2, 3, 3, 3, 3, 4, 4, 4, 5, 5, 6, 6, 7, 7, 8, 9, 10, 11, 12, 13, 14, 15, 0, 0, 0, 0, 0, 0};
__device__ const unsigned char CAND_B[56] = {0, 1, 2, 3, 4, 5, 6, 7, 8, 9, 10, 11, 12, 13, 14, 15, 0, 1, 2, 3, 4, 5, 6, 7, 0, 1, 2, 3, 4, 0, 1, 2, 3, 0, 1, 2, 0, 1, 0, 1, 0, 1, 0, 0, 0, 0, 0, 0, 0, 0, 0, 0, 0, 0, 0, 0};

#define WSP(T, off) ((T*)(p.ws + (off)))

#define XB_TMO      128
#define XB_XCNT(j)  (256  + 64 * (j))
#define XB_XSUB(j)  (1280 + 64 * (j))
#define XB_XGEN(j)  (2304 + 64 * (j))
#define XB_TOP      3328
#define XB_TOPGEN   3392
#define XCD_BAR_WORDS 3456
#define XB_SPIN_CAP (1u << 18)
#define LAS __attribute__((address_space(3)))
DI unsigned xb_ld(unsigned* p) { return __hip_atomic_load(p, __ATOMIC_RELAXED, __HIP_MEMORY_SCOPE_AGENT); }
DI unsigned xb_add(unsigned* p, unsigned v) { return __hip_atomic_fetch_add(p, v, __ATOMIC_RELAXED, __HIP_MEMORY_SCOPE_AGENT); }
DI unsigned xb_xcc_id() { return (unsigned)__builtin_amdgcn_s_getreg((3 << 11) | 20) & 0xFu; }
#define XB_SPIN(cond, bar) do { unsigned _sp = 0; while (cond) { __builtin_amdgcn_s_sleep(1); \
    if ((++_sp & 255u) == 0u) { if (xb_ld(&(bar)[XB_TMO])) break; if (_sp > XB_SPIN_CAP) { atomicAdd(&(bar)[XB_TMO], 1u); break; } } } } while (0)
struct XcdBarrier { unsigned* bar; unsigned x; volatile LAS unsigned* st; };
DI XcdBarrier xcd_barrier_post(unsigned* bar, volatile LAS unsigned* st) {
  XcdBarrier b; b.bar = bar; b.x = xb_xcc_id(); b.st = st;
  if (threadIdx.x == 0) (void)xb_add(&bar[XB_XCNT(b.x)], 1u);
  return b;
}
DI void xcd_barrier_complete(unsigned* bar, unsigned x, unsigned& nloc, unsigned& nx) {
  const unsigned G = gridDim.x * gridDim.y * gridDim.z;
  unsigned sum, cnt, mine, sp = 0u;
  for (;;) {
    sum = 0u; cnt = 0u; mine = 0u;
#pragma unroll
    for (unsigned j = 0; j < 16; ++j) { const unsigned c = xb_ld(&bar[XB_XCNT(j)]); sum += c; cnt += (c > 0u) ? 1u : 0u; mine = (j == x) ? c : mine; }
    if (sum == G) break;
    __builtin_amdgcn_s_sleep(1);
    if ((++sp & 255u) == 0u) { if (xb_ld(&bar[XB_TMO])) break; if (sp > XB_SPIN_CAP) { atomicAdd(&bar[XB_TMO], 1u); break; } }
  }
  nloc = mine > 0u ? mine : 1u; nx = cnt > 0u ? cnt : 1u;
}
DI void xcd_barrier(const XcdBarrier& b) {
  asm volatile("s_waitcnt vmcnt(0)" ::: "memory");
  __syncthreads();
  if (threadIdx.x == 0) {
    unsigned* bar = b.bar;
    __builtin_amdgcn_s_waitcnt(0);
    unsigned nloc = b.st[0], nx = b.st[1];
    if (nloc == 0u) { xcd_barrier_complete(bar, b.x, nloc, nx); b.st[0] = nloc; b.st[1] = nx; }
    const unsigned old = xb_add(&bar[XB_XSUB(b.x)], 1u);
    const unsigned gen = old / nloc;
    if (old + 1u == (gen + 1u) * nloc) {
      __builtin_amdgcn_fence(__ATOMIC_RELEASE, "agent");
      asm volatile("s_waitcnt vmcnt(0)" ::: "memory");
      const unsigned og = xb_add(&bar[XB_TOP], 1u);
      const unsigned tg = og / nx;
      if (og + 1u == (tg + 1u) * nx) xb_add(&bar[XB_TOPGEN], 1u);
      else XB_SPIN(xb_ld(&bar[XB_TOPGEN]) == tg, bar);
      __builtin_amdgcn_fence(__ATOMIC_ACQUIRE, "agent");
      xb_add(&bar[XB_XGEN(b.x)], 1u);
      asm volatile("s_waitcnt vmcnt(0)" ::: "memory");
    } else {
      XB_SPIN(xb_ld(&bar[XB_XGEN(b.x)]) == gen, bar);
      __builtin_amdgcn_fence(__ATOMIC_ACQUIRE, "agent");
      asm volatile("s_waitcnt vmcnt(0)" ::: "memory");
    }
  }
  __syncthreads();
}


template <bool SWAP, int MI, class AF, class BF, class EF>
DI void gemm_tile(const AF& af, const BF& bfn, const EF& ef, int m0, int n0, int K, char* smem) {
  constexpr int AROWS = MI * 64;
  u16* As = (u16*)smem;
  u16* Bs = As + 2 * AROWS * 40;
  const int tid = TID(), lane = tid & 63, w = tid >> 6;
  const int wm = w >> 1, wn = w & 1, l32 = lane & 31, h = lane >> 5;
  const int lrow = (tid >> 6) * 16 + ((tid >> 5) & 1) * 8 + ((tid >> 2) & 1) * 4 + ((tid >> 3) & 3), lk = (tid & 3) * 8;
  f32x16 acc[MI][2];
#pragma unroll
  for (int i = 0; i < MI; ++i)
#pragma unroll
    for (int j = 0; j < 2; ++j)
#pragma unroll
      for (int r = 0; r < 16; ++r) acc[i][j][r] = 0.f;
  u32x4 ra[MI], rb[2];
  const int nk = K >> 5;
#pragma unroll
  for (int i = 0; i < MI; ++i) ra[i] = *(const u32x4*)af(m0 + lrow + 64 * i, lk);
#pragma unroll
  for (int i = 0; i < 2; ++i) rb[i] = *(const u32x4*)bfn(n0 + lrow + 64 * i, lk);
#pragma unroll
  for (int i = 0; i < MI; ++i) *(u32x4*)&As[(lrow + 64 * i) * 40 + lk] = ra[i];
#pragma unroll
  for (int i = 0; i < 2; ++i) *(u32x4*)&Bs[(lrow + 64 * i) * 40 + lk] = rb[i];
  {
    const int k1 = (nk > 1) ? 32 + lk : lk;
#pragma unroll
    for (int i = 0; i < MI; ++i) ra[i] = *(const u32x4*)af(m0 + lrow + 64 * i, k1);
#pragma unroll
    for (int i = 0; i < 2; ++i) rb[i] = *(const u32x4*)bfn(n0 + lrow + 64 * i, k1);
  }
  __syncthreads();
  for (int kt = 0; kt < nk; ++kt) {
    const int cur = kt & 1;
    const u16* Ab = As + cur * AROWS * 40;
    const u16* Bb = Bs + cur * 128 * 40;
#pragma unroll
    for (int ks = 0; ks < 2; ++ks) {
      bf16x8 a[MI], b[2];
#pragma unroll
      for (int i = 0; i < MI; ++i) a[i] = *(const bf16x8*)&Ab[(wm * (MI * 32) + i * 32 + l32) * 40 + ks * 16 + h * 8];
#pragma unroll
      for (int i = 0; i < 2; ++i) b[i] = *(const bf16x8*)&Bb[(wn * 64 + i * 32 + l32) * 40 + ks * 16 + h * 8];
#pragma unroll
      for (int i = 0; i < MI; ++i)
#pragma unroll
        for (int j = 0; j < 2; ++j)
          acc[i][j] = SWAP ? __builtin_amdgcn_mfma_f32_32x32x16_bf16(b[j], a[i], acc[i][j], 0, 0, 0)
                           : __builtin_amdgcn_mfma_f32_32x32x16_bf16(a[i], b[j], acc[i][j], 0, 0, 0);
    }
    {
      u16* An = As + (cur ^ 1) * AROWS * 40;
      u16* Bn = Bs + (cur ^ 1) * 128 * 40;
#pragma unroll
      for (int i = 0; i < MI; ++i) *(u32x4*)&An[(lrow + 64 * i) * 40 + lk] = ra[i];
#pragma unroll
      for (int i = 0; i < 2; ++i) *(u32x4*)&Bn[(lrow + 64 * i) * 40 + lk] = rb[i];
      const int kn = (kt + 2 < nk) ? kt + 2 : nk - 1;
      const int k0 = kn * 32 + lk;
#pragma unroll
      for (int i = 0; i < MI; ++i) ra[i] = *(const u32x4*)af(m0 + lrow + 64 * i, k0);
#pragma unroll
      for (int i = 0; i < 2; ++i) rb[i] = *(const u32x4*)bfn(n0 + lrow + 64 * i, k0);
    }
    __syncthreads();
  }
#pragma unroll
  for (int i = 0; i < MI; ++i)
#pragma unroll
    for (int j = 0; j < 2; ++j)
#pragma unroll
      for (int rg = 0; rg < 4; ++rg) {
        const int m = SWAP ? (m0 + wm * (MI * 32) + i * 32 + l32) : (m0 + wm * (MI * 32) + i * 32 + rg * 8 + h * 4);
        const int n = SWAP ? (n0 + wn * 64 + j * 32 + rg * 8 + h * 4) : (n0 + wn * 64 + j * 32 + l32);
        ef(m, n, acc[i][j][rg * 4 + 0], acc[i][j][rg * 4 + 1], acc[i][j][rg * 4 + 2], acc[i][j][rg * 4 + 3]);
      }
}

DI float wave_sum(float v) {
#pragma unroll
  for (int o = 32; o >= 1; o >>= 1) v += __shfl_xor(v, o);
  return v;
}
DI float silu_f(float x) { return x / (1.f + __expf(-x)); }
DI float gelu_tanh(float x) {
  const float u = 0.7978845608028654f * (x + 0.044715f * x * x * x);
  return 0.5f * x * (1.f + tanhf(u));
}

DI const float* xrow_ptr(const Params& p, bool from_input, int b, int pos) {
  if (pos < CTXL) return (from_input ? p.in[I_CTX] : WSP(const float, OFF_XC)) + ((size_t)b * CTXL + pos) * D;
  return (from_input ? p.in[I_X] : (const float*)p.out) + ((size_t)b * SEQ + (pos - CTXL)) * D;
}
DI float* xrow_wptr(const Params& p, int b, int pos) {
  if (pos < CTXL) return WSP(float, OFF_XC) + ((size_t)b * CTXL + pos) * D;
  return p.out + ((size_t)b * SEQ + (pos - CTXL)) * D;
}

DI void phase_prologue(const Params& p, int bid, int nblk, char* smem) {
  const int tid = TID();
  const int gtid = bid * NTHR + tid, gn = nblk * NTHR;
  {
    float* scs = (float*)smem;
    for (int it = bid; it < 192; it += nblk) {
      const int l = it / 96, col0 = (it % 96) * 64;
      for (int e = tid; e < 17 * 1024; e += NTHR) {
        const int j = e >> 10, k = e & 1023;
        const float v = (j < 16) ? p.in[I_C][j * 1024 + k] : p.in[I_CCTX][k];
        scs[e] = v / (1.f + expf(-v));
      }
      __syncthreads();
      const int col = tid & 63, kq = tid >> 6;
      float acc[17];
#pragma unroll
      for (int j = 0; j < 17; ++j) acc[j] = 0.f;
      const float* wa = p.in[I_WADA] + (size_t)l * 1024 * 6144 + col0 + col;
      for (int k0 = kq * 256; k0 < kq * 256 + 256; k0 += 8) {
        float wv[8];
#pragma unroll
        for (int kk = 0; kk < 8; ++kk) wv[kk] = wa[(size_t)(k0 + kk) * 6144];
#pragma unroll
        for (int kk = 0; kk < 8; ++kk)
#pragma unroll
          for (int j = 0; j < 17; ++j) acc[j] += scs[j * 1024 + k0 + kk] * wv[kk];
      }
      __syncthreads();
#pragma unroll
      for (int j = 0; j < 17; ++j) scs[(kq * 17 + j) * 64 + col] = acc[j];
      __syncthreads();
      for (int e = tid; e < 17 * 64; e += NTHR) {
        const int j = e >> 6, cc = e & 63;
        float s = p.in[I_BADA][l * 6144 + col0 + cc];
#pragma unroll
        for (int q = 0; q < 4; ++q) s += scs[(q * 17 + j) * 64 + cc];
        WSP(float, OFF_MOD)[(size_t)(l * 17 + j) * 6144 + col0 + cc] = s;
      }
      __syncthreads();
    }
  }
  {
    float* zs = (float*)smem;
    float* h1s = zs + 64 * 33;
    float* h2s = h1s + 64 * 64;
    for (int it = (nblk >= 260 ? (bid >= 192 ? bid - 192 : 1 << 20) : bid); it < 68; it += nblk) {
      const int f = it < 32 ? 0 : (it < 64 ? 1 : 2);
      const int tile = it - (f == 0 ? 0 : (f == 1 ? 32 : 64));
      const int L = (f == 2) ? 256 : 2048;
      const int lyr = (f == 1) ? 1 : 0;
      const int pos0 = tile * 64;
      const float* w1 = p.in[I_HFW1] + lyr * 33 * 64;
      const float* b1 = p.in[I_HFB1] + lyr * 64;
      const float* w2 = p.in[I_HFW2] + lyr * 64 * 64;
      const float* b2 = p.in[I_HFB2] + lyr * 64;
      const float* w3 = p.in[I_HFW3] + lyr * 64 * 512;
      const float* fq = p.in[I_HFFREQ] + lyr * 64;
      for (int e = tid; e < 64 * 33; e += NTHR) {
        const int pi = e / 33, q = e % 33;
        const int pos = pos0 + pi;
        const float tt = (float)pos / (float)(L - 1);
        const float wv = 6.283185307179586f * (float)pos / (float)L;
        float z;
        if (q == 0) z = tt;
        else if (q <= 16) { const float fi = 1e-4f + (float)(q - 1) * ((15.f - 1e-4f) / 15.f); z = cosf(fi * wv); }
        else { const float fi = 1e-4f + (float)(q - 17) * ((15.f - 1e-4f) / 15.f); z = -sinf(fi * wv); }
        zs[e] = z;
      }
      __syncthreads();
      for (int e = tid; e < 64 * 64; e += NTHR) {
        const int pi = e >> 6, j = e & 63;
        float s = b1[j];
        for (int q = 0; q < 33; ++q) s += zs[pi * 33 + q] * w1[q * 64 + j];
        h1s[e] = sinf(fq[j] * s);
      }
      __syncthreads();
      for (int e = tid; e < 64 * 64; e += NTHR) {
        const int pi = e >> 6, j = e & 63;
        float s = b2[j];
        for (int k = 0; k < 64; ++k) s += h1s[pi * 64 + k] * w2[k * 64 + j];
        h2s[e] = sinf(fq[j] * s);
      }
      __syncthreads();
      {
        const int c = tid;
        const float mind = logf(1e-2f) / 1.5f, maxd = logf(1e-2f) / 0.3f;
        const float delta = fabsf(mind + (float)c * ((maxd - mind) / 255.f));
        u16* R0 = WSP(u16, OFF_RF) + ((size_t)(f * 256 + c) * 2 + 0) * RSTR;
        u16* R1 = R0 + RSTR;
        float ssq = 0.f;
        for (int pb = 0; pb < 4; ++pb) {
          float af_[16], ab_[16];
#pragma unroll
          for (int i = 0; i < 16; ++i) { af_[i] = 0.f; ab_[i] = 0.f; }
          for (int k = 0; k < 64; ++k) {
            const float wf = w3[k * 512 + c], wb = w3[k * 512 + 256 + c];
#pragma unroll
            for (int i = 0; i < 16; ++i) {
              const float hv = h2s[(pb * 16 + i) * 64 + k];
              af_[i] += hv * wf;
              ab_[i] += hv * wb;
            }
          }
#pragma unroll
          for (int i = 0; i < 16; ++i) {
            const int pos = pos0 + pb * 16 + i;
            const float tt = (float)pos / (float)(L - 1);
            const float win = expf(-tt * delta);
            const float vf = af_[i] * win, vb = ab_[i] * win;
            const u16 bfv = f2bf(vf), bbv = f2bf(vb);
            R0[L - pos] = bfv;
            R1[L - pos - 1] = bfv;
            ssq += vf * vf;
            if (pos >= 1) {
              R0[L + pos] = bbv;
              R1[L + pos - 1] = bbv;
              ssq += vb * vb;
            }
          }
        }
        WSP(float, OFF_PART)[(size_t)(f * 32 + tile) * 256 + c] = ssq;
      }
      __syncthreads();
    }
  }
  for (int e = gtid; e < 2 * NIN * 128; e += gn) {
    const int l = e / (NIN * 128);
    const int r = e % (NIN * 128);
    const int kc = r / NIN, n = r % NIN;
    const int k0 = kc * 8;
    const float* wsrc = p.in[I_WIN] + (size_t)l * 1024 * 2576;
    float v[8];
    if (n < 2304) {
#pragma unroll
      for (int j = 0; j < 8; ++j) v[j] = wsrc[(size_t)(k0 + j) * 2576 + n];
    } else if (n < 2816) {
      const int np = n - 2304, g = np >> 7, rr = np & 127, pq = rr >> 6, kk = rr & 63;
#pragma unroll
      for (int j = 0; j < 8; ++j) v[j] = 0.f;
      for (int jj = 0; jj < 64; ++jj) {
        const float ang = 6.283185307179586f * (float)((jj * kk) & 63) / 64.f;
        const float tr = pq ? sinf(ang) : cosf(ang);
#pragma unroll
        for (int j = 0; j < 8; ++j) v[j] += wsrc[(size_t)(k0 + j) * 2576 + 2320 + g * 64 + jj] * tr;
      }
    } else if (n < 2832) {
#pragma unroll
      for (int j = 0; j < 8; ++j) v[j] = wsrc[(size_t)(k0 + j) * 2576 + 2304 + (n - 2816)];
    } else {
#pragma unroll
      for (int j = 0; j < 8; ++j) v[j] = 0.f;
    }
    uint4 o = {pack2(v[0], v[1]), pack2(v[2], v[3]), pack2(v[4], v[5]), pack2(v[6], v[7])};
    *(uint4*)&WSP(u16, OFF_WIN)[((size_t)l * NIN + n) * 1024 + k0] = o;
  }
  for (int e = gtid; e < 2 * 1024 * 128; e += gn) {
    const int l = e / (1024 * 128), r = e % (1024 * 128), kc = r / 1024, n = r % 1024, k0 = kc * 8;
    const float* wsrc = p.in[I_WOUT] + (size_t)l * 1024 * 1024;
    float v[8];
#pragma unroll
    for (int j = 0; j < 8; ++j) v[j] = wsrc[(size_t)(k0 + j) * 1024 + n];
    uint4 o = {pack2(v[0], v[1]), pack2(v[2], v[3]), pack2(v[4], v[5]), pack2(v[6], v[7])};
    *(uint4*)&WSP(u16, OFF_WOUT)[((size_t)l * 1024 + n) * 1024 + k0] = o;
  }
  for (int e = gtid; e < 2 * 2048 * 128; e += gn) {
    const int l = e / (2048 * 128), r = e % (2048 * 128), kc = r / 2048, n = r % 2048, k0 = kc * 8;
    const float* wsrc = p.in[I_WQ] + (size_t)l * 1024 * 2048;
    float v[8];
#pragma unroll
    for (int j = 0; j < 8; ++j) v[j] = wsrc[(size_t)(k0 + j) * 2048 + n];
    uint4 o = {pack2(v[0], v[1]), pack2(v[2], v[3]), pack2(v[4], v[5]), pack2(v[6], v[7])};
    *(uint4*)&WSP(u16, OFF_WQ)[((size_t)l * 2048 + n) * 1024 + k0] = o;
  }
  for (int e = gtid; e < 2 * 2 * 128 * 128; e += gn) {
    const int l = e / (2 * 16384), r = e % (2 * 16384), which = r / 16384, i = r % 16384;
    const float v = (which ? p.in[I_K2] : p.in[I_K1])[l * 16384 + i];
    WSP(u16, OFF_K12)[e] = f2bf(v);
  }
  for (int e = gtid; e < 2048 * 512; e += gn) {
    const int tp = e >> 9, k0 = (e & 511) * 8;
    const float s = 1.f / sqrtf(2048.f * 64.f);
    float v[8];
#pragma unroll
    for (int j = 0; j < 8; ++j) {
      const int k = k0 + j, t = k & 2047;
      const float ang = 6.283185307179586f * (float)((tp * t) & 2047) / 2048.f;
      v[j] = (k < 2048) ? cosf(ang) * s : -sinf(ang) * s;
    }
    uint4 o = {pack2(v[0], v[1]), pack2(v[2], v[3]), pack2(v[4], v[5]), pack2(v[6], v[7])};
    *(uint4*)&WSP(u16, OFF_DFT)[(size_t)tp * 4096 + k0] = o;
  }
  for (int e = gtid; e < 256 * 64; e += gn) {
    const int tp = e >> 6, k0 = (e & 63) * 8;
    const float s = 1.f / sqrtf(256.f * 64.f);
    float v[8];
#pragma unroll
    for (int j = 0; j < 8; ++j) {
      const int k = k0 + j, t = k & 255;
      const float ang = 6.283185307179586f * (float)((tp * t) & 255) / 256.f;
      v[j] = (k < 256) ? cosf(ang) * s : -sinf(ang) * s;
    }
    uint4 o = {pack2(v[0], v[1]), pack2(v[2], v[3]), pack2(v[4], v[5]), pack2(v[6], v[7])};
    *(uint4*)&WSP(u16, OFF_DFTC)[(size_t)tp * 512 + k0] = o;
  }
}

DI void phase_norm(const Params& p, int l, int which, int bid, int nblk) {
  const int lane = TID() & 63, w = TID() >> 6;
  const float* g = (which ? p.in[I_G2] : p.in[I_G1]) + l * 1024;
  const bool from_input = (which == 0 && l == 0);
  for (int row = bid * 4 + w; row < ROWS; row += nblk * 4) {
    const int b = row / TPB, pos = row % TPB;
    if (which == 1 && l == 1 && pos < CTXL) continue;
    const float* xr = xrow_ptr(p, from_input, b, pos);
    const float* mod = WSP(const float, OFF_MOD) + (size_t)(l * 17 + (pos < CTXL ? 16 : b)) * 6144 + which * 3072;
    float x[16];
#pragma unroll
    for (int hh = 0; hh < 2; ++hh) {
      const float4 a = *(const float4*)(xr + hh * 512 + lane * 8);
      const float4 c = *(const float4*)(xr + hh * 512 + lane * 8 + 4);
      x[hh * 8 + 0] = a.x; x[hh * 8 + 1] = a.y; x[hh * 8 + 2] = a.z; x[hh * 8 + 3] = a.w;
      x[hh * 8 + 4] = c.x; x[hh * 8 + 5] = c.y; x[hh * 8 + 6] = c.z; x[hh * 8 + 7] = c.w;
    }
    float ss = 0.f;
#pragma unroll
    for (int i = 0; i < 16; ++i) ss += x[i] * x[i];
    ss = wave_sum(ss);
    const float rs = rsqrtf(ss * (1.f / 1024.f) + EPSF);
#pragma unroll
    for (int hh = 0; hh < 2; ++hh) {
      const int c0 = hh * 512 + lane * 8;
      float y[8];
#pragma unroll
      for (int i = 0; i < 8; ++i) {
        const float yn = x[hh * 8 + i] * rs * g[c0 + i];
        y[i] = yn * (1.f + mod[1024 + c0 + i]) + mod[c0 + i];
      }
      uint4 o = {pack2(y[0], y[1]), pack2(y[2], y[3]), pack2(y[4], y[5]), pack2(y[6], y[7])};
      *(uint4*)&WSP(u16, OFF_ACT)[(size_t)row * 1024 + c0] = o;
    }
  }
}

constexpr float U_SCALE = 64.f, V_SCALE = 4.f;
DI void phase_tables(const Params& p, int l, int bid, int nblk) {
  const int gtid = bid * NTHR + TID(), gn = nblk * NTHR;
  unsigned char* dst = WSP(unsigned char, OFF_XBCA);
  for (int e = gtid; e < 2 * 16384 * 64; e += gn) {
    const int which = e / (16384 * 64), r = e % (16384 * 64);
    const float sc = which ? V_SCALE : U_SCALE;
    const float* src = (which ? p.in[I_PV] : p.in[I_PU]) + (size_t)l * 16384 * 1024 + (size_t)r * 16;
    u32 o[4];
#pragma unroll
    for (int q = 0; q < 4; ++q) {
      const float4 a = *(const float4*)(src + q * 4);
      int v = __builtin_amdgcn_cvt_pk_fp8_f32(a.x * sc, a.y * sc, 0, false);
      v = __builtin_amdgcn_cvt_pk_fp8_f32(a.z * sc, a.w * sc, v, true);
      o[q] = (u32)v;
    }
    uint4 ov = {o[0], o[1], o[2], o[3]};
    *(uint4*)&dst[(size_t)e * 16] = ov;
  }
}

DI void phase_inproj(const Params& p, int l, int bid, int nblk, char* smem) {
  const u16* A = WSP(const u16, OFF_ACT);
  const u16* B = WSP(const u16, OFF_WIN) + (size_t)l * NIN * 1024;
  u16* PHY = WSP(u16, OFF_PHY);
  u16* PZ = WSP(u16, OFF_PZ);
  u16* PXBC = WSP(u16, OFF_PXBC);
  u16* PQT = WSP(u16, OFF_PQT);
  float* DT = WSP(float, OFF_DT);
  auto af = [=](int m, int k) { return A + (size_t)m * 1024 + k; };
  auto bfn = [=](int n, int k) { return B + (size_t)n * 1024 + k; };
  auto efT = [=](int m, int n, float v0, float v1, float v2, float v3) {
    const uint2 o = {pack2(v0, v1), pack2(v2, v3)};
    if (n < 768) *(uint2*)&PHY[(size_t)m * 768 + n] = o;
    else if (n < 1280) *(uint2*)&PZ[(size_t)m * 512 + (n - 768)] = o;
    else if (n < 2304) *(uint2*)&PXBC[(size_t)m * 1024 + (n - 1280)] = o;
    else if (n >= 2816 && n < 2832) { float4 f = {v0, v1, v2, v3}; *(float4*)&DT[(size_t)m * 16 + (n - 2816)] = f; }
  };
  auto efN = [=](int m, int n, float v0, float v1, float v2, float v3) {
    const int b = m / TPB, pos = m % TPB, np = n - 2304;
    uint2 o = {pack2(v0, v1), pack2(v2, v3)};
    *(uint2*)&PQT[((size_t)(b * 512 + np)) * TPB + pos] = o;
  };
  const int ntile = (ROWS / 256) * (NIN / 128);
  const int vb = (nblk % 8 == 0) ? (bid & 7) * (nblk >> 3) + (bid >> 3) : bid;
  for (int t = vb; t < ntile; t += nblk) {
    const int mt = t / (NIN / 128), nt = t % (NIN / 128);
    if (nt >= 18 && nt < 22) gemm_tile<false, 4>(af, bfn, efN, mt * 256, nt * 128, 1024, smem);
    else gemm_tile<true, 4>(af, bfn, efT, mt * 256, nt * 128, 1024, smem);
  }
}

DI void unpack8(const uint4& v, float* f) {
  f[0] = bflo(v.x); f[1] = bfhi(v.x); f[2] = bflo(v.y); f[3] = bfhi(v.y);
  f[4] = bflo(v.z); f[5] = bfhi(v.z); f[6] = bflo(v.w); f[7] = bfhi(v.w);
}
DI void phase_prep(const Params& p, int l, int bid, int nblk, char* smem) {
  const int tid = TID();
  u16* tile = (u16*)smem;
  const u16* PHY = WSP(const u16, OFF_PHY);
  const u16* PXBC = WSP(const u16, OFF_PXBC);
  u16* UT = WSP(u16, OFF_UT);
  u16* X1C = WSP(u16, OFF_X1C);
  u16* XBCA = WSP(u16, OFF_XBCA);
  u16* TX = WSP(u16, OFF_TX);
  const float* hw = p.in[I_HYCW] + l * 3 * 768;
  const float* hb = p.in[I_HYCB] + l * 768;
  const float* sw = p.in[I_SCW] + l * 3 * 1024;
  const float* sb = p.in[I_SCB] + l * 1024;
  const int cg8 = (tid & 31) * 8, pg = tid >> 5;
  for (int it = bid; it < NB * 36 * 6; it += nblk) {
    const int pass = it % 6, bt = it / 6;
    const int b = bt / 36, pt = bt % 36, pos0 = pt * 64;
    const int seg_lo = (pos0 < CTXL) ? 0 : CTXL, seg_hi = (pos0 < CTXL) ? CTXL : TPB;
    const size_t rbase = (size_t)b * TPB;
    const int pfirst = pos0 + pg * 8;
    bool transposed = false;
    if (pass <= 1) {
      if (l == 1 && pos0 < CTXL) continue;
      float cv0[8][8];
#pragma unroll
      for (int sg = 0; sg < 2; ++sg) {
        if (pass == 0 && sg == 1) break;
        const int sgrp = (pass == 0) ? 1 : (sg == 0 ? 0 : 2);
        const int col = sgrp * 256 + cg8;
        float w0[8], w1[8], w2[8], bb[8];
#pragma unroll
        for (int e = 0; e < 8; ++e) { w0[e] = hw[col + e]; w1[e] = hw[768 + col + e]; w2[e] = hw[1536 + col + e]; bb[e] = hb[col + e]; }
        uint4 raw[10];
#pragma unroll
        for (int k = 0; k < 10; ++k) {
          const int pn = pfirst + k - 1;
          raw[k] = (pn >= seg_lo && pn < seg_hi) ? *(const uint4*)&PHY[(rbase + pn) * 768 + col] : make_uint4(0u, 0u, 0u, 0u);
        }
        float xm[8], x0[8], xp[8];
        unpack8(raw[0], xm);
        unpack8(raw[1], x0);
#pragma unroll
        for (int k = 0; k < 8; ++k) {
          unpack8(raw[k + 2], xp);
          float o[8];
#pragma unroll
          for (int e = 0; e < 8; ++e) {
            o[e] = w0[e] * xm[e] + w1[e] * x0[e] + w2[e] * xp[e] + bb[e];
            xm[e] = x0[e]; x0[e] = xp[e];
          }
          if (pass == 0) {
            uint4 o1 = {pack2(o[0], o[1]), pack2(o[2], o[3]), pack2(o[4], o[5]), pack2(o[6], o[7])};
            *(uint4*)&X1C[(rbase + pfirst + k) * 256 + cg8] = o1;
          } else if (sg == 0) {
#pragma unroll
            for (int e = 0; e < 8; ++e) cv0[k][e] = o[e];
          } else {
            uint4 ou = {pack2(o[0] * cv0[k][0], o[1] * cv0[k][1]), pack2(o[2] * cv0[k][2], o[3] * cv0[k][3]),
                        pack2(o[4] * cv0[k][4], o[5] * cv0[k][5]), pack2(o[6] * cv0[k][6], o[7] * cv0[k][7])};
            *(uint4*)&tile[(pg * 8 + k) * 264 + cg8] = ou;
          }
        }
      }
      transposed = (pass == 1);
    } else {
      const int col = (pass - 2) * 256 + cg8;
      float w0[8], w1[8], w2[8], bb[8];
#pragma unroll
      for (int e = 0; e < 8; ++e) { w0[e] = sw[col + e]; w1[e] = sw[1024 + col + e]; w2[e] = sw[2048 + col + e]; bb[e] = sb[col + e]; }
      uint4 raw[10];
#pragma unroll
      for (int k = 0; k < 10; ++k) {
        const int pn = pfirst + k - 1;
        raw[k] = (pn >= seg_lo && pn < seg_hi) ? *(const uint4*)&PXBC[(rbase + pn) * 1024 + col] : make_uint4(0u, 0u, 0u, 0u);
      }
      float xm[8], x0[8], xp[8];
      unpack8(raw[0], xm);
      unpack8(raw[1], x0);
#pragma unroll
      for (int k = 0; k < 8; ++k) {
        unpack8(raw[k + 2], xp);
        float o[8];
#pragma unroll
        for (int e = 0; e < 8; ++e) {
          o[e] = silu_f(w0[e] * xm[e] + w1[e] * x0[e] + w2[e] * xp[e] + bb[e]);
          xm[e] = x0[e]; x0[e] = xp[e];
        }
        uint4 ov = {pack2(o[0], o[1]), pack2(o[2], o[3]), pack2(o[4], o[5]), pack2(o[6], o[7])};
        *(uint4*)&XBCA[(rbase + pfirst + k) * 1024 + col] = ov;
        if (pass < 5) *(uint4*)&tile[(pg * 8 + k) * 264 + cg8] = ov;
      }
      transposed = pass < 5;
    }
    if (transposed) {
      __syncthreads();
      u16* dst = (pass == 1) ? (UT + ((size_t)(tid * 16 + b)) * TPB + pos0) : (TX + ((size_t)(b * 768 + (pass - 2) * 256 + tid)) * TPB + pos0);
#pragma unroll
      for (int pc = 0; pc < 8; ++pc) {
        u32 wv[4];
#pragma unroll
        for (int e = 0; e < 4; ++e)
          wv[e] = (u32)tile[(pc * 8 + 2 * e) * 264 + tid] | ((u32)tile[(pc * 8 + 2 * e + 1) * 264 + tid] << 16);
        uint4 o = {wv[0], wv[1], wv[2], wv[3]};
        *(uint4*)&dst[pc * 8] = o;
      }
      __syncthreads();
    }
  }
}

DI void ssd_item(const Params& p, int l, int it, char* smem) {
  const int tid = TID(), lane = tid & 63, w = tid >> 6, l32 = lane & 31, h = lane >> 5;
  const int b = it >> 4, hd = (it >> 1) & 7, dir = it & 1, g = hd >> 2;
  u16* BG = (u16*)smem;
  u16* HL = BG + 128 * 136;
  float* fa = (float*)(HL + 64 * 136);
  float* fdt = fa + 128;
  float* fsw = fdt + 128;
  float* fea = fsw + 128;
  float* ftot = fea + 128;
  const u16* XBCA = WSP(const u16, OFF_XBCA);
  const u16* TX = WSP(const u16, OFF_TX);
  const float* DT = WSP(const float, OFF_DT);
  u16* Y = WSP(u16, OFF_PXBC) + (dir ? (size_t)ROWS * 512 : 0);
  const float dtb = p.in[I_SDTB][l * 16 + dir * 8 + hd];
  const float a = -expf(p.in[I_SALOG][l * 16 + dir * 8 + hd]);
  const size_t rbase = (size_t)b * TPB;
  f32x16 Hacc[2];
#pragma unroll
  for (int i = 0; i < 2; ++i)
#pragma unroll
    for (int r = 0; r < 16; ++r) Hacc[i][r] = 0.f;
  for (int e = tid; e < 64 * 136; e += NTHR) HL[e] = 0;
  for (int ci = 0; ci < 18; ++ci) {
    const int pos0 = dir ? ((ci < 2) ? (1 - ci) * 128 : (CTXL + (17 - ci) * 128)) : ci * 128;
    asm volatile("s_waitcnt vmcnt(0)" ::: "memory");
    bf16x8 creg[8];
    const u16* cr = XBCA + (rbase + pos0 + w * 32 + l32) * 1024 + 768 + g * 128 + h * 8;
#pragma unroll
    for (int ks = 0; ks < 4; ++ks) creg[ks] = *(const bf16x8*)(cr + ks * 16);
    __builtin_amdgcn_sched_barrier(0);
#pragma unroll
    for (int i = 0; i < 8; ++i) {
      const int q = tid + 256 * i, j = q >> 4, ch = q & 15;
      *(uint4*)&BG[j * 136 + ch * 8] = *(const uint4*)&XBCA[(rbase + pos0 + j) * 1024 + 512 + g * 128 + ch * 8];
    }
    if (w == 0) {
      const float r0 = DT[(rbase + pos0 + 2 * lane) * 16 + dir * 8 + hd] + dtb;
      const float r1 = DT[(rbase + pos0 + 2 * lane + 1) * 16 + dir * 8 + hd] + dtb;
      const float dt0 = (r0 > 20.f) ? r0 : log1pf(expf(r0));
      const float dt1 = (r1 > 20.f) ? r1 : log1pf(expf(r1));
      const float a0 = dt0 * a, a1 = dt1 * a;
      const float sm = a0 + a1;
      float incl = sm;
#pragma unroll
      for (int o = 1; o < 64; o <<= 1) {
        const float t = __shfl_up(incl, o);
        if (lane >= o) incl += t;
      }
      const float excl = incl - sm;
      const float total = __shfl(incl, 63);
      float ac0, ac1;
      if (!dir) { ac0 = excl + a0; ac1 = excl + sm; }
      else { ac0 = total - excl; ac1 = total - excl - a0; }
      fa[2 * lane] = ac0; fa[2 * lane + 1] = ac1;
      fdt[2 * lane] = dt0; fdt[2 * lane + 1] = dt1;
      fsw[2 * lane] = dt0 * __expf(total - ac0); fsw[2 * lane + 1] = dt1 * __expf(total - ac1);
      fea[2 * lane] = __expf(ac0); fea[2 * lane + 1] = __expf(ac1);
      if (lane == 0) ftot[0] = __expf(total);
    }
    __syncthreads();
#pragma unroll
    for (int ks = 4; ks < 8; ++ks) creg[ks] = *(const bf16x8*)(cr + ks * 16);
    f32x16 acc[4], yd[2];
#pragma unroll
    for (int i = 0; i < 4; ++i)
#pragma unroll
      for (int r = 0; r < 16; ++r) acc[i][r] = 0.f;
#pragma unroll
    for (int i = 0; i < 2; ++i)
#pragma unroll
      for (int r = 0; r < 16; ++r) yd[i][r] = 0.f;
#pragma unroll
    for (int ks = 0; ks < 8; ++ks) {
      const bf16x8 areg = creg[ks];
#pragma unroll
      for (int jb = 0; jb < 4; ++jb) {
        const bf16x8 bb = *(const bf16x8*)&BG[(jb * 32 + l32) * 136 + ks * 16 + h * 8];
        acc[jb] = __builtin_amdgcn_mfma_f32_32x32x16_bf16(areg, bb, acc[jb], 0, 0, 0);
      }
    }
    {
      const float eai = fea[w * 32 + l32];
#pragma unroll
      for (int ks = 0; ks < 8; ++ks) {
        union { u32 u[4]; bf16x8 v; } t;
        t.v = creg[ks];
#pragma unroll
        for (int q = 0; q < 4; ++q) t.u[q] = pack2(bflo(t.u[q]) * eai, bfhi(t.u[q]) * eai);
#pragma unroll
        for (int pb = 0; pb < 2; ++pb) {
          const bf16x8 bb = *(const bf16x8*)&HL[(pb * 32 + l32) * 136 + ks * 16 + h * 8];
          yd[pb] = __builtin_amdgcn_mfma_f32_32x32x16_bf16(t.v, bb, yd[pb], 0, 0, 0);
        }
      }
    }
    __syncthreads();
    int l32v = l32, hv_ = h;
    asm volatile("" : "+v"(l32v), "+v"(hv_));
    bf16x8 xf[2][8];
    const u16* xt = TX + ((size_t)(b * 768 + hd * 64 + l32v)) * TPB + pos0 + hv_ * 8;
#pragma unroll
    for (int jb = 0; jb < 4; ++jb) {
      const int j = jb * 32 + l32v;
      const float aj = fa[j], dtj = fdt[j];
#pragma unroll
      for (int r = 0; r < 16; ++r) {
        const int i = w * 32 + (r & 3) + 8 * (r >> 2) + 4 * hv_;
        const float ai = fa[i];
        const bool valid = dir ? (j >= i) : (j <= i);
        const float v = valid ? acc[jb][r] * __expf(ai - aj) * dtj : 0.f;
        BG[i * 136 + j] = f2bf(v);
      }
      __builtin_amdgcn_sched_barrier(0);
      if (jb == 1) {
#pragma unroll
        for (int ks = 0; ks < 8; ++ks) xf[0][ks] = *(const bf16x8*)(xt + ks * 16);
        __builtin_amdgcn_sched_barrier(0);
      }
    }
#pragma unroll
    for (int ks = 0; ks < 8; ++ks) xf[1][ks] = *(const bf16x8*)(xt + (size_t)32 * TPB + ks * 16);
    __builtin_amdgcn_sched_barrier(0);
#pragma unroll
    for (int pb = 0; pb < 2; ++pb)
#pragma unroll
      for (int ks = 0; ks < 8; ++ks) {
        const bf16x8 aa = *(const bf16x8*)&BG[(w * 32 + l32v) * 136 + ks * 16 + hv_ * 8];
        yd[pb] = __builtin_amdgcn_mfma_f32_32x32x16_bf16(aa, xf[pb][ks], yd[pb], 0, 0, 0);
      }
#pragma unroll
    for (int pb = 0; pb < 2; ++pb)
#pragma unroll
      for (int r = 0; r < 16; ++r) {
        const int i = w * 32 + (r & 3) + 8 * (r >> 2) + 4 * hv_;
        Y[(rbase + pos0 + i) * 512 + hd * 64 + pb * 32 + l32v] = f2bf(yd[pb][r]);
      }
    {
      u32x4 braw[8];
      {
        const u16* bt = TX + ((size_t)(b * 768 + 512 + g * 128 + w * 32 + l32v)) * TPB + pos0 + hv_ * 8;
#pragma unroll
        for (int ks = 0; ks < 8; ++ks) braw[ks] = *(const u32x4*)(bt + ks * 16);
      }
      const float eend = ftot[0];
#pragma unroll
      for (int pm = 0; pm < 2; ++pm)
#pragma unroll
        for (int r = 0; r < 16; ++r) Hacc[pm][r] *= eend;
#pragma unroll
      for (int ks = 0; ks < 8; ++ks) {
        const u32x4 raw = braw[ks];
        const float4 s0 = *(const float4*)&fsw[ks * 16 + hv_ * 8];
        const float4 s1 = *(const float4*)&fsw[ks * 16 + hv_ * 8 + 4];
        union { u32 u[4]; bf16x8 v; } bs;
        bs.u[0] = pack2(bflo(raw[0]) * s0.x, bfhi(raw[0]) * s0.y);
        bs.u[1] = pack2(bflo(raw[1]) * s0.z, bfhi(raw[1]) * s0.w);
        bs.u[2] = pack2(bflo(raw[2]) * s1.x, bfhi(raw[2]) * s1.y);
        bs.u[3] = pack2(bflo(raw[3]) * s1.z, bfhi(raw[3]) * s1.w);
#pragma unroll
        for (int pm = 0; pm < 2; ++pm) Hacc[pm] = __builtin_amdgcn_mfma_f32_32x32x16_bf16(xf[pm][ks], bs.v, Hacc[pm], 0, 0, 0);
      }
#pragma unroll
      for (int pm = 0; pm < 2; ++pm)
#pragma unroll
        for (int r = 0; r < 16; ++r) {
          const int pp = pm * 32 + (r & 3) + 8 * (r >> 2) + 4 * hv_;
          HL[pp * 136 + w * 32 + l32v] = f2bf(Hacc[pm][r]);
        }
    }
    __syncthreads();
  }
}

DI void hyena_item(const Params& p, int l, int it) {
  const int lane = TID() & 63, w = TID() >> 6;
  int c, f, L, posoff, tt0, ntile;
  if (it < 2048) { c = it >> 3; f = l; L = 2048; posoff = CTXL; tt0 = (it & 7) * 256 + w * 64; ntile = 32; }
  else { c = it - 2048; f = 2; L = 256; posoff = 0; tt0 = w * 64; ntile = 4; }
  const u16* R0 = WSP(const u16, OFF_RF) + ((size_t)(f * 256 + c) * 2) * RSTR;
  const u16* R1 = R0 + RSTR;
  const u16* UT = WSP(const u16, OFF_UT);
  const int l16 = lane & 15, kg = lane >> 4;
  f32x4 acc[4];
#pragma unroll
  for (int i = 0; i < 4; ++i) acc[i] = (f32x4){0.f, 0.f, 0.f, 0.f};
  const u16* ub = UT + ((size_t)(c * 16 + l16)) * TPB + posoff + kg * 8;
  const u16* rsel = (l16 & 1) ? (R1 - 1) : R0;
  const int nb = L - (tt0 + l16) + kg * 8;
  for (int s0 = 0; s0 < L; s0 += 32) {
    const bf16x8 bfrag = *(const bf16x8*)(ub + s0);
#pragma unroll
    for (int i = 0; i < 4; ++i) {
      const u32* ap = (const u32*)(rsel + (nb - 16 * i + s0));
      union { u32 u[4]; bf16x8 v; } au;
      au.u[0] = ap[0]; au.u[1] = ap[1]; au.u[2] = ap[2]; au.u[3] = ap[3];
      acc[i] = __builtin_amdgcn_mfma_f32_16x16x32_bf16(au.v, bfrag, acc[i], 0, 0, 0);
    }
  }
  float ssq = 0.f;
  for (int t = 0; t < ntile; ++t) ssq += WSP(const float, OFF_PART)[(size_t)(f * 32 + t) * 256 + c];
  const float scale = rsqrtf(ssq + EPSF);
  const float bias = p.in[I_HYBIAS][l * 256 + c];
  const u16* X1C = WSP(const u16, OFF_X1C);
  u16* YM = WSP(u16, OFF_ACT);
  const int b = l16;
#pragma unroll
  for (int i = 0; i < 4; ++i)
#pragma unroll
    for (int r = 0; r < 4; ++r) {
      const int t = tt0 + 16 * i + kg * 4 + r;
      const size_t row = (size_t)b * TPB + posoff + t;
      const float u = bf2f(UT[((size_t)(c * 16 + b)) * TPB + posoff + t]);
      const float x1 = bf2f(X1C[row * 256 + c]);
      YM[row * 1024 + c] = f2bf(x1 * (scale * acc[i][r] + bias * u));
    }
}

DI void hyena_item_lat(const Params& p, int l, int it) {
  const int lane = TID() & 63, w = TID() >> 6;
  const int c = it >> 2, f = l, L = 2048, posoff = CTXL;
  const int tt0 = (it & 3) * 512 + w * 128;
  const u16* R0 = WSP(const u16, OFF_RF) + ((size_t)(f * 256 + c) * 2) * RSTR;
  const u16* R1 = R0 + RSTR;
  const u16* UT = WSP(const u16, OFF_UT);
  const int l16 = lane & 15, kg = lane >> 4;
  f32x4 acc[8];
#pragma unroll
  for (int i = 0; i < 8; ++i) acc[i] = (f32x4){0.f, 0.f, 0.f, 0.f};
  const u16* ub = UT + ((size_t)(c * 16 + l16)) * TPB + posoff + kg * 8;
  const u16* rsel = (l16 & 1) ? (R1 - 1) : R0;
  const int nb = L - (tt0 + l16) + kg * 8;
  union AF { u32 u[4]; bf16x8 v; };
  AF a[8];
#define HY_LOADA(dst, off) { const u32* ap_ = (const u32*)(rsel + (off)); dst.u[0] = ap_[0]; dst.u[1] = ap_[1]; dst.u[2] = ap_[2]; dst.u[3] = ap_[3]; }
#pragma unroll
  for (int i = 2; i < 8; ++i) HY_LOADA(a[i], nb - 16 * i)
#pragma unroll 1
  for (int sb = 0; sb < L; sb += 128) {
#pragma unroll
    for (int u = 0; u < 4; ++u) {
      const int s0 = sb + 32 * u;
      HY_LOADA(a[(0 - 2 * u) & 7], nb + s0)
      HY_LOADA(a[(1 - 2 * u) & 7], nb - 16 + s0)
      const bf16x8 bfrag = *(const bf16x8*)(ub + s0);
#pragma unroll
      for (int i = 0; i < 8; ++i) acc[i] = __builtin_amdgcn_mfma_f32_16x16x32_bf16(a[(i - 2 * u) & 7].v, bfrag, acc[i], 0, 0, 0);
    }
  }
#undef HY_LOADA
  float ssq = 0.f;
  for (int t = 0; t < 32; ++t) ssq += WSP(const float, OFF_PART)[(size_t)(f * 32 + t) * 256 + c];
  const float scale = rsqrtf(ssq + EPSF);
  const float bias = p.in[I_HYBIAS][l * 256 + c];
  const u16* X1C = WSP(const u16, OFF_X1C);
  u16* YM = WSP(u16, OFF_ACT);
  const int b = l16;
#pragma unroll
  for (int i = 0; i < 8; ++i)
#pragma unroll
    for (int r = 0; r < 4; ++r) {
      const int t = tt0 + 16 * i + kg * 4 + r;
      const size_t row = (size_t)b * TPB + posoff + t;
      const float uu = bf2f(UT[((size_t)(c * 16 + b)) * TPB + posoff + t]);
      const float x1 = bf2f(X1C[row * 256 + c]);
      YM[row * 1024 + c] = f2bf(x1 * (scale * acc[i][r] + bias * uu));
    }
}

DI void fnet_item(const Params& p, int it, char* smem) {
  const u16* PQT = WSP(const u16, OFF_PQT);
  u16* YM = WSP(u16, OFF_ACT);
  if (it < 256) {
    const int mt = it >> 5, nt = it & 31;
    const u16* A = WSP(const u16, OFF_DFT);
    auto af = [=](int m, int k) { return A + (size_t)m * 4096 + k; };
    auto bfn = [=](int n, int k) {
      const int b = n >> 8, n2 = n & 255, g = n2 >> 6, kk = n2 & 63, pq = k >> 11, t = k & 2047;
      return PQT + ((size_t)(b * 512 + g * 128 + pq * 64 + kk)) * TPB + CTXL + t;
    };
    auto ef = [=](int m, int n, float v0, float v1, float v2, float v3) {
      const int b = n >> 8, n2 = n & 255;
      const uint2 o = {pack2(v0, v1), pack2(v2, v3)};
      *(uint2*)&YM[((size_t)b * TPB + CTXL + m) * 1024 + 768 + n2] = o;
    };
    gemm_tile<true, 4>(af, bfn, ef, mt * 256, nt * 128, 4096, smem);
  } else {
    const int i2 = it - 256, mt = i2 >> 5, nt = i2 & 31;
    const u16* A = WSP(const u16, OFF_DFTC);
    auto af = [=](int m, int k) { return A + (size_t)m * 512 + k; };
    auto bfn = [=](int n, int k) {
      const int b = n >> 8, n2 = n & 255, g = n2 >> 6, kk = n2 & 63, pq = k >> 8, t = k & 255;
      return PQT + ((size_t)(b * 512 + g * 128 + pq * 64 + kk)) * TPB + t;
    };
    auto ef = [=](int m, int n, float v0, float v1, float v2, float v3) {
      const int b = n >> 8, n2 = n & 255;
      const uint2 o = {pack2(v0, v1), pack2(v2, v3)};
      *(uint2*)&YM[((size_t)b * TPB + m) * 1024 + 768 + n2] = o;
    };
    gemm_tile<true, 4>(af, bfn, ef, mt * 256, nt * 128, 512, smem);
  }
}

DI void phase_mixers(const Params& p, int l, int bid, int nblk, char* smem, int rep = 0) {
  for (int it = bid; it < 256; it += nblk) ssd_item(p, l, it, smem);
  const int nf = (l == 0) ? 288 : 256;
  const int nh = (l == 0) ? 1280 : 1024;
  int* ctr = WSP(int, OFF_CTR) + l + 2 * rep;
  int* sitem = (int*)(smem + LDS_BYTES - 16);
  for (;;) {
    if (TID() == 0) *sitem = atomicAdd(ctr, 1);
    __syncthreads();
    const int it = *sitem;
    __syncthreads();
    if (it >= nf + nh) break;
    if (it < nf) fnet_item(p, it, smem);
    else if (it - nf < 1024) hyena_item_lat(p, l, it - nf);
    else hyena_item(p, l, it - nf + 1024);
  }
}

DI void phase_ssd_combine(const Params& p, int l, int bid, int nblk) {
  const int lane = TID() & 63, w = TID() >> 6;
  const u16* YF = WSP(const u16, OFF_PXBC);
  const u16* YB = YF + (size_t)ROWS * 512;
  const u16* XBCA = WSP(const u16, OFF_XBCA);
  const u16* PZ = WSP(const u16, OFF_PZ);
  u16* YM = WSP(u16, OFF_ACT);
  const float* ng = p.in[I_SNG] + l * 512;
  const int c0 = lane * 8;
  const float dsk = p.in[I_SD][l * 8 + (c0 >> 6)];
  for (int row = bid * 4 + w; row < ROWS; row += nblk * 4) {
    const int pos = row % TPB;
    if (l == 1 && pos < CTXL) continue;
    const uint4 vf = *(const uint4*)(YF + (size_t)row * 512 + c0);
    const uint4 vb = *(const uint4*)(YB + (size_t)row * 512 + c0);
    const uint4 vx = *(const uint4*)(XBCA + (size_t)row * 1024 + c0);
    const uint4 vz = *(const uint4*)(PZ + (size_t)row * 512 + c0);
    const u32 af_[4] = {vf.x, vf.y, vf.z, vf.w}, ab_[4] = {vb.x, vb.y, vb.z, vb.w};
    const u32 ax_[4] = {vx.x, vx.y, vx.z, vx.w}, az_[4] = {vz.x, vz.y, vz.z, vz.w};
    float y[8];
    float ss = 0.f;
#pragma unroll
    for (int i = 0; i < 4; ++i) {
      const float y0 = bflo(af_[i]) + bflo(ab_[i]) + dsk * bflo(ax_[i]);
      const float y1 = bfhi(af_[i]) + bfhi(ab_[i]) + dsk * bfhi(ax_[i]);
      y[2 * i] = y0 * silu_f(bflo(az_[i]));
      y[2 * i + 1] = y1 * silu_f(bfhi(az_[i]));
      ss += y[2 * i] * y[2 * i] + y[2 * i + 1] * y[2 * i + 1];
    }
#pragma unroll
    for (int o = 16; o >= 1; o >>= 1) ss += __shfl_xor(ss, o);
    const float rs = rsqrtf(ss * (1.f / 256.f) + EPSF);
    float o8[8];
#pragma unroll
    for (int i = 0; i < 8; ++i) o8[i] = y[i] * rs * ng[c0 + i];
    uint4 o = {pack2(o8[0], o8[1]), pack2(o8[2], o8[3]), pack2(o8[4], o8[5]), pack2(o8[6], o8[7])};
    *(uint4*)&YM[(size_t)row * 1024 + 256 + c0] = o;
  }
}

DI void phase_outproj(const Params& p, int l, int bid, int nblk, char* smem) {
  const u16* A = WSP(const u16, OFF_ACT);
  const u16* B = WSP(const u16, OFF_WOUT) + (size_t)l * 1024 * 1024;
  const float* MOD = WSP(const float, OFF_MOD);
  const Params pp = p;
  auto af = [=](int m, int k) { return A + (size_t)m * 1024 + k; };
  auto bfn = [=](int n, int k) { return B + (size_t)n * 1024 + k; };
  auto ef = [=](int m, int n, float v0, float v1, float v2, float v3) {
    const int b = m / TPB, pos = m % TPB;
    const float4 ga = *(const float4*)&MOD[(size_t)(l * 17 + (pos < CTXL ? 16 : b)) * 6144 + 2048 + n];
    const float4 xo = *(const float4*)(xrow_ptr(pp, l == 0, b, pos) + n);
    const float4 o = {xo.x + ga.x * v0, xo.y + ga.y * v1, xo.z + ga.z * v2, xo.w + ga.w * v3};
    *(float4*)(xrow_wptr(pp, b, pos) + n) = o;
  };
  const int ntile = (ROWS / 128) * 8;
  const int vb = (nblk % 8 == 0) ? (bid & 7) * (nblk >> 3) + (bid >> 3) : bid;
  for (int t = vb; t < ntile; t += nblk) {
    const int mt = t >> 3, nt = t & 7;
    if (l == 1 && (mt % 18) < 2) continue;
    gemm_tile<true, 2>(af, bfn, ef, mt * 128, nt * 128, 1024, smem);
  }
}

DI void phase_q(const Params& p, int l, int bid, int nblk, char* smem) {
  const u16* A = WSP(const u16, OFF_ACT);
  const u16* B = WSP(const u16, OFF_WQ) + (size_t)l * 2048 * 1024;
  u16* Q = WSP(u16, OFF_Q);
  auto af = [=](int m, int k) { return A + (size_t)m * 1024 + k; };
  auto bfn = [=](int n, int k) { return B + (size_t)n * 1024 + k; };
  auto ef = [=](int m, int n, float v0, float v1, float v2, float v3) {
    const uint2 o = {pack2(v0, v1), pack2(v2, v3)};
    *(uint2*)&Q[(size_t)m * 2048 + n] = o;
  };
  const int ntile = (ROWS / 256) * 16;
  const int vb = (nblk % 8 == 0) ? (bid & 7) * (nblk >> 3) + (bid >> 3) : bid;
  for (int t = vb; t < ntile; t += nblk) {
    const int mt = t >> 4, nt = t & 15;
    if (l == 1 && (mt % 9) < 1) continue;
    gemm_tile<true, 4>(af, bfn, ef, mt * 256, nt * 128, 1024, smem);
  }
}

DI void phase_topk(const Params& p, int l, int bid, int nblk, char* smem) {
  const int tid = TID(), lane = tid & 63, w = tid >> 6, l32 = lane & 31, h = lane >> 5;
  u16* qs = (u16*)smem;
  float* sc = (float*)(smem + 64 * 136 * 2);
  const u16* Q = WSP(const u16, OFF_Q);
  float* TV = WSP(float, OFF_TV);
  int* TI = WSP(int, OFF_TI);
  for (int it = bid; it < (ROWS / 64) * 16; it += nblk) {
    const int hh = it & 15, rt = it >> 4;
    if (l == 1 && (rt % 36) < 4) continue;
    const int row0 = rt * 64;
#pragma unroll
    for (int i = 0; i < 4; ++i) {
      const int q = tid + 256 * i, r = q >> 4, ch = q & 15;
      *(uint4*)&qs[r * 136 + ch * 8] = *(const uint4*)&Q[(size_t)(row0 + r) * 2048 + hh * 128 + ch * 8];
    }
    __syncthreads();
    const u16* kb = WSP(const u16, OFF_K12) + (size_t)(l * 2 + (hh & 1)) * 16384;
    f32x16 acc[2];
#pragma unroll
    for (int i = 0; i < 2; ++i)
#pragma unroll
      for (int r = 0; r < 16; ++r) acc[i][r] = 0.f;
#pragma unroll
    for (int ks = 0; ks < 8; ++ks) {
      const bf16x8 bq = *(const bf16x8*)&kb[(w * 32 + l32) * 128 + ks * 16 + h * 8];
      const bf16x8 a0 = *(const bf16x8*)&qs[(l32) * 136 + ks * 16 + h * 8];
      const bf16x8 a1 = *(const bf16x8*)&qs[(32 + l32) * 136 + ks * 16 + h * 8];
      acc[0] = __builtin_amdgcn_mfma_f32_32x32x16_bf16(a0, bq, acc[0], 0, 0, 0);
      acc[1] = __builtin_amdgcn_mfma_f32_32x32x16_bf16(a1, bq, acc[1], 0, 0, 0);
    }
#pragma unroll
    for (int mt = 0; mt < 2; ++mt)
#pragma unroll
      for (int i = 0; i < 16; ++i) {
        const int r = mt * 32 + (i & 3) + 8 * (i >> 2) + 4 * h;
        sc[r * 133 + w * 33 + l32] = acc[mt][i];
      }
    __syncthreads();
    {
      const int r = tid >> 2, part = tid & 3;
      u32 key[32];
#pragma unroll
      for (int j = 0; j < 32; ++j) {
        const u32 u = __float_as_uint(sc[r * 133 + part * 33 + j]);
        const u32 ord = (u & 0x80000000u) ? ~u : (u | 0x80000000u);
        key[j] = (ord & ~127u) | (u32)(127 - (part * 32 + j));
      }
      float* tv = TV + ((size_t)(row0 + r) * 16 + hh) * 16;
      int* ti = TI + ((size_t)(row0 + r) * 16 + hh) * 16;
      u32 prev = 0xFFFFFFFFu;
#pragma unroll
      for (int rd = 0; rd < 16; ++rd) {
        u32 m = 0u;
#pragma unroll
        for (int j = 0; j < 32; ++j) { const u32 d = key[j] - prev; m = d > m ? d : m; }
        { const u32 o = (u32)__shfl_xor((int)m, 1); m = o > m ? o : m; }
        { const u32 o = (u32)__shfl_xor((int)m, 2); m = o > m ? o : m; }
        const u32 best = prev + m;
        prev = best;
        if (part == 0) {
          const u32 ordv = best & ~127u;
          const u32 uu = (ordv & 0x80000000u) ? (ordv & 0x7FFFFFFFu) : ~ordv;
          tv[rd] = __uint_as_float(uu);
          ti[rd] = 127 - (int)(best & 127u);
        }
      }
    }
    __syncthreads();
  }
}

DI void phase_peer(const Params& p, int l, int bid, int nblk) {
  const int w = TID() >> 6;
  const float* TV = WSP(const float, OFF_TV);
  const int* TI = WSP(const int, OFF_TI);
  const u16* H2 = WSP(const u16, OFF_ACT);
  const unsigned char* UB = WSP(const unsigned char, OFF_XBCA);
  const unsigned char* VB = UB + (size_t)16384 * 1024;
  const float* gfin = p.in[I_GF];
  for (int row = bid * 4 + w; row < ROWS; row += nblk * 4) {
    const int b = row / TPB, pos = row % TPB;
    if (l == 1 && pos < CTXL) continue;
    const int lane = TID() & 63;
    const int head = lane >> 3, sub = lane & 7;
    const float* tv1 = TV + ((size_t)row * 16 + head * 2) * 16;
    const float* tv2 = tv1 + 16;
    const int* ti1 = TI + ((size_t)row * 16 + head * 2) * 16;
    const int* ti2 = ti1 + 16;
    u32 ck[7];
#pragma unroll
    for (int s = 0; s < 7; ++s) {
      const int c = sub + 8 * s;
      if (c < 50) {
        const u32 u = __float_as_uint(tv1[CAND_A[c]] + tv2[CAND_B[c]]);
        const u32 ord = (u & 0x80000000u) ? ~u : (u | 0x80000000u);
        ck[s] = (ord & ~63u) | (u32)(63 - c);
      } else ck[s] = 0u;
    }
    float w0v = 0.f, w1v = 0.f, mx = 0.f;
    int w0c = 0, w1c = 0;
    u32 prevk = 0xFFFFFFFFu;
#pragma unroll
    for (int r = 0; r < 16; ++r) {
      u32 m = 0u;
#pragma unroll
      for (int s = 0; s < 7; ++s) { const u32 d = ck[s] - prevk; m = d > m ? d : m; }
#pragma unroll
      for (int o = 1; o <= 4; o <<= 1) { const u32 ov = (u32)__shfl_xor((int)m, o); m = ov > m ? ov : m; }
      const u32 best = prevk + m;
      prevk = best;
      const u32 ordv = best & ~63u;
      const float bv = __uint_as_float((ordv & 0x80000000u) ? (ordv & 0x7FFFFFFFu) : ~ordv);
      const int bc = 63 - (int)(best & 63u);
      if (r == 0) mx = bv;
      if (sub == (r & 7)) {
        if (r < 8) { w0v = bv; w0c = bc; } else { w1v = bv; w1c = bc; }
      }
    }
    const float e0 = expf(w0v - mx), e1 = expf(w1v - mx);
    float es = e0 + e1;
#pragma unroll
    for (int o = 1; o <= 4; o <<= 1) es += __shfl_xor(es, o);
    const float g0 = e0 / es, g1 = e1 / es;
    const int idx0 = ti1[CAND_A[w0c]] * 128 + ti2[CAND_B[w0c]];
    const int idx1 = ti1[CAND_A[w1c]] * 128 + ti2[CAND_B[w1c]];
    const u16* hrow = H2 + (size_t)row * 1024;
    float hv[16];
    {
      const uint4 ha = *(const uint4*)(hrow + lane * 16), hb = *(const uint4*)(hrow + lane * 16 + 8);
      hv[0] = bflo(ha.x); hv[1] = bfhi(ha.x); hv[2] = bflo(ha.y); hv[3] = bfhi(ha.y);
      hv[4] = bflo(ha.z); hv[5] = bfhi(ha.z); hv[6] = bflo(ha.w); hv[7] = bfhi(ha.w);
      hv[8] = bflo(hb.x); hv[9] = bfhi(hb.x); hv[10] = bflo(hb.y); hv[11] = bfhi(hb.y);
      hv[12] = bflo(hb.z); hv[13] = bfhi(hb.z); hv[14] = bflo(hb.w); hv[15] = bfhi(hb.w);
    }
    float acc[16];
#pragma unroll 1
    for (int prep_ = 0; prep_ < PEER_REPS; ++prep_) {
    const bool b0 = lane & 1, b1 = lane & 2, b2 = lane & 4;
    float act0 = 0.f, act1 = 0.f;
    u32x4 rb[2][8];
#define PEER_LOAD(buf, k, TAB)                                                                     \
  _Pragma("unroll") for (int j = 0; j < 8; ++j) {                                                  \
    const int e = (k) * 8 + j;                                                                     \
    const int id = __builtin_amdgcn_readlane(((k) < 8) ? idx0 : idx1, e & 63);                     \
    rb[buf][j] = *(const u32x4*)(TAB + (size_t)id * 1024 + lane * 16);                             \
  }
#define PEER_DOT(buf, k)                                                                           \
  {                                                                                                \
    float d[8];                                                                                    \
    _Pragma("unroll") for (int j = 0; j < 8; ++j) {                                                \
      const u32 uw[4] = {rb[buf][j][0], rb[buf][j][1], rb[buf][j][2], rb[buf][j][3]};              \
      float sd = 0.f;                                                                              \
      _Pragma("unroll") for (int q = 0; q < 4; ++q) {                                              \
        const f32x2 lo = __builtin_amdgcn_cvt_pk_f32_fp8((int)uw[q], false);                       \
        const f32x2 hi = __builtin_amdgcn_cvt_pk_f32_fp8((int)uw[q], true);                        \
        sd += hv[q * 4 + 0] * lo.x + hv[q * 4 + 1] * lo.y + hv[q * 4 + 2] * hi.x + hv[q * 4 + 3] * hi.y; \
      }                                                                                            \
      d[j] = sd;                                                                                   \
    }                                                                                              \
    float a4[4];                                                                                   \
    _Pragma("unroll") for (int q = 0; q < 4; ++q) {                                                \
      const float keep = b0 ? d[2 * q + 1] : d[2 * q], send = b0 ? d[2 * q] : d[2 * q + 1];        \
      a4[q] = keep + __shfl_xor(send, 1);                                                          \
    }                                                                                              \
    float a2[2];                                                                                   \
    _Pragma("unroll") for (int q = 0; q < 2; ++q) {                                                \
      const float keep = b1 ? a4[2 * q + 1] : a4[2 * q], send = b1 ? a4[2 * q] : a4[2 * q + 1];    \
      a2[q] = keep + __shfl_xor(send, 2);                                                          \
    }                                                                                              \
    const float keep = b2 ? a2[1] : a2[0], send = b2 ? a2[0] : a2[1];                              \
    float c1 = keep + __shfl_xor(send, 4);                                                         \
    c1 += __shfl_xor(c1, 8);                                                                       \
    c1 += __shfl_xor(c1, 16);                                                                      \
    c1 += __shfl_xor(c1, 32);                                                                      \
    if ((lane >> 3) == ((k) & 7)) { if ((k) < 8) act0 = c1; else act1 = c1; }                      \
  }
    PEER_LOAD(0, 0, UB)
#pragma unroll 1
    for (int k = 0; k < 16; k += 2) {
      PEER_LOAD(1, k + 1, UB)
      __builtin_amdgcn_sched_barrier(0);
      PEER_DOT(0, k)
      { const int kn = (k + 2 < 16) ? k + 2 : 15; PEER_LOAD(0, kn, UB) }
      __builtin_amdgcn_sched_barrier(0);
      PEER_DOT(1, k + 1)
    }
    const float ga0 = gelu_tanh(act0 * (1.f / U_SCALE)) * g0 * (1.f / V_SCALE);
    const float ga1 = gelu_tanh(act1 * (1.f / U_SCALE)) * g1 * (1.f / V_SCALE);
#pragma unroll
    for (int i = 0; i < 16; ++i) acc[i] = 0.f;
#define PEER_ACC(buf, k)                                                                           \
  _Pragma("unroll") for (int j = 0; j < 8; ++j) {                                                  \
    const int e = (k) * 8 + j;                                                                     \
    const int ai = __builtin_amdgcn_readlane(__builtin_bit_cast(int, ((k) < 8) ? ga0 : ga1), e & 63); \
    const float a = __builtin_bit_cast(float, ai);                                                 \
    const u32 vw[4] = {rb[buf][j][0], rb[buf][j][1], rb[buf][j][2], rb[buf][j][3]};                \
    _Pragma("unroll") for (int q = 0; q < 4; ++q) {                                                \
      const f32x2 lo = __builtin_amdgcn_cvt_pk_f32_fp8((int)vw[q], false);                         \
      const f32x2 hi = __builtin_amdgcn_cvt_pk_f32_fp8((int)vw[q], true);                          \
      acc[q * 4 + 0] += a * lo.x; acc[q * 4 + 1] += a * lo.y; acc[q * 4 + 2] += a * hi.x; acc[q * 4 + 3] += a * hi.y; \
    }                                                                                              \
  }
    PEER_LOAD(0, 0, VB)
#pragma unroll 1
    for (int k = 0; k < 16; k += 2) {
      PEER_LOAD(1, k + 1, VB)
      __builtin_amdgcn_sched_barrier(0);
      PEER_ACC(0, k)
      { const int kn = (k + 2 < 16) ? k + 2 : 15; PEER_LOAD(0, kn, VB) }
      __builtin_amdgcn_sched_barrier(0);
      PEER_ACC(1, k + 1)
    }
#undef PEER_LOAD
#undef PEER_DOT
#undef PEER_ACC
      if (prep_ + 1 < PEER_REPS) { _Pragma("unroll") for (int i = 0; i < 16; ++i) asm volatile("" :: "v"(acc[i])); }
    }
    int row2 = row;
    asm volatile("" : "+v"(row2));
    const int lane2 = TID() & 63;
    const int b2 = row2 / TPB, pos2 = row2 % TPB;
    const float* xr = xrow_ptr(p, false, b2, pos2);
    float* xw = xrow_wptr(p, b2, pos2);
    const float* ga = WSP(const float, OFF_MOD) + (size_t)(l * 17 + (pos2 < CTXL ? 16 : b2)) * 6144 + 5120;
    float xn[16];
    float ss = 0.f;
#pragma unroll
    for (int q = 0; q < 4; ++q) {
      const float4 xv = *(const float4*)(xr + lane2 * 16 + q * 4);
      const float4 gv = *(const float4*)(ga + lane2 * 16 + q * 4);
      xn[q * 4 + 0] = xv.x + gv.x * acc[q * 4 + 0];
      xn[q * 4 + 1] = xv.y + gv.y * acc[q * 4 + 1];
      xn[q * 4 + 2] = xv.z + gv.z * acc[q * 4 + 2];
      xn[q * 4 + 3] = xv.w + gv.w * acc[q * 4 + 3];
    }
    if (l == 1) {
#pragma unroll
      for (int i = 0; i < 16; ++i) ss += xn[i] * xn[i];
      ss = wave_sum(ss);
      const float rs = rsqrtf(ss * (1.f / 1024.f) + EPSF);
#pragma unroll
      for (int i = 0; i < 16; ++i) xn[i] = xn[i] * rs * gfin[lane2 * 16 + i];
    }
#pragma unroll
    for (int q = 0; q < 4; ++q) {
      float4 o = {xn[q * 4 + 0], xn[q * 4 + 1], xn[q * 4 + 2], xn[q * 4 + 3]};
      *(float4*)(xw + lane2 * 16 + q * 4) = o;
    }
  }
}

template <int S>
DI void run_stage(const Params& p, int l, int bid, int nblk, char* smem) {
  for (int rep = 0; rep < 1 + ((REP_MASK >> (S + 1)) & 1); ++rep) {
  if (S == 0) { if (PH_MASK & 2) phase_norm(p, l, 0, bid, nblk); }
  else if (S == 1) { if (PH_MASK & 4) phase_inproj(p, l, bid, nblk, smem); }
  else if (S == 2) { if (PH_MASK & 8) phase_prep(p, l, bid, nblk, smem); }
  else if (S == 3) { if (PH_MASK & 16) phase_mixers(p, l, bid, nblk, smem, rep); }
  else if (S == 4) { if (PH_MASK & 32) phase_ssd_combine(p, l, bid, nblk); }
  else if (S == 5) { if (PH_MASK & 64) phase_outproj(p, l, bid, nblk, smem); }
  else if (S == 6) { if (PH_MASK & 128) { phase_norm(p, l, 1, bid, nblk); phase_tables(p, l, bid, nblk); } }
  else if (S == 7) { if (PH_MASK & 256) phase_q(p, l, bid, nblk, smem); }
  else if (S == 8) { if (PH_MASK & 512) phase_topk(p, l, bid, nblk, smem); }
  else { if (PH_MASK & 1024) phase_peer(p, l, bid, nblk); }
  }
}

#if ONE_LAUNCH
__global__ void __launch_bounds__(NTHR, 2) mega(Params p) {
  extern __shared__ __attribute__((aligned(16))) char smem[];
  const int bid = blockIdx.x, nblk = gridDim.x;
  cg::grid_group grid = cg::this_grid();
  volatile LAS unsigned* bst = (volatile LAS unsigned*)(smem + LDS_BYTES - 32);
  if (threadIdx.x == 0) { bst[0] = 0u; bst[1] = 0u; }
  __syncthreads();
  const XcdBarrier bar = xcd_barrier_post(WSP(unsigned, OFF_BAR), bst);
  for (int rep = 0; rep < 1 + (REP_MASK & 1); ++rep) { if (PH_MASK & 1) phase_prologue(p, bid, nblk, smem); }
  grid.sync();
#define GBAR() xcd_barrier(bar)
#pragma nounroll
  for (int l = 0; l < 2; ++l) {
    for (int xs = 0; xs < EXTRA_SYNCS; ++xs) GBAR();
    run_stage<0>(p, l, bid, nblk, smem); GBAR();
    run_stage<1>(p, l, bid, nblk, smem); GBAR();
    run_stage<2>(p, l, bid, nblk, smem); GBAR();
    run_stage<3>(p, l, bid, nblk, smem); GBAR();
    run_stage<4>(p, l, bid, nblk, smem); GBAR();
    run_stage<5>(p, l, bid, nblk, smem); GBAR();
    run_stage<6>(p, l, bid, nblk, smem); GBAR();
    run_stage<7>(p, l, bid, nblk, smem); GBAR();
    run_stage<8>(p, l, bid, nblk, smem); GBAR();
    run_stage<9>(p, l, bid, nblk, smem);
    if (l == 0) GBAR();
  }
}
#else
template <int S>
__global__ void __launch_bounds__(NTHR, 2) stage_kernel(Params p, int l) {
  extern __shared__ __attribute__((aligned(16))) char smem[];
  if (S < 0) phase_prologue(p, blockIdx.x, gridDim.x, smem);
  else run_stage<(S < 0 ? 0 : S)>(p, l, blockIdx.x, gridDim.x, smem);
}

template <int S>
static void launch_stage(const Params& p, int l, int grid, hipStream_t stream) {
  (void)hipFuncSetAttribute((const void*)stage_kernel<S>, hipFuncAttributeMaxDynamicSharedMemorySize, LDS_BYTES);
  hipLaunchKernelGGL(stage_kernel<S>, dim3(grid), dim3(NTHR), LDS_BYTES, stream, p, l);
}

#endif

extern "C" void kernel_launch(void* const* d_in, const int* in_sizes, int n_in, void* d_out, int out_size, void* d_ws,
                              size_t ws_size, hipStream_t stream) {
  static int grid = 0;
  if (grid == 0) {
    if (ws_size < WS_END || n_in != 31) { fprintf(stderr, "kernel_launch: ws %zu < %zu or n_in %d\n", ws_size, (size_t)WS_END, n_in); grid = -1; return; }
    int dev = 0, cus = 0, per_cu = 0;
    (void)hipGetDevice(&dev);
    (void)hipDeviceGetAttribute(&cus, hipDeviceAttributeMultiprocessorCount, dev);
#if ONE_LAUNCH
    (void)hipFuncSetAttribute((const void*)mega, hipFuncAttributeMaxDynamicSharedMemorySize, LDS_BYTES);
    (void)hipOccupancyMaxActiveBlocksPerMultiprocessor(&per_cu, (const void*)mega, NTHR, LDS_BYTES);
#else
    (void)hipFuncSetAttribute((const void*)stage_kernel<3>, hipFuncAttributeMaxDynamicSharedMemorySize, LDS_BYTES);
    (void)hipOccupancyMaxActiveBlocksPerMultiprocessor(&per_cu, (const void*)stage_kernel<3>, NTHR, LDS_BYTES);
#endif
    if (per_cu < 1) per_cu = 1;
    if (per_cu > 2) per_cu = 2;
    grid = cus * per_cu;
  }
  if (grid < 0) return;
  (void)hipMemsetAsync((char*)d_ws + OFF_CTR, 0, 256 + 3456 * 4, stream);
  Params p{};
  for (int i = 0; i < 31; ++i) p.in[i] = (const float*)d_in[i];
  p.out = (float*)d_out;
  p.ws = (unsigned char*)d_ws;
#if ONE_LAUNCH
  void* args[] = {&p};
  hipError_t e = hipLaunchCooperativeKernel((const void*)mega, dim3(grid), dim3(NTHR), args, LDS_BYTES, stream);
  if (e != hipSuccess) fprintf(stderr, "cooperative launch failed: %s (grid %d)\n", hipGetErrorString(e), grid);
#else
  launch_stage<-1>(p, 0, grid, stream);
  for (int l = 0; l < 2; ++l) {
    launch_stage<0>(p, l, grid, stream);
    launch_stage<1>(p, l, grid, stream);
    launch_stage<2>(p, l, grid, stream);
    launch_stage<3>(p, l, grid, stream);
    launch_stage<4>(p, l, grid, stream);
    launch_stage<5>(p, l, grid, stream);
    launch_stage<6>(p, l, grid, stream);
    launch_stage<7>(p, l, grid, stream);
    launch_stage<8>(p, l, grid, stream);
    launch_stage<9>(p, l, grid, stream);
  }
#endif
}
```

```cpp
#include <hip/hip_runtime.h>
#include <hip/hip_cooperative_groups.h>
#include <cstdio>
namespace cg = cooperative_groups;

#ifndef PH_MASK
#define PH_MASK 0xFFFF
#endif
#ifndef PEER_REPS
#define PEER_REPS 1
#endif
#ifndef EXTRA_SYNCS
#define EXTRA_SYNCS 0
#endif
#ifndef REP_MASK
#define REP_MASK 0
#endif
#ifndef ONE_LAUNCH
#define ONE_LAUNCH 1
#endif

typedef unsigned short u16;
typedef unsigned int u32;
typedef __attribute__((ext_vector_type(8))) short bf16x8;
typedef __attribute__((ext_vector_type(16))) float f32x16;
typedef __attribute__((ext_vector_type(4))) float f32x4;
typedef __attribute__((ext_vector_type(2))) float f32x2;
typedef __attribute__((ext_vector_type(4))) unsigned int u32x4;
#define DI __device__ __forceinline__
DI int TID() { int t = threadIdx.x; asm volatile("" : "+v"(t)); return t; }

DI u16 f2bf(float x) { u32 u = __float_as_uint(x); u += 0x7fffu + ((u >> 16) & 1u); return (u16)(u >> 16); }
DI float bf2f(u16 v) { return __uint_as_float(((u32)v) << 16); }
DI u32 pack2(float a, float b) { return (u32)f2bf(a) | ((u32)f2bf(b) << 16); }
DI float bflo(u32 v) { return __uint_as_float(v << 16); }
DI float bfhi(u32 v) { return __uint_as_float(v & 0xffff0000u); }

constexpr int D = 1024, NB = 16, SEQ = 2048, CTXL = 256, TPB = 2304, ROWS = NB * TPB;
constexpr int NIN = 2944;
constexpr int RSTR = 4112;
constexpr int NTHR = 256;
constexpr int LDS_BYTES = 73728;
constexpr float EPSF = 1e-6f;

constexpr size_t SZ_PHY = (size_t)ROWS * 768 * 2, SZ_PZ = (size_t)ROWS * 512 * 2, SZ_PXBC = (size_t)ROWS * 1024 * 2;
constexpr size_t OFF_PHY = 0;
constexpr size_t OFF_PZ = OFF_PHY + SZ_PHY;
constexpr size_t OFF_PXBC = OFF_PZ + SZ_PZ;
constexpr size_t OFF_Q = OFF_PHY;
constexpr size_t OFF_ACT = OFF_PXBC + SZ_PXBC;
constexpr size_t OFF_XBCA = OFF_ACT + (size_t)ROWS * 1024 * 2;
constexpr size_t OFF_DREG = OFF_XBCA + (size_t)ROWS * 1024 * 2;
constexpr size_t OFF_PQT = OFF_DREG;
constexpr size_t OFF_UT = OFF_PQT + (size_t)NB * 512 * TPB * 2;
constexpr size_t OFF_X1C = OFF_UT + (size_t)256 * 16 * TPB * 2;
constexpr size_t OFF_TV = OFF_DREG;
constexpr size_t OFF_TI = OFF_TV + (size_t)ROWS * 256 * 4;
constexpr size_t OFF_XC = OFF_DREG + (size_t)ROWS * 256 * 8;
constexpr size_t OFF_WIN = OFF_XC + (size_t)NB * CTXL * D * 4;
constexpr size_t OFF_WOUT = OFF_WIN + (size_t)2 * NIN * 1024 * 2;
constexpr size_t OFF_WQ = OFF_WOUT + (size_t)2 * 1024 * 1024 * 2;
constexpr size_t OFF_K12 = OFF_WQ + (size_t)2 * 2048 * 1024 * 2;
constexpr size_t OFF_DFT = OFF_K12 + (size_t)2 * 2 * 128 * 128 * 2;
constexpr size_t OFF_DFTC = OFF_DFT + (size_t)2048 * 4096 * 2;
constexpr size_t OFF_RF = OFF_DFTC + (size_t)256 * 512 * 2;
constexpr size_t OFF_PART = OFF_RF + (size_t)3 * 256 * 2 * RSTR * 2;
constexpr size_t OFF_MOD = OFF_PART + (size_t)3 * 32 * 256 * 4;
constexpr size_t OFF_DT = OFF_MOD + (size_t)2 * 17 * 6144 * 4;
constexpr size_t OFF_CTR = OFF_DT + (size_t)ROWS * 16 * 4;
constexpr size_t OFF_BAR = OFF_CTR + 256;
constexpr size_t OFF_TX = OFF_BAR + 3456 * 4;
constexpr size_t WS_END = OFF_TX + (size_t)NB * 768 * TPB * 2;

struct Params {
  const float* in[31];
  float* out;
  unsigned char* ws;
  int pad0, pad1;
};

enum { I_X = 0, I_C, I_CTX, I_CCTX, I_WADA, I_BADA, I_G1, I_G2, I_WIN, I_HYCW, I_HYCB, I_HFW1, I_HFB1, I_HFW2, I_HFB2,
       I_HFW3, I_HFFREQ, I_HYBIAS, I_SCW, I_SCB, I_SDTB, I_SALOG, I_SD, I_SNG, I_WOUT, I_WQ, I_K1, I_K2, I_PU, I_PV, I_GF };

__device__ const unsigned char CAND_A[56] = {0, 0, 0, 0, 0, 0, 0, 0, 0, 0, 0, 0, 0, 0, 0, 0, 1, 1, 1, 1, 1, 1, 1, 1, 2, 2, 2, 2, 2, 3, 3, 3, 3, 4, 4, 4, 5, 5, 6, 6, 7, 7, 8, 9, 10, 11, 12, 13, 14, 15, 0, 0, 0, 0, 0, 0};
__device__ const unsigned char CAND_B[56] = {0, 1, 2, 3, 4, 5, 6, 7, 8, 9, 10, 11, 12, 13, 14, 15, 0, 1, 2, 3, 4, 5, 6, 7, 0, 1, 2, 3, 4, 0, 1, 2, 3, 0, 1, 2, 0, 1, 0, 1, 0, 1, 0, 0, 0, 0, 0, 0, 0, 0, 0, 0, 0, 0, 0, 0};

#define WSP(T, off) ((T*)(p.ws + (off)))

#define XB_TMO      128
#define XB_XCNT(j)  (256  + 64 * (j))
#define XB_XSUB(j)  (1280 + 64 * (j))
#define XB_XGEN(j)  (2304 + 64 * (j))
#define XB_TOP      3328
#define XB_TOPGEN   3392
#define XCD_BAR_WORDS 3456
#define XB_SPIN_CAP (1u << 18)
#define LAS __attribute__((address_space(3)))
DI unsigned xb_ld(unsigned* p) { return __hip_atomic_load(p, __ATOMIC_RELAXED, __HIP_MEMORY_SCOPE_AGENT); }
DI unsigned xb_add(unsigned* p, unsigned v) { return __hip_atomic_fetch_add(p, v, __ATOMIC_RELAXED, __HIP_MEMORY_SCOPE_AGENT); }
DI unsigned xb_xcc_id() { return (unsigned)__builtin_amdgcn_s_getreg((3 << 11) | 20) & 0xFu; }
#define XB_SPIN(cond, bar) do { unsigned _sp = 0; while (cond) { __builtin_amdgcn_s_sleep(1); \
    if ((++_sp & 255u) == 0u) { if (xb_ld(&(bar)[XB_TMO])) break; if (_sp > XB_SPIN_CAP) { atomicAdd(&(bar)[XB_TMO], 1u); break; } } } } while (0)
struct XcdBarrier { unsigned* bar; unsigned x; volatile LAS unsigned* st; };
DI XcdBarrier xcd_barrier_post(unsigned* bar, volatile LAS unsigned* st) {
  XcdBarrier b; b.bar = bar; b.x = xb_xcc_id(); b.st = st;
  if (threadIdx.x == 0) (void)xb_add(&bar[XB_XCNT(b.x)], 1u);
  return b;
}
DI void xcd_barrier_complete(unsigned* bar, unsigned x, unsigned& nloc, unsigned& nx) {
  const unsigned G = gridDim.x * gridDim.y * gridDim.z;
  unsigned sum, cnt, mine, sp = 0u;
  for (;;) {
    sum = 0u; cnt = 0u; mine = 0u;
#pragma unroll
    for (unsigned j = 0; j < 16; ++j) { const unsigned c = xb_ld(&bar[XB_XCNT(j)]); sum += c; cnt += (c > 0u) ? 1u : 0u; mine = (j == x) ? c : mine; }
    if (sum == G) break;
    __builtin_amdgcn_s_sleep(1);
    if ((++sp & 255u) == 0u) { if (xb_ld(&bar[XB_TMO])) break; if (sp > XB_SPIN_CAP) { atomicAdd(&bar[XB_TMO], 1u); break; } }
  }
  nloc = mine > 0u ? mine : 1u; nx = cnt > 0u ? cnt : 1u;
}
DI void xcd_barrier(const XcdBarrier& b) {
  asm volatile("s_waitcnt vmcnt(0)" ::: "memory");
  __syncthreads();
  if (threadIdx.x == 0) {
    unsigned* bar = b.bar;
    __builtin_amdgcn_s_waitcnt(0);
    unsigned nloc = b.st[0], nx = b.st[1];
    if (nloc == 0u) { xcd_barrier_complete(bar, b.x, nloc, nx); b.st[0] = nloc; b.st[1] = nx; }
    const unsigned old = xb_add(&bar[XB_XSUB(b.x)], 1u);
    const unsigned gen = old / nloc;
    if (old + 1u == (gen + 1u) * nloc) {
      __builtin_amdgcn_fence(__ATOMIC_RELEASE, "agent");
      asm volatile("s_waitcnt vmcnt(0)" ::: "memory");
      const unsigned og = xb_add(&bar[XB_TOP], 1u);
      const unsigned tg = og / nx;
      if (og + 1u == (tg + 1u) * nx) xb_add(&bar[XB_TOPGEN], 1u);
      else XB_SPIN(xb_ld(&bar[XB_TOPGEN]) == tg, bar);
      __builtin_amdgcn_fence(__ATOMIC_ACQUIRE, "agent");
      xb_add(&bar[XB_XGEN(b.x)], 1u);
      asm volatile("s_waitcnt vmcnt(0)" ::: "memory");
    } else {
      XB_SPIN(xb_ld(&bar[XB_XGEN(b.x)]) == gen, bar);
      __builtin_amdgcn_fence(__ATOMIC_ACQUIRE, "agent");
      asm volatile("s_waitcnt vmcnt(0)" ::: "memory");
    }
  }
  __syncthreads();
}


template <bool SWAP, int MI, class AF, class BF, class EF>
DI void gemm_tile(const AF& af, const BF& bfn, const EF& ef, int m0, int n0, int K, char* smem) {
  constexpr int AROWS = MI * 64;
  u16* As = (u16*)smem;
  u16* Bs = As + 2 * AROWS * 40;
  const int tid = TID(), lane = tid & 63, w = tid >> 6;
  const int wm = w >> 1, wn = w & 1, l32 = lane & 31, h = lane >> 5;
  const int lrow = (tid >> 6) * 16 + ((tid >> 5) & 1) * 8 + ((tid >> 2) & 1) * 4 + ((tid >> 3) & 3), lk = (tid & 3) * 8;
  f32x16 acc[MI][2];
#pragma unroll
  for (int i = 0; i < MI; ++i)
#pragma unroll
    for (int j = 0; j < 2; ++j)
#pragma unroll
      for (int r = 0; r < 16; ++r) acc[i][j][r] = 0.f;
  u32x4 ra[MI], rb[2];
  const int nk = K >> 5;
#pragma unroll
  for (int i = 0; i < MI; ++i) ra[i] = *(const u32x4*)af(m0 + lrow + 64 * i, lk);
#pragma unroll
  for (int i = 0; i < 2; ++i) rb[i] = *(const u32x4*)bfn(n0 + lrow + 64 * i, lk);
#pragma unroll
  for (int i = 0; i < MI; ++i) *(u32x4*)&As[(lrow + 64 * i) * 40 + lk] = ra[i];
#pragma unroll
  for (int i = 0; i < 2; ++i) *(u32x4*)&Bs[(lrow + 64 * i) * 40 + lk] = rb[i];
  {
    const int k1 = (nk > 1) ? 32 + lk : lk;
#pragma unroll
    for (int i = 0; i < MI; ++i) ra[i] = *(const u32x4*)af(m0 + lrow + 64 * i, k1);
#pragma unroll
    for (int i = 0; i < 2; ++i) rb[i] = *(const u32x4*)bfn(n0 + lrow + 64 * i, k1);
  }
  __syncthreads();
  for (int kt = 0; kt < nk; ++kt) {
    const int cur = kt & 1;
    const u16* Ab = As + cur * AROWS * 40;
    const u16* Bb = Bs + cur * 128 * 40;
#pragma unroll
    for (int ks = 0; ks < 2; ++ks) {
      bf16x8 a[MI], b[2];
#pragma unroll
      for (int i = 0; i < MI; ++i) a[i] = *(const bf16x8*)&Ab[(wm * (MI * 32) + i * 32 + l32) * 40 + ks * 16 + h * 8];
#pragma unroll
      for (int i = 0; i < 2; ++i) b[i] = *(const bf16x8*)&Bb[(wn * 64 + i * 32 + l32) * 40 + ks * 16 + h * 8];
#pragma unroll
      for (int i = 0; i < MI; ++i)
#pragma unroll
        for (int j = 0; j < 2; ++j)
          acc[i][j] = SWAP ? __builtin_amdgcn_mfma_f32_32x32x16_bf16(b[j], a[i], acc[i][j], 0, 0, 0)
                           : __builtin_amdgcn_mfma_f32_32x32x16_bf16(a[i], b[j], acc[i][j], 0, 0, 0);
    }
    {
      u16* An = As + (cur ^ 1) * AROWS * 40;
      u16* Bn = Bs + (cur ^ 1) * 128 * 40;
#pragma unroll
      for (int i = 0; i < MI; ++i) *(u32x4*)&An[(lrow + 64 * i) * 40 + lk] = ra[i];
#pragma unroll
      for (int i = 0; i < 2; ++i) *(u32x4*)&Bn[(lrow + 64 * i) * 40 + lk] = rb[i];
      const int kn = (kt + 2 < nk) ? kt + 2 : nk - 1;
      const int k0 = kn * 32 + lk;
#pragma unroll
      for (int i = 0; i < MI; ++i) ra[i] = *(const u32x4*)af(m0 + lrow + 64 * i, k0);
#pragma unroll
      for (int i = 0; i < 2; ++i) rb[i] = *(const u32x4*)bfn(n0 + lrow + 64 * i, k0);
    }
    __syncthreads();
  }
#pragma unroll
  for (int i = 0; i < MI; ++i)
#pragma unroll
    for (int j = 0; j < 2; ++j)
#pragma unroll
      for (int rg = 0; rg < 4; ++rg) {
        const int m = SWAP ? (m0 + wm * (MI * 32) + i * 32 + l32) : (m0 + wm * (MI * 32) + i * 32 + rg * 8 + h * 4);
        const int n = SWAP ? (n0 + wn * 64 + j * 32 + rg * 8 + h * 4) : (n0 + wn * 64 + j * 32 + l32);
        ef(m, n, acc[i][j][rg * 4 + 0], acc[i][j][rg * 4 + 1], acc[i][j][rg * 4 + 2], acc[i][j][rg * 4 + 3]);
      }
}

DI float wave_sum(float v) {
#pragma unroll
  for (int o = 32; o >= 1; o >>= 1) v += __shfl_xor(v, o);
  return v;
}
DI float silu_f(float x) { return x / (1.f + __expf(-x)); }
DI float gelu_tanh(float x) {
  const float u = 0.7978845608028654f * (x + 0.044715f * x * x * x);
  return 0.5f * x * (1.f + tanhf(u));
}

DI const float* xrow_ptr(const Params& p, bool from_input, int b, int pos) {
  if (pos < CTXL) return (from_input ? p.in[I_CTX] : WSP(const float, OFF_XC)) + ((size_t)b * CTXL + pos) * D;
  return (from_input ? p.in[I_X] : (const float*)p.out) + ((size_t)b * SEQ + (pos - CTXL)) * D;
}
DI float* xrow_wptr(const Params& p, int b, int pos) {
  if (pos < CTXL) return WSP(float, OFF_XC) + ((size_t)b * CTXL + pos) * D;
  return p.out + ((size_t)b * SEQ + (pos - CTXL)) * D;
}

DI void phase_prologue(const Params& p, int bid, int nblk, char* smem) {
  const int tid = TID();
  const int gtid = bid * NTHR + tid, gn = nblk * NTHR;
  {
    float* scs = (float*)smem;
    for (int it = bid; it < 192; it += nblk) {
      const int l = it / 96, col0 = (it % 96) * 64;
      for (int e = tid; e < 17 * 1024; e += NTHR) {
        const int j = e >> 10, k = e & 1023;
        const float v = (j < 16) ? p.in[I_C][j * 1024 + k] : p.in[I_CCTX][k];
        scs[e] = v / (1.f + expf(-v));
      }
      __syncthreads();
      const int col = tid & 63, kq = tid >> 6;
      float acc[17];
#pragma unroll
      for (int j = 0; j < 17; ++j) acc[j] = 0.f;
      const float* wa = p.in[I_WADA] + (size_t)l * 1024 * 6144 + col0 + col;
      for (int k0 = kq * 256; k0 < kq * 256 + 256; k0 += 8) {
        float wv[8];
#pragma unroll
        for (int kk = 0; kk < 8; ++kk) wv[kk] = wa[(size_t)(k0 + kk) * 6144];
#pragma unroll
        for (int kk = 0; kk < 8; ++kk)
#pragma unroll
          for (int j = 0; j < 17; ++j) acc[j] += scs[j * 1024 + k0 + kk] * wv[kk];
      }
      __syncthreads();
#pragma unroll
      for (int j = 0; j < 17; ++j) scs[(kq * 17 + j) * 64 + col] = acc[j];
      __syncthreads();
      for (int e = tid; e < 17 * 64; e += NTHR) {
        const int j = e >> 6, cc = e & 63;
        float s = p.in[I_BADA][l * 6144 + col0 + cc];
#pragma unroll
        for (int q = 0; q < 4; ++q) s += scs[(q * 17 + j) * 64 + cc];
        WSP(float, OFF_MOD)[(size_t)(l * 17 + j) * 6144 + col0 + cc] = s;
      }
      __syncthreads();
    }
  }
  {
    float* zs = (float*)smem;
    float* h1s = zs + 64 * 33;
    float* h2s = h1s + 64 * 64;
    for (int it = (nblk >= 260 ? (bid >= 192 ? bid - 192 : 1 << 20) : bid); it < 68; it += nblk) {
      const int f = it < 32 ? 0 : (it < 64 ? 1 : 2);
      const int tile = it - (f == 0 ? 0 : (f == 1 ? 32 : 64));
      const int L = (f == 2) ? 256 : 2048;
      const int lyr = (f == 1) ? 1 : 0;
      const int pos0 = tile * 64;
      const float* w1 = p.in[I_HFW1] + lyr * 33 * 64;
      const float* b1 = p.in[I_HFB1] + lyr * 64;
      const float* w2 = p.in[I_HFW2] + lyr * 64 * 64;
      const float* b2 = p.in[I_HFB2] + lyr * 64;
      const float* w3 = p.in[I_HFW3] + lyr * 64 * 512;
      const float* fq = p.in[I_HFFREQ] + lyr * 64;
      for (int e = tid; e < 64 * 33; e += NTHR) {
        const int pi = e / 33, q = e % 33;
        const int pos = pos0 + pi;
        const float tt = (float)pos / (float)(L - 1);
        const float wv = 6.283185307179586f * (float)pos / (float)L;
        float z;
        if (q == 0) z = tt;
        else if (q <= 16) { const float fi = 1e-4f + (float)(q - 1) * ((15.f - 1e-4f) / 15.f); z = cosf(fi * wv); }
        else { const float fi = 1e-4f + (float)(q - 17) * ((15.f - 1e-4f) / 15.f); z = -sinf(fi * wv); }
        zs[e] = z;
      }
      __syncthreads();
      for (int e = tid; e < 64 * 64; e += NTHR) {
        const int pi = e >> 6, j = e & 63;
        float s = b1[j];
        for (int q = 0; q < 33; ++q) s += zs[pi * 33 + q] * w1[q * 64 + j];
        h1s[e] = sinf(fq[j] * s);
      }
      __syncthreads();
      for (int e = tid; e < 64 * 64; e += NTHR) {
        const int pi = e >> 6, j = e & 63;
        float s = b2[j];
        for (int k = 0; k < 64; ++k) s += h1s[pi * 64 + k] * w2[k * 64 + j];
        h2s[e] = sinf(fq[j] * s);
      }
      __syncthreads();
      {
        const int c = tid;
        const float mind = logf(1e-2f) / 1.5f, maxd = logf(1e-2f) / 0.3f;
        const float delta = fabsf(mind + (float)c * ((maxd - mind) / 255.f));
        u16* R0 = WSP(u16, OFF_RF) + ((size_t)(f * 256 + c) * 2 + 0) * RSTR;
        u16* R1 = R0 + RSTR;
        float ssq = 0.f;
        for (int pb = 0; pb < 4; ++pb) {
          float af_[16], ab_[16];
#pragma unroll
          for (int i = 0; i < 16; ++i) { af_[i] = 0.f; ab_[i] = 0.f; }
          for (int k = 0; k < 64; ++k) {
            const float wf = w3[k * 512 + c], wb = w3[k * 512 + 256 + c];
#pragma unroll
            for (int i = 0; i < 16; ++i) {
              const float hv = h2s[(pb * 16 + i) * 64 + k];
              af_[i] += hv * wf;
              ab_[i] += hv * wb;
            }
          }
#pragma unroll
          for (int i = 0; i < 16; ++i) {
            const int pos = pos0 + pb * 16 + i;
            const float tt = (float)pos / (float)(L - 1);
            const float win = expf(-tt * delta);
            const float vf = af_[i] * win, vb = ab_[i] * win;
            const u16 bfv = f2bf(vf), bbv = f2bf(vb);
            R0[L - pos] = bfv;
            R1[L - pos - 1] = bfv;
            ssq += vf * vf;
            if (pos >= 1) {
              R0[L + pos] = bbv;
              R1[L + pos - 1] = bbv;
              ssq += vb * vb;
            }
          }
        }
        WSP(float, OFF_PART)[(size_t)(f * 32 + tile) * 256 + c] = ssq;
      }
      __syncthreads();
    }
  }
  for (int e = gtid; e < 2 * NIN * 128; e += gn) {
    const int l = e / (NIN * 128);
    const int r = e % (NIN * 128);
    const int kc = r / NIN, n = r % NIN;
    const int k0 = kc * 8;
    const float* wsrc = p.in[I_WIN] + (size_t)l * 1024 * 2576;
    float v[8];
    if (n < 2304) {
#pragma unroll
      for (int j = 0; j < 8; ++j) v[j] = wsrc[(size_t)(k0 + j) * 2576 + n];
    } else if (n < 2816) {
      const int np = n - 2304, g = np >> 7, rr = np & 127, pq = rr >> 6, kk = rr & 63;
#pragma unroll
      for (int j = 0; j < 8; ++j) v[j] = 0.f;
      for (int jj = 0; jj < 64; ++jj) {
        const float ang = 6.283185307179586f * (float)((jj * kk) & 63) / 64.f;
        const float tr = pq ? sinf(ang) : cosf(ang);
#pragma unroll
        for (int j = 0; j < 8; ++j) v[j] += wsrc[(size_t)(k0 + j) * 2576 + 2320 + g * 64 + jj] * tr;
      }
    } else if (n < 2832) {
#pragma unroll
      for (int j = 0; j < 8; ++j) v[j] = wsrc[(size_t)(k0 + j) * 2576 + 2304 + (n - 2816)];
    } else {
#pragma unroll
      for (int j = 0; j < 8; ++j) v[j] = 0.f;
    }
    uint4 o = {pack2(v[0], v[1]), pack2(v[2], v[3]), pack2(v[4], v[5]), pack2(v[6], v[7])};
    *(uint4*)&WSP(u16, OFF_WIN)[((size_t)l * NIN + n) * 1024 + k0] = o;
  }
  for (int e = gtid; e < 2 * 1024 * 128; e += gn) {
    const int l = e / (1024 * 128), r = e % (1024 * 128), kc = r / 1024, n = r % 1024, k0 = kc * 8;
    const float* wsrc = p.in[I_WOUT] + (size_t)l * 1024 * 1024;
    float v[8];
#pragma unroll
    for (int j = 0; j < 8; ++j) v[j] = wsrc[(size_t)(k0 + j) * 1024 + n];
    uint4 o = {pack2(v[0], v[1]), pack2(v[2], v[3]), pack2(v[4], v[5]), pack2(v[6], v[7])};
    *(uint4*)&WSP(u16, OFF_WOUT)[((size_t)l * 1024 + n) * 1024 + k0] = o;
  }
  for (int e = gtid; e < 2 * 2048 * 128; e += gn) {
    const int l = e / (2048 * 128), r = e % (2048 * 128), kc = r / 2048, n = r % 2048, k0 = kc * 8;
    const float* wsrc = p.in[I_WQ] + (size_t)l * 1024 * 2048;
    float v[8];
#pragma unroll
    for (int j = 0; j < 8; ++j) v[j] = wsrc[(size_t)(k0 + j) * 2048 + n];
    uint4 o = {pack2(v[0], v[1]), pack2(v[2], v[3]), pack2(v[4], v[5]), pack2(v[6], v[7])};
    *(uint4*)&WSP(u16, OFF_WQ)[((size_t)l * 2048 + n) * 1024 + k0] = o;
  }
  for (int e = gtid; e < 2 * 2 * 128 * 128; e += gn) {
    const int l = e / (2 * 16384), r = e % (2 * 16384), which = r / 16384, i = r % 16384;
    const float v = (which ? p.in[I_K2] : p.in[I_K1])[l * 16384 + i];
    WSP(u16, OFF_K12)[e] = f2bf(v);
  }
  for (int e = gtid; e < 2048 * 512; e += gn) {
    const int tp = e >> 9, k0 = (e & 511) * 8;
    const float s = 1.f / sqrtf(2048.f * 64.f);
    float v[8];
#pragma unroll
    for (int j = 0; j < 8; ++j) {
      const int k = k0 + j, t = k & 2047;
      const float ang = 6.283185307179586f * (float)((tp * t) & 2047) / 2048.f;
      v[j] = (k < 2048) ? cosf(ang) * s : -sinf(ang) * s;
    }
    uint4 o = {pack2(v[0], v[1]), pack2(v[2], v[3]), pack2(v[4], v[5]), pack2(v[6], v[7])};
    *(uint4*)&WSP(u16, OFF_DFT)[(size_t)tp * 4096 + k0] = o;
  }
  for (int e = gtid; e < 256 * 64; e += gn) {
    const int tp = e >> 6, k0 = (e & 63) * 8;
    const float s = 1.f / sqrtf(256.f * 64.f);
    float v[8];
#pragma unroll
    for (int j = 0; j < 8; ++j) {
      const int k = k0 + j, t = k & 255;
      const float ang = 6.283185307179586f * (float)((tp * t) & 255) / 256.f;
      v[j] = (k < 256) ? cosf(ang) * s : -sinf(ang) * s;
    }
    uint4 o = {pack2(v[0], v[1]), pack2(v[2], v[3]), pack2(v[4], v[5]), pack2(v[6], v[7])};
    *(uint4*)&WSP(u16, OFF_DFTC)[(size_t)tp * 512 + k0] = o;
  }
}

DI void phase_norm(const Params& p, int l, int which, int bid, int nblk) {
  const int lane = TID() & 63, w = TID() >> 6;
  const float* g = (which ? p.in[I_G2] : p.in[I_G1]) + l * 1024;
  const bool from_input = (which == 0 && l == 0);
  for (int row = bid * 4 + w; row < ROWS; row += nblk * 4) {
    const int b = row / TPB, pos = row % TPB;
    if (which == 1 && l == 1 && pos < CTXL) continue;
    const float* xr = xrow_ptr(p, from_input, b, pos);
    const float* mod = WSP(const float, OFF_MOD) + (size_t)(l * 17 + (pos < CTXL ? 16 : b)) * 6144 + which * 3072;
    float x[16];
#pragma unroll
    for (int hh = 0; hh < 2; ++hh) {
      const float4 a = *(const float4*)(xr + hh * 512 + lane * 8);
      const float4 c = *(const float4*)(xr + hh * 512 + lane * 8 + 4);
      x[hh * 8 + 0] = a.x; x[hh * 8 + 1] = a.y; x[hh * 8 + 2] = a.z; x[hh * 8 + 3] = a.w;
      x[hh * 8 + 4] = c.x; x[hh * 8 + 5] = c.y; x[hh * 8 + 6] = c.z; x[hh * 8 + 7] = c.w;
    }
    float ss = 0.f;
#pragma unroll
    for (int i = 0; i < 16; ++i) ss += x[i] * x[i];
    ss = wave_sum(ss);
    const float rs = rsqrtf(ss * (1.f / 1024.f) + EPSF);
#pragma unroll
    for (int hh = 0; hh < 2; ++hh) {
      const int c0 = hh * 512 + lane * 8;
      float y[8];
#pragma unroll
      for (int i = 0; i < 8; ++i) {
        const float yn = x[hh * 8 + i] * rs * g[c0 + i];
        y[i] = yn * (1.f + mod[1024 + c0 + i]) + mod[c0 + i];
      }
      uint4 o = {pack2(y[0], y[1]), pack2(y[2], y[3]), pack2(y[4], y[5]), pack2(y[6], y[7])};
      *(uint4*)&WSP(u16, OFF_ACT)[(size_t)row * 1024 + c0] = o;
    }
  }
}

constexpr float U_SCALE = 64.f, V_SCALE = 4.f;
DI void phase_tables(const Params& p, int l, int bid, int nblk) {
  const int gtid = bid * NTHR + TID(), gn = nblk * NTHR;
  unsigned char* dst = WSP(unsigned char, OFF_XBCA);
  for (int e = gtid; e < 2 * 16384 * 64; e += gn) {
    const int which = e / (16384 * 64), r = e % (16384 * 64);
    const float sc = which ? V_SCALE : U_SCALE;
    const float* src = (which ? p.in[I_PV] : p.in[I_PU]) + (size_t)l * 16384 * 1024 + (size_t)r * 16;
    u32 o[4];
#pragma unroll
    for (int q = 0; q < 4; ++q) {
      const float4 a = *(const float4*)(src + q * 4);
      int v = __builtin_amdgcn_cvt_pk_fp8_f32(a.x * sc, a.y * sc, 0, false);
      v = __builtin_amdgcn_cvt_pk_fp8_f32(a.z * sc, a.w * sc, v, true);
      o[q] = (u32)v;
    }
    uint4 ov = {o[0], o[1], o[2], o[3]};
    *(uint4*)&dst[(size_t)e * 16] = ov;
  }
}

DI void phase_inproj(const Params& p, int l, int bid, int nblk, char* smem) {
  const u16* A = WSP(const u16, OFF_ACT);
  const u16* B = WSP(const u16, OFF_WIN) + (size_t)l * NIN * 1024;
  u16* PHY = WSP(u16, OFF_PHY);
  u16* PZ = WSP(u16, OFF_PZ);
  u16* PXBC = WSP(u16, OFF_PXBC);
  u16* PQT = WSP(u16, OFF_PQT);
  float* DT = WSP(float, OFF_DT);
  auto af = [=](int m, int k) { return A + (size_t)m * 1024 + k; };
  auto bfn = [=](int n, int k) { return B + (size_t)n * 1024 + k; };
  auto efT = [=](int m, int n, float v0, float v1, float v2, float v3) {
    const uint2 o = {pack2(v0, v1), pack2(v2, v3)};
    if (n < 768) *(uint2*)&PHY[(size_t)m * 768 + n] = o;
    else if (n < 1280) *(uint2*)&PZ[(size_t)m * 512 + (n - 768)] = o;
    else if (n < 2304) *(uint2*)&PXBC[(size_t)m * 1024 + (n - 1280)] = o;
    else if (n >= 2816 && n < 2832) { float4 f = {v0, v1, v2, v3}; *(float4*)&DT[(size_t)m * 16 + (n - 2816)] = f; }
  };
  auto efN = [=](int m, int n, float v0, float v1, float v2, float v3) {
    const int b = m / TPB, pos = m % TPB, np = n - 2304;
    uint2 o = {pack2(v0, v1), pack2(v2, v3)};
    *(uint2*)&PQT[((size_t)(b * 512 + np)) * TPB + pos] = o;
  };
  const int ntile = (ROWS / 256) * (NIN / 128);
  const int vb = (nblk % 8 == 0) ? (bid & 7) * (nblk >> 3) + (bid >> 3) : bid;
  for (int t = vb; t < ntile; t += nblk) {
    const int mt = t / (NIN / 128), nt = t % (NIN / 128);
    if (nt >= 18 && nt < 22) gemm_tile<false, 4>(af, bfn, efN, mt * 256, nt * 128, 1024, smem);
    else gemm_tile<true, 4>(af, bfn, efT, mt * 256, nt * 128, 1024, smem);
  }
}

DI void unpack8(const uint4& v, float* f) {
  f[0] = bflo(v.x); f[1] = bfhi(v.x); f[2] = bflo(v.y); f[3] = bfhi(v.y);
  f[4] = bflo(v.z); f[5] = bfhi(v.z); f[6] = bflo(v.w); f[7] = bfhi(v.w);
}
DI void phase_prep(const Params& p, int l, int bid, int nblk, char* smem) {
  const int tid = TID();
  u16* tile = (u16*)smem;
  const u16* PHY = WSP(const u16, OFF_PHY);
  const u16* PXBC = WSP(const u16, OFF_PXBC);
  u16* UT = WSP(u16, OFF_UT);
  u16* X1C = WSP(u16, OFF_X1C);
  u16* XBCA = WSP(u16, OFF_XBCA);
  u16* TX = WSP(u16, OFF_TX);
  const float* hw = p.in[I_HYCW] + l * 3 * 768;
  const float* hb = p.in[I_HYCB] + l * 768;
  const float* sw = p.in[I_SCW] + l * 3 * 1024;
  const float* sb = p.in[I_SCB] + l * 1024;
  const int cg8 = (tid & 31) * 8, pg = tid >> 5;
  for (int it = bid; it < NB * 36 * 6; it += nblk) {
    const int pass = it % 6, bt = it / 6;
    const int b = bt / 36, pt = bt % 36, pos0 = pt * 64;
    const int seg_lo = (pos0 < CTXL) ? 0 : CTXL, seg_hi = (pos0 < CTXL) ? CTXL : TPB;
    const size_t rbase = (size_t)b * TPB;
    const int pfirst = pos0 + pg * 8;
    bool transposed = false;
    if (pass <= 1) {
      if (l == 1 && pos0 < CTXL) continue;
      float cv0[8][8];
#pragma unroll
      for (int sg = 0; sg < 2; ++sg) {
        if (pass == 0 && sg == 1) break;
        const int sgrp = (pass == 0) ? 1 : (sg == 0 ? 0 : 2);
        const int col = sgrp * 256 + cg8;
        float w0[8], w1[8], w2[8], bb[8];
#pragma unroll
        for (int e = 0; e < 8; ++e) { w0[e] = hw[col + e]; w1[e] = hw[768 + col + e]; w2[e] = hw[1536 + col + e]; bb[e] = hb[col + e]; }
        uint4 raw[10];
#pragma unroll
        for (int k = 0; k < 10; ++k) {
          const int pn = pfirst + k - 1;
          raw[k] = (pn >= seg_lo && pn < seg_hi) ? *(const uint4*)&PHY[(rbase + pn) * 768 + col] : make_uint4(0u, 0u, 0u, 0u);
        }
        float xm[8], x0[8], xp[8];
        unpack8(raw[0], xm);
        unpack8(raw[1], x0);
#pragma unroll
        for (int k = 0; k < 8; ++k) {
          unpack8(raw[k + 2], xp);
          float o[8];
#pragma unroll
          for (int e = 0; e < 8; ++e) {
            o[e] = w0[e] * xm[e] + w1[e] * x0[e] + w2[e] * xp[e] + bb[e];
            xm[e] = x0[e]; x0[e] = xp[e];
          }
          if (pass == 0) {
            uint4 o1 = {pack2(o[0], o[1]), pack2(o[2], o[3]), pack2(o[4], o[5]), pack2(o[6], o[7])};
            *(uint4*)&X1C[(rbase + pfirst + k) * 256 + cg8] = o1;
          } else if (sg == 0) {
#pragma unroll
            for (int e = 0; e < 8; ++e) cv0[k][e] = o[e];
          } else {
            uint4 ou = {pack2(o[0] * cv0[k][0], o[1] * cv0[k][1]), pack2(o[2] * cv0[k][2], o[3] * cv0[k][3]),
                        pack2(o[4] * cv0[k][4], o[5] * cv0[k][5]), pack2(o[6] * cv0[k][6], o[7] * cv0[k][7])};
            *(uint4*)&tile[(pg * 8 + k) * 264 + cg8] = ou;
          }
        }
      }
      transposed = (pass == 1);
    } else {
      const int col = (pass - 2) * 256 + cg8;
      float w0[8], w1[8], w2[8], bb[8];
#pragma unroll
      for (int e = 0; e < 8; ++e) { w0[e] = sw[col + e]; w1[e] = sw[1024 + col + e]; w2[e] = sw[2048 + col + e]; bb[e] = sb[col + e]; }
      uint4 raw[10];
#pragma unroll
      for (int k = 0; k < 10; ++k) {
        const int pn = pfirst + k - 1;
        raw[k] = (pn >= seg_lo && pn < seg_hi) ? *(const uint4*)&PXBC[(rbase + pn) * 1024 + col] : make_uint4(0u, 0u, 0u, 0u);
      }
      float xm[8], x0[8], xp[8];
      unpack8(raw[0], xm);
      unpack8(raw[1], x0);
#pragma unroll
      for (int k = 0; k < 8; ++k) {
        unpack8(raw[k + 2], xp);
        float o[8];
#pragma unroll
        for (int e = 0; e < 8; ++e) {
          o[e] = silu_f(w0[e] * xm[e] + w1[e] * x0[e] + w2[e] * xp[e] + bb[e]);
          xm[e] = x0[e]; x0[e] = xp[e];
        }
        uint4 ov = {pack2(o[0], o[1]), pack2(o[2], o[3]), pack2(o[4], o[5]), pack2(o[6], o[7])};
        *(uint4*)&XBCA[(rbase + pfirst + k) * 1024 + col] = ov;
        if (pass < 5) *(uint4*)&tile[(pg * 8 + k) * 264 + cg8] = ov;
      }
      transposed = pass < 5;
    }
    if (transposed) {
      __syncthreads();
      u16* dst = (pass == 1) ? (UT + ((size_t)(tid * 16 + b)) * TPB + pos0) : (TX + ((size_t)(b * 768 + (pass - 2) * 256 + tid)) * TPB + pos0);
#pragma unroll
      for (int pc = 0; pc < 8; ++pc) {
        u32 wv[4];
#pragma unroll
        for (int e = 0; e < 4; ++e)
          wv[e] = (u32)tile[(pc * 8 + 2 * e) * 264 + tid] | ((u32)tile[(pc * 8 + 2 * e + 1) * 264 + tid] << 16);
        uint4 o = {wv[0], wv[1], wv[2], wv[3]};
        *(uint4*)&dst[pc * 8] = o;
      }
      __syncthreads();
    }
  }
}

DI void ssd_item(const Params& p, int l, int it, char* smem) {
  const int tid = TID(), lane = tid & 63, w = tid >> 6, l32 = lane & 31, h = lane >> 5;
  const int b = it >> 4, hd = (it >> 1) & 7, dir = it & 1, g = hd >> 2;
  u16* BG = (u16*)smem;
  u16* HL = BG + 128 * 136;
  float* fa = (float*)(HL + 64 * 136);
  float* fdt = fa + 128;
  float* fsw = fdt + 128;
  float* fea = fsw + 128;
  float* ftot = fea + 128;
  const u16* XBCA = WSP(const u16, OFF_XBCA);
  const u16* TX = WSP(const u16, OFF_TX);
  const float* DT = WSP(const float, OFF_DT);
  u16* Y = WSP(u16, OFF_PXBC) + (dir ? (size_t)ROWS * 512 : 0);
  const float dtb = p.in[I_SDTB][l * 16 + dir * 8 + hd];
  const float a = -expf(p.in[I_SALOG][l * 16 + dir * 8 + hd]);
  const size_t rbase = (size_t)b * TPB;
  f32x16 Hacc[2];
#pragma unroll
  for (int i = 0; i < 2; ++i)
#pragma unroll
    for (int r = 0; r < 16; ++r) Hacc[i][r] = 0.f;
  for (int e = tid; e < 64 * 136; e += NTHR) HL[e] = 0;
  for (int ci = 0; ci < 18; ++ci) {
    const int pos0 = dir ? ((ci < 2) ? (1 - ci) * 128 : (CTXL + (17 - ci) * 128)) : ci * 128;
    asm volatile("s_waitcnt vmcnt(0)" ::: "memory");
    bf16x8 creg[8];
    const u16* cr = XBCA + (rbase + pos0 + w * 32 + l32) * 1024 + 768 + g * 128 + h * 8;
#pragma unroll
    for (int ks = 0; ks < 4; ++ks) creg[ks] = *(const bf16x8*)(cr + ks * 16);
    __builtin_amdgcn_sched_barrier(0);
#pragma unroll
    for (int i = 0; i < 8; ++i) {
      const int q = tid + 256 * i, j = q >> 4, ch = q & 15;
      *(uint4*)&BG[j * 136 + ch * 8] = *(const uint4*)&XBCA[(rbase + pos0 + j) * 1024 + 512 + g * 128 + ch * 8];
    }
    if (w == 0) {
      const float r0 = DT[(rbase + pos0 + 2 * lane) * 16 + dir * 8 + hd] + dtb;
      const float r1 = DT[(rbase + pos0 + 2 * lane + 1) * 16 + dir * 8 + hd] + dtb;
      const float dt0 = (r0 > 20.f) ? r0 : log1pf(expf(r0));
      const float dt1 = (r1 > 20.f) ? r1 : log1pf(expf(r1));
      const float a0 = dt0 * a, a1 = dt1 * a;
      const float sm = a0 + a1;
      float incl = sm;
#pragma unroll
      for (int o = 1; o < 64; o <<= 1) {
        const float t = __shfl_up(incl, o);
        if (lane >= o) incl += t;
      }
      const float excl = incl - sm;
      const float total = __shfl(incl, 63);
      float ac0, ac1;
      if (!dir) { ac0 = excl + a0; ac1 = excl + sm; }
      else { ac0 = total - excl; ac1 = total - excl - a0; }
      fa[2 * lane] = ac0; fa[2 * lane + 1] = ac1;
      fdt[2 * lane] = dt0; fdt[2 * lane + 1] = dt1;
      fsw[2 * lane] = dt0 * __expf(total - ac0); fsw[2 * lane + 1] = dt1 * __expf(total - ac1);
      fea[2 * lane] = __expf(ac0); fea[2 * lane + 1] = __expf(ac1);
      if (lane == 0) ftot[0] = __expf(total);
    }
    __syncthreads();
#pragma unroll
    for (int ks = 4; ks < 8; ++ks) creg[ks] = *(const bf16x8*)(cr + ks * 16);
    f32x16 acc[4], yd[2];
#pragma unroll
    for (int i = 0; i < 4; ++i)
#pragma unroll
      for (int r = 0; r < 16; ++r) acc[i][r] = 0.f;
#pragma unroll
    for (int i = 0; i < 2; ++i)
#pragma unroll
      for (int r = 0; r < 16; ++r) yd[i][r] = 0.f;
#pragma unroll
    for (int ks = 0; ks < 8; ++ks) {
      const bf16x8 areg = creg[ks];
#pragma unroll
      for (int jb = 0; jb < 4; ++jb) {
        const bf16x8 bb = *(const bf16x8*)&BG[(jb * 32 + l32) * 136 + ks * 16 + h * 8];
        acc[jb] = __builtin_amdgcn_mfma_f32_32x32x16_bf16(areg, bb, acc[jb], 0, 0, 0);
      }
    }
    {
      const float eai = fea[w * 32 + l32];
#pragma unroll
      for (int ks = 0; ks < 8; ++ks) {
        union { u32 u[4]; bf16x8 v; } t;
        t.v = creg[ks];
#pragma unroll
        for (int q = 0; q < 4; ++q) t.u[q] = pack2(bflo(t.u[q]) * eai, bfhi(t.u[q]) * eai);
#pragma unroll
        for (int pb = 0; pb < 2; ++pb) {
          const bf16x8 bb = *(const bf16x8*)&HL[(pb * 32 + l32) * 136 + ks * 16 + h * 8];
          yd[pb] = __builtin_amdgcn_mfma_f32_32x32x16_bf16(t.v, bb, yd[pb], 0, 0, 0);
        }
      }
    }
    __syncthreads();
    int l32v = l32, hv_ = h;
    asm volatile("" : "+v"(l32v), "+v"(hv_));
    bf16x8 xf[2][8];
    const u16* xt = TX + ((size_t)(b * 768 + hd * 64 + l32v)) * TPB + pos0 + hv_ * 8;
#pragma unroll
    for (int jb = 0; jb < 4; ++jb) {
      const int j = jb * 32 + l32v;
      const float aj = fa[j], dtj = fdt[j];
#pragma unroll
      for (int r = 0; r < 16; ++r) {
        const int i = w * 32 + (r & 3) + 8 * (r >> 2) + 4 * hv_;
        const float ai = fa[i];
        const bool valid = dir ? (j >= i) : (j <= i);
        const float v = valid ? acc[jb][r] * __expf(ai - aj) * dtj : 0.f;
        BG[i * 136 + j] = f2bf(v);
      }
      __builtin_amdgcn_sched_barrier(0);
      if (jb == 1) {
#pragma unroll
        for (int ks = 0; ks < 8; ++ks) xf[0][ks] = *(const bf16x8*)(xt + ks * 16);
        __builtin_amdgcn_sched_barrier(0);
      }
    }
#pragma unroll
    for (int ks = 0; ks < 8; ++ks) xf[1][ks] = *(const bf16x8*)(xt + (size_t)32 * TPB + ks * 16);
    __builtin_amdgcn_sched_barrier(0);
#pragma unroll
    for (int pb = 0; pb < 2; ++pb)
#pragma unroll
      for (int ks = 0; ks < 8; ++ks) {
        const bf16x8 aa = *(const bf16x8*)&BG[(w * 32 + l32v) * 136 + ks * 16 + hv_ * 8];
        yd[pb] = __builtin_amdgcn_mfma_f32_32x32x16_bf16(aa, xf[pb][ks], yd[pb], 0, 0, 0);
      }
#pragma unroll
    for (int pb = 0; pb < 2; ++pb)
#pragma unroll
      for (int r = 0; r < 16; ++r) {
        const int i = w * 32 + (r & 3) + 8 * (r >> 2) + 4 * hv_;
        Y[(rbase + pos0 + i) * 512 + hd * 64 + pb * 32 + l32v] = f2bf(yd[pb][r]);
      }
    {
      u32x4 braw[8];
      {
        const u16* bt = TX + ((size_t)(b * 768 + 512 + g * 128 + w * 32 + l32v)) * TPB + pos0 + hv_ * 8;
#pragma unroll
        for (int ks = 0; ks < 8; ++ks) braw[ks] = *(const u32x4*)(bt + ks * 16);
      }
      const float eend = ftot[0];
#pragma unroll
      for (int pm = 0; pm < 2; ++pm)
#pragma unroll
        for (int r = 0; r < 16; ++r) Hacc[pm][r] *= eend;
#pragma unroll
      for (int ks = 0; ks < 8; ++ks) {
        const u32x4 raw = braw[ks];
        const float4 s0 = *(const float4*)&fsw[ks * 16 + hv_ * 8];
        const float4 s1 = *(const float4*)&fsw[ks * 16 + hv_ * 8 + 4];
        union { u32 u[4]; bf16x8 v; } bs;
        bs.u[0] = pack2(bflo(raw[0]) * s0.x, bfhi(raw[0]) * s0.y);
        bs.u[1] = pack2(bflo(raw[1]) * s0.z, bfhi(raw[1]) * s0.w);
        bs.u[2] = pack2(bflo(raw[2]) * s1.x, bfhi(raw[2]) * s1.y);
        bs.u[3] = pack2(bflo(raw[3]) * s1.z, bfhi(raw[3]) * s1.w);
#pragma unroll
        for (int pm = 0; pm < 2; ++pm) Hacc[pm] = __builtin_amdgcn_mfma_f32_32x32x16_bf16(xf[pm][ks], bs.v, Hacc[pm], 0, 0, 0);
      }
#pragma unroll
      for (int pm = 0; pm < 2; ++pm)
#pragma unroll
        for (int r = 0; r < 16; ++r) {
          const int pp = pm * 32 + (r & 3) + 8 * (r >> 2) + 4 * hv_;
          HL[pp * 136 + w * 32 + l32v] = f2bf(Hacc[pm][r]);
        }
    }
    __syncthreads();
  }
}

DI void hyena_item(const Params& p, int l, int it) {
  const int lane = TID() & 63, w = TID() >> 6;
  int c, f, L, posoff, tt0, ntile;
  if (it < 2048) { c = it >> 3; f = l; L = 2048; posoff = CTXL; tt0 = (it & 7) * 256 + w * 64; ntile = 32; }
  else { c = it - 2048; f = 2; L = 256; posoff = 0; tt0 = w * 64; ntile = 4; }
  const u16* R0 = WSP(const u16, OFF_RF) + ((size_t)(f * 256 + c) * 2) * RSTR;
  const u16* R1 = R0 + RSTR;
  const u16* UT = WSP(const u16, OFF_UT);
  const int l16 = lane & 15, kg = lane >> 4;
  f32x4 acc[4];
#pragma unroll
  for (int i = 0; i < 4; ++i) acc[i] = (f32x4){0.f, 0.f, 0.f, 0.f};
  const u16* ub = UT + ((size_t)(c * 16 + l16)) * TPB + posoff + kg * 8;
  const u16* rsel = (l16 & 1) ? (R1 - 1) : R0;
  const int nb = L - (tt0 + l16) + kg * 8;
  for (int s0 = 0; s0 < L; s0 += 32) {
    const bf16x8 bfrag = *(const bf16x8*)(ub + s0);
#pragma unroll
    for (int i = 0; i < 4; ++i) {
      const u32* ap = (const u32*)(rsel + (nb - 16 * i + s0));
      union { u32 u[4]; bf16x8 v; } au;
      au.u[0] = ap[0]; au.u[1] = ap[1]; au.u[2] = ap[2]; au.u[3] = ap[3];
      acc[i] = __builtin_amdgcn_mfma_f32_16x16x32_bf16(au.v, bfrag, acc[i], 0, 0, 0);
    }
  }
  float ssq = 0.f;
  for (int t = 0; t < ntile; ++t) ssq += WSP(const float, OFF_PART)[(size_t)(f * 32 + t) * 256 + c];
  const float scale = rsqrtf(ssq + EPSF);
  const float bias = p.in[I_HYBIAS][l * 256 + c];
  const u16* X1C = WSP(const u16, OFF_X1C);
  u16* YM = WSP(u16, OFF_ACT);
  const int b = l16;
#pragma unroll
  for (int i = 0; i < 4; ++i)
#pragma unroll
    for (int r = 0; r < 4; ++r) {
      const int t = tt0 + 16 * i + kg * 4 + r;
      const size_t row = (size_t)b * TPB + posoff + t;
      const float u = bf2f(UT[((size_t)(c * 16 + b)) * TPB + posoff + t]);
      const float x1 = bf2f(X1C[row * 256 + c]);
      YM[row * 1024 + c] = f2bf(x1 * (scale * acc[i][r] + bias * u));
    }
}

DI void hyena_item_lat(const Params& p, int l, int it) {
  const int lane = TID() & 63, w = TID() >> 6;
  const int c = it >> 2, f = l, L = 2048, posoff = CTXL;
  const int tt0 = (it & 3) * 512 + w * 128;
  const u16* R0 = WSP(const u16, OFF_RF) + ((size_t)(f * 256 + c) * 2) * RSTR;
  const u16* R1 = R0 + RSTR;
  const u16* UT = WSP(const u16, OFF_UT);
  const int l16 = lane & 15, kg = lane >> 4;
  f32x4 acc[8];
#pragma unroll
  for (int i = 0; i < 8; ++i) acc[i] = (f32x4){0.f, 0.f, 0.f, 0.f};
  const u16* ub = UT + ((size_t)(c * 16 + l16)) * TPB + posoff + kg * 8;
  const u16* rsel = (l16 & 1) ? (R1 - 1) : R0;
  const int nb = L - (tt0 + l16) + kg * 8;
  union AF { u32 u[4]; bf16x8 v; };
  AF a[8];
#define HY_LOADA(dst, off) { const u32* ap_ = (const u32*)(rsel + (off)); dst.u[0] = ap_[0]; dst.u[1] = ap_[1]; dst.u[2] = ap_[2]; dst.u[3] = ap_[3]; }
#pragma unroll
  for (int i = 2; i < 8; ++i) HY_LOADA(a[i], nb - 16 * i)
#pragma unroll 1
  for (int sb = 0; sb < L; sb += 128) {
#pragma unroll
    for (int u = 0; u < 4; ++u) {
      const int s0 = sb + 32 * u;
      HY_LOADA(a[(0 - 2 * u) & 7], nb + s0)
      HY_LOADA(a[(1 - 2 * u) & 7], nb - 16 + s0)
      const bf16x8 bfrag = *(const bf16x8*)(ub + s0);
#pragma unroll
      for (int i = 0; i < 8; ++i) acc[i] = __builtin_amdgcn_mfma_f32_16x16x32_bf16(a[(i - 2 * u) & 7].v, bfrag, acc[i], 0, 0, 0);
    }
  }
#undef HY_LOADA
  float ssq = 0.f;
  for (int t = 0; t < 32; ++t) ssq += WSP(const float, OFF_PART)[(size_t)(f * 32 + t) * 256 + c];
  const float scale = rsqrtf(ssq + EPSF);
  const float bias = p.in[I_HYBIAS][l * 256 + c];
  const u16* X1C = WSP(const u16, OFF_X1C);
  u16* YM = WSP(u16, OFF_ACT);
  const int b = l16;
#pragma unroll
  for (int i = 0; i < 8; ++i)
#pragma unroll
    for (int r = 0; r < 4; ++r) {
      const int t = tt0 + 16 * i + kg * 4 + r;
      const size_t row = (size_t)b * TPB + posoff + t;
      const float uu = bf2f(UT[((size_t)(c * 16 + b)) * TPB + posoff + t]);
      const float x1 = bf2f(X1C[row * 256 + c]);
      YM[row * 1024 + c] = f2bf(x1 * (scale * acc[i][r] + bias * uu));
    }
}

DI void fnet_item(const Params& p, int it, char* smem) {
  const u16* PQT = WSP(const u16, OFF_PQT);
  u16* YM = WSP(u16, OFF_ACT);
  if (it < 256) {
    const int mt = it >> 5, nt = it & 31;
    const u16* A = WSP(const u16, OFF_DFT);
    auto af = [=](int m, int k) { return A + (size_t)m * 4096 + k; };
    auto bfn = [=](int n, int k) {
      const int b = n >> 8, n2 = n & 255, g = n2 >> 6, kk = n2 & 63, pq = k >> 11, t = k & 2047;
      return PQT + ((size_t)(b * 512 + g * 128 + pq * 64 + kk)) * TPB + CTXL + t;
    };
    auto ef = [=](int m, int n, float v0, float v1, float v2, float v3) {
      const int b = n >> 8, n2 = n & 255;
      const uint2 o = {pack2(v0, v1), pack2(v2, v3)};
      *(uint2*)&YM[((size_t)b * TPB + CTXL + m) * 1024 + 768 + n2] = o;
    };
    gemm_tile<true, 4>(af, bfn, ef, mt * 256, nt * 128, 4096, smem);
  } else {
    const int i2 = it - 256, mt = i2 >> 5, nt = i2 & 31;
    const u16* A = WSP(const u16, OFF_DFTC);
    auto af = [=](int m, int k) { return A + (size_t)m * 512 + k; };
    auto bfn = [=](int n, int k) {
      const int b = n >> 8, n2 = n & 255, g = n2 >> 6, kk = n2 & 63, pq = k >> 8, t = k & 255;
      return PQT + ((size_t)(b * 512 + g * 128 + pq * 64 + kk)) * TPB + t;
    };
    auto ef = [=](int m, int n, float v0, float v1, float v2, float v3) {
      const int b = n >> 8, n2 = n & 255;
      const uint2 o = {pack2(v0, v1), pack2(v2, v3)};
      *(uint2*)&YM[((size_t)b * TPB + m) * 1024 + 768 + n2] = o;
    };
    gemm_tile<true, 4>(af, bfn, ef, mt * 256, nt * 128, 512, smem);
  }
}

DI void phase_mixers(const Params& p, int l, int bid, int nblk, char* smem, int rep = 0) {
  for (int it = bid; it < 256; it += nblk) ssd_item(p, l, it, smem);
  const int nf = (l == 0) ? 288 : 256;
  const int nh = (l == 0) ? 1280 : 1024;
  int* ctr = WSP(int, OFF_CTR) + l + 2 * rep;
  int* sitem = (int*)(smem + LDS_BYTES - 16);
  for (;;) {
    if (TID() == 0) *sitem = atomicAdd(ctr, 1);
    __syncthreads();
    const int it = *sitem;
    __syncthreads();
    if (it >= nf + nh) break;
    if (it < nf) fnet_item(p, it, smem);
    else if (it - nf < 1024) hyena_item_lat(p, l, it - nf);
    else hyena_item(p, l, it - nf + 1024);
  }
}

DI void phase_ssd_combine(const Params& p, int l, int bid, int nblk) {
  const int lane = TID() & 63, w = TID() >> 6;
  const u16* YF = WSP(const u16, OFF_PXBC);
  const u16* YB = YF + (size_t)ROWS * 512;
  const u16* XBCA = WSP(const u16, OFF_XBCA);
  const u16* PZ = WSP(const u16, OFF_PZ);
  u16* YM = WSP(u16, OFF_ACT);
  const float* ng = p.in[I_SNG] + l * 512;
  const int c0 = lane * 8;
  const float dsk = p.in[I_SD][l * 8 + (c0 >> 6)];
  for (int row = bid * 4 + w; row < ROWS; row += nblk * 4) {
    const int pos = row % TPB;
    if (l == 1 && pos < CTXL) continue;
    const uint4 vf = *(const uint4*)(YF + (size_t)row * 512 + c0);
    const uint4 vb = *(const uint4*)(YB + (size_t)row * 512 + c0);
    const uint4 vx = *(const uint4*)(XBCA + (size_t)row * 1024 + c0);
    const uint4 vz = *(const uint4*)(PZ + (size_t)row * 512 + c0);
    const u32 af_[4] = {vf.x, vf.y, vf.z, vf.w}, ab_[4] = {vb.x, vb.y, vb.z, vb.w};
    const u32 ax_[4] = {vx.x, vx.y, vx.z, vx.w}, az_[4] = {vz.x, vz.y, vz.z, vz.w};
    float y[8];
    float ss = 0.f;
#pragma unroll
    for (int i = 0; i < 4; ++i) {
      const float y0 = bflo(af_[i]) + bflo(ab_[i]) + dsk * bflo(ax_[i]);
      const float y1 = bfhi(af_[i]) + bfhi(ab_[i]) + dsk * bfhi(ax_[i]);
      y[2 * i] = y0 * silu_f(bflo(az_[i]));
      y[2 * i + 1] = y1 * silu_f(bfhi(az_[i]));
      ss += y[2 * i] * y[2 * i] + y[2 * i + 1] * y[2 * i + 1];
    }
#pragma unroll
    for (int o = 16; o >= 1; o >>= 1) ss += __shfl_xor(ss, o);
    const float rs = rsqrtf(ss * (1.f / 256.f) + EPSF);
    float o8[8];
#pragma unroll
    for (int i = 0; i < 8; ++i) o8[i] = y[i] * rs * ng[c0 + i];
    uint4 o = {pack2(o8[0], o8[1]), pack2(o8[2], o8[3]), pack2(o8[4], o8[5]), pack2(o8[6], o8[7])};
    *(uint4*)&YM[(size_t)row * 1024 + 256 + c0] = o;
  }
}

DI void phase_outproj(const Params& p, int l, int bid, int nblk, char* smem) {
  const u16* A = WSP(const u16, OFF_ACT);
  const u16* B = WSP(const u16, OFF_WOUT) + (size_t)l * 1024 * 1024;
  const float* MOD = WSP(const float, OFF_MOD);
  const Params pp = p;
  auto af = [=](int m, int k) { return A + (size_t)m * 1024 + k; };
  auto bfn = [=](int n, int k) { return B + (size_t)n * 1024 + k; };
  auto ef = [=](int m, int n, float v0, float v1, float v2, float v3) {
    const int b = m / TPB, pos = m % TPB;
    const float4 ga = *(const float4*)&MOD[(size_t)(l * 17 + (pos < CTXL ? 16 : b)) * 6144 + 2048 + n];
    const float4 xo = *(const float4*)(xrow_ptr(pp, l == 0, b, pos) + n);
    const float4 o = {xo.x + ga.x * v0, xo.y + ga.y * v1, xo.z + ga.z * v2, xo.w + ga.w * v3};
    *(float4*)(xrow_wptr(pp, b, pos) + n) = o;
  };
  const int ntile = (ROWS / 128) * 8;
  const int vb = (nblk % 8 == 0) ? (bid & 7) * (nblk >> 3) + (bid >> 3) : bid;
  for (int t = vb; t < ntile; t += nblk) {
    const int mt = t >> 3, nt = t & 7;
    if (l == 1 && (mt % 18) < 2) continue;
    gemm_tile<true, 2>(af, bfn, ef, mt * 128, nt * 128, 1024, smem);
  }
}

DI void phase_q(const Params& p, int l, int bid, int nblk, char* smem) {
  const u16* A = WSP(const u16, OFF_ACT);
  const u16* B = WSP(const u16, OFF_WQ) + (size_t)l * 2048 * 1024;
  u16* Q = WSP(u16, OFF_Q);
  auto af = [=](int m, int k) { return A + (size_t)m * 1024 + k; };
  auto bfn = [=](int n, int k) { return B + (size_t)n * 1024 + k; };
  auto ef = [=](int m, int n, float v0, float v1, float v2, float v3) {
    const uint2 o = {pack2(v0, v1), pack2(v2, v3)};
    *(uint2*)&Q[(size_t)m * 2048 + n] = o;
  };
  const int ntile = (ROWS / 256) * 16;
  const int vb = (nblk % 8 == 0) ? (bid & 7) * (nblk >> 3) + (bid >> 3) : bid;
  for (int t = vb; t < ntile; t += nblk) {
    const int mt = t >> 4, nt = t & 15;
    if (l == 1 && (mt % 9) < 1) continue;
    gemm_tile<true, 4>(af, bfn, ef, mt * 256, nt * 128, 1024, smem);
  }
}

DI void phase_topk(const Params& p, int l, int bid, int nblk, char* smem) {
  const int tid = TID(), lane = tid & 63, w = tid >> 6, l32 = lane & 31, h = lane >> 5;
  u16* qs = (u16*)smem;
  float* sc = (float*)(smem + 64 * 136 * 2);
  const u16* Q = WSP(const u16, OFF_Q);
  float* TV = WSP(float, OFF_TV);
  int* TI = WSP(int, OFF_TI);
  for (int it = bid; it < (ROWS / 64) * 16; it += nblk) {
    const int hh = it & 15, rt = it >> 4;
    if (l == 1 && (rt % 36) < 4) continue;
    const int row0 = rt * 64;
#pragma unroll
    for (int i = 0; i < 4; ++i) {
      const int q = tid + 256 * i, r = q >> 4, ch = q & 15;
      *(uint4*)&qs[r * 136 + ch * 8] = *(const uint4*)&Q[(size_t)(row0 + r) * 2048 + hh * 128 + ch * 8];
    }
    __syncthreads();
    const u16* kb = WSP(const u16, OFF_K12) + (size_t)(l * 2 + (hh & 1)) * 16384;
    f32x16 acc[2];
#pragma unroll
    for (int i = 0; i < 2; ++i)
#pragma unroll
      for (int r = 0; r < 16; ++r) acc[i][r] = 0.f;
#pragma unroll
    for (int ks = 0; ks < 8; ++ks) {
      const bf16x8 bq = *(const bf16x8*)&kb[(w * 32 + l32) * 128 + ks * 16 + h * 8];
      const bf16x8 a0 = *(const bf16x8*)&qs[(l32) * 136 + ks * 16 + h * 8];
      const bf16x8 a1 = *(const bf16x8*)&qs[(32 + l32) * 136 + ks * 16 + h * 8];
      acc[0] = __builtin_amdgcn_mfma_f32_32x32x16_bf16(a0, bq, acc[0], 0, 0, 0);
      acc[1] = __builtin_amdgcn_mfma_f32_32x32x16_bf16(a1, bq, acc[1], 0, 0, 0);
    }
#pragma unroll
    for (int mt = 0; mt < 2; ++mt)
#pragma unroll
      for (int i = 0; i < 16; ++i) {
        const int r = mt * 32 + (i & 3) + 8 * (i >> 2) + 4 * h;
        sc[r * 133 + w * 33 + l32] = acc[mt][i];
      }
    __syncthreads();
    {
      const int r = tid >> 2, part = tid & 3;
      u32 key[32];
#pragma unroll
      for (int j = 0; j < 32; ++j) {
        const u32 u = __float_as_uint(sc[r * 133 + part * 33 + j]);
        const u32 ord = (u & 0x80000000u) ? ~u : (u | 0x80000000u);
        key[j] = (ord & ~127u) | (u32)(127 - (part * 32 + j));
      }
      float* tv = TV + ((size_t)(row0 + r) * 16 + hh) * 16;
      int* ti = TI + ((size_t)(row0 + r) * 16 + hh) * 16;
      u32 prev = 0xFFFFFFFFu;
#pragma unroll
      for (int rd = 0; rd < 16; ++rd) {
        u32 m = 0u;
#pragma unroll
        for (int j = 0; j < 32; ++j) { const u32 d = key[j] - prev; m = d > m ? d : m; }
        { const u32 o = (u32)__shfl_xor((int)m, 1); m = o > m ? o : m; }
        { const u32 o = (u32)__shfl_xor((int)m, 2); m = o > m ? o : m; }
        const u32 best = prev + m;
        prev = best;
        if (part == 0) {
          const u32 ordv = best & ~127u;
          const u32 uu = (ordv & 0x80000000u) ? (ordv & 0x7FFFFFFFu) : ~ordv;
          tv[rd] = __uint_as_float(uu);
          ti[rd] = 127 - (int)(best & 127u);
        }
      }
    }
    __syncthreads();
  }
}

DI int cand_a(int c) {
  const u32 T[7] = {0x00000000u, 0x00000000u, 0x11111111u, 0x33322222u, 0x66554443u, 0xDCBA9877u, 0x000000FEu};
  u32 wv = T[0];
#pragma unroll
  for (int s = 1; s < 7; ++s) wv = ((c >> 3) == s) ? T[s] : wv;
  return (int)((wv >> ((c & 7) * 4)) & 15u);
}
DI int cand_b(int c) {
  const u32 T[7] = {0x76543210u, 0xFEDCBA98u, 0x76543210u, 0x21043210u, 0x10102103u, 0x00000010u, 0x00000000u};
  u32 wv = T[0];
#pragma unroll
  for (int s = 1; s < 7; ++s) wv = ((c >> 3) == s) ? T[s] : wv;
  return (int)((wv >> ((c & 7) * 4)) & 15u);
}
DI void phase_peer(const Params& p, int l, int bid, int nblk) {
  const int w = TID() >> 6;
  const float* TV = WSP(const float, OFF_TV);
  const int* TI = WSP(const int, OFF_TI);
  const u16* H2 = WSP(const u16, OFF_ACT);
  const unsigned char* UB = WSP(const unsigned char, OFF_XBCA);
  const unsigned char* VB = UB + (size_t)16384 * 1024;
  const float* gfin = p.in[I_GF];
  for (int row = bid * 4 + w; row < ROWS; row += nblk * 4) {
    const int b = row / TPB, pos = row % TPB;
    if (l == 1 && pos < CTXL) continue;
    const int lane = TID() & 63;
    const int head = lane >> 3, sub = lane & 7;
    const float* tv1 = TV + ((size_t)row * 16 + head * 2) * 16;
    const float* tv2 = tv1 + 16;
    const int* ti1 = TI + ((size_t)row * 16 + head * 2) * 16;
    const int* ti2 = ti1 + 16;
    u32 ck[7];
#pragma unroll
    for (int s = 0; s < 7; ++s) {
      const int c = sub + 8 * s;
      if (c < 50) {
        const u32 u = __float_as_uint(tv1[cand_a(c)] + tv2[cand_b(c)]);
        const u32 ord = (u & 0x80000000u) ? ~u : (u | 0x80000000u);
        ck[s] = (ord & ~63u) | (u32)(63 - c);
      } else ck[s] = 0u;
    }
    float w0v = 0.f, w1v = 0.f, mx = 0.f;
    int w0c = 0, w1c = 0;
    u32 prevk = 0xFFFFFFFFu;
#pragma unroll
    for (int r = 0; r < 16; ++r) {
      u32 m = 0u;
#pragma unroll
      for (int s = 0; s < 7; ++s) { const u32 d = ck[s] - prevk; m = d > m ? d : m; }
#pragma unroll
      for (int o = 1; o <= 4; o <<= 1) { const u32 ov = (u32)__shfl_xor((int)m, o); m = ov > m ? ov : m; }
      const u32 best = prevk + m;
      prevk = best;
      const u32 ordv = best & ~63u;
      const float bv = __uint_as_float((ordv & 0x80000000u) ? (ordv & 0x7FFFFFFFu) : ~ordv);
      const int bc = 63 - (int)(best & 63u);
      if (r == 0) mx = bv;
      if (sub == (r & 7)) {
        if (r < 8) { w0v = bv; w0c = bc; } else { w1v = bv; w1c = bc; }
      }
    }
    const float e0 = expf(w0v - mx), e1 = expf(w1v - mx);
    float es = e0 + e1;
#pragma unroll
    for (int o = 1; o <= 4; o <<= 1) es += __shfl_xor(es, o);
    const float g0 = e0 / es, g1 = e1 / es;
    const int idx0 = ti1[cand_a(w0c)] * 128 + ti2[cand_b(w0c)];
    const int idx1 = ti1[cand_a(w1c)] * 128 + ti2[cand_b(w1c)];
    const u16* hrow = H2 + (size_t)row * 1024;
    float hv[16];
    {
      const uint4 ha = *(const uint4*)(hrow + lane * 16), hb = *(const uint4*)(hrow + lane * 16 + 8);
      hv[0] = bflo(ha.x); hv[1] = bfhi(ha.x); hv[2] = bflo(ha.y); hv[3] = bfhi(ha.y);
      hv[4] = bflo(ha.z); hv[5] = bfhi(ha.z); hv[6] = bflo(ha.w); hv[7] = bfhi(ha.w);
      hv[8] = bflo(hb.x); hv[9] = bfhi(hb.x); hv[10] = bflo(hb.y); hv[11] = bfhi(hb.y);
      hv[12] = bflo(hb.z); hv[13] = bfhi(hb.z); hv[14] = bflo(hb.w); hv[15] = bfhi(hb.w);
    }
    float acc[16];
#pragma unroll 1
    for (int prep_ = 0; prep_ < PEER_REPS; ++prep_) {
    f32x2 hv2[8];
#pragma unroll
    for (int i = 0; i < 8; ++i) hv2[i] = (f32x2){hv[2 * i], hv[2 * i + 1]};
    const bool b0 = lane & 1, b1 = lane & 2, b2 = lane & 4;
    float act0 = 0.f, act1 = 0.f;
    u32x4 rb[2][8];
#define PEER_LOAD(buf, k, TAB)                                                                     \
  _Pragma("unroll") for (int j = 0; j < 8; ++j) {                                                  \
    const int e = (k) * 8 + j;                                                                     \
    const int id = __builtin_amdgcn_readlane(((k) < 8) ? idx0 : idx1, e & 63);                     \
    rb[buf][j] = *(const u32x4*)(TAB + (size_t)id * 1024 + lane * 16);                             \
  }
#define PEER_DOT(buf, k)                                                                           \
  {                                                                                                \
    float d[8];                                                                                    \
    _Pragma("unroll") for (int j = 0; j < 8; ++j) {                                                \
      const u32 uw[4] = {rb[buf][j][0], rb[buf][j][1], rb[buf][j][2], rb[buf][j][3]};              \
      f32x2 sa = {0.f, 0.f}, sb = {0.f, 0.f};                   \
      _Pragma("unroll") for (int q = 0; q < 4; ++q) {                                              \
        const f32x2 lo = __builtin_amdgcn_cvt_pk_f32_fp8((int)uw[q], false);                       \
        const f32x2 hi = __builtin_amdgcn_cvt_pk_f32_fp8((int)uw[q], true);                        \
        sa = __builtin_elementwise_fma(hv2[2 * q], lo, sa);                                        \
        sb = __builtin_elementwise_fma(hv2[2 * q + 1], hi, sb);                                    \
      }                                                                                            \
      sa += sb;                                                                                    \
      d[j] = sa.x + sa.y;                                                                          \
    }                                                                                              \
    float a4[4];                                                                                   \
    _Pragma("unroll") for (int q = 0; q < 4; ++q) {                                                \
      const float keep = b0 ? d[2 * q + 1] : d[2 * q], send = b0 ? d[2 * q] : d[2 * q + 1];        \
      a4[q] = keep + __shfl_xor(send, 1);                                                          \
    }                                                                                              \
    float a2[2];                                                                                   \
    _Pragma("unroll") for (int q = 0; q < 2; ++q) {                                                \
      const float keep = b1 ? a4[2 * q + 1] : a4[2 * q], send = b1 ? a4[2 * q] : a4[2 * q + 1];    \
      a2[q] = keep + __shfl_xor(send, 2);                                                          \
    }                                                                                              \
    const float keep = b2 ? a2[1] : a2[0], send = b2 ? a2[0] : a2[1];                              \
    float c1 = keep + __shfl_xor(send, 4);                                                         \
    c1 += __shfl_xor(c1, 8);                                                                       \
    c1 += __shfl_xor(c1, 16);                                                                      \
    c1 += __shfl_xor(c1, 32);                                                                      \
    if ((lane >> 3) == ((k) & 7)) { if ((k) < 8) act0 = c1; else act1 = c1; }                      \
  }
    PEER_LOAD(0, 0, UB)
#pragma unroll 1
    for (int k = 0; k < 16; k += 2) {
      PEER_LOAD(1, k + 1, UB)
      __builtin_amdgcn_sched_barrier(0);
      PEER_DOT(0, k)
      { const int kn = (k + 2 < 16) ? k + 2 : 15; PEER_LOAD(0, kn, UB) }
      __builtin_amdgcn_sched_barrier(0);
      PEER_DOT(1, k + 1)
    }
    const float ga0 = gelu_tanh(act0 * (1.f / U_SCALE)) * g0 * (1.f / V_SCALE);
    const float ga1 = gelu_tanh(act1 * (1.f / U_SCALE)) * g1 * (1.f / V_SCALE);
#pragma unroll
    for (int i = 0; i < 16; ++i) acc[i] = 0.f;
#define PEER_ACC(buf, k)                                                                           \
  _Pragma("unroll") for (int j = 0; j < 8; ++j) {                                                  \
    const int e = (k) * 8 + j;                                                                     \
    const int ai = __builtin_amdgcn_readlane(__builtin_bit_cast(int, ((k) < 8) ? ga0 : ga1), e & 63); \
    const float a = __builtin_bit_cast(float, ai);                                                 \
    const u32 vw[4] = {rb[buf][j][0], rb[buf][j][1], rb[buf][j][2], rb[buf][j][3]};                \
    _Pragma("unroll") for (int q = 0; q < 4; ++q) {                                                \
      const f32x2 lo = __builtin_amdgcn_cvt_pk_f32_fp8((int)vw[q], false);                         \
      const f32x2 hi = __builtin_amdgcn_cvt_pk_f32_fp8((int)vw[q], true);                          \
      acc[q * 4 + 0] += a * lo.x; acc[q * 4 + 1] += a * lo.y; acc[q * 4 + 2] += a * hi.x; acc[q * 4 + 3] += a * hi.y; \
    }                                                                                              \
  }
    PEER_LOAD(0, 0, VB)
#pragma unroll 1
    for (int k = 0; k < 16; k += 2) {
      PEER_LOAD(1, k + 1, VB)
      __builtin_amdgcn_sched_barrier(0);
      PEER_ACC(0, k)
      { const int kn = (k + 2 < 16) ? k + 2 : 15; PEER_LOAD(0, kn, VB) }
      __builtin_amdgcn_sched_barrier(0);
      PEER_ACC(1, k + 1)
    }
#undef PEER_LOAD
#undef PEER_DOT
#undef PEER_ACC
      if (prep_ + 1 < PEER_REPS) { _Pragma("unroll") for (int i = 0; i < 16; ++i) asm volatile("" :: "v"(acc[i])); }
    }
    int row2 = row;
    asm volatile("" : "+v"(row2));
    const int lane2 = TID() & 63;
    const int b2 = row2 / TPB, pos2 = row2 % TPB;
    const float* xr = xrow_ptr(p, false, b2, pos2);
    float* xw = xrow_wptr(p, b2, pos2);
    const float* ga = WSP(const float, OFF_MOD) + (size_t)(l * 17 + (pos2 < CTXL ? 16 : b2)) * 6144 + 5120;
    float xn[16];
    float ss = 0.f;
#pragma unroll
    for (int q = 0; q < 4; ++q) {
      const float4 xv = *(const float4*)(xr + lane2 * 16 + q * 4);
      const float4 gv = *(const float4*)(ga + lane2 * 16 + q * 4);
      xn[q * 4 + 0] = xv.x + gv.x * acc[q * 4 + 0];
      xn[q * 4 + 1] = xv.y + gv.y * acc[q * 4 + 1];
      xn[q * 4 + 2] = xv.z + gv.z * acc[q * 4 + 2];
      xn[q * 4 + 3] = xv.w + gv.w * acc[q * 4 + 3];
    }
    if (l == 1) {
#pragma unroll
      for (int i = 0; i < 16; ++i) ss += xn[i] * xn[i];
      ss = wave_sum(ss);
      const float rs = rsqrtf(ss * (1.f / 1024.f) + EPSF);
#pragma unroll
      for (int i = 0; i < 16; ++i) xn[i] = xn[i] * rs * gfin[lane2 * 16 + i];
    }
#pragma unroll
    for (int q = 0; q < 4; ++q) {
      float4 o = {xn[q * 4 + 0], xn[q * 4 + 1], xn[q * 4 + 2], xn[q * 4 + 3]};
      *(float4*)(xw + lane2 * 16 + q * 4) = o;
    }
  }
}

template <int S>
DI void run_stage(const Params& p, int l, int bid, int nblk, char* smem) {
  for (int rep = 0; rep < 1 + ((REP_MASK >> (S + 1)) & 1); ++rep) {
  if (S == 0) { if (PH_MASK & 2) phase_norm(p, l, 0, bid, nblk); }
  else if (S == 1) { if (PH_MASK & 4) phase_inproj(p, l, bid, nblk, smem); }
  else if (S == 2) { if (PH_MASK & 8) phase_prep(p, l, bid, nblk, smem); }
  else if (S == 3) { if (PH_MASK & 16) phase_mixers(p, l, bid, nblk, smem, rep); }
  else if (S == 4) { if (PH_MASK & 32) phase_ssd_combine(p, l, bid, nblk); }
  else if (S == 5) { if (PH_MASK & 64) phase_outproj(p, l, bid, nblk, smem); }
  else if (S == 6) { if (PH_MASK & 128) { phase_norm(p, l, 1, bid, nblk); phase_tables(p, l, bid, nblk); } }
  else if (S == 7) { if (PH_MASK & 256) phase_q(p, l, bid, nblk, smem); }
  else if (S == 8) { if (PH_MASK & 512) phase_topk(p, l, bid, nblk, smem); }
  else { if (PH_MASK & 1024) phase_peer(p, l, bid, nblk); }
  }
}

#if ONE_LAUNCH
__global__ void __launch_bounds__(NTHR, 2) mega(Params p) {
  extern __shared__ __attribute__((aligned(16))) char smem[];
  const int bid = blockIdx.x, nblk = gridDim.x;
  cg::grid_group grid = cg::this_grid();
  volatile LAS unsigned* bst = (volatile LAS unsigned*)(smem + LDS_BYTES - 32);
  if (threadIdx.x == 0) { bst[0] = 0u; bst[1] = 0u; }
  __syncthreads();
  const XcdBarrier bar = xcd_barrier_post(WSP(unsigned, OFF_BAR), bst);
  for (int rep = 0; rep < 1 + (REP_MASK & 1); ++rep) { if (PH_MASK & 1) phase_prologue(p, bid, nblk, smem); }
  grid.sync();
#define GBAR() xcd_barrier(bar)
#pragma nounroll
  for (int l = 0; l < 2; ++l) {
    for (int xs = 0; xs < EXTRA_SYNCS; ++xs) GBAR();
    run_stage<0>(p, l, bid, nblk, smem); GBAR();
    run_stage<1>(p, l, bid, nblk, smem); GBAR();
    run_stage<2>(p, l, bid, nblk, smem); GBAR();
    run_stage<3>(p, l, bid, nblk, smem); GBAR();
    run_stage<4>(p, l, bid, nblk, smem); GBAR();
    run_stage<5>(p, l, bid, nblk, smem); GBAR();
    run_stage<6>(p, l, bid, nblk, smem); GBAR();
    run_stage<7>(p, l, bid, nblk, smem); GBAR();
    run_stage<8>(p, l, bid, nblk, smem); GBAR();
    run_stage<9>(p, l, bid, nblk, smem);
    if (l == 0) GBAR();
  }
}
#else
template <int S>
__global__ void __launch_bounds__(NTHR, 2) stage_kernel(Params p, int l) {
  extern __shared__ __attribute__((aligned(16))) char smem[];
  if (S < 0) phase_prologue(p, blockIdx.x, gridDim.x, smem);
  else run_stage<(S < 0 ? 0 : S)>(p, l, blockIdx.x, gridDim.x, smem);
}

template <int S>
static void launch_stage(const Params& p, int l, int grid, hipStream_t stream) {
  (void)hipFuncSetAttribute((const void*)stage_kernel<S>, hipFuncAttributeMaxDynamicSharedMemorySize, LDS_BYTES);
  hipLaunchKernelGGL(stage_kernel<S>, dim3(grid), dim3(NTHR), LDS_BYTES, stream, p, l);
}

#endif

extern "C" void kernel_launch(void* const* d_in, const int* in_sizes, int n_in, void* d_out, int out_size, void* d_ws,
                              size_t ws_size, hipStream_t stream) {
  static int grid = 0;
  if (grid == 0) {
    if (ws_size < WS_END || n_in != 31) { fprintf(stderr, "kernel_launch: ws %zu < %zu or n_in %d\n", ws_size, (size_t)WS_END, n_in); grid = -1; return; }
    int dev = 0, cus = 0, per_cu = 0;
    (void)hipGetDevice(&dev);
    (void)hipDeviceGetAttribute(&cus, hipDeviceAttributeMultiprocessorCount, dev);
#if ONE_LAUNCH
    (void)hipFuncSetAttribute((const void*)mega, hipFuncAttributeMaxDynamicSharedMemorySize, LDS_BYTES);
    (void)hipOccupancyMaxActiveBlocksPerMultiprocessor(&per_cu, (const void*)mega, NTHR, LDS_BYTES);
#else
    (void)hipFuncSetAttribute((const void*)stage_kernel<3>, hipFuncAttributeMaxDynamicSharedMemorySize, LDS_BYTES);
    (void)hipOccupancyMaxActiveBlocksPerMultiprocessor(&per_cu, (const void*)stage_kernel<3>, NTHR, LDS_BYTES);
#endif
    if (per_cu < 1) per_cu = 1;
    if (per_cu > 2) per_cu = 2;
    grid = cus * per_cu;
  }
  if (grid < 0) return;
  (void)hipMemsetAsync((char*)d_ws + OFF_CTR, 0, 256 + 3456 * 4, stream);
  Params p{};
  for (int i = 0; i < 31; ++i) p.in[i] = (const float*)d_in[i];
  p.out = (float*)d_out;
  p.ws = (unsigned char*)d_ws;
#if ONE_LAUNCH
  void* args[] = {&p};
  hipError_t e = hipLaunchCooperativeKernel((const void*)mega, dim3(grid), dim3(NTHR), args, LDS_BYTES, stream);
  if (e != hipSuccess) fprintf(stderr, "cooperative launch failed: %s (grid %d)\n", hipGetErrorString(e), grid);
#else
  launch_stage<-1>(p, 0, grid, stream);
  for (int l = 0; l < 2; ++l) {
    launch_stage<0>(p, l, grid, stream);
    launch_stage<1>(p, l, grid, stream);
    launch_stage<2>(p, l, grid, stream);
    launch_stage<3>(p, l, grid, stream);
    launch_stage<4>(p, l, grid, stream);
    launch_stage<5>(p, l, grid, stream);
    launch_stage<6>(p, l, grid, stream);
    launch_stage<7>(p, l, grid, stream);
    launch_stage<8>(p, l, grid, stream);
    launch_stage<9>(p, l, grid, stream);
  }
#endif
}
```

```cpp
#include <hip/hip_runtime.h>
#include <hip/hip_cooperative_groups.h>
#include <cstdio>
namespace cg = cooperative_groups;

#ifndef PH_MASK
#define PH_MASK 0xFFFF
#endif
#ifndef PEER_REPS
#define PEER_REPS 1
#endif
#ifndef EXTRA_SYNCS
#define EXTRA_SYNCS 0
#endif
#ifndef REP_MASK
#define REP_MASK 0
#endif
#ifndef ONE_LAUNCH
#define ONE_LAUNCH 1
#endif

typedef unsigned short u16;
typedef unsigned int u32;
typedef __attribute__((ext_vector_type(8))) short bf16x8;
typedef __attribute__((ext_vector_type(16))) float f32x16;
typedef __attribute__((ext_vector_type(4))) float f32x4;
typedef __attribute__((ext_vector_type(2))) float f32x2;
typedef __attribute__((ext_vector_type(4))) unsigned int u32x4;
#define DI __device__ __forceinline__
DI int TID() { int t = threadIdx.x; asm volatile("" : "+v"(t)); return t; }

DI u16 f2bf(float x) { u32 u = __float_as_uint(x); u += 0x7fffu + ((u >> 16) & 1u); return (u16)(u >> 16); }
DI float bf2f(u16 v) { return __uint_as_float(((u32)v) << 16); }
DI u32 pack2(float a, float b) { return (u32)f2bf(a) | ((u32)f2bf(b) << 16); }
DI float bflo(u32 v) { return __uint_as_float(v << 16); }
DI float bfhi(u32 v) { return __uint_as_float(v & 0xffff0000u); }

constexpr int D = 1024, NB = 16, SEQ = 2048, CTXL = 256, TPB = 2304, ROWS = NB * TPB;
constexpr int NIN = 2944;
constexpr int RSTR = 4112;
constexpr int NTHR = 256;
constexpr int LDS_BYTES = 73728;
constexpr float EPSF = 1e-6f;

constexpr size_t SZ_PHY = (size_t)ROWS * 768 * 2, SZ_PZ = (size_t)ROWS * 512 * 2, SZ_PXBC = (size_t)ROWS * 1024 * 2;
constexpr size_t OFF_PHY = 0;
constexpr size_t OFF_PZ = OFF_PHY + SZ_PHY;
constexpr size_t OFF_PXBC = OFF_PZ + SZ_PZ;
constexpr size_t OFF_Q = OFF_PHY;
constexpr size_t OFF_ACT = OFF_PXBC + SZ_PXBC;
constexpr size_t OFF_XBCA = OFF_ACT + (size_t)ROWS * 1024 * 2;
constexpr size_t OFF_DREG = OFF_XBCA + (size_t)ROWS * 1024 * 2;
constexpr size_t OFF_PQT = OFF_DREG;
constexpr size_t OFF_UT = OFF_PQT + (size_t)NB * 512 * TPB * 2;
constexpr size_t OFF_X1C = OFF_UT + (size_t)256 * 16 * TPB * 2;
constexpr size_t OFF_TV = OFF_DREG;
constexpr size_t OFF_TI = OFF_TV + (size_t)ROWS * 256 * 4;
constexpr size_t OFF_XC = OFF_DREG + (size_t)ROWS * 256 * 8;
constexpr size_t OFF_WIN = OFF_XC + (size_t)NB * CTXL * D * 4;
constexpr size_t OFF_WOUT = OFF_WIN + (size_t)2 * NIN * 1024 * 2;
constexpr size_t OFF_WQ = OFF_WOUT + (size_t)2 * 1024 * 1024 * 2;
constexpr size_t OFF_K12 = OFF_WQ + (size_t)2 * 2048 * 1024 * 2;
constexpr size_t OFF_DFT = OFF_K12 + (size_t)2 * 2 * 128 * 128 * 2;
constexpr size_t OFF_DFTC = OFF_DFT + (size_t)2048 * 4096 * 2;
constexpr size_t OFF_RF = OFF_DFTC + (size_t)256 * 512 * 2;
constexpr size_t OFF_PART = OFF_RF + (size_t)3 * 256 * 2 * RSTR * 2;
constexpr size_t OFF_MOD = OFF_PART + (size_t)3 * 32 * 256 * 4;
constexpr size_t OFF_DT = OFF_MOD + (size_t)2 * 17 * 6144 * 4;
constexpr size_t OFF_CTR = OFF_DT + (size_t)ROWS * 16 * 4;
constexpr size_t OFF_BAR = OFF_CTR + 256;
constexpr size_t OFF_TX = OFF_BAR + 3456 * 4;
constexpr size_t WS_END = OFF_TX + (size_t)NB * 768 * TPB * 2;

struct Params {
  const float* in[31];
  float* out;
  unsigned char* ws;
  int pad0, pad1;
};

enum { I_X = 0, I_C, I_CTX, I_CCTX, I_WADA, I_BADA, I_G1, I_G2, I_WIN, I_HYCW, I_HYCB, I_HFW1, I_HFB1, I_HFW2, I_HFB2,
       I_HFW3, I_HFFREQ, I_HYBIAS, I_SCW, I_SCB, I_SDTB, I_SALOG, I_SD, I_SNG, I_WOUT, I_WQ, I_K1, I_K2, I_PU, I_PV, I_GF };

__device__ const unsigned char CAND_A[56] = {0, 0, 0, 0, 0, 0, 0, 0, 0, 0, 0, 0, 0, 0, 0, 0, 1, 1, 1, 1, 1, 1, 1, 1, 2, 2, 2, 2, 2, 3, 3, 3, 3, 4, 4, 4, 5, 5, 6, 6, 7, 7, 8, 9, 10, 11, 12, 13, 14, 15, 0, 0, 0, 0, 0, 0};
__device__ const unsigned char CAND_B[56] = {0, 1, 2, 3, 4, 5, 6, 7, 8, 9, 10, 11, 12, 13, 14, 15, 0, 1, 2, 3, 4, 5, 6, 7, 0, 1, 2, 3, 4, 0, 1, 2, 3, 0, 1, 2, 0, 1, 0, 1, 0, 1, 0, 0, 0, 0, 0, 0, 0, 0, 0, 0, 0, 0, 0, 0};

#define WSP(T, off) ((T*)(p.ws + (off)))

#define XB_TMO      128
#define XB_XCNT(j)  (256  + 64 * (j))
#define XB_XSUB(j)  (1280 + 64 * (j))
#define XB_XGEN(j)  (2304 + 64 * (j))
#define XB_TOP      3328
#define XB_TOPGEN   3392
#define XCD_BAR_WORDS 3456
#define XB_SPIN_CAP (1u << 18)
#define LAS __attribute__((address_space(3)))
DI unsigned xb_ld(unsigned* p) { return __hip_atomic_load(p, __ATOMIC_RELAXED, __HIP_MEMORY_SCOPE_AGENT); }
DI unsigned xb_add(unsigned* p, unsigned v) { return __hip_atomic_fetch_add(p, v, __ATOMIC_RELAXED, __HIP_MEMORY_SCOPE_AGENT); }
DI unsigned xb_xcc_id() { return (unsigned)__builtin_amdgcn_s_getreg((3 << 11) | 20) & 0xFu; }
#define XB_SPIN(cond, bar) do { unsigned _sp = 0; while (cond) { __builtin_amdgcn_s_sleep(1); \
    if ((++_sp & 255u) == 0u) { if (xb_ld(&(bar)[XB_TMO])) break; if (_sp > XB_SPIN_CAP) { atomicAdd(&(bar)[XB_TMO], 1u); break; } } } } while (0)
struct XcdBarrier { unsigned* bar; unsigned x; volatile LAS unsigned* st; };
DI XcdBarrier xcd_barrier_post(unsigned* bar, volatile LAS unsigned* st) {
  XcdBarrier b; b.bar = bar; b.x = xb_xcc_id(); b.st = st;
  if (threadIdx.x == 0) (void)xb_add(&bar[XB_XCNT(b.x)], 1u);
  return b;
}
DI void xcd_barrier_complete(unsigned* bar, unsigned x, unsigned& nloc, unsigned& nx) {
  const unsigned G = gridDim.x * gridDim.y * gridDim.z;
  unsigned sum, cnt, mine, sp = 0u;
  for (;;) {
    sum = 0u; cnt = 0u; mine = 0u;
#pragma unroll
    for (unsigned j = 0; j < 16; ++j) { const unsigned c = xb_ld(&bar[XB_XCNT(j)]); sum += c; cnt += (c > 0u) ? 1u : 0u; mine = (j == x) ? c : mine; }
    if (sum == G) break;
    __builtin_amdgcn_s_sleep(1);
    if ((++sp & 255u) == 0u) { if (xb_ld(&bar[XB_TMO])) break; if (sp > XB_SPIN_CAP) { atomicAdd(&bar[XB_TMO], 1u); break; } }
  }
  nloc = mine > 0u ? mine : 1u; nx = cnt > 0u ? cnt : 1u;
}
DI void xcd_barrier(const XcdBarrier& b) {
  asm volatile("s_waitcnt vmcnt(0)" ::: "memory");
  __syncthreads();
  if (threadIdx.x == 0) {
    unsigned* bar = b.bar;
    __builtin_amdgcn_s_waitcnt(0);
    unsigned nloc = b.st[0], nx = b.st[1];
    if (nloc == 0u) { xcd_barrier_complete(bar, b.x, nloc, nx); b.st[0] = nloc; b.st[1] = nx; }
    const unsigned old = xb_add(&bar[XB_XSUB(b.x)], 1u);
    const unsigned gen = old / nloc;
    if (old + 1u == (gen + 1u) * nloc) {
      __builtin_amdgcn_fence(__ATOMIC_RELEASE, "agent");
      asm volatile("s_waitcnt vmcnt(0)" ::: "memory");
      const unsigned og = xb_add(&bar[XB_TOP], 1u);
      const unsigned tg = og / nx;
      if (og + 1u == (tg + 1u) * nx) xb_add(&bar[XB_TOPGEN], 1u);
      else XB_SPIN(xb_ld(&bar[XB_TOPGEN]) == tg, bar);
      __builtin_amdgcn_fence(__ATOMIC_ACQUIRE, "agent");
      xb_add(&bar[XB_XGEN(b.x)], 1u);
      asm volatile("s_waitcnt vmcnt(0)" ::: "memory");
    } else {
      XB_SPIN(xb_ld(&bar[XB_XGEN(b.x)]) == gen, bar);
      __builtin_amdgcn_fence(__ATOMIC_ACQUIRE, "agent");
      asm volatile("s_waitcnt vmcnt(0)" ::: "memory");
    }
  }
  __syncthreads();
}


template <bool SWAP, int MI, class AF, class BF, class EF>
DI void gemm_tile(const AF& af, const BF& bfn, const EF& ef, int m0, int n0, int K, char* smem) {
  constexpr int AROWS = MI * 64;
  u16* As = (u16*)smem;
  u16* Bs = As + 2 * AROWS * 40;
  const int tid = TID(), lane = tid & 63, w = tid >> 6;
  const int wm = w >> 1, wn = w & 1, l32 = lane & 31, h = lane >> 5;
  const int lrow = (tid >> 6) * 16 + ((tid >> 5) & 1) * 8 + ((tid >> 2) & 1) * 4 + ((tid >> 3) & 3), lk = (tid & 3) * 8;
  f32x16 acc[MI][2];
#pragma unroll
  for (int i = 0; i < MI; ++i)
#pragma unroll
    for (int j = 0; j < 2; ++j)
#pragma unroll
      for (int r = 0; r < 16; ++r) acc[i][j][r] = 0.f;
  u32x4 ra[MI], rb[2];
  const int nk = K >> 5;
#pragma unroll
  for (int i = 0; i < MI; ++i) ra[i] = *(const u32x4*)af(m0 + lrow + 64 * i, lk);
#pragma unroll
  for (int i = 0; i < 2; ++i) rb[i] = *(const u32x4*)bfn(n0 + lrow + 64 * i, lk);
#pragma unroll
  for (int i = 0; i < MI; ++i) *(u32x4*)&As[(lrow + 64 * i) * 40 + lk] = ra[i];
#pragma unroll
  for (int i = 0; i < 2; ++i) *(u32x4*)&Bs[(lrow + 64 * i) * 40 + lk] = rb[i];
  {
    const int k1 = (nk > 1) ? 32 + lk : lk;
#pragma unroll
    for (int i = 0; i < MI; ++i) ra[i] = *(const u32x4*)af(m0 + lrow + 64 * i, k1);
#pragma unroll
    for (int i = 0; i < 2; ++i) rb[i] = *(const u32x4*)bfn(n0 + lrow + 64 * i, k1);
  }
  __syncthreads();
  for (int kt = 0; kt < nk; ++kt) {
    const int cur = kt & 1;
    const u16* Ab = As + cur * AROWS * 40;
    const u16* Bb = Bs + cur * 128 * 40;
#pragma unroll
    for (int ks = 0; ks < 2; ++ks) {
      bf16x8 a[MI], b[2];
#pragma unroll
      for (int i = 0; i < MI; ++i) a[i] = *(const bf16x8*)&Ab[(wm * (MI * 32) + i * 32 + l32) * 40 + ks * 16 + h * 8];
#pragma unroll
      for (int i = 0; i < 2; ++i) b[i] = *(const bf16x8*)&Bb[(wn * 64 + i * 32 + l32) * 40 + ks * 16 + h * 8];
#pragma unroll
      for (int i = 0; i < MI; ++i)
#pragma unroll
        for (int j = 0; j < 2; ++j)
          acc[i][j] = SWAP ? __builtin_amdgcn_mfma_f32_32x32x16_bf16(b[j], a[i], acc[i][j], 0, 0, 0)
                           : __builtin_amdgcn_mfma_f32_32x32x16_bf16(a[i], b[j], acc[i][j], 0, 0, 0);
    }
    {
      u16* An = As + (cur ^ 1) * AROWS * 40;
      u16* Bn = Bs + (cur ^ 1) * 128 * 40;
#pragma unroll
      for (int i = 0; i < MI; ++i) *(u32x4*)&An[(lrow + 64 * i) * 40 + lk] = ra[i];
#pragma unroll
      for (int i = 0; i < 2; ++i) *(u32x4*)&Bn[(lrow + 64 * i) * 40 + lk] = rb[i];
      const int kn = (kt + 2 < nk) ? kt + 2 : nk - 1;
      const int k0 = kn * 32 + lk;
#pragma unroll
      for (int i = 0; i < MI; ++i) ra[i] = *(const u32x4*)af(m0 + lrow + 64 * i, k0);
#pragma unroll
      for (int i = 0; i < 2; ++i) rb[i] = *(const u32x4*)bfn(n0 + lrow + 64 * i, k0);
    }
    __syncthreads();
  }
#pragma unroll
  for (int i = 0; i < MI; ++i)
#pragma unroll
    for (int j = 0; j < 2; ++j)
#pragma unroll
      for (int rg = 0; rg < 4; ++rg) {
        const int m = SWAP ? (m0 + wm * (MI * 32) + i * 32 + l32) : (m0 + wm * (MI * 32) + i * 32 + rg * 8 + h * 4);
        const int n = SWAP ? (n0 + wn * 64 + j * 32 + rg * 8 + h * 4) : (n0 + wn * 64 + j * 32 + l32);
        ef(m, n, acc[i][j][rg * 4 + 0], acc[i][j][rg * 4 + 1], acc[i][j][rg * 4 + 2], acc[i][j][rg * 4 + 3]);
      }
}

template <int CTRL> DI int dpp_i(int v) { return __builtin_amdgcn_mov_dpp(v, CTRL, 0xF, 0xF, true); }
template <int CTRL> DI float dpp_f(float v) { return __builtin_bit_cast(float, __builtin_amdgcn_mov_dpp(__builtin_bit_cast(int, v), CTRL, 0xF, 0xF, true)); }
#define DPP_XOR1 0xB1
#define DPP_XOR2 0x4E
#define DPP_MIRROR8 0x141
DI float wave_sum(float v) {
#pragma unroll
  for (int o = 32; o >= 1; o >>= 1) v += __shfl_xor(v, o);
  return v;
}
DI float silu_f(float x) { return x / (1.f + __expf(-x)); }
DI float gelu_tanh(float x) {
  const float u = 0.7978845608028654f * (x + 0.044715f * x * x * x);
  return 0.5f * x * (1.f + tanhf(u));
}

DI const float* xrow_ptr(const Params& p, bool from_input, int b, int pos) {
  if (pos < CTXL) return (from_input ? p.in[I_CTX] : WSP(const float, OFF_XC)) + ((size_t)b * CTXL + pos) * D;
  return (from_input ? p.in[I_X] : (const float*)p.out) + ((size_t)b * SEQ + (pos - CTXL)) * D;
}
DI float* xrow_wptr(const Params& p, int b, int pos) {
  if (pos < CTXL) return WSP(float, OFF_XC) + ((size_t)b * CTXL + pos) * D;
  return p.out + ((size_t)b * SEQ + (pos - CTXL)) * D;
}

DI void phase_prologue(const Params& p, int bid, int nblk, char* smem) {
  const int tid = TID();
  const int gtid = bid * NTHR + tid, gn = nblk * NTHR;
  {
    float* scs = (float*)smem;
    for (int it = bid; it < 192; it += nblk) {
      const int l = it / 96, col0 = (it % 96) * 64;
      for (int e = tid; e < 17 * 1024; e += NTHR) {
        const int j = e >> 10, k = e & 1023;
        const float v = (j < 16) ? p.in[I_C][j * 1024 + k] : p.in[I_CCTX][k];
        scs[e] = v / (1.f + expf(-v));
      }
      __syncthreads();
      const int col = tid & 63, kq = tid >> 6;
      float acc[17];
#pragma unroll
      for (int j = 0; j < 17; ++j) acc[j] = 0.f;
      const float* wa = p.in[I_WADA] + (size_t)l * 1024 * 6144 + col0 + col;
      for (int k0 = kq * 256; k0 < kq * 256 + 256; k0 += 8) {
        float wv[8];
#pragma unroll
        for (int kk = 0; kk < 8; ++kk) wv[kk] = wa[(size_t)(k0 + kk) * 6144];
#pragma unroll
        for (int kk = 0; kk < 8; ++kk)
#pragma unroll
          for (int j = 0; j < 17; ++j) acc[j] += scs[j * 1024 + k0 + kk] * wv[kk];
      }
      __syncthreads();
#pragma unroll
      for (int j = 0; j < 17; ++j) scs[(kq * 17 + j) * 64 + col] = acc[j];
      __syncthreads();
      for (int e = tid; e < 17 * 64; e += NTHR) {
        const int j = e >> 6, cc = e & 63;
        float s = p.in[I_BADA][l * 6144 + col0 + cc];
#pragma unroll
        for (int q = 0; q < 4; ++q) s += scs[(q * 17 + j) * 64 + cc];
        WSP(float, OFF_MOD)[(size_t)(l * 17 + j) * 6144 + col0 + cc] = s;
      }
      __syncthreads();
    }
  }
  {
    float* zs = (float*)smem;
    float* h1s = zs + 64 * 33;
    float* h2s = h1s + 64 * 64;
    for (int it = (nblk >= 260 ? (bid >= 192 ? bid - 192 : 1 << 20) : bid); it < 68; it += nblk) {
      const int f = it < 32 ? 0 : (it < 64 ? 1 : 2);
      const int tile = it - (f == 0 ? 0 : (f == 1 ? 32 : 64));
      const int L = (f == 2) ? 256 : 2048;
      const int lyr = (f == 1) ? 1 : 0;
      const int pos0 = tile * 64;
      const float* w1 = p.in[I_HFW1] + lyr * 33 * 64;
      const float* b1 = p.in[I_HFB1] + lyr * 64;
      const float* w2 = p.in[I_HFW2] + lyr * 64 * 64;
      const float* b2 = p.in[I_HFB2] + lyr * 64;
      const float* w3 = p.in[I_HFW3] + lyr * 64 * 512;
      const float* fq = p.in[I_HFFREQ] + lyr * 64;
      for (int e = tid; e < 64 * 33; e += NTHR) {
        const int pi = e / 33, q = e % 33;
        const int pos = pos0 + pi;
        const float tt = (float)pos / (float)(L - 1);
        const float wv = 6.283185307179586f * (float)pos / (float)L;
        float z;
        if (q == 0) z = tt;
        else if (q <= 16) { const float fi = 1e-4f + (float)(q - 1) * ((15.f - 1e-4f) / 15.f); z = cosf(fi * wv); }
        else { const float fi = 1e-4f + (float)(q - 17) * ((15.f - 1e-4f) / 15.f); z = -sinf(fi * wv); }
        zs[e] = z;
      }
      __syncthreads();
      for (int e = tid; e < 64 * 64; e += NTHR) {
        const int pi = e >> 6, j = e & 63;
        float s = b1[j];
        for (int q = 0; q < 33; ++q) s += zs[pi * 33 + q] * w1[q * 64 + j];
        h1s[e] = sinf(fq[j] * s);
      }
      __syncthreads();
      for (int e = tid; e < 64 * 64; e += NTHR) {
        const int pi = e >> 6, j = e & 63;
        float s = b2[j];
        for (int k = 0; k < 64; ++k) s += h1s[pi * 64 + k] * w2[k * 64 + j];
        h2s[e] = sinf(fq[j] * s);
      }
      __syncthreads();
      {
        const int c = tid;
        const float mind = logf(1e-2f) / 1.5f, maxd = logf(1e-2f) / 0.3f;
        const float delta = fabsf(mind + (float)c * ((maxd - mind) / 255.f));
        u16* R0 = WSP(u16, OFF_RF) + ((size_t)(f * 256 + c) * 2 + 0) * RSTR;
        u16* R1 = R0 + RSTR;
        float ssq = 0.f;
        for (int pb = 0; pb < 4; ++pb) {
          float af_[16], ab_[16];
#pragma unroll
          for (int i = 0; i < 16; ++i) { af_[i] = 0.f; ab_[i] = 0.f; }
          for (int k = 0; k < 64; ++k) {
            const float wf = w3[k * 512 + c], wb = w3[k * 512 + 256 + c];
#pragma unroll
            for (int i = 0; i < 16; ++i) {
              const float hv = h2s[(pb * 16 + i) * 64 + k];
              af_[i] += hv * wf;
              ab_[i] += hv * wb;
            }
          }
#pragma unroll
          for (int i = 0; i < 16; ++i) {
            const int pos = pos0 + pb * 16 + i;
            const float tt = (float)pos / (float)(L - 1);
            const float win = expf(-tt * delta);
            const float vf = af_[i] * win, vb = ab_[i] * win;
            const u16 bfv = f2bf(vf), bbv = f2bf(vb);
            R0[L - pos] = bfv;
            R1[L - pos - 1] = bfv;
            ssq += vf * vf;
            if (pos >= 1) {
              R0[L + pos] = bbv;
              R1[L + pos - 1] = bbv;
              ssq += vb * vb;
            }
          }
        }
        WSP(float, OFF_PART)[(size_t)(f * 32 + tile) * 256 + c] = ssq;
      }
      __syncthreads();
    }
  }
  for (int e = gtid; e < 2 * NIN * 128; e += gn) {
    const int l = e / (NIN * 128);
    const int r = e % (NIN * 128);
    const int kc = r / NIN, n = r % NIN;
    const int k0 = kc * 8;
    const float* wsrc = p.in[I_WIN] + (size_t)l * 1024 * 2576;
    float v[8];
    if (n < 2304) {
#pragma unroll
      for (int j = 0; j < 8; ++j) v[j] = wsrc[(size_t)(k0 + j) * 2576 + n];
    } else if (n < 2816) {
      const int np = n - 2304, g = np >> 7, rr = np & 127, pq = rr >> 6, kk = rr & 63;
#pragma unroll
      for (int j = 0; j < 8; ++j) v[j] = 0.f;
      for (int jj = 0; jj < 64; ++jj) {
        const float ang = 6.283185307179586f * (float)((jj * kk) & 63) / 64.f;
        const float tr = pq ? sinf(ang) : cosf(ang);
#pragma unroll
        for (int j = 0; j < 8; ++j) v[j] += wsrc[(size_t)(k0 + j) * 2576 + 2320 + g * 64 + jj] * tr;
      }
    } else if (n < 2832) {
#pragma unroll
      for (int j = 0; j < 8; ++j) v[j] = wsrc[(size_t)(k0 + j) * 2576 + 2304 + (n - 2816)];
    } else {
#pragma unroll
      for (int j = 0; j < 8; ++j) v[j] = 0.f;
    }
    uint4 o = {pack2(v[0], v[1]), pack2(v[2], v[3]), pack2(v[4], v[5]), pack2(v[6], v[7])};
    *(uint4*)&WSP(u16, OFF_WIN)[((size_t)l * NIN + n) * 1024 + k0] = o;
  }
  for (int e = gtid; e < 2 * 1024 * 128; e += gn) {
    const int l = e / (1024 * 128), r = e % (1024 * 128), kc = r / 1024, n = r % 1024, k0 = kc * 8;
    const float* wsrc = p.in[I_WOUT] + (size_t)l * 1024 * 1024;
    float v[8];
#pragma unroll
    for (int j = 0; j < 8; ++j) v[j] = wsrc[(size_t)(k0 + j) * 1024 + n];
    uint4 o = {pack2(v[0], v[1]), pack2(v[2], v[3]), pack2(v[4], v[5]), pack2(v[6], v[7])};
    *(uint4*)&WSP(u16, OFF_WOUT)[((size_t)l * 1024 + n) * 1024 + k0] = o;
  }
  for (int e = gtid; e < 2 * 2048 * 128; e += gn) {
    const int l = e / (2048 * 128), r = e % (2048 * 128), kc = r / 2048, n = r % 2048, k0 = kc * 8;
    const float* wsrc = p.in[I_WQ] + (size_t)l * 1024 * 2048;
    float v[8];
#pragma unroll
    for (int j = 0; j < 8; ++j) v[j] = wsrc[(size_t)(k0 + j) * 2048 + n];
    uint4 o = {pack2(v[0], v[1]), pack2(v[2], v[3]), pack2(v[4], v[5]), pack2(v[6], v[7])};
    *(uint4*)&WSP(u16, OFF_WQ)[((size_t)l * 2048 + n) * 1024 + k0] = o;
  }
  for (int e = gtid; e < 2 * 2 * 128 * 128; e += gn) {
    const int l = e / (2 * 16384), r = e % (2 * 16384), which = r / 16384, i = r % 16384;
    const float v = (which ? p.in[I_K2] : p.in[I_K1])[l * 16384 + i];
    WSP(u16, OFF_K12)[e] = f2bf(v);
  }
  for (int e = gtid; e < 2048 * 512; e += gn) {
    const int tp = e >> 9, k0 = (e & 511) * 8;
    const float s = 1.f / sqrtf(2048.f * 64.f);
    float v[8];
#pragma unroll
    for (int j = 0; j < 8; ++j) {
      const int k = k0 + j, t = k & 2047;
      const float ang = 6.283185307179586f * (float)((tp * t) & 2047) / 2048.f;
      v[j] = (k < 2048) ? cosf(ang) * s : -sinf(ang) * s;
    }
    uint4 o = {pack2(v[0], v[1]), pack2(v[2], v[3]), pack2(v[4], v[5]), pack2(v[6], v[7])};
    *(uint4*)&WSP(u16, OFF_DFT)[(size_t)tp * 4096 + k0] = o;
  }
  for (int e = gtid; e < 256 * 64; e += gn) {
    const int tp = e >> 6, k0 = (e & 63) * 8;
    const float s = 1.f / sqrtf(256.f * 64.f);
    float v[8];
#pragma unroll
    for (int j = 0; j < 8; ++j) {
      const int k = k0 + j, t = k & 255;
      const float ang = 6.283185307179586f * (float)((tp * t) & 255) / 256.f;
      v[j] = (k < 256) ? cosf(ang) * s : -sinf(ang) * s;
    }
    uint4 o = {pack2(v[0], v[1]), pack2(v[2], v[3]), pack2(v[4], v[5]), pack2(v[6], v[7])};
    *(uint4*)&WSP(u16, OFF_DFTC)[(size_t)tp * 512 + k0] = o;
  }
}

DI void phase_norm(const Params& p, int l, int which, int bid, int nblk) {
  const int lane = TID() & 63, w = TID() >> 6;
  const float* g = (which ? p.in[I_G2] : p.in[I_G1]) + l * 1024;
  const bool from_input = (which == 0 && l == 0);
  for (int row = bid * 4 + w; row < ROWS; row += nblk * 4) {
    const int b = row / TPB, pos = row % TPB;
    if (which == 1 && l == 1 && pos < CTXL) continue;
    const float* xr = xrow_ptr(p, from_input, b, pos);
    const float* mod = WSP(const float, OFF_MOD) + (size_t)(l * 17 + (pos < CTXL ? 16 : b)) * 6144 + which * 3072;
    float x[16];
#pragma unroll
    for (int hh = 0; hh < 2; ++hh) {
      const float4 a = *(const float4*)(xr + hh * 512 + lane * 8);
      const float4 c = *(const float4*)(xr + hh * 512 + lane * 8 + 4);
      x[hh * 8 + 0] = a.x; x[hh * 8 + 1] = a.y; x[hh * 8 + 2] = a.z; x[hh * 8 + 3] = a.w;
      x[hh * 8 + 4] = c.x; x[hh * 8 + 5] = c.y; x[hh * 8 + 6] = c.z; x[hh * 8 + 7] = c.w;
    }
    float ss = 0.f;
#pragma unroll
    for (int i = 0; i < 16; ++i) ss += x[i] * x[i];
    ss = wave_sum(ss);
    const float rs = rsqrtf(ss * (1.f / 1024.f) + EPSF);
#pragma unroll
    for (int hh = 0; hh < 2; ++hh) {
      const int c0 = hh * 512 + lane * 8;
      float y[8];
#pragma unroll
      for (int i = 0; i < 8; ++i) {
        const float yn = x[hh * 8 + i] * rs * g[c0 + i];
        y[i] = yn * (1.f + mod[1024 + c0 + i]) + mod[c0 + i];
      }
      uint4 o = {pack2(y[0], y[1]), pack2(y[2], y[3]), pack2(y[4], y[5]), pack2(y[6], y[7])};
      *(uint4*)&WSP(u16, OFF_ACT)[(size_t)row * 1024 + c0] = o;
    }
  }
}

constexpr float U_SCALE = 64.f, V_SCALE = 4.f;
DI void phase_tables(const Params& p, int l, int bid, int nblk) {
  const int gtid = bid * NTHR + TID(), gn = nblk * NTHR;
  unsigned char* dst = WSP(unsigned char, OFF_XBCA);
  for (int e = gtid; e < 2 * 16384 * 64; e += gn) {
    const int which = e / (16384 * 64), r = e % (16384 * 64);
    const float sc = which ? V_SCALE : U_SCALE;
    const float* src = (which ? p.in[I_PV] : p.in[I_PU]) + (size_t)l * 16384 * 1024 + (size_t)r * 16;
    u32 o[4];
#pragma unroll
    for (int q = 0; q < 4; ++q) {
      const float4 a = *(const float4*)(src + q * 4);
      int v = __builtin_amdgcn_cvt_pk_fp8_f32(a.x * sc, a.y * sc, 0, false);
      v = __builtin_amdgcn_cvt_pk_fp8_f32(a.z * sc, a.w * sc, v, true);
      o[q] = (u32)v;
    }
    uint4 ov = {o[0], o[1], o[2], o[3]};
    *(uint4*)&dst[(size_t)e * 16] = ov;
  }
}

DI void phase_inproj(const Params& p, int l, int bid, int nblk, char* smem) {
  const u16* A = WSP(const u16, OFF_ACT);
  const u16* B = WSP(const u16, OFF_WIN) + (size_t)l * NIN * 1024;
  u16* PHY = WSP(u16, OFF_PHY);
  u16* PZ = WSP(u16, OFF_PZ);
  u16* PXBC = WSP(u16, OFF_PXBC);
  u16* PQT = WSP(u16, OFF_PQT);
  float* DT = WSP(float, OFF_DT);
  auto af = [=](int m, int k) { return A + (size_t)m * 1024 + k; };
  auto bfn = [=](int n, int k) { return B + (size_t)n * 1024 + k; };
  auto efT = [=](int m, int n, float v0, float v1, float v2, float v3) {
    const uint2 o = {pack2(v0, v1), pack2(v2, v3)};
    if (n < 768) *(uint2*)&PHY[(size_t)m * 768 + n] = o;
    else if (n < 1280) *(uint2*)&PZ[(size_t)m * 512 + (n - 768)] = o;
    else if (n < 2304) *(uint2*)&PXBC[(size_t)m * 1024 + (n - 1280)] = o;
    else if (n >= 2816 && n < 2832) { float4 f = {v0, v1, v2, v3}; *(float4*)&DT[(size_t)m * 16 + (n - 2816)] = f; }
  };
  auto efN = [=](int m, int n, float v0, float v1, float v2, float v3) {
    const int b = m / TPB, pos = m % TPB, np = n - 2304;
    uint2 o = {pack2(v0, v1), pack2(v2, v3)};
    *(uint2*)&PQT[((size_t)(b * 512 + np)) * TPB + pos] = o;
  };
  const int ntile = (ROWS / 256) * (NIN / 128);
  const int vb = (nblk % 8 == 0) ? (bid & 7) * (nblk >> 3) + (bid >> 3) : bid;
  for (int t = vb; t < ntile; t += nblk) {
    const int mt = t / (NIN / 128), nt = t % (NIN / 128);
    if (nt >= 18 && nt < 22) gemm_tile<false, 4>(af, bfn, efN, mt * 256, nt * 128, 1024, smem);
    else gemm_tile<true, 4>(af, bfn, efT, mt * 256, nt * 128, 1024, smem);
  }
}

DI void unpack8(const uint4& v, float* f) {
  f[0] = bflo(v.x); f[1] = bfhi(v.x); f[2] = bflo(v.y); f[3] = bfhi(v.y);
  f[4] = bflo(v.z); f[5] = bfhi(v.z); f[6] = bflo(v.w); f[7] = bfhi(v.w);
}
DI void phase_prep(const Params& p, int l, int bid, int nblk, char* smem) {
  const int tid = TID();
  u16* tile = (u16*)smem;
  const u16* PHY = WSP(const u16, OFF_PHY);
  const u16* PXBC = WSP(const u16, OFF_PXBC);
  u16* UT = WSP(u16, OFF_UT);
  u16* X1C = WSP(u16, OFF_X1C);
  u16* XBCA = WSP(u16, OFF_XBCA);
  u16* TX = WSP(u16, OFF_TX);
  const float* hw = p.in[I_HYCW] + l * 3 * 768;
  const float* hb = p.in[I_HYCB] + l * 768;
  const float* sw = p.in[I_SCW] + l * 3 * 1024;
  const float* sb = p.in[I_SCB] + l * 1024;
  const int cg8 = (tid & 31) * 8, pg = tid >> 5;
  for (int it = bid; it < NB * 36 * 6; it += nblk) {
    const int pass = it % 6, bt = it / 6;
    const int b = bt / 36, pt = bt % 36, pos0 = pt * 64;
    const int seg_lo = (pos0 < CTXL) ? 0 : CTXL, seg_hi = (pos0 < CTXL) ? CTXL : TPB;
    const size_t rbase = (size_t)b * TPB;
    const int pfirst = pos0 + pg * 8;
    bool transposed = false;
    if (pass <= 1) {
      if (l == 1 && pos0 < CTXL) continue;
      float cv0[8][8];
#pragma unroll
      for (int sg = 0; sg < 2; ++sg) {
        if (pass == 0 && sg == 1) break;
        const int sgrp = (pass == 0) ? 1 : (sg == 0 ? 0 : 2);
        const int col = sgrp * 256 + cg8;
        float w0[8], w1[8], w2[8], bb[8];
#pragma unroll
        for (int e = 0; e < 8; ++e) { w0[e] = hw[col + e]; w1[e] = hw[768 + col + e]; w2[e] = hw[1536 + col + e]; bb[e] = hb[col + e]; }
        uint4 raw[10];
#pragma unroll
        for (int k = 0; k < 10; ++k) {
          const int pn = pfirst + k - 1;
          raw[k] = (pn >= seg_lo && pn < seg_hi) ? *(const uint4*)&PHY[(rbase + pn) * 768 + col] : make_uint4(0u, 0u, 0u, 0u);
        }
        float xm[8], x0[8], xp[8];
        unpack8(raw[0], xm);
        unpack8(raw[1], x0);
#pragma unroll
        for (int k = 0; k < 8; ++k) {
          unpack8(raw[k + 2], xp);
          float o[8];
#pragma unroll
          for (int e = 0; e < 8; ++e) {
            o[e] = w0[e] * xm[e] + w1[e] * x0[e] + w2[e] * xp[e] + bb[e];
            xm[e] = x0[e]; x0[e] = xp[e];
          }
          if (pass == 0) {
            uint4 o1 = {pack2(o[0], o[1]), pack2(o[2], o[3]), pack2(o[4], o[5]), pack2(o[6], o[7])};
            *(uint4*)&X1C[(rbase + pfirst + k) * 256 + cg8] = o1;
          } else if (sg == 0) {
#pragma unroll
            for (int e = 0; e < 8; ++e) cv0[k][e] = o[e];
          } else {
            uint4 ou = {pack2(o[0] * cv0[k][0], o[1] * cv0[k][1]), pack2(o[2] * cv0[k][2], o[3] * cv0[k][3]),
                        pack2(o[4] * cv0[k][4], o[5] * cv0[k][5]), pack2(o[6] * cv0[k][6], o[7] * cv0[k][7])};
            *(uint4*)&tile[(pg * 8 + k) * 264 + cg8] = ou;
          }
        }
      }
      transposed = (pass == 1);
    } else {
      const int col = (pass - 2) * 256 + cg8;
      float w0[8], w1[8], w2[8], bb[8];
#pragma unroll
      for (int e = 0; e < 8; ++e) { w0[e] = sw[col + e]; w1[e] = sw[1024 + col + e]; w2[e] = sw[2048 + col + e]; bb[e] = sb[col + e]; }
      uint4 raw[10];
#pragma unroll
      for (int k = 0; k < 10; ++k) {
        const int pn = pfirst + k - 1;
        raw[k] = (pn >= seg_lo && pn < seg_hi) ? *(const uint4*)&PXBC[(rbase + pn) * 1024 + col] : make_uint4(0u, 0u, 0u, 0u);
      }
      float xm[8], x0[8], xp[8];
      unpack8(raw[0], xm);
      unpack8(raw[1], x0);
#pragma unroll
      for (int k = 0; k < 8; ++k) {
        unpack8(raw[k + 2], xp);
        float o[8];
#pragma unroll
        for (int e = 0; e < 8; ++e) {
          o[e] = silu_f(w0[e] * xm[e] + w1[e] * x0[e] + w2[e] * xp[e] + bb[e]);
          xm[e] = x0[e]; x0[e] = xp[e];
        }
        uint4 ov = {pack2(o[0], o[1]), pack2(o[2], o[3]), pack2(o[4], o[5]), pack2(o[6], o[7])};
        *(uint4*)&XBCA[(rbase + pfirst + k) * 1024 + col] = ov;
        if (pass < 5) *(uint4*)&tile[(pg * 8 + k) * 264 + cg8] = ov;
      }
      transposed = pass < 5;
    }
    if (transposed) {
      __syncthreads();
      u16* dst = (pass == 1) ? (UT + ((size_t)(tid * 16 + b)) * TPB + pos0) : (TX + ((size_t)(b * 768 + (pass - 2) * 256 + tid)) * TPB + pos0);
#pragma unroll
      for (int pc = 0; pc < 8; ++pc) {
        u32 wv[4];
#pragma unroll
        for (int e = 0; e < 4; ++e)
          wv[e] = (u32)tile[(pc * 8 + 2 * e) * 264 + tid] | ((u32)tile[(pc * 8 + 2 * e + 1) * 264 + tid] << 16);
        uint4 o = {wv[0], wv[1], wv[2], wv[3]};
        *(uint4*)&dst[pc * 8] = o;
      }
      __syncthreads();
    }
  }
}

DI void ssd_item(const Params& p, int l, int it, char* smem) {
  const int tid = TID(), lane = tid & 63, w = tid >> 6, l32 = lane & 31, h = lane >> 5;
  const int b = it >> 4, hd = (it >> 1) & 7, dir = it & 1, g = hd >> 2;
  u16* BG = (u16*)smem;
  u16* HL = BG + 128 * 136;
  float* fa = (float*)(HL + 64 * 136);
  float* fdt = fa + 128;
  float* fsw = fdt + 128;
  float* fea = fsw + 128;
  float* ftot = fea + 128;
  const u16* XBCA = WSP(const u16, OFF_XBCA);
  const u16* TX = WSP(const u16, OFF_TX);
  const float* DT = WSP(const float, OFF_DT);
  u16* Y = WSP(u16, OFF_PXBC) + (dir ? (size_t)ROWS * 512 : 0);
  const float dtb = p.in[I_SDTB][l * 16 + dir * 8 + hd];
  const float a = -expf(p.in[I_SALOG][l * 16 + dir * 8 + hd]);
  const size_t rbase = (size_t)b * TPB;
  f32x16 Hacc[2];
#pragma unroll
  for (int i = 0; i < 2; ++i)
#pragma unroll
    for (int r = 0; r < 16; ++r) Hacc[i][r] = 0.f;
  for (int e = tid; e < 64 * 136; e += NTHR) HL[e] = 0;
  for (int ci = 0; ci < 18; ++ci) {
    const int pos0 = dir ? ((ci < 2) ? (1 - ci) * 128 : (CTXL + (17 - ci) * 128)) : ci * 128;
    asm volatile("s_waitcnt vmcnt(0)" ::: "memory");
    bf16x8 creg[8];
    const u16* cr = XBCA + (rbase + pos0 + w * 32 + l32) * 1024 + 768 + g * 128 + h * 8;
#pragma unroll
    for (int ks = 0; ks < 4; ++ks) creg[ks] = *(const bf16x8*)(cr + ks * 16);
    __builtin_amdgcn_sched_barrier(0);
#pragma unroll
    for (int i = 0; i < 8; ++i) {
      const int q = tid + 256 * i, j = q >> 4, ch = q & 15;
      *(uint4*)&BG[j * 136 + ch * 8] = *(const uint4*)&XBCA[(rbase + pos0 + j) * 1024 + 512 + g * 128 + ch * 8];
    }
    if (w == 0) {
      const float r0 = DT[(rbase + pos0 + 2 * lane) * 16 + dir * 8 + hd] + dtb;
      const float r1 = DT[(rbase + pos0 + 2 * lane + 1) * 16 + dir * 8 + hd] + dtb;
      const float dt0 = (r0 > 20.f) ? r0 : log1pf(expf(r0));
      const float dt1 = (r1 > 20.f) ? r1 : log1pf(expf(r1));
      const float a0 = dt0 * a, a1 = dt1 * a;
      const float sm = a0 + a1;
      float incl = sm;
#pragma unroll
      for (int o = 1; o < 64; o <<= 1) {
        const float t = __shfl_up(incl, o);
        if (lane >= o) incl += t;
      }
      const float excl = incl - sm;
      const float total = __shfl(incl, 63);
      float ac0, ac1;
      if (!dir) { ac0 = excl + a0; ac1 = excl + sm; }
      else { ac0 = total - excl; ac1 = total - excl - a0; }
      fa[2 * lane] = ac0; fa[2 * lane + 1] = ac1;
      fdt[2 * lane] = dt0; fdt[2 * lane + 1] = dt1;
      fsw[2 * lane] = dt0 * __expf(total - ac0); fsw[2 * lane + 1] = dt1 * __expf(total - ac1);
      fea[2 * lane] = __expf(ac0); fea[2 * lane + 1] = __expf(ac1);
      if (lane == 0) ftot[0] = __expf(total);
    }
    __syncthreads();
#pragma unroll
    for (int ks = 4; ks < 8; ++ks) creg[ks] = *(const bf16x8*)(cr + ks * 16);
    f32x16 acc[4], yd[2];
#pragma unroll
    for (int i = 0; i < 4; ++i)
#pragma unroll
      for (int r = 0; r < 16; ++r) acc[i][r] = 0.f;
#pragma unroll
    for (int i = 0; i < 2; ++i)
#pragma unroll
      for (int r = 0; r < 16; ++r) yd[i][r] = 0.f;
#pragma unroll
    for (int ks = 0; ks < 8; ++ks) {
      const bf16x8 areg = creg[ks];
#pragma unroll
      for (int jb = 0; jb < 4; ++jb) {
        const bf16x8 bb = *(const bf16x8*)&BG[(jb * 32 + l32) * 136 + ks * 16 + h * 8];
        acc[jb] = __builtin_amdgcn_mfma_f32_32x32x16_bf16(areg, bb, acc[jb], 0, 0, 0);
      }
    }
    {
      const float eai = fea[w * 32 + l32];
#pragma unroll
      for (int ks = 0; ks < 8; ++ks) {
        union { u32 u[4]; bf16x8 v; } t;
        t.v = creg[ks];
#pragma unroll
        for (int q = 0; q < 4; ++q) t.u[q] = pack2(bflo(t.u[q]) * eai, bfhi(t.u[q]) * eai);
#pragma unroll
        for (int pb = 0; pb < 2; ++pb) {
          const bf16x8 bb = *(const bf16x8*)&HL[(pb * 32 + l32) * 136 + ks * 16 + h * 8];
          yd[pb] = __builtin_amdgcn_mfma_f32_32x32x16_bf16(t.v, bb, yd[pb], 0, 0, 0);
        }
      }
    }
    __syncthreads();
    int l32v = l32, hv_ = h;
    asm volatile("" : "+v"(l32v), "+v"(hv_));
    bf16x8 xf[2][8];
    const u16* xt = TX + ((size_t)(b * 768 + hd * 64 + l32v)) * TPB + pos0 + hv_ * 8;
#pragma unroll
    for (int jb = 0; jb < 4; ++jb) {
      const int j = jb * 32 + l32v;
      const float aj = fa[j], dtj = fdt[j];
#pragma unroll
      for (int r = 0; r < 16; ++r) {
        const int i = w * 32 + (r & 3) + 8 * (r >> 2) + 4 * hv_;
        const float ai = fa[i];
        const bool valid = dir ? (j >= i) : (j <= i);
        const float v = valid ? acc[jb][r] * __expf(ai - aj) * dtj : 0.f;
        BG[i * 136 + j] = f2bf(v);
      }
      __builtin_amdgcn_sched_barrier(0);
      if (jb == 1) {
#pragma unroll
        for (int ks = 0; ks < 8; ++ks) xf[0][ks] = *(const bf16x8*)(xt + ks * 16);
        __builtin_amdgcn_sched_barrier(0);
      }
    }
#pragma unroll
    for (int ks = 0; ks < 8; ++ks) xf[1][ks] = *(const bf16x8*)(xt + (size_t)32 * TPB + ks * 16);
    __builtin_amdgcn_sched_barrier(0);
#pragma unroll
    for (int pb = 0; pb < 2; ++pb)
#pragma unroll
      for (int ks = 0; ks < 8; ++ks) {
        const bf16x8 aa = *(const bf16x8*)&BG[(w * 32 + l32v) * 136 + ks * 16 + hv_ * 8];
        yd[pb] = __builtin_amdgcn_mfma_f32_32x32x16_bf16(aa, xf[pb][ks], yd[pb], 0, 0, 0);
      }
#pragma unroll
    for (int pb = 0; pb < 2; ++pb)
#pragma unroll
      for (int r = 0; r < 16; ++r) {
        const int i = w * 32 + (r & 3) + 8 * (r >> 2) + 4 * hv_;
        Y[(rbase + pos0 + i) * 512 + hd * 64 + pb * 32 + l32v] = f2bf(yd[pb][r]);
      }
    {
      u32x4 braw[8];
      {
        const u16* bt = TX + ((size_t)(b * 768 + 512 + g * 128 + w * 32 + l32v)) * TPB + pos0 + hv_ * 8;
#pragma unroll
        for (int ks = 0; ks < 8; ++ks) braw[ks] = *(const u32x4*)(bt + ks * 16);
      }
      const float eend = ftot[0];
#pragma unroll
      for (int pm = 0; pm < 2; ++pm)
#pragma unroll
        for (int r = 0; r < 16; ++r) Hacc[pm][r] *= eend;
#pragma unroll
      for (int ks = 0; ks < 8; ++ks) {
        const u32x4 raw = braw[ks];
        const float4 s0 = *(const float4*)&fsw[ks * 16 + hv_ * 8];
        const float4 s1 = *(const float4*)&fsw[ks * 16 + hv_ * 8 + 4];
        union { u32 u[4]; bf16x8 v; } bs;
        bs.u[0] = pack2(bflo(raw[0]) * s0.x, bfhi(raw[0]) * s0.y);
        bs.u[1] = pack2(bflo(raw[1]) * s0.z, bfhi(raw[1]) * s0.w);
        bs.u[2] = pack2(bflo(raw[2]) * s1.x, bfhi(raw[2]) * s1.y);
        bs.u[3] = pack2(bflo(raw[3]) * s1.z, bfhi(raw[3]) * s1.w);
#pragma unroll
        for (int pm = 0; pm < 2; ++pm) Hacc[pm] = __builtin_amdgcn_mfma_f32_32x32x16_bf16(xf[pm][ks], bs.v, Hacc[pm], 0, 0, 0);
      }
#pragma unroll
      for (int pm = 0; pm < 2; ++pm)
#pragma unroll
        for (int r = 0; r < 16; ++r) {
          const int pp = pm * 32 + (r & 3) + 8 * (r >> 2) + 4 * hv_;
          HL[pp * 136 + w * 32 + l32v] = f2bf(Hacc[pm][r]);
        }
    }
    __syncthreads();
  }
}

DI void hyena_item(const Params& p, int l, int it) {
  const int lane = TID() & 63, w = TID() >> 6;
  int c, f, L, posoff, tt0, ntile;
  if (it < 2048) { c = it >> 3; f = l; L = 2048; posoff = CTXL; tt0 = (it & 7) * 256 + w * 64; ntile = 32; }
  else { c = it - 2048; f = 2; L = 256; posoff = 0; tt0 = w * 64; ntile = 4; }
  const u16* R0 = WSP(const u16, OFF_RF) + ((size_t)(f * 256 + c) * 2) * RSTR;
  const u16* R1 = R0 + RSTR;
  const u16* UT = WSP(const u16, OFF_UT);
  const int l16 = lane & 15, kg = lane >> 4;
  f32x4 acc[4];
#pragma unroll
  for (int i = 0; i < 4; ++i) acc[i] = (f32x4){0.f, 0.f, 0.f, 0.f};
  const u16* ub = UT + ((size_t)(c * 16 + l16)) * TPB + posoff + kg * 8;
  const u16* rsel = (l16 & 1) ? (R1 - 1) : R0;
  const int nb = L - (tt0 + l16) + kg * 8;
  for (int s0 = 0; s0 < L; s0 += 32) {
    const bf16x8 bfrag = *(const bf16x8*)(ub + s0);
#pragma unroll
    for (int i = 0; i < 4; ++i) {
      const u32* ap = (const u32*)(rsel + (nb - 16 * i + s0));
      union { u32 u[4]; bf16x8 v; } au;
      au.u[0] = ap[0]; au.u[1] = ap[1]; au.u[2] = ap[2]; au.u[3] = ap[3];
      acc[i] = __builtin_amdgcn_mfma_f32_16x16x32_bf16(au.v, bfrag, acc[i], 0, 0, 0);
    }
  }
  float ssq = 0.f;
  for (int t = 0; t < ntile; ++t) ssq += WSP(const float, OFF_PART)[(size_t)(f * 32 + t) * 256 + c];
  const float scale = rsqrtf(ssq + EPSF);
  const float bias = p.in[I_HYBIAS][l * 256 + c];
  const u16* X1C = WSP(const u16, OFF_X1C);
  u16* YM = WSP(u16, OFF_ACT);
  const int b = l16;
#pragma unroll
  for (int i = 0; i < 4; ++i)
#pragma unroll
    for (int r = 0; r < 4; ++r) {
      const int t = tt0 + 16 * i + kg * 4 + r;
      const size_t row = (size_t)b * TPB + posoff + t;
      const float u = bf2f(UT[((size_t)(c * 16 + b)) * TPB + posoff + t]);
      const float x1 = bf2f(X1C[row * 256 + c]);
      YM[row * 1024 + c] = f2bf(x1 * (scale * acc[i][r] + bias * u));
    }
}

DI void hyena_item_lat(const Params& p, int l, int it) {
  const int lane = TID() & 63, w = TID() >> 6;
  const int c = it >> 2, f = l, L = 2048, posoff = CTXL;
  const int tt0 = (it & 3) * 512 + w * 128;
  const u16* R0 = WSP(const u16, OFF_RF) + ((size_t)(f * 256 + c) * 2) * RSTR;
  const u16* R1 = R0 + RSTR;
  const u16* UT = WSP(const u16, OFF_UT);
  const int l16 = lane & 15, kg = lane >> 4;
  f32x4 acc[8];
#pragma unroll
  for (int i = 0; i < 8; ++i) acc[i] = (f32x4){0.f, 0.f, 0.f, 0.f};
  const u16* ub = UT + ((size_t)(c * 16 + l16)) * TPB + posoff + kg * 8;
  const u16* rsel = (l16 & 1) ? (R1 - 1) : R0;
  const int nb = L - (tt0 + l16) + kg * 8;
  union AF { u32 u[4]; bf16x8 v; };
  AF a[8];
#define HY_LOADA(dst, off) { const u32* ap_ = (const u32*)(rsel + (off)); dst.u[0] = ap_[0]; dst.u[1] = ap_[1]; dst.u[2] = ap_[2]; dst.u[3] = ap_[3]; }
#pragma unroll
  for (int i = 2; i < 8; ++i) HY_LOADA(a[i], nb - 16 * i)
#pragma unroll 1
  for (int sb = 0; sb < L; sb += 128) {
#pragma unroll
    for (int u = 0; u < 4; ++u) {
      const int s0 = sb + 32 * u;
      HY_LOADA(a[(0 - 2 * u) & 7], nb + s0)
      HY_LOADA(a[(1 - 2 * u) & 7], nb - 16 + s0)
      const bf16x8 bfrag = *(const bf16x8*)(ub + s0);
#pragma unroll
      for (int i = 0; i < 8; ++i) acc[i] = __builtin_amdgcn_mfma_f32_16x16x32_bf16(a[(i - 2 * u) & 7].v, bfrag, acc[i], 0, 0, 0);
    }
  }
#undef HY_LOADA
  float ssq = 0.f;
  for (int t = 0; t < 32; ++t) ssq += WSP(const float, OFF_PART)[(size_t)(f * 32 + t) * 256 + c];
  const float scale = rsqrtf(ssq + EPSF);
  const float bias = p.in[I_HYBIAS][l * 256 + c];
  const u16* X1C = WSP(const u16, OFF_X1C);
  u16* YM = WSP(u16, OFF_ACT);
  const int b = l16;
#pragma unroll
  for (int i = 0; i < 8; ++i)
#pragma unroll
    for (int r = 0; r < 4; ++r) {
      const int t = tt0 + 16 * i + kg * 4 + r;
      const size_t row = (size_t)b * TPB + posoff + t;
      const float uu = bf2f(UT[((size_t)(c * 16 + b)) * TPB + posoff + t]);
      const float x1 = bf2f(X1C[row * 256 + c]);
      YM[row * 1024 + c] = f2bf(x1 * (scale * acc[i][r] + bias * uu));
    }
}

DI void fnet_item(const Params& p, int it, char* smem) {
  const u16* PQT = WSP(const u16, OFF_PQT);
  u16* YM = WSP(u16, OFF_ACT);
  if (it < 256) {
    const int mt = it >> 5, nt = it & 31;
    const u16* A = WSP(const u16, OFF_DFT);
    auto af = [=](int m, int k) { return A + (size_t)m * 4096 + k; };
    auto bfn = [=](int n, int k) {
      const int b = n >> 8, n2 = n & 255, g = n2 >> 6, kk = n2 & 63, pq = k >> 11, t = k & 2047;
      return PQT + ((size_t)(b * 512 + g * 128 + pq * 64 + kk)) * TPB + CTXL + t;
    };
    auto ef = [=](int m, int n, float v0, float v1, float v2, float v3) {
      const int b = n >> 8, n2 = n & 255;
      const uint2 o = {pack2(v0, v1), pack2(v2, v3)};
      *(uint2*)&YM[((size_t)b * TPB + CTXL + m) * 1024 + 768 + n2] = o;
    };
    gemm_tile<true, 4>(af, bfn, ef, mt * 256, nt * 128, 4096, smem);
  } else {
    const int i2 = it - 256, mt = i2 >> 5, nt = i2 & 31;
    const u16* A = WSP(const u16, OFF_DFTC);
    auto af = [=](int m, int k) { return A + (size_t)m * 512 + k; };
    auto bfn = [=](int n, int k) {
      const int b = n >> 8, n2 = n & 255, g = n2 >> 6, kk = n2 & 63, pq = k >> 8, t = k & 255;
      return PQT + ((size_t)(b * 512 + g * 128 + pq * 64 + kk)) * TPB + t;
    };
    auto ef = [=](int m, int n, float v0, float v1, float v2, float v3) {
      const int b = n >> 8, n2 = n & 255;
      const uint2 o = {pack2(v0, v1), pack2(v2, v3)};
      *(uint2*)&YM[((size_t)b * TPB + m) * 1024 + 768 + n2] = o;
    };
    gemm_tile<true, 4>(af, bfn, ef, mt * 256, nt * 128, 512, smem);
  }
}

DI void phase_mixers(const Params& p, int l, int bid, int nblk, char* smem, int rep = 0) {
  for (int it = bid; it < 256; it += nblk) ssd_item(p, l, it, smem);
  const int nf = (l == 0) ? 288 : 256;
  const int nh = (l == 0) ? 1280 : 1024;
  int* ctr = WSP(int, OFF_CTR) + l + 2 * rep;
  int* sitem = (int*)(smem + LDS_BYTES - 16);
  for (;;) {
    if (TID() == 0) *sitem = atomicAdd(ctr, 1);
    __syncthreads();
    const int it = *sitem;
    __syncthreads();
    if (it >= nf + nh) break;
    if (it < nf) fnet_item(p, it, smem);
    else if (it - nf < 1024) hyena_item_lat(p, l, it - nf);
    else hyena_item(p, l, it - nf + 1024);
  }
}

DI void phase_ssd_combine(const Params& p, int l, int bid, int nblk) {
  const int lane = TID() & 63, w = TID() >> 6;
  const u16* YF = WSP(const u16, OFF_PXBC);
  const u16* YB = YF + (size_t)ROWS * 512;
  const u16* XBCA = WSP(const u16, OFF_XBCA);
  const u16* PZ = WSP(const u16, OFF_PZ);
  u16* YM = WSP(u16, OFF_ACT);
  const float* ng = p.in[I_SNG] + l * 512;
  const int c0 = lane * 8;
  const float dsk = p.in[I_SD][l * 8 + (c0 >> 6)];
  for (int row = bid * 4 + w; row < ROWS; row += nblk * 4) {
    const int pos = row % TPB;
    if (l == 1 && pos < CTXL) continue;
    const uint4 vf = *(const uint4*)(YF + (size_t)row * 512 + c0);
    const uint4 vb = *(const uint4*)(YB + (size_t)row * 512 + c0);
    const uint4 vx = *(const uint4*)(XBCA + (size_t)row * 1024 + c0);
    const uint4 vz = *(const uint4*)(PZ + (size_t)row * 512 + c0);
    const u32 af_[4] = {vf.x, vf.y, vf.z, vf.w}, ab_[4] = {vb.x, vb.y, vb.z, vb.w};
    const u32 ax_[4] = {vx.x, vx.y, vx.z, vx.w}, az_[4] = {vz.x, vz.y, vz.z, vz.w};
    float y[8];
    float ss = 0.f;
#pragma unroll
    for (int i = 0; i < 4; ++i) {
      const float y0 = bflo(af_[i]) + bflo(ab_[i]) + dsk * bflo(ax_[i]);
      const float y1 = bfhi(af_[i]) + bfhi(ab_[i]) + dsk * bfhi(ax_[i]);
      y[2 * i] = y0 * silu_f(bflo(az_[i]));
      y[2 * i + 1] = y1 * silu_f(bfhi(az_[i]));
      ss += y[2 * i] * y[2 * i] + y[2 * i + 1] * y[2 * i + 1];
    }
#pragma unroll
    for (int o = 16; o >= 1; o >>= 1) ss += __shfl_xor(ss, o);
    const float rs = rsqrtf(ss * (1.f / 256.f) + EPSF);
    float o8[8];
#pragma unroll
    for (int i = 0; i < 8; ++i) o8[i] = y[i] * rs * ng[c0 + i];
    uint4 o = {pack2(o8[0], o8[1]), pack2(o8[2], o8[3]), pack2(o8[4], o8[5]), pack2(o8[6], o8[7])};
    *(uint4*)&YM[(size_t)row * 1024 + 256 + c0] = o;
  }
}

DI void phase_outproj(const Params& p, int l, int bid, int nblk, char* smem) {
  const u16* A = WSP(const u16, OFF_ACT);
  const u16* B = WSP(const u16, OFF_WOUT) + (size_t)l * 1024 * 1024;
  const float* MOD = WSP(const float, OFF_MOD);
  const Params pp = p;
  auto af = [=](int m, int k) { return A + (size_t)m * 1024 + k; };
  auto bfn = [=](int n, int k) { return B + (size_t)n * 1024 + k; };
  auto ef = [=](int m, int n, float v0, float v1, float v2, float v3) {
    const int b = m / TPB, pos = m % TPB;
    const float4 ga = *(const float4*)&MOD[(size_t)(l * 17 + (pos < CTXL ? 16 : b)) * 6144 + 2048 + n];
    const float4 xo = *(const float4*)(xrow_ptr(pp, l == 0, b, pos) + n);
    const float4 o = {xo.x + ga.x * v0, xo.y + ga.y * v1, xo.z + ga.z * v2, xo.w + ga.w * v3};
    *(float4*)(xrow_wptr(pp, b, pos) + n) = o;
  };
  const int ntile = (ROWS / 128) * 8;
  const int vb = (nblk % 8 == 0) ? (bid & 7) * (nblk >> 3) + (bid >> 3) : bid;
  for (int t = vb; t < ntile; t += nblk) {
    const int mt = t >> 3, nt = t & 7;
    if (l == 1 && (mt % 18) < 2) continue;
    gemm_tile<true, 2>(af, bfn, ef, mt * 128, nt * 128, 1024, smem);
  }
}

DI void phase_q(const Params& p, int l, int bid, int nblk, char* smem) {
  const u16* A = WSP(const u16, OFF_ACT);
  const u16* B = WSP(const u16, OFF_WQ) + (size_t)l * 2048 * 1024;
  u16* Q = WSP(u16, OFF_Q);
  auto af = [=](int m, int k) { return A + (size_t)m * 1024 + k; };
  auto bfn = [=](int n, int k) { return B + (size_t)n * 1024 + k; };
  auto ef = [=](int m, int n, float v0, float v1, float v2, float v3) {
    const uint2 o = {pack2(v0, v1), pack2(v2, v3)};
    *(uint2*)&Q[(size_t)m * 2048 + n] = o;
  };
  const int ntile = (ROWS / 256) * 16;
  const int vb = (nblk % 8 == 0) ? (bid & 7) * (nblk >> 3) + (bid >> 3) : bid;
  for (int t = vb; t < ntile; t += nblk) {
    const int mt = t >> 4, nt = t & 15;
    if (l == 1 && (mt % 9) < 1) continue;
    gemm_tile<true, 4>(af, bfn, ef, mt * 256, nt * 128, 1024, smem);
  }
}

DI void phase_topk(const Params& p, int l, int bid, int nblk, char* smem) {
  const int tid = TID(), lane = tid & 63, w = tid >> 6, l32 = lane & 31, h = lane >> 5;
  u16* qs = (u16*)smem;
  float* sc = (float*)(smem + 64 * 136 * 2);
  const u16* Q = WSP(const u16, OFF_Q);
  float* TV = WSP(float, OFF_TV);
  int* TI = WSP(int, OFF_TI);
  for (int it = bid; it < (ROWS / 64) * 16; it += nblk) {
    const int hh = it & 15, rt = it >> 4;
    if (l == 1 && (rt % 36) < 4) continue;
    const int row0 = rt * 64;
#pragma unroll
    for (int i = 0; i < 4; ++i) {
      const int q = tid + 256 * i, r = q >> 4, ch = q & 15;
      *(uint4*)&qs[r * 136 + ch * 8] = *(const uint4*)&Q[(size_t)(row0 + r) * 2048 + hh * 128 + ch * 8];
    }
    __syncthreads();
    const u16* kb = WSP(const u16, OFF_K12) + (size_t)(l * 2 + (hh & 1)) * 16384;
    f32x16 acc[2];
#pragma unroll
    for (int i = 0; i < 2; ++i)
#pragma unroll
      for (int r = 0; r < 16; ++r) acc[i][r] = 0.f;
#pragma unroll
    for (int ks = 0; ks < 8; ++ks) {
      const bf16x8 bq = *(const bf16x8*)&kb[(w * 32 + l32) * 128 + ks * 16 + h * 8];
      const bf16x8 a0 = *(const bf16x8*)&qs[(l32) * 136 + ks * 16 + h * 8];
      const bf16x8 a1 = *(const bf16x8*)&qs[(32 + l32) * 136 + ks * 16 + h * 8];
      acc[0] = __builtin_amdgcn_mfma_f32_32x32x16_bf16(a0, bq, acc[0], 0, 0, 0);
      acc[1] = __builtin_amdgcn_mfma_f32_32x32x16_bf16(a1, bq, acc[1], 0, 0, 0);
    }
#pragma unroll
    for (int mt = 0; mt < 2; ++mt)
#pragma unroll
      for (int i = 0; i < 16; ++i) {
        const int r = mt * 32 + (i & 3) + 8 * (i >> 2) + 4 * h;
        sc[r * 133 + w * 33 + l32] = acc[mt][i];
      }
    __syncthreads();
    {
      const int r = tid >> 2, part = tid & 3;
      u32 key[32];
#pragma unroll
      for (int j = 0; j < 32; ++j) {
        const u32 u = __float_as_uint(sc[r * 133 + part * 33 + j]);
        const u32 ord = (u & 0x80000000u) ? ~u : (u | 0x80000000u);
        key[j] = (ord & ~127u) | (u32)(127 - (part * 32 + j));
      }
      float* tv = TV + ((size_t)(row0 + r) * 16 + hh) * 16;
      int* ti = TI + ((size_t)(row0 + r) * 16 + hh) * 16;
      u32 prev = 0xFFFFFFFFu;
#pragma unroll
      for (int rd = 0; rd < 16; ++rd) {
        u32 m = 0u;
#pragma unroll
        for (int j = 0; j < 32; ++j) { const u32 d = key[j] - prev; m = d > m ? d : m; }
        { const u32 o = (u32)__shfl_xor((int)m, 1); m = o > m ? o : m; }
        { const u32 o = (u32)__shfl_xor((int)m, 2); m = o > m ? o : m; }
        const u32 best = prev + m;
        prev = best;
        if (part == 0) {
          const u32 ordv = best & ~127u;
          const u32 uu = (ordv & 0x80000000u) ? (ordv & 0x7FFFFFFFu) : ~ordv;
          tv[rd] = __uint_as_float(uu);
          ti[rd] = 127 - (int)(best & 127u);
        }
      }
    }
    __syncthreads();
  }
}

DI int cand_a(int c) {
  const u32 T[7] = {0x00000000u, 0x00000000u, 0x11111111u, 0x33322222u, 0x66554443u, 0xDCBA9877u, 0x000000FEu};
  u32 wv = T[0];
#pragma unroll
  for (int s = 1; s < 7; ++s) wv = ((c >> 3) == s) ? T[s] : wv;
  return (int)((wv >> ((c & 7) * 4)) & 15u);
}
DI int cand_b(int c) {
  const u32 T[7] = {0x76543210u, 0xFEDCBA98u, 0x76543210u, 0x21043210u, 0x10102103u, 0x00000010u, 0x00000000u};
  u32 wv = T[0];
#pragma unroll
  for (int s = 1; s < 7; ++s) wv = ((c >> 3) == s) ? T[s] : wv;
  return (int)((wv >> ((c & 7) * 4)) & 15u);
}
DI void phase_peer(const Params& p, int l, int bid, int nblk) {
  const int w = TID() >> 6;
  const float* TV = WSP(const float, OFF_TV);
  const int* TI = WSP(const int, OFF_TI);
  const u16* H2 = WSP(const u16, OFF_ACT);
  const unsigned char* UB = WSP(const unsigned char, OFF_XBCA);
  const unsigned char* VB = UB + (size_t)16384 * 1024;
  const float* gfin = p.in[I_GF];
  for (int row = bid * 4 + w; row < ROWS; row += nblk * 4) {
    const int b = row / TPB, pos = row % TPB;
    if (l == 1 && pos < CTXL) continue;
    const int lane = TID() & 63;
    const int head = lane >> 3, sub = lane & 7;
    const float* tv1 = TV + ((size_t)row * 16 + head * 2) * 16;
    const float* tv2 = tv1 + 16;
    const int* ti1 = TI + ((size_t)row * 16 + head * 2) * 16;
    const int* ti2 = ti1 + 16;
    u32 ck[7];
#pragma unroll
    for (int s = 0; s < 7; ++s) {
      const int c = sub + 8 * s;
      if (c < 50) {
        const u32 u = __float_as_uint(tv1[cand_a(c)] + tv2[cand_b(c)]);
        const u32 ord = (u & 0x80000000u) ? ~u : (u | 0x80000000u);
        ck[s] = (ord & ~63u) | (u32)(63 - c);
      } else ck[s] = 0u;
    }
    float w0v = 0.f, w1v = 0.f, mx = 0.f;
    int w0c = 0, w1c = 0;
    u32 prevk = 0xFFFFFFFFu;
#pragma unroll
    for (int r = 0; r < 16; ++r) {
      u32 m = 0u;
#pragma unroll
      for (int s = 0; s < 7; ++s) { const u32 d = ck[s] - prevk; m = d > m ? d : m; }
      { const u32 ov = (u32)dpp_i<DPP_XOR1>((int)m); m = ov > m ? ov : m; }
      { const u32 ov = (u32)dpp_i<DPP_XOR2>((int)m); m = ov > m ? ov : m; }
      { const u32 ov = (u32)dpp_i<DPP_MIRROR8>((int)m); m = ov > m ? ov : m; }
      const u32 best = prevk + m;
      prevk = best;
      const u32 ordv = best & ~63u;
      const float bv = __uint_as_float((ordv & 0x80000000u) ? (ordv & 0x7FFFFFFFu) : ~ordv);
      const int bc = 63 - (int)(best & 63u);
      if (r == 0) mx = bv;
      if (sub == (r & 7)) {
        if (r < 8) { w0v = bv; w0c = bc; } else { w1v = bv; w1c = bc; }
      }
    }
    const float e0 = expf(w0v - mx), e1 = expf(w1v - mx);
    float es = e0 + e1;
    es += dpp_f<DPP_XOR1>(es);
    es += dpp_f<DPP_XOR2>(es);
    es += dpp_f<DPP_MIRROR8>(es);
    const float g0 = e0 / es, g1 = e1 / es;
    const int idx0 = ti1[cand_a(w0c)] * 128 + ti2[cand_b(w0c)];
    const int idx1 = ti1[cand_a(w1c)] * 128 + ti2[cand_b(w1c)];
    const u16* hrow = H2 + (size_t)row * 1024;
    float hv[16];
    {
      const uint4 ha = *(const uint4*)(hrow + lane * 16), hb = *(const uint4*)(hrow + lane * 16 + 8);
      hv[0] = bflo(ha.x); hv[1] = bfhi(ha.x); hv[2] = bflo(ha.y); hv[3] = bfhi(ha.y);
      hv[4] = bflo(ha.z); hv[5] = bfhi(ha.z); hv[6] = bflo(ha.w); hv[7] = bfhi(ha.w);
      hv[8] = bflo(hb.x); hv[9] = bfhi(hb.x); hv[10] = bflo(hb.y); hv[11] = bfhi(hb.y);
      hv[12] = bflo(hb.z); hv[13] = bfhi(hb.z); hv[14] = bflo(hb.w); hv[15] = bfhi(hb.w);
    }
    float acc[16];
#pragma unroll 1
    for (int prep_ = 0; prep_ < PEER_REPS; ++prep_) {
    f32x2 hv2[8];
#pragma unroll
    for (int i = 0; i < 8; ++i) hv2[i] = (f32x2){hv[2 * i], hv[2 * i + 1]};
    const bool b0 = lane & 1, b1 = lane & 2, b2 = lane & 4;
    float act0 = 0.f, act1 = 0.f;
    u32x4 rb[2][8];
#define PEER_LOAD(buf, k, TAB)                                                                     \
  _Pragma("unroll") for (int j = 0; j < 8; ++j) {                                                  \
    const int e = (k) * 8 + j;                                                                     \
    const int id = __builtin_amdgcn_readlane(((k) < 8) ? idx0 : idx1, e & 63);                     \
    rb[buf][j] = *(const u32x4*)(TAB + (size_t)id * 1024 + lane * 16);                             \
  }
#define PEER_DOT(buf, k)                                                                           \
  {                                                                                                \
    float d[8];                                                                                    \
    _Pragma("unroll") for (int j = 0; j < 8; ++j) {                                                \
      const u32 uw[4] = {rb[buf][j][0], rb[buf][j][1], rb[buf][j][2], rb[buf][j][3]};              \
      f32x2 sa = {0.f, 0.f}, sb = {0.f, 0.f};                   \
      _Pragma("unroll") for (int q = 0; q < 4; ++q) {                                              \
        const f32x2 lo = __builtin_amdgcn_cvt_pk_f32_fp8((int)uw[q], false);                       \
        const f32x2 hi = __builtin_amdgcn_cvt_pk_f32_fp8((int)uw[q], true);                        \
        sa = __builtin_elementwise_fma(hv2[2 * q], lo, sa);                                        \
        sb = __builtin_elementwise_fma(hv2[2 * q + 1], hi, sb);                                    \
      }                                                                                            \
      sa += sb;                                                                                    \
      d[j] = sa.x + sa.y;                                                                          \
    }                                                                                              \
    float a4[4];                                                                                   \
    _Pragma("unroll") for (int q = 0; q < 4; ++q) {                                                \
      const float keep = b0 ? d[2 * q + 1] : d[2 * q], send = b0 ? d[2 * q] : d[2 * q + 1];        \
      a4[q] = keep + __shfl_xor(send, 1);                                                          \
    }                                                                                              \
    float a2[2];                                                                                   \
    _Pragma("unroll") for (int q = 0; q < 2; ++q) {                                                \
      const float keep = b1 ? a4[2 * q + 1] : a4[2 * q], send = b1 ? a4[2 * q] : a4[2 * q + 1];    \
      a2[q] = keep + __shfl_xor(send, 2);                                                          \
    }                                                                                              \
    const float keep = b2 ? a2[1] : a2[0], send = b2 ? a2[0] : a2[1];                              \
    float c1 = keep + __shfl_xor(send, 4);                                                         \
    c1 += __shfl_xor(c1, 8);                                                                       \
    c1 += __shfl_xor(c1, 16);                                                                      \
    c1 += __shfl_xor(c1, 32);                                                                      \
    if ((lane >> 3) == ((k) & 7)) { if ((k) < 8) act0 = c1; else act1 = c1; }                      \
  }
    PEER_LOAD(0, 0, UB)
#pragma unroll 1
    for (int k = 0; k < 16; k += 2) {
      PEER_LOAD(1, k + 1, UB)
      __builtin_amdgcn_sched_barrier(0);
      PEER_DOT(0, k)
      { const int kn = (k + 2 < 16) ? k + 2 : 15; PEER_LOAD(0, kn, UB) }
      __builtin_amdgcn_sched_barrier(0);
      PEER_DOT(1, k + 1)
    }
    const float ga0 = gelu_tanh(act0 * (1.f / U_SCALE)) * g0 * (1.f / V_SCALE);
    const float ga1 = gelu_tanh(act1 * (1.f / U_SCALE)) * g1 * (1.f / V_SCALE);
#pragma unroll
    for (int i = 0; i < 16; ++i) acc[i] = 0.f;
#define PEER_ACC(buf, k)                                                                           \
  _Pragma("unroll") for (int j = 0; j < 8; ++j) {                                                  \
    const int e = (k) * 8 + j;                                                                     \
    const int ai = __builtin_amdgcn_readlane(__builtin_bit_cast(int, ((k) < 8) ? ga0 : ga1), e & 63); \
    const float a = __builtin_bit_cast(float, ai);                                                 \
    const u32 vw[4] = {rb[buf][j][0], rb[buf][j][1], rb[buf][j][2], rb[buf][j][3]};                \
    _Pragma("unroll") for (int q = 0; q < 4; ++q) {                                                \
      const f32x2 lo = __builtin_amdgcn_cvt_pk_f32_fp8((int)vw[q], false);                         \
      const f32x2 hi = __builtin_amdgcn_cvt_pk_f32_fp8((int)vw[q], true);                          \
      acc[q * 4 + 0] += a * lo.x; acc[q * 4 + 1] += a * lo.y; acc[q * 4 + 2] += a * hi.x; acc[q * 4 + 3] += a * hi.y; \
    }                                                                                              \
  }
    PEER_LOAD(0, 0, VB)
#pragma unroll 1
    for (int k = 0; k < 16; k += 2) {
      PEER_LOAD(1, k + 1, VB)
      __builtin_amdgcn_sched_barrier(0);
      PEER_ACC(0, k)
      { const int kn = (k + 2 < 16) ? k + 2 : 15; PEER_LOAD(0, kn, VB) }
      __builtin_amdgcn_sched_barrier(0);
      PEER_ACC(1, k + 1)
    }
#undef PEER_LOAD
#undef PEER_DOT
#undef PEER_ACC
      if (prep_ + 1 < PEER_REPS) { _Pragma("unroll") for (int i = 0; i < 16; ++i) asm volatile("" :: "v"(acc[i])); }
    }
    int row2 = row;
    asm volatile("" : "+v"(row2));
    const int lane2 = TID() & 63;
    const int b2 = row2 / TPB, pos2 = row2 % TPB;
    const float* xr = xrow_ptr(p, false, b2, pos2);
    float* xw = xrow_wptr(p, b2, pos2);
    const float* ga = WSP(const float, OFF_MOD) + (size_t)(l * 17 + (pos2 < CTXL ? 16 : b2)) * 6144 + 5120;
    float xn[16];
    float ss = 0.f;
#pragma unroll
    for (int q = 0; q < 4; ++q) {
      const float4 xv = *(const float4*)(xr + lane2 * 16 + q * 4);
      const float4 gv = *(const float4*)(ga + lane2 * 16 + q * 4);
      xn[q * 4 + 0] = xv.x + gv.x * acc[q * 4 + 0];
      xn[q * 4 + 1] = xv.y + gv.y * acc[q * 4 + 1];
      xn[q * 4 + 2] = xv.z + gv.z * acc[q * 4 + 2];
      xn[q * 4 + 3] = xv.w + gv.w * acc[q * 4 + 3];
    }
    if (l == 1) {
#pragma unroll
      for (int i = 0; i < 16; ++i) ss += xn[i] * xn[i];
      ss = wave_sum(ss);
      const float rs = rsqrtf(ss * (1.f / 1024.f) + EPSF);
#pragma unroll
      for (int i = 0; i < 16; ++i) xn[i] = xn[i] * rs * gfin[lane2 * 16 + i];
    }
#pragma unroll
    for (int q = 0; q < 4; ++q) {
      float4 o = {xn[q * 4 + 0], xn[q * 4 + 1], xn[q * 4 + 2], xn[q * 4 + 3]};
      *(float4*)(xw + lane2 * 16 + q * 4) = o;
    }
  }
}

template <int S>
DI void run_stage(const Params& p, int l, int bid, int nblk, char* smem) {
  for (int rep = 0; rep < 1 + ((REP_MASK >> (S + 1)) & 1); ++rep) {
  if (S == 0) { if (PH_MASK & 2) phase_norm(p, l, 0, bid, nblk); }
  else if (S == 1) { if (PH_MASK & 4) phase_inproj(p, l, bid, nblk, smem); }
  else if (S == 2) { if (PH_MASK & 8) phase_prep(p, l, bid, nblk, smem); }
  else if (S == 3) { if (PH_MASK & 16) phase_mixers(p, l, bid, nblk, smem, rep); }
  else if (S == 4) { if (PH_MASK & 32) phase_ssd_combine(p, l, bid, nblk); }
  else if (S == 5) { if (PH_MASK & 64) phase_outproj(p, l, bid, nblk, smem); }
  else if (S == 6) { if (PH_MASK & 128) { phase_norm(p, l, 1, bid, nblk); phase_tables(p, l, bid, nblk); } }
  else if (S == 7) { if (PH_MASK & 256) phase_q(p, l, bid, nblk, smem); }
  else if (S == 8) { if (PH_MASK & 512) phase_topk(p, l, bid, nblk, smem); }
  else { if (PH_MASK & 1024) phase_peer(p, l, bid, nblk); }
  }
}

#if ONE_LAUNCH
__global__ void __launch_bounds__(NTHR, 2) mega(Params p) {
  extern __shared__ __attribute__((aligned(16))) char smem[];
  const int bid = blockIdx.x, nblk = gridDim.x;
  cg::grid_group grid = cg::this_grid();
  volatile LAS unsigned* bst = (volatile LAS unsigned*)(smem + LDS_BYTES - 32);
  if (threadIdx.x == 0) { bst[0] = 0u; bst[1] = 0u; }
  __syncthreads();
  const XcdBarrier bar = xcd_barrier_post(WSP(unsigned, OFF_BAR), bst);
  for (int rep = 0; rep < 1 + (REP_MASK & 1); ++rep) { if (PH_MASK & 1) phase_prologue(p, bid, nblk, smem); }
  grid.sync();
#define GBAR() xcd_barrier(bar)
#pragma nounroll
  for (int l = 0; l < 2; ++l) {
    for (int xs = 0; xs < EXTRA_SYNCS; ++xs) GBAR();
    run_stage<0>(p, l, bid, nblk, smem); GBAR();
    run_stage<1>(p, l, bid, nblk, smem); GBAR();
    run_stage<2>(p, l, bid, nblk, smem); GBAR();
    run_stage<3>(p, l, bid, nblk, smem); GBAR();
    run_stage<4>(p, l, bid, nblk, smem); GBAR();
    run_stage<5>(p, l, bid, nblk, smem); GBAR();
    run_stage<6>(p, l, bid, nblk, smem); GBAR();
    run_stage<7>(p, l, bid, nblk, smem); GBAR();
    run_stage<8>(p, l, bid, nblk, smem); GBAR();
    run_stage<9>(p, l, bid, nblk, smem);
    if (l == 0) GBAR();
  }
}
#else
template <int S>
__global__ void __launch_bounds__(NTHR, 2) stage_kernel(Params p, int l) {
  extern __shared__ __attribute__((aligned(16))) char smem[];
  if (S < 0) phase_prologue(p, blockIdx.x, gridDim.x, smem);
  else run_stage<(S < 0 ? 0 : S)>(p, l, blockIdx.x, gridDim.x, smem);
}

template <int S>
static void launch_stage(const Params& p, int l, int grid, hipStream_t stream) {
  (void)hipFuncSetAttribute((const void*)stage_kernel<S>, hipFuncAttributeMaxDynamicSharedMemorySize, LDS_BYTES);
  hipLaunchKernelGGL(stage_kernel<S>, dim3(grid), dim3(NTHR), LDS_BYTES, stream, p, l);
}

#endif

extern "C" void kernel_launch(void* const* d_in, const int* in_sizes, int n_in, void* d_out, int out_size, void* d_ws,
                              size_t ws_size, hipStream_t stream) {
  static int grid = 0;
  if (grid == 0) {
    if (ws_size < WS_END || n_in != 31) { fprintf(stderr, "kernel_launch: ws %zu < %zu or n_in %d\n", ws_size, (size_t)WS_END, n_in); grid = -1; return; }
    int dev = 0, cus = 0, per_cu = 0;
    (void)hipGetDevice(&dev);
    (void)hipDeviceGetAttribute(&cus, hipDeviceAttributeMultiprocessorCount, dev);
#if ONE_LAUNCH
    (void)hipFuncSetAttribute((const void*)mega, hipFuncAttributeMaxDynamicSharedMemorySize, LDS_BYTES);
    (void)hipOccupancyMaxActiveBlocksPerMultiprocessor(&per_cu, (const void*)mega, NTHR, LDS_BYTES);
#else
    (void)hipFuncSetAttribute((const void*)stage_kernel<3>, hipFuncAttributeMaxDynamicSharedMemorySize, LDS_BYTES);
    (void)hipOccupancyMaxActiveBlocksPerMultiprocessor(&per_cu, (const void*)stage_kernel<3>, NTHR, LDS_BYTES);
#endif
    if (per_cu < 1) per_cu = 1;
    if (per_cu > 2) per_cu = 2;
    grid = cus * per_cu;
  }
  if (grid < 0) return;
  (void)hipMemsetAsync((char*)d_ws + OFF_CTR, 0, 256 + 3456 * 4, stream);
  Params p{};
  for (int i = 0; i < 31; ++i) p.in[i] = (const float*)d_in[i];
  p.out = (float*)d_out;
  p.ws = (unsigned char*)d_ws;
#if ONE_LAUNCH
  void* args[] = {&p};
  hipError_t e = hipLaunchCooperativeKernel((const void*)mega, dim3(grid), dim3(NTHR), args, LDS_BYTES, stream);
  if (e != hipSuccess) fprintf(stderr, "cooperative launch failed: %s (grid %d)\n", hipGetErrorString(e), grid);
#else
  launch_stage<-1>(p, 0, grid, stream);
  for (int l = 0; l < 2; ++l) {
    launch_stage<0>(p, l, grid, stream);
    launch_stage<1>(p, l, grid, stream);
    launch_stage<2>(p, l, grid, stream);
    launch_stage<3>(p, l, grid, stream);
    launch_stage<4>(p, l, grid, stream);
    launch_stage<5>(p, l, grid, stream);
    launch_stage<6>(p, l, grid, stream);
    launch_stage<7>(p, l, grid, stream);
    launch_stage<8>(p, l, grid, stream);
    launch_stage<9>(p, l, grid, stream);
  }
#endif
}
```

```cpp
#include <hip/hip_runtime.h>
#include <hip/hip_cooperative_groups.h>
#include <cstdio>
namespace cg = cooperative_groups;

#ifndef PH_MASK
#define PH_MASK 0xFFFF
#endif
#ifndef PEER_REPS
#define PEER_REPS 1
#endif
#ifndef EXTRA_SYNCS
#define EXTRA_SYNCS 0
#endif
#ifndef REP_MASK
#define REP_MASK 0
#endif
#ifndef ONE_LAUNCH
#define ONE_LAUNCH 1
#endif

typedef unsigned short u16;
typedef unsigned int u32;
typedef __attribute__((ext_vector_type(8))) short bf16x8;
typedef __attribute__((ext_vector_type(16))) float f32x16;
typedef __attribute__((ext_vector_type(4))) float f32x4;
typedef __attribute__((ext_vector_type(2))) float f32x2;
typedef __attribute__((ext_vector_type(4))) unsigned int u32x4;
#define DI __device__ __forceinline__
DI int TID() { int t = threadIdx.x; asm volatile("" : "+v"(t)); return t; }

DI u16 f2bf(float x) { u32 u = __float_as_uint(x); u += 0x7fffu + ((u >> 16) & 1u); return (u16)(u >> 16); }
DI float bf2f(u16 v) { return __uint_as_float(((u32)v) << 16); }
DI u32 pack2(float a, float b) { return (u32)f2bf(a) | ((u32)f2bf(b) << 16); }
DI float bflo(u32 v) { return __uint_as_float(v << 16); }
DI float bfhi(u32 v) { return __uint_as_float(v & 0xffff0000u); }

constexpr int D = 1024, NB = 16, SEQ = 2048, CTXL = 256, TPB = 2304, ROWS = NB * TPB;
constexpr int NIN = 2944;
constexpr int RSTR = 4112;
constexpr int NTHR = 256;
constexpr int LDS_BYTES = 73728;
constexpr float EPSF = 1e-6f;

constexpr size_t SZ_PHY = (size_t)ROWS * 768 * 2, SZ_PZ = (size_t)ROWS * 512 * 2, SZ_PXBC = (size_t)ROWS * 1024 * 2;
constexpr size_t OFF_PHY = 0;
constexpr size_t OFF_PZ = OFF_PHY + SZ_PHY;
constexpr size_t OFF_PXBC = OFF_PZ + SZ_PZ;
constexpr size_t OFF_Q = OFF_PHY;
constexpr size_t OFF_ACT = OFF_PXBC + SZ_PXBC;
constexpr size_t OFF_XBCA = OFF_ACT + (size_t)ROWS * 1024 * 2;
constexpr size_t OFF_DREG = OFF_XBCA + (size_t)ROWS * 1024 * 2;
constexpr size_t OFF_PQT = OFF_DREG;
constexpr size_t OFF_UT = OFF_PQT + (size_t)NB * 512 * TPB * 2;
constexpr size_t OFF_X1C = OFF_UT + (size_t)256 * 16 * TPB * 2;
constexpr size_t OFF_TV = OFF_DREG;
constexpr size_t OFF_TI = OFF_TV + (size_t)ROWS * 256 * 4;
constexpr size_t OFF_XC = OFF_DREG + (size_t)ROWS * 256 * 8;
constexpr size_t OFF_WIN = OFF_XC + (size_t)NB * CTXL * D * 4;
constexpr size_t OFF_WOUT = OFF_WIN + (size_t)2 * NIN * 1024 * 2;
constexpr size_t OFF_WQ = OFF_WOUT + (size_t)2 * 1024 * 1024 * 2;
constexpr size_t OFF_K12 = OFF_WQ + (size_t)2 * 2048 * 1024 * 2;
constexpr size_t OFF_DFT = OFF_K12 + (size_t)2 * 2 * 128 * 128 * 2;
constexpr size_t OFF_DFTC = OFF_DFT + (size_t)2048 * 4096 * 2;
constexpr size_t OFF_RF = OFF_DFTC + (size_t)256 * 512 * 2;
constexpr size_t OFF_PART = OFF_RF + (size_t)3 * 256 * 2 * RSTR * 2;
constexpr size_t OFF_MOD = OFF_PART + (size_t)3 * 32 * 256 * 4;
constexpr size_t OFF_DT = OFF_MOD + (size_t)2 * 17 * 6144 * 4;
constexpr size_t OFF_CTR = OFF_DT + (size_t)ROWS * 16 * 4;
constexpr size_t OFF_BAR = OFF_CTR + 256;
constexpr size_t OFF_TX = OFF_BAR + 3456 * 4;
constexpr size_t WS_END = OFF_TX + (size_t)NB * 768 * TPB * 2;

struct Params {
  const float* in[31];
  float* out;
  unsigned char* ws;
  int pad0, pad1;
};

enum { I_X = 0, I_C, I_CTX, I_CCTX, I_WADA, I_BADA, I_G1, I_G2, I_WIN, I_HYCW, I_HYCB, I_HFW1, I_HFB1, I_HFW2, I_HFB2,
       I_HFW3, I_HFFREQ, I_HYBIAS, I_SCW, I_SCB, I_SDTB, I_SALOG, I_SD, I_SNG, I_WOUT, I_WQ, I_K1, I_K2, I_PU, I_PV, I_GF };

__device__ const unsigned char CAND_A[56] = {0, 0, 0, 0, 0, 0, 0, 0, 0, 0, 0, 0, 0, 0, 0, 0, 1, 1, 1, 1, 1, 1, 1, 1, 2, 2, 2, 2, 2, 3, 3, 3, 3, 4, 4, 4, 5, 5, 6, 6, 7, 7, 8, 9, 10, 11, 12, 13, 14, 15, 0, 0, 0, 0, 0, 0};
__device__ const unsigned char CAND_B[56] = {0, 1, 2, 3, 4, 5, 6, 7, 8, 9, 10, 11, 12, 13, 14, 15, 0, 1, 2, 3, 4, 5, 6, 7, 0, 1, 2, 3, 4, 0, 1, 2, 3, 0, 1, 2, 0, 1, 0, 1, 0, 1, 0, 0, 0, 0, 0, 0, 0, 0, 0, 0, 0, 0, 0, 0};

#define WSP(T, off) ((T*)(p.ws + (off)))

#define XB_TMO      128
#define XB_XCNT(j)  (256  + 64 * (j))
#define XB_XSUB(j)  (1280 + 64 * (j))
#define XB_XGEN(j)  (2304 + 64 * (j))
#define XB_TOP      3328
#define XB_TOPGEN   3392
#define XCD_BAR_WORDS 3456
#define XB_SPIN_CAP (1u << 18)
#define LAS __attribute__((address_space(3)))
DI unsigned xb_ld(unsigned* p) { return __hip_atomic_load(p, __ATOMIC_RELAXED, __HIP_MEMORY_SCOPE_AGENT); }
DI unsigned xb_add(unsigned* p, unsigned v) { return __hip_atomic_fetch_add(p, v, __ATOMIC_RELAXED, __HIP_MEMORY_SCOPE_AGENT); }
DI unsigned xb_xcc_id() { return (unsigned)__builtin_amdgcn_s_getreg((3 << 11) | 20) & 0xFu; }
#define XB_SPIN(cond, bar) do { unsigned _sp = 0; while (cond) { __builtin_amdgcn_s_sleep(1); \
    if ((++_sp & 255u) == 0u) { if (xb_ld(&(bar)[XB_TMO])) break; if (_sp > XB_SPIN_CAP) { atomicAdd(&(bar)[XB_TMO], 1u); break; } } } } while (0)
struct XcdBarrier { unsigned* bar; unsigned x; volatile LAS unsigned* st; };
DI XcdBarrier xcd_barrier_post(unsigned* bar, volatile LAS unsigned* st) {
  XcdBarrier b; b.bar = bar; b.x = xb_xcc_id(); b.st = st;
  if (threadIdx.x == 0) (void)xb_add(&bar[XB_XCNT(b.x)], 1u);
  return b;
}
DI void xcd_barrier_complete(unsigned* bar, unsigned x, unsigned& nloc, unsigned& nx) {
  const unsigned G = gridDim.x * gridDim.y * gridDim.z;
  unsigned sum, cnt, mine, sp = 0u;
  for (;;) {
    sum = 0u; cnt = 0u; mine = 0u;
#pragma unroll
    for (unsigned j = 0; j < 16; ++j) { const unsigned c = xb_ld(&bar[XB_XCNT(j)]); sum += c; cnt += (c > 0u) ? 1u : 0u; mine = (j == x) ? c : mine; }
    if (sum == G) break;
    __builtin_amdgcn_s_sleep(1);
    if ((++sp & 255u) == 0u) { if (xb_ld(&bar[XB_TMO])) break; if (sp > XB_SPIN_CAP) { atomicAdd(&bar[XB_TMO], 1u); break; } }
  }
  nloc = mine > 0u ? mine : 1u; nx = cnt > 0u ? cnt : 1u;
}
DI void xcd_barrier(const XcdBarrier& b) {
  asm volatile("s_waitcnt vmcnt(0)" ::: "memory");
  __syncthreads();
  if (threadIdx.x == 0) {
    unsigned* bar = b.bar;
    __builtin_amdgcn_s_waitcnt(0);
    unsigned nloc = b.st[0], nx = b.st[1];
    if (nloc == 0u) { xcd_barrier_complete(bar, b.x, nloc, nx); b.st[0] = nloc; b.st[1] = nx; }
    const unsigned old = xb_add(&bar[XB_XSUB(b.x)], 1u);
    const unsigned gen = old / nloc;
    if (old + 1u == (gen + 1u) * nloc) {
      __builtin_amdgcn_fence(__ATOMIC_RELEASE, "agent");
      asm volatile("s_waitcnt vmcnt(0)" ::: "memory");
      const unsigned og = xb_add(&bar[XB_TOP], 1u);
      const unsigned tg = og / nx;
      if (og + 1u == (tg + 1u) * nx) xb_add(&bar[XB_TOPGEN], 1u);
      else XB_SPIN(xb_ld(&bar[XB_TOPGEN]) == tg, bar);
      __builtin_amdgcn_fence(__ATOMIC_ACQUIRE, "agent");
      xb_add(&bar[XB_XGEN(b.x)], 1u);
      asm volatile("s_waitcnt vmcnt(0)" ::: "memory");
    } else {
      XB_SPIN(xb_ld(&bar[XB_XGEN(b.x)]) == gen, bar);
      __builtin_amdgcn_fence(__ATOMIC_ACQUIRE, "agent");
      asm volatile("s_waitcnt vmcnt(0)" ::: "memory");
    }
  }
  __syncthreads();
}


template <bool SWAP, int MI, class AF, class BF, class EF>
DI void gemm_tile(const AF& af, const BF& bfn, const EF& ef, int m0, int n0, int K, char* smem) {
  constexpr int AROWS = MI * 64;
  u16* As = (u16*)smem;
  u16* Bs = As + 2 * AROWS * 40;
  const int tid = TID(), lane = tid & 63, w = tid >> 6;
  const int wm = w >> 1, wn = w & 1, l32 = lane & 31, h = lane >> 5;
  const int lrow = (tid >> 6) * 16 + ((tid >> 5) & 1) * 8 + ((tid >> 2) & 1) * 4 + ((tid >> 3) & 3), lk = (tid & 3) * 8;
  f32x16 acc[MI][2];
#pragma unroll
  for (int i = 0; i < MI; ++i)
#pragma unroll
    for (int j = 0; j < 2; ++j)
#pragma unroll
      for (int r = 0; r < 16; ++r) acc[i][j][r] = 0.f;
  u32x4 ra[MI], rb[2];
  const int nk = K >> 5;
#pragma unroll
  for (int i = 0; i < MI; ++i) ra[i] = *(const u32x4*)af(m0 + lrow + 64 * i, lk);
#pragma unroll
  for (int i = 0; i < 2; ++i) rb[i] = *(const u32x4*)bfn(n0 + lrow + 64 * i, lk);
#pragma unroll
  for (int i = 0; i < MI; ++i) *(u32x4*)&As[(lrow + 64 * i) * 40 + lk] = ra[i];
#pragma unroll
  for (int i = 0; i < 2; ++i) *(u32x4*)&Bs[(lrow + 64 * i) * 40 + lk] = rb[i];
  {
    const int k1 = (nk > 1) ? 32 + lk : lk;
#pragma unroll
    for (int i = 0; i < MI; ++i) ra[i] = *(const u32x4*)af(m0 + lrow + 64 * i, k1);
#pragma unroll
    for (int i = 0; i < 2; ++i) rb[i] = *(const u32x4*)bfn(n0 + lrow + 64 * i, k1);
  }
  __syncthreads();
  for (int kt = 0; kt < nk; ++kt) {
    const int cur = kt & 1;
    const u16* Ab = As + cur * AROWS * 40;
    const u16* Bb = Bs + cur * 128 * 40;
#pragma unroll
    for (int ks = 0; ks < 2; ++ks) {
      bf16x8 a[MI], b[2];
#pragma unroll
      for (int i = 0; i < MI; ++i) a[i] = *(const bf16x8*)&Ab[(wm * (MI * 32) + i * 32 + l32) * 40 + ks * 16 + h * 8];
#pragma unroll
      for (int i = 0; i < 2; ++i) b[i] = *(const bf16x8*)&Bb[(wn * 64 + i * 32 + l32) * 40 + ks * 16 + h * 8];
#pragma unroll
      for (int i = 0; i < MI; ++i)
#pragma unroll
        for (int j = 0; j < 2; ++j)
          acc[i][j] = SWAP ? __builtin_amdgcn_mfma_f32_32x32x16_bf16(b[j], a[i], acc[i][j], 0, 0, 0)
                           : __builtin_amdgcn_mfma_f32_32x32x16_bf16(a[i], b[j], acc[i][j], 0, 0, 0);
    }
    {
      u16* An = As + (cur ^ 1) * AROWS * 40;
      u16* Bn = Bs + (cur ^ 1) * 128 * 40;
#pragma unroll
      for (int i = 0; i < MI; ++i) *(u32x4*)&An[(lrow + 64 * i) * 40 + lk] = ra[i];
#pragma unroll
      for (int i = 0; i < 2; ++i) *(u32x4*)&Bn[(lrow + 64 * i) * 40 + lk] = rb[i];
      const int kn = (kt + 2 < nk) ? kt + 2 : nk - 1;
      const int k0 = kn * 32 + lk;
#pragma unroll
      for (int i = 0; i < MI; ++i) ra[i] = *(const u32x4*)af(m0 + lrow + 64 * i, k0);
#pragma unroll
      for (int i = 0; i < 2; ++i) rb[i] = *(const u32x4*)bfn(n0 + lrow + 64 * i, k0);
    }
    __syncthreads();
  }
#pragma unroll
  for (int i = 0; i < MI; ++i)
#pragma unroll
    for (int j = 0; j < 2; ++j)
#pragma unroll
      for (int rg = 0; rg < 4; ++rg) {
        const int m = SWAP ? (m0 + wm * (MI * 32) + i * 32 + l32) : (m0 + wm * (MI * 32) + i * 32 + rg * 8 + h * 4);
        const int n = SWAP ? (n0 + wn * 64 + j * 32 + rg * 8 + h * 4) : (n0 + wn * 64 + j * 32 + l32);
        ef(m, n, acc[i][j][rg * 4 + 0], acc[i][j][rg * 4 + 1], acc[i][j][rg * 4 + 2], acc[i][j][rg * 4 + 3]);
      }
}

template <int CTRL> DI int dpp_i(int v) { return __builtin_amdgcn_mov_dpp(v, CTRL, 0xF, 0xF, true); }
template <int CTRL> DI float dpp_f(float v) { return __builtin_bit_cast(float, __builtin_amdgcn_mov_dpp(__builtin_bit_cast(int, v), CTRL, 0xF, 0xF, true)); }
#define DPP_XOR1 0xB1
#define DPP_XOR2 0x4E
#define DPP_MIRROR8 0x141
DI float wave_sum(float v) {
#pragma unroll
  for (int o = 32; o >= 1; o >>= 1) v += __shfl_xor(v, o);
  return v;
}
DI float silu_f(float x) { return x / (1.f + __expf(-x)); }
DI float gelu_tanh(float x) {
  const float u = 0.7978845608028654f * (x + 0.044715f * x * x * x);
  return 0.5f * x * (1.f + tanhf(u));
}

DI const float* xrow_ptr(const Params& p, bool from_input, int b, int pos) {
  if (pos < CTXL) return (from_input ? p.in[I_CTX] : WSP(const float, OFF_XC)) + ((size_t)b * CTXL + pos) * D;
  return (from_input ? p.in[I_X] : (const float*)p.out) + ((size_t)b * SEQ + (pos - CTXL)) * D;
}
DI float* xrow_wptr(const Params& p, int b, int pos) {
  if (pos < CTXL) return WSP(float, OFF_XC) + ((size_t)b * CTXL + pos) * D;
  return p.out + ((size_t)b * SEQ + (pos - CTXL)) * D;
}

DI void phase_prologue(const Params& p, int bid, int nblk, char* smem) {
  const int tid = TID();
  const int gtid = bid * NTHR + tid, gn = nblk * NTHR;
  {
    float* scs = (float*)smem;
    for (int it = bid; it < 192; it += nblk) {
      const int l = it / 96, col0 = (it % 96) * 64;
      for (int e = tid; e < 17 * 1024; e += NTHR) {
        const int j = e >> 10, k = e & 1023;
        const float v = (j < 16) ? p.in[I_C][j * 1024 + k] : p.in[I_CCTX][k];
        scs[e] = v / (1.f + expf(-v));
      }
      __syncthreads();
      const int col = tid & 63, kq = tid >> 6;
      float acc[17];
#pragma unroll
      for (int j = 0; j < 17; ++j) acc[j] = 0.f;
      const float* wa = p.in[I_WADA] + (size_t)l * 1024 * 6144 + col0 + col;
      for (int k0 = kq * 256; k0 < kq * 256 + 256; k0 += 8) {
        float wv[8];
#pragma unroll
        for (int kk = 0; kk < 8; ++kk) wv[kk] = wa[(size_t)(k0 + kk) * 6144];
#pragma unroll
        for (int kk = 0; kk < 8; ++kk)
#pragma unroll
          for (int j = 0; j < 17; ++j) acc[j] += scs[j * 1024 + k0 + kk] * wv[kk];
      }
      __syncthreads();
#pragma unroll
      for (int j = 0; j < 17; ++j) scs[(kq * 17 + j) * 64 + col] = acc[j];
      __syncthreads();
      for (int e = tid; e < 17 * 64; e += NTHR) {
        const int j = e >> 6, cc = e & 63;
        float s = p.in[I_BADA][l * 6144 + col0 + cc];
#pragma unroll
        for (int q = 0; q < 4; ++q) s += scs[(q * 17 + j) * 64 + cc];
        WSP(float, OFF_MOD)[(size_t)(l * 17 + j) * 6144 + col0 + cc] = s;
      }
      __syncthreads();
    }
  }
  {
    float* zs = (float*)smem;
    float* h1s = zs + 64 * 33;
    float* h2s = h1s + 64 * 64;
    for (int it = (nblk >= 260 ? (bid >= 192 ? bid - 192 : 1 << 20) : bid); it < 68; it += nblk) {
      const int f = it < 32 ? 0 : (it < 64 ? 1 : 2);
      const int tile = it - (f == 0 ? 0 : (f == 1 ? 32 : 64));
      const int L = (f == 2) ? 256 : 2048;
      const int lyr = (f == 1) ? 1 : 0;
      const int pos0 = tile * 64;
      const float* w1 = p.in[I_HFW1] + lyr * 33 * 64;
      const float* b1 = p.in[I_HFB1] + lyr * 64;
      const float* w2 = p.in[I_HFW2] + lyr * 64 * 64;
      const float* b2 = p.in[I_HFB2] + lyr * 64;
      const float* w3 = p.in[I_HFW3] + lyr * 64 * 512;
      const float* fq = p.in[I_HFFREQ] + lyr * 64;
      for (int e = tid; e < 64 * 33; e += NTHR) {
        const int pi = e / 33, q = e % 33;
        const int pos = pos0 + pi;
        const float tt = (float)pos / (float)(L - 1);
        const float wv = 6.283185307179586f * (float)pos / (float)L;
        float z;
        if (q == 0) z = tt;
        else if (q <= 16) { const float fi = 1e-4f + (float)(q - 1) * ((15.f - 1e-4f) / 15.f); z = cosf(fi * wv); }
        else { const float fi = 1e-4f + (float)(q - 17) * ((15.f - 1e-4f) / 15.f); z = -sinf(fi * wv); }
        zs[e] = z;
      }
      __syncthreads();
      for (int e = tid; e < 64 * 64; e += NTHR) {
        const int pi = e >> 6, j = e & 63;
        float s = b1[j];
        for (int q = 0; q < 33; ++q) s += zs[pi * 33 + q] * w1[q * 64 + j];
        h1s[e] = sinf(fq[j] * s);
      }
      __syncthreads();
      for (int e = tid; e < 64 * 64; e += NTHR) {
        const int pi = e >> 6, j = e & 63;
        float s = b2[j];
        for (int k = 0; k < 64; ++k) s += h1s[pi * 64 + k] * w2[k * 64 + j];
        h2s[e] = sinf(fq[j] * s);
      }
      __syncthreads();
      {
        const int c = tid;
        const float mind = logf(1e-2f) / 1.5f, maxd = logf(1e-2f) / 0.3f;
        const float delta = fabsf(mind + (float)c * ((maxd - mind) / 255.f));
        u16* R0 = WSP(u16, OFF_RF) + ((size_t)(f * 256 + c) * 2 + 0) * RSTR;
        u16* R1 = R0 + RSTR;
        float ssq = 0.f;
        for (int pb = 0; pb < 4; ++pb) {
          float af_[16], ab_[16];
#pragma unroll
          for (int i = 0; i < 16; ++i) { af_[i] = 0.f; ab_[i] = 0.f; }
          for (int k = 0; k < 64; ++k) {
            const float wf = w3[k * 512 + c], wb = w3[k * 512 + 256 + c];
#pragma unroll
            for (int i = 0; i < 16; ++i) {
              const float hv = h2s[(pb * 16 + i) * 64 + k];
              af_[i] += hv * wf;
              ab_[i] += hv * wb;
            }
          }
#pragma unroll
          for (int i = 0; i < 16; ++i) {
            const int pos = pos0 + pb * 16 + i;
            const float tt = (float)pos / (float)(L - 1);
            const float win = expf(-tt * delta);
            const float vf = af_[i] * win, vb = ab_[i] * win;
            const u16 bfv = f2bf(vf), bbv = f2bf(vb);
            R0[L - pos] = bfv;
            R1[L - pos - 1] = bfv;
            ssq += vf * vf;
            if (pos >= 1) {
              R0[L + pos] = bbv;
              R1[L + pos - 1] = bbv;
              ssq += vb * vb;
            }
          }
        }
        WSP(float, OFF_PART)[(size_t)(f * 32 + tile) * 256 + c] = ssq;
      }
      __syncthreads();
    }
  }
  for (int e = gtid; e < 2 * NIN * 128; e += gn) {
    const int l = e / (NIN * 128);
    const int r = e % (NIN * 128);
    const int kc = r / NIN, n = r % NIN;
    const int k0 = kc * 8;
    const float* wsrc = p.in[I_WIN] + (size_t)l * 1024 * 2576;
    float v[8];
    if (n < 2304) {
#pragma unroll
      for (int j = 0; j < 8; ++j) v[j] = wsrc[(size_t)(k0 + j) * 2576 + n];
    } else if (n < 2816) {
      const int np = n - 2304, g = np >> 7, rr = np & 127, pq = rr >> 6, kk = rr & 63;
#pragma unroll
      for (int j = 0; j < 8; ++j) v[j] = 0.f;
      for (int jj = 0; jj < 64; ++jj) {
        const float ang = 6.283185307179586f * (float)((jj * kk) & 63) / 64.f;
        const float tr = pq ? sinf(ang) : cosf(ang);
#pragma unroll
        for (int j = 0; j < 8; ++j) v[j] += wsrc[(size_t)(k0 + j) * 2576 + 2320 + g * 64 + jj] * tr;
      }
    } else if (n < 2832) {
#pragma unroll
      for (int j = 0; j < 8; ++j) v[j] = wsrc[(size_t)(k0 + j) * 2576 + 2304 + (n - 2816)];
    } else {
#pragma unroll
      for (int j = 0; j < 8; ++j) v[j] = 0.f;
    }
    uint4 o = {pack2(v[0], v[1]), pack2(v[2], v[3]), pack2(v[4], v[5]), pack2(v[6], v[7])};
    *(uint4*)&WSP(u16, OFF_WIN)[((size_t)l * NIN + n) * 1024 + k0] = o;
  }
  for (int e = gtid; e < 2 * 1024 * 128; e += gn) {
    const int l = e / (1024 * 128), r = e % (1024 * 128), kc = r / 1024, n = r % 1024, k0 = kc * 8;
    const float* wsrc = p.in[I_WOUT] + (size_t)l * 1024 * 1024;
    float v[8];
#pragma unroll
    for (int j = 0; j < 8; ++j) v[j] = wsrc[(size_t)(k0 + j) * 1024 + n];
    uint4 o = {pack2(v[0], v[1]), pack2(v[2], v[3]), pack2(v[4], v[5]), pack2(v[6], v[7])};
    *(uint4*)&WSP(u16, OFF_WOUT)[((size_t)l * 1024 + n) * 1024 + k0] = o;
  }
  for (int e = gtid; e < 2 * 2048 * 128; e += gn) {
    const int l = e / (2048 * 128), r = e % (2048 * 128), kc = r / 2048, n = r % 2048, k0 = kc * 8;
    const float* wsrc = p.in[I_WQ] + (size_t)l * 1024 * 2048;
    float v[8];
#pragma unroll
    for (int j = 0; j < 8; ++j) v[j] = wsrc[(size_t)(k0 + j) * 2048 + n];
    uint4 o = {pack2(v[0], v[1]), pack2(v[2], v[3]), pack2(v[4], v[5]), pack2(v[6], v[7])};
    *(uint4*)&WSP(u16, OFF_WQ)[((size_t)l * 2048 + n) * 1024 + k0] = o;
  }
  for (int e = gtid; e < 2 * 2 * 128 * 128; e += gn) {
    const int l = e / (2 * 16384), r = e % (2 * 16384), which = r / 16384, i = r % 16384;
    const float v = (which ? p.in[I_K2] : p.in[I_K1])[l * 16384 + i];
    WSP(u16, OFF_K12)[e] = f2bf(v);
  }
  for (int e = gtid; e < 2048 * 512; e += gn) {
    const int tp = e >> 9, k0 = (e & 511) * 8;
    const float s = 1.f / sqrtf(2048.f * 64.f);
    float v[8];
#pragma unroll
    for (int j = 0; j < 8; ++j) {
      const int k = k0 + j, t = k & 2047;
      const float ang = 6.283185307179586f * (float)((tp * t) & 2047) / 2048.f;
      v[j] = (k < 2048) ? cosf(ang) * s : -sinf(ang) * s;
    }
    uint4 o = {pack2(v[0], v[1]), pack2(v[2], v[3]), pack2(v[4], v[5]), pack2(v[6], v[7])};
    *(uint4*)&WSP(u16, OFF_DFT)[(size_t)tp * 4096 + k0] = o;
  }
  for (int e = gtid; e < 256 * 64; e += gn) {
    const int tp = e >> 6, k0 = (e & 63) * 8;
    const float s = 1.f / sqrtf(256.f * 64.f);
    float v[8];
#pragma unroll
    for (int j = 0; j < 8; ++j) {
      const int k = k0 + j, t = k & 255;
      const float ang = 6.283185307179586f * (float)((tp * t) & 255) / 256.f;
      v[j] = (k < 256) ? cosf(ang) * s : -sinf(ang) * s;
    }
    uint4 o = {pack2(v[0], v[1]), pack2(v[2], v[3]), pack2(v[4], v[5]), pack2(v[6], v[7])};
    *(uint4*)&WSP(u16, OFF_DFTC)[(size_t)tp * 512 + k0] = o;
  }
}

DI void phase_norm(const Params& p, int l, int which, int bid, int nblk) {
  const int lane = TID() & 63, w = TID() >> 6;
  const float* g = (which ? p.in[I_G2] : p.in[I_G1]) + l * 1024;
  const bool from_input = (which == 0 && l == 0);
  for (int row = bid * 4 + w; row < ROWS; row += nblk * 4) {
    const int b = row / TPB, pos = row % TPB;
    if (which == 1 && l == 1 && pos < CTXL) continue;
    const float* xr = xrow_ptr(p, from_input, b, pos);
    const float* mod = WSP(const float, OFF_MOD) + (size_t)(l * 17 + (pos < CTXL ? 16 : b)) * 6144 + which * 3072;
    float x[16];
#pragma unroll
    for (int hh = 0; hh < 2; ++hh) {
      const float4 a = *(const float4*)(xr + hh * 512 + lane * 8);
      const float4 c = *(const float4*)(xr + hh * 512 + lane * 8 + 4);
      x[hh * 8 + 0] = a.x; x[hh * 8 + 1] = a.y; x[hh * 8 + 2] = a.z; x[hh * 8 + 3] = a.w;
      x[hh * 8 + 4] = c.x; x[hh * 8 + 5] = c.y; x[hh * 8 + 6] = c.z; x[hh * 8 + 7] = c.w;
    }
    float ss = 0.f;
#pragma unroll
    for (int i = 0; i < 16; ++i) ss += x[i] * x[i];
    ss = wave_sum(ss);
    const float rs = rsqrtf(ss * (1.f / 1024.f) + EPSF);
#pragma unroll
    for (int hh = 0; hh < 2; ++hh) {
      const int c0 = hh * 512 + lane * 8;
      float y[8];
#pragma unroll
      for (int i = 0; i < 8; ++i) {
        const float yn = x[hh * 8 + i] * rs * g[c0 + i];
        y[i] = yn * (1.f + mod[1024 + c0 + i]) + mod[c0 + i];
      }
      uint4 o = {pack2(y[0], y[1]), pack2(y[2], y[3]), pack2(y[4], y[5]), pack2(y[6], y[7])};
      *(uint4*)&WSP(u16, OFF_ACT)[(size_t)row * 1024 + c0] = o;
    }
  }
}

constexpr float U_SCALE = 64.f, V_SCALE = 4.f;
DI void phase_tables(const Params& p, int l, int bid, int nblk) {
  const int gtid = bid * NTHR + TID(), gn = nblk * NTHR;
  unsigned char* dst = WSP(unsigned char, OFF_XBCA);
  for (int e = gtid; e < 2 * 16384 * 64; e += gn) {
    const int which = e / (16384 * 64), r = e % (16384 * 64);
    const float sc = which ? V_SCALE : U_SCALE;
    const float* src = (which ? p.in[I_PV] : p.in[I_PU]) + (size_t)l * 16384 * 1024 + (size_t)r * 16;
    u32 o[4];
#pragma unroll
    for (int q = 0; q < 4; ++q) {
      const float4 a = *(const float4*)(src + q * 4);
      int v = __builtin_amdgcn_cvt_pk_fp8_f32(a.x * sc, a.y * sc, 0, false);
      v = __builtin_amdgcn_cvt_pk_fp8_f32(a.z * sc, a.w * sc, v, true);
      o[q] = (u32)v;
    }
    uint4 ov = {o[0], o[1], o[2], o[3]};
    *(uint4*)&dst[(size_t)e * 16] = ov;
  }
}

DI void phase_inproj(const Params& p, int l, int bid, int nblk, char* smem) {
  const u16* A = WSP(const u16, OFF_ACT);
  const u16* B = WSP(const u16, OFF_WIN) + (size_t)l * NIN * 1024;
  u16* PHY = WSP(u16, OFF_PHY);
  u16* PZ = WSP(u16, OFF_PZ);
  u16* PXBC = WSP(u16, OFF_PXBC);
  u16* PQT = WSP(u16, OFF_PQT);
  float* DT = WSP(float, OFF_DT);
  auto af = [=](int m, int k) { return A + (size_t)m * 1024 + k; };
  auto bfn = [=](int n, int k) { return B + (size_t)n * 1024 + k; };
  auto efT = [=](int m, int n, float v0, float v1, float v2, float v3) {
    const uint2 o = {pack2(v0, v1), pack2(v2, v3)};
    if (n < 768) *(uint2*)&PHY[(size_t)m * 768 + n] = o;
    else if (n < 1280) *(uint2*)&PZ[(size_t)m * 512 + (n - 768)] = o;
    else if (n < 2304) *(uint2*)&PXBC[(size_t)m * 1024 + (n - 1280)] = o;
    else if (n >= 2816 && n < 2832) { float4 f = {v0, v1, v2, v3}; *(float4*)&DT[(size_t)m * 16 + (n - 2816)] = f; }
  };
  auto efN = [=](int m, int n, float v0, float v1, float v2, float v3) {
    const int b = m / TPB, pos = m % TPB, np = n - 2304;
    uint2 o = {pack2(v0, v1), pack2(v2, v3)};
    *(uint2*)&PQT[((size_t)(b * 512 + np)) * TPB + pos] = o;
  };
  const int ntile = (ROWS / 256) * (NIN / 128);
  const int vb = (nblk % 8 == 0) ? (bid & 7) * (nblk >> 3) + (bid >> 3) : bid;
  for (int t = vb; t < ntile; t += nblk) {
    const int mt = t / (NIN / 128), nt = t % (NIN / 128);
    if (nt >= 18 && nt < 22) gemm_tile<false, 4>(af, bfn, efN, mt * 256, nt * 128, 1024, smem);
    else gemm_tile<true, 4>(af, bfn, efT, mt * 256, nt * 128, 1024, smem);
  }
}

DI void unpack8(const uint4& v, float* f) {
  f[0] = bflo(v.x); f[1] = bfhi(v.x); f[2] = bflo(v.y); f[3] = bfhi(v.y);
  f[4] = bflo(v.z); f[5] = bfhi(v.z); f[6] = bflo(v.w); f[7] = bfhi(v.w);
}
DI void phase_prep(const Params& p, int l, int bid, int nblk, char* smem) {
  const int tid = TID();
  u16* tile = (u16*)smem;
  const u16* PHY = WSP(const u16, OFF_PHY);
  const u16* PXBC = WSP(const u16, OFF_PXBC);
  u16* UT = WSP(u16, OFF_UT);
  u16* X1C = WSP(u16, OFF_X1C);
  u16* XBCA = WSP(u16, OFF_XBCA);
  u16* TX = WSP(u16, OFF_TX);
  const float* hw = p.in[I_HYCW] + l * 3 * 768;
  const float* hb = p.in[I_HYCB] + l * 768;
  const float* sw = p.in[I_SCW] + l * 3 * 1024;
  const float* sb = p.in[I_SCB] + l * 1024;
  const int cg8 = (tid & 31) * 8, pg = tid >> 5;
  for (int it = bid; it < NB * 36 * 6; it += nblk) {
    const int pass = it % 6, bt = it / 6;
    const int b = bt / 36, pt = bt % 36, pos0 = pt * 64;
    const int seg_lo = (pos0 < CTXL) ? 0 : CTXL, seg_hi = (pos0 < CTXL) ? CTXL : TPB;
    const size_t rbase = (size_t)b * TPB;
    const int pfirst = pos0 + pg * 8;
    bool transposed = false;
    if (pass <= 1) {
      if (l == 1 && pos0 < CTXL) continue;
      float cv0[8][8];
#pragma unroll
      for (int sg = 0; sg < 2; ++sg) {
        if (pass == 0 && sg == 1) break;
        const int sgrp = (pass == 0) ? 1 : (sg == 0 ? 0 : 2);
        const int col = sgrp * 256 + cg8;
        float w0[8], w1[8], w2[8], bb[8];
#pragma unroll
        for (int e = 0; e < 8; ++e) { w0[e] = hw[col + e]; w1[e] = hw[768 + col + e]; w2[e] = hw[1536 + col + e]; bb[e] = hb[col + e]; }
        uint4 raw[10];
#pragma unroll
        for (int k = 0; k < 10; ++k) {
          const int pn = pfirst + k - 1;
          raw[k] = (pn >= seg_lo && pn < seg_hi) ? *(const uint4*)&PHY[(rbase + pn) * 768 + col] : make_uint4(0u, 0u, 0u, 0u);
        }
        float xm[8], x0[8], xp[8];
        unpack8(raw[0], xm);
        unpack8(raw[1], x0);
#pragma unroll
        for (int k = 0; k < 8; ++k) {
          unpack8(raw[k + 2], xp);
          float o[8];
#pragma unroll
          for (int e = 0; e < 8; ++e) {
            o[e] = w0[e] * xm[e] + w1[e] * x0[e] + w2[e] * xp[e] + bb[e];
            xm[e] = x0[e]; x0[e] = xp[e];
          }
          if (pass == 0) {
            uint4 o1 = {pack2(o[0], o[1]), pack2(o[2], o[3]), pack2(o[4], o[5]), pack2(o[6], o[7])};
            *(uint4*)&X1C[(rbase + pfirst + k) * 256 + cg8] = o1;
          } else if (sg == 0) {
#pragma unroll
            for (int e = 0; e < 8; ++e) cv0[k][e] = o[e];
          } else {
            uint4 ou = {pack2(o[0] * cv0[k][0], o[1] * cv0[k][1]), pack2(o[2] * cv0[k][2], o[3] * cv0[k][3]),
                        pack2(o[4] * cv0[k][4], o[5] * cv0[k][5]), pack2(o[6] * cv0[k][6], o[7] * cv0[k][7])};
            *(uint4*)&tile[(pg * 8 + k) * 264 + cg8] = ou;
          }
        }
      }
      transposed = (pass == 1);
    } else {
      const int col = (pass - 2) * 256 + cg8;
      float w0[8], w1[8], w2[8], bb[8];
#pragma unroll
      for (int e = 0; e < 8; ++e) { w0[e] = sw[col + e]; w1[e] = sw[1024 + col + e]; w2[e] = sw[2048 + col + e]; bb[e] = sb[col + e]; }
      uint4 raw[10];
#pragma unroll
      for (int k = 0; k < 10; ++k) {
        const int pn = pfirst + k - 1;
        raw[k] = (pn >= seg_lo && pn < seg_hi) ? *(const uint4*)&PXBC[(rbase + pn) * 1024 + col] : make_uint4(0u, 0u, 0u, 0u);
      }
      float xm[8], x0[8], xp[8];
      unpack8(raw[0], xm);
      unpack8(raw[1], x0);
#pragma unroll
      for (int k = 0; k < 8; ++k) {
        unpack8(raw[k + 2], xp);
        float o[8];
#pragma unroll
        for (int e = 0; e < 8; ++e) {
          o[e] = silu_f(w0[e] * xm[e] + w1[e] * x0[e] + w2[e] * xp[e] + bb[e]);
          xm[e] = x0[e]; x0[e] = xp[e];
        }
        uint4 ov = {pack2(o[0], o[1]), pack2(o[2], o[3]), pack2(o[4], o[5]), pack2(o[6], o[7])};
        *(uint4*)&XBCA[(rbase + pfirst + k) * 1024 + col] = ov;
        if (pass < 5) *(uint4*)&tile[(pg * 8 + k) * 264 + cg8] = ov;
      }
      transposed = pass < 5;
    }
    if (transposed) {
      __syncthreads();
      u16* dst = (pass == 1) ? (UT + ((size_t)(tid * 16 + b)) * TPB + pos0) : (TX + ((size_t)(b * 768 + (pass - 2) * 256 + tid)) * TPB + pos0);
#pragma unroll
      for (int pc = 0; pc < 8; ++pc) {
        u32 wv[4];
#pragma unroll
        for (int e = 0; e < 4; ++e)
          wv[e] = (u32)tile[(pc * 8 + 2 * e) * 264 + tid] | ((u32)tile[(pc * 8 + 2 * e + 1) * 264 + tid] << 16);
        uint4 o = {wv[0], wv[1], wv[2], wv[3]};
        *(uint4*)&dst[pc * 8] = o;
      }
      __syncthreads();
    }
  }
}

DI void ssd_item(const Params& p, int l, int it, char* smem) {
  const int tid = TID(), lane = tid & 63, w = tid >> 6, l32 = lane & 31, h = lane >> 5;
  const int b = it >> 4, hd = (it >> 1) & 7, dir = it & 1, g = hd >> 2;
  u16* BG = (u16*)smem;
  u16* HL = BG + 128 * 136;
  float* fa = (float*)(HL + 64 * 136);
  float* fdt = fa + 128;
  float* fsw = fdt + 128;
  float* fea = fsw + 128;
  float* ftot = fea + 128;
  const u16* XBCA = WSP(const u16, OFF_XBCA);
  const u16* TX = WSP(const u16, OFF_TX);
  const float* DT = WSP(const float, OFF_DT);
  u16* Y = WSP(u16, OFF_PXBC) + (dir ? (size_t)ROWS * 512 : 0);
  const float dtb = p.in[I_SDTB][l * 16 + dir * 8 + hd];
  const float a = -expf(p.in[I_SALOG][l * 16 + dir * 8 + hd]);
  const size_t rbase = (size_t)b * TPB;
  f32x16 Hacc[2];
#pragma unroll
  for (int i = 0; i < 2; ++i)
#pragma unroll
    for (int r = 0; r < 16; ++r) Hacc[i][r] = 0.f;
  for (int e = tid; e < 64 * 136; e += NTHR) HL[e] = 0;
  for (int ci = 0; ci < 18; ++ci) {
    const int pos0 = dir ? ((ci < 2) ? (1 - ci) * 128 : (CTXL + (17 - ci) * 128)) : ci * 128;
    asm volatile("s_waitcnt vmcnt(0)" ::: "memory");
    bf16x8 creg[8];
    const u16* cr = XBCA + (rbase + pos0 + w * 32 + l32) * 1024 + 768 + g * 128 + h * 8;
#pragma unroll
    for (int ks = 0; ks < 4; ++ks) creg[ks] = *(const bf16x8*)(cr + ks * 16);
    __builtin_amdgcn_sched_barrier(0);
#pragma unroll
    for (int i = 0; i < 8; ++i) {
      const int q = tid + 256 * i, j = q >> 4, ch = q & 15;
      *(uint4*)&BG[j * 136 + ch * 8] = *(const uint4*)&XBCA[(rbase + pos0 + j) * 1024 + 512 + g * 128 + ch * 8];
    }
    if (w == 0) {
      const float r0 = DT[(rbase + pos0 + 2 * lane) * 16 + dir * 8 + hd] + dtb;
      const float r1 = DT[(rbase + pos0 + 2 * lane + 1) * 16 + dir * 8 + hd] + dtb;
      const float dt0 = (r0 > 20.f) ? r0 : log1pf(expf(r0));
      const float dt1 = (r1 > 20.f) ? r1 : log1pf(expf(r1));
      const float a0 = dt0 * a, a1 = dt1 * a;
      const float sm = a0 + a1;
      float incl = sm;
#pragma unroll
      for (int o = 1; o < 64; o <<= 1) {
        const float t = __shfl_up(incl, o);
        if (lane >= o) incl += t;
      }
      const float excl = incl - sm;
      const float total = __shfl(incl, 63);
      float ac0, ac1;
      if (!dir) { ac0 = excl + a0; ac1 = excl + sm; }
      else { ac0 = total - excl; ac1 = total - excl - a0; }
      fa[2 * lane] = ac0; fa[2 * lane + 1] = ac1;
      fdt[2 * lane] = dt0; fdt[2 * lane + 1] = dt1;
      fsw[2 * lane] = dt0 * __expf(total - ac0); fsw[2 * lane + 1] = dt1 * __expf(total - ac1);
      fea[2 * lane] = __expf(ac0); fea[2 * lane + 1] = __expf(ac1);
      if (lane == 0) ftot[0] = __expf(total);
    }
    __syncthreads();
#pragma unroll
    for (int ks = 4; ks < 8; ++ks) creg[ks] = *(const bf16x8*)(cr + ks * 16);
    f32x16 acc[4], yd[2];
#pragma unroll
    for (int i = 0; i < 4; ++i)
#pragma unroll
      for (int r = 0; r < 16; ++r) acc[i][r] = 0.f;
#pragma unroll
    for (int i = 0; i < 2; ++i)
#pragma unroll
      for (int r = 0; r < 16; ++r) yd[i][r] = 0.f;
#pragma unroll
    for (int ks = 0; ks < 8; ++ks) {
      const bf16x8 areg = creg[ks];
#pragma unroll
      for (int jb = 0; jb < 4; ++jb) {
        const bf16x8 bb = *(const bf16x8*)&BG[(jb * 32 + l32) * 136 + ks * 16 + h * 8];
        acc[jb] = __builtin_amdgcn_mfma_f32_32x32x16_bf16(areg, bb, acc[jb], 0, 0, 0);
      }
    }
    {
      const float eai = fea[w * 32 + l32];
#pragma unroll
      for (int ks = 0; ks < 8; ++ks) {
        union { u32 u[4]; bf16x8 v; } t;
        t.v = creg[ks];
#pragma unroll
        for (int q = 0; q < 4; ++q) t.u[q] = pack2(bflo(t.u[q]) * eai, bfhi(t.u[q]) * eai);
#pragma unroll
        for (int pb = 0; pb < 2; ++pb) {
          const bf16x8 bb = *(const bf16x8*)&HL[(pb * 32 + l32) * 136 + ks * 16 + h * 8];
          yd[pb] = __builtin_amdgcn_mfma_f32_32x32x16_bf16(t.v, bb, yd[pb], 0, 0, 0);
        }
      }
    }
    __syncthreads();
    int l32v = l32, hv_ = h;
    asm volatile("" : "+v"(l32v), "+v"(hv_));
    bf16x8 xf[2][8];
    const u16* xt = TX + ((size_t)(b * 768 + hd * 64 + l32v)) * TPB + pos0 + hv_ * 8;
#pragma unroll
    for (int jb = 0; jb < 4; ++jb) {
      const int j = jb * 32 + l32v;
      const float aj = fa[j], dtj = fdt[j];
#pragma unroll
      for (int r = 0; r < 16; ++r) {
        const int i = w * 32 + (r & 3) + 8 * (r >> 2) + 4 * hv_;
        const float ai = fa[i];
        const bool valid = dir ? (j >= i) : (j <= i);
        const float v = valid ? acc[jb][r] * __expf(ai - aj) * dtj : 0.f;
        BG[i * 136 + j] = f2bf(v);
      }
      __builtin_amdgcn_sched_barrier(0);
      if (jb == 1) {
#pragma unroll
        for (int ks = 0; ks < 8; ++ks) xf[0][ks] = *(const bf16x8*)(xt + ks * 16);
        __builtin_amdgcn_sched_barrier(0);
      }
    }
#pragma unroll
    for (int ks = 0; ks < 8; ++ks) xf[1][ks] = *(const bf16x8*)(xt + (size_t)32 * TPB + ks * 16);
    __builtin_amdgcn_sched_barrier(0);
#pragma unroll
    for (int pb = 0; pb < 2; ++pb)
#pragma unroll
      for (int ks = 0; ks < 8; ++ks) {
        const bf16x8 aa = *(const bf16x8*)&BG[(w * 32 + l32v) * 136 + ks * 16 + hv_ * 8];
        yd[pb] = __builtin_amdgcn_mfma_f32_32x32x16_bf16(aa, xf[pb][ks], yd[pb], 0, 0, 0);
      }
#pragma unroll
    for (int pb = 0; pb < 2; ++pb)
#pragma unroll
      for (int r = 0; r < 16; ++r) {
        const int i = w * 32 + (r & 3) + 8 * (r >> 2) + 4 * hv_;
        Y[(rbase + pos0 + i) * 512 + hd * 64 + pb * 32 + l32v] = f2bf(yd[pb][r]);
      }
    {
      u32x4 braw[8];
      {
        const u16* bt = TX + ((size_t)(b * 768 + 512 + g * 128 + w * 32 + l32v)) * TPB + pos0 + hv_ * 8;
#pragma unroll
        for (int ks = 0; ks < 8; ++ks) braw[ks] = *(const u32x4*)(bt + ks * 16);
      }
      const float eend = ftot[0];
#pragma unroll
      for (int pm = 0; pm < 2; ++pm)
#pragma unroll
        for (int r = 0; r < 16; ++r) Hacc[pm][r] *= eend;
#pragma unroll
      for (int ks = 0; ks < 8; ++ks) {
        const u32x4 raw = braw[ks];
        const float4 s0 = *(const float4*)&fsw[ks * 16 + hv_ * 8];
        const float4 s1 = *(const float4*)&fsw[ks * 16 + hv_ * 8 + 4];
        union { u32 u[4]; bf16x8 v; } bs;
        bs.u[0] = pack2(bflo(raw[0]) * s0.x, bfhi(raw[0]) * s0.y);
        bs.u[1] = pack2(bflo(raw[1]) * s0.z, bfhi(raw[1]) * s0.w);
        bs.u[2] = pack2(bflo(raw[2]) * s1.x, bfhi(raw[2]) * s1.y);
        bs.u[3] = pack2(bflo(raw[3]) * s1.z, bfhi(raw[3]) * s1.w);
#pragma unroll
        for (int pm = 0; pm < 2; ++pm) Hacc[pm] = __builtin_amdgcn_mfma_f32_32x32x16_bf16(xf[pm][ks], bs.v, Hacc[pm], 0, 0, 0);
      }
#pragma unroll
      for (int pm = 0; pm < 2; ++pm)
#pragma unroll
        for (int r = 0; r < 16; ++r) {
          const int pp = pm * 32 + (r & 3) + 8 * (r >> 2) + 4 * hv_;
          HL[pp * 136 + w * 32 + l32v] = f2bf(Hacc[pm][r]);
        }
    }
    __syncthreads();
  }
}

DI void hyena_item(const Params& p, int l, int it) {
  const int lane = TID() & 63, w = TID() >> 6;
  int c, f, L, posoff, tt0, ntile;
  if (it < 2048) { c = it >> 3; f = l; L = 2048; posoff = CTXL; tt0 = (it & 7) * 256 + w * 64; ntile = 32; }
  else { c = it - 2048; f = 2; L = 256; posoff = 0; tt0 = w * 64; ntile = 4; }
  const u16* R0 = WSP(const u16, OFF_RF) + ((size_t)(f * 256 + c) * 2) * RSTR;
  const u16* R1 = R0 + RSTR;
  const u16* UT = WSP(const u16, OFF_UT);
  const int l16 = lane & 15, kg = lane >> 4;
  f32x4 acc[4];
#pragma unroll
  for (int i = 0; i < 4; ++i) acc[i] = (f32x4){0.f, 0.f, 0.f, 0.f};
  const u16* ub = UT + ((size_t)(c * 16 + l16)) * TPB + posoff + kg * 8;
  const u16* rsel = (l16 & 1) ? (R1 - 1) : R0;
  const int nb = L - (tt0 + l16) + kg * 8;
  for (int s0 = 0; s0 < L; s0 += 32) {
    const bf16x8 bfrag = *(const bf16x8*)(ub + s0);
#pragma unroll
    for (int i = 0; i < 4; ++i) {
      const u32* ap = (const u32*)(rsel + (nb - 16 * i + s0));
      union { u32 u[4]; bf16x8 v; } au;
      au.u[0] = ap[0]; au.u[1] = ap[1]; au.u[2] = ap[2]; au.u[3] = ap[3];
      acc[i] = __builtin_amdgcn_mfma_f32_16x16x32_bf16(au.v, bfrag, acc[i], 0, 0, 0);
    }
  }
  float ssq = 0.f;
  for (int t = 0; t < ntile; ++t) ssq += WSP(const float, OFF_PART)[(size_t)(f * 32 + t) * 256 + c];
  const float scale = rsqrtf(ssq + EPSF);
  const float bias = p.in[I_HYBIAS][l * 256 + c];
  const u16* X1C = WSP(const u16, OFF_X1C);
  u16* YM = WSP(u16, OFF_ACT);
  const int b = l16;
#pragma unroll
  for (int i = 0; i < 4; ++i)
#pragma unroll
    for (int r = 0; r < 4; ++r) {
      const int t = tt0 + 16 * i + kg * 4 + r;
      const size_t row = (size_t)b * TPB + posoff + t;
      const float u = bf2f(UT[((size_t)(c * 16 + b)) * TPB + posoff + t]);
      const float x1 = bf2f(X1C[row * 256 + c]);
      YM[row * 1024 + c] = f2bf(x1 * (scale * acc[i][r] + bias * u));
    }
}

DI void hyena_item_lat(const Params& p, int l, int it) {
  const int lane = TID() & 63, w = TID() >> 6;
  const int c = it >> 2, f = l, L = 2048, posoff = CTXL;
  const int tt0 = (it & 3) * 512 + w * 128;
  const u16* R0 = WSP(const u16, OFF_RF) + ((size_t)(f * 256 + c) * 2) * RSTR;
  const u16* R1 = R0 + RSTR;
  const u16* UT = WSP(const u16, OFF_UT);
  const int l16 = lane & 15, kg = lane >> 4;
  f32x4 acc[8];
#pragma unroll
  for (int i = 0; i < 8; ++i) acc[i] = (f32x4){0.f, 0.f, 0.f, 0.f};
  const u16* ub = UT + ((size_t)(c * 16 + l16)) * TPB + posoff + kg * 8;
  const u16* rsel = (l16 & 1) ? (R1 - 1) : R0;
  const int nb = L - (tt0 + l16) + kg * 8;
  union AF { u32 u[4]; bf16x8 v; };
  AF a[8];
#define HY_LOADA(dst, off) { const u32* ap_ = (const u32*)(rsel + (off)); dst.u[0] = ap_[0]; dst.u[1] = ap_[1]; dst.u[2] = ap_[2]; dst.u[3] = ap_[3]; }
#pragma unroll
  for (int i = 2; i < 8; ++i) HY_LOADA(a[i], nb - 16 * i)
#pragma unroll 1
  for (int sb = 0; sb < L; sb += 128) {
#pragma unroll
    for (int u = 0; u < 4; ++u) {
      const int s0 = sb + 32 * u;
      HY_LOADA(a[(0 - 2 * u) & 7], nb + s0)
      HY_LOADA(a[(1 - 2 * u) & 7], nb - 16 + s0)
      const bf16x8 bfrag = *(const bf16x8*)(ub + s0);
#pragma unroll
      for (int i = 0; i < 8; ++i) acc[i] = __builtin_amdgcn_mfma_f32_16x16x32_bf16(a[(i - 2 * u) & 7].v, bfrag, acc[i], 0, 0, 0);
    }
  }
#undef HY_LOADA
  float ssq = 0.f;
  for (int t = 0; t < 32; ++t) ssq += WSP(const float, OFF_PART)[(size_t)(f * 32 + t) * 256 + c];
  const float scale = rsqrtf(ssq + EPSF);
  const float bias = p.in[I_HYBIAS][l * 256 + c];
  const u16* X1C = WSP(const u16, OFF_X1C);
  u16* YM = WSP(u16, OFF_ACT);
  const int b = l16;
#pragma unroll
  for (int i = 0; i < 8; ++i)
#pragma unroll
    for (int r = 0; r < 4; ++r) {
      const int t = tt0 + 16 * i + kg * 4 + r;
      const size_t row = (size_t)b * TPB + posoff + t;
      const float uu = bf2f(UT[((size_t)(c * 16 + b)) * TPB + posoff + t]);
      const float x1 = bf2f(X1C[row * 256 + c]);
      YM[row * 1024 + c] = f2bf(x1 * (scale * acc[i][r] + bias * uu));
    }
}

DI void fnet_item(const Params& p, int it, char* smem) {
  const u16* PQT = WSP(const u16, OFF_PQT);
  u16* YM = WSP(u16, OFF_ACT);
  if (it < 256) {
    const int mt = it >> 5, nt = it & 31;
    const u16* A = WSP(const u16, OFF_DFT);
    auto af = [=](int m, int k) { return A + (size_t)m * 4096 + k; };
    auto bfn = [=](int n, int k) {
      const int b = n >> 8, n2 = n & 255, g = n2 >> 6, kk = n2 & 63, pq = k >> 11, t = k & 2047;
      return PQT + ((size_t)(b * 512 + g * 128 + pq * 64 + kk)) * TPB + CTXL + t;
    };
    auto ef = [=](int m, int n, float v0, float v1, float v2, float v3) {
      const int b = n >> 8, n2 = n & 255;
      const uint2 o = {pack2(v0, v1), pack2(v2, v3)};
      *(uint2*)&YM[((size_t)b * TPB + CTXL + m) * 1024 + 768 + n2] = o;
    };
    gemm_tile<true, 4>(af, bfn, ef, mt * 256, nt * 128, 4096, smem);
  } else {
    const int i2 = it - 256, mt = i2 >> 5, nt = i2 & 31;
    const u16* A = WSP(const u16, OFF_DFTC);
    auto af = [=](int m, int k) { return A + (size_t)m * 512 + k; };
    auto bfn = [=](int n, int k) {
      const int b = n >> 8, n2 = n & 255, g = n2 >> 6, kk = n2 & 63, pq = k >> 8, t = k & 255;
      return PQT + ((size_t)(b * 512 + g * 128 + pq * 64 + kk)) * TPB + t;
    };
    auto ef = [=](int m, int n, float v0, float v1, float v2, float v3) {
      const int b = n >> 8, n2 = n & 255;
      const uint2 o = {pack2(v0, v1), pack2(v2, v3)};
      *(uint2*)&YM[((size_t)b * TPB + m) * 1024 + 768 + n2] = o;
    };
    gemm_tile<true, 4>(af, bfn, ef, mt * 256, nt * 128, 512, smem);
  }
}

DI void phase_mixers(const Params& p, int l, int bid, int nblk, char* smem, int rep = 0) {
  for (int it = bid; it < 256; it += nblk) ssd_item(p, l, it, smem);
  const int nf = (l == 0) ? 288 : 256;
  const int nh = (l == 0) ? 1280 : 1024;
  int* ctr = WSP(int, OFF_CTR) + l + 2 * rep;
  int* sitem = (int*)(smem + LDS_BYTES - 16);
  for (;;) {
    if (TID() == 0) *sitem = atomicAdd(ctr, 1);
    __syncthreads();
    const int it = *sitem;
    __syncthreads();
    if (it >= nf + nh) break;
    if (it < nf) fnet_item(p, it, smem);
    else if (it - nf < 1024) hyena_item_lat(p, l, it - nf);
    else hyena_item(p, l, it - nf + 1024);
  }
}

DI void phase_ssd_combine(const Params& p, int l, int bid, int nblk) {
  const int lane = TID() & 63, w = TID() >> 6;
  const u16* YF = WSP(const u16, OFF_PXBC);
  const u16* YB = YF + (size_t)ROWS * 512;
  const u16* XBCA = WSP(const u16, OFF_XBCA);
  const u16* PZ = WSP(const u16, OFF_PZ);
  u16* YM = WSP(u16, OFF_ACT);
  const float* ng = p.in[I_SNG] + l * 512;
  const int c0 = lane * 8;
  const float dsk = p.in[I_SD][l * 8 + (c0 >> 6)];
  for (int row = bid * 4 + w; row < ROWS; row += nblk * 4) {
    const int pos = row % TPB;
    if (l == 1 && pos < CTXL) continue;
    const uint4 vf = *(const uint4*)(YF + (size_t)row * 512 + c0);
    const uint4 vb = *(const uint4*)(YB + (size_t)row * 512 + c0);
    const uint4 vx = *(const uint4*)(XBCA + (size_t)row * 1024 + c0);
    const uint4 vz = *(const uint4*)(PZ + (size_t)row * 512 + c0);
    const u32 af_[4] = {vf.x, vf.y, vf.z, vf.w}, ab_[4] = {vb.x, vb.y, vb.z, vb.w};
    const u32 ax_[4] = {vx.x, vx.y, vx.z, vx.w}, az_[4] = {vz.x, vz.y, vz.z, vz.w};
    float y[8];
    float ss = 0.f;
#pragma unroll
    for (int i = 0; i < 4; ++i) {
      const float y0 = bflo(af_[i]) + bflo(ab_[i]) + dsk * bflo(ax_[i]);
      const float y1 = bfhi(af_[i]) + bfhi(ab_[i]) + dsk * bfhi(ax_[i]);
      y[2 * i] = y0 * silu_f(bflo(az_[i]));
      y[2 * i + 1] = y1 * silu_f(bfhi(az_[i]));
      ss += y[2 * i] * y[2 * i] + y[2 * i + 1] * y[2 * i + 1];
    }
#pragma unroll
    for (int o = 16; o >= 1; o >>= 1) ss += __shfl_xor(ss, o);
    const float rs = rsqrtf(ss * (1.f / 256.f) + EPSF);
    float o8[8];
#pragma unroll
    for (int i = 0; i < 8; ++i) o8[i] = y[i] * rs * ng[c0 + i];
    uint4 o = {pack2(o8[0], o8[1]), pack2(o8[2], o8[3]), pack2(o8[4], o8[5]), pack2(o8[6], o8[7])};
    *(uint4*)&YM[(size_t)row * 1024 + 256 + c0] = o;
  }
}

DI void phase_outproj(const Params& p, int l, int bid, int nblk, char* smem) {
  const u16* A = WSP(const u16, OFF_ACT);
  const u16* B = WSP(const u16, OFF_WOUT) + (size_t)l * 1024 * 1024;
  const float* MOD = WSP(const float, OFF_MOD);
  const Params pp = p;
  auto af = [=](int m, int k) { return A + (size_t)m * 1024 + k; };
  auto bfn = [=](int n, int k) { return B + (size_t)n * 1024 + k; };
  auto ef = [=](int m, int n, float v0, float v1, float v2, float v3) {
    const int b = m / TPB, pos = m % TPB;
    const float4 ga = *(const float4*)&MOD[(size_t)(l * 17 + (pos < CTXL ? 16 : b)) * 6144 + 2048 + n];
    const float4 xo = *(const float4*)(xrow_ptr(pp, l == 0, b, pos) + n);
    const float4 o = {xo.x + ga.x * v0, xo.y + ga.y * v1, xo.z + ga.z * v2, xo.w + ga.w * v3};
    *(float4*)(xrow_wptr(pp, b, pos) + n) = o;
  };
  const int ntile = (ROWS / 128) * 8;
  const int vb = (nblk % 8 == 0) ? (bid & 7) * (nblk >> 3) + (bid >> 3) : bid;
  for (int t = vb; t < ntile; t += nblk) {
    const int mt = t >> 3, nt = t & 7;
    if (l == 1 && (mt % 18) < 2) continue;
    gemm_tile<true, 2>(af, bfn, ef, mt * 128, nt * 128, 1024, smem);
  }
}

DI void phase_q(const Params& p, int l, int bid, int nblk, char* smem) {
  const u16* A = WSP(const u16, OFF_ACT);
  const u16* B = WSP(const u16, OFF_WQ) + (size_t)l * 2048 * 1024;
  u16* Q = WSP(u16, OFF_Q);
  auto af = [=](int m, int k) { return A + (size_t)m * 1024 + k; };
  auto bfn = [=](int n, int k) { return B + (size_t)n * 1024 + k; };
  auto ef = [=](int m, int n, float v0, float v1, float v2, float v3) {
    const uint2 o = {pack2(v0, v1), pack2(v2, v3)};
    *(uint2*)&Q[(size_t)m * 2048 + n] = o;
  };
  const int ntile = (ROWS / 256) * 16;
  const int vb = (nblk % 8 == 0) ? (bid & 7) * (nblk >> 3) + (bid >> 3) : bid;
  for (int t = vb; t < ntile; t += nblk) {
    const int mt = t >> 4, nt = t & 15;
    if (l == 1 && (mt % 9) < 1) continue;
    gemm_tile<true, 4>(af, bfn, ef, mt * 256, nt * 128, 1024, smem);
  }
}

DI void phase_topk(const Params& p, int l, int bid, int nblk, char* smem) {
  const int tid = TID(), lane = tid & 63, w = tid >> 6, l32 = lane & 31, h = lane >> 5;
  u16* qs = (u16*)smem;
  float* sc = (float*)(smem + 64 * 136 * 2);
  const u16* Q = WSP(const u16, OFF_Q);
  float* TV = WSP(float, OFF_TV);
  int* TI = WSP(int, OFF_TI);
  for (int it = bid; it < (ROWS / 64) * 16; it += nblk) {
    const int hh = it & 15, rt = it >> 4;
    if (l == 1 && (rt % 36) < 4) continue;
    const int row0 = rt * 64;
#pragma unroll
    for (int i = 0; i < 4; ++i) {
      const int q = tid + 256 * i, r = q >> 4, ch = q & 15;
      *(uint4*)&qs[r * 136 + ch * 8] = *(const uint4*)&Q[(size_t)(row0 + r) * 2048 + hh * 128 + ch * 8];
    }
    __syncthreads();
    const u16* kb = WSP(const u16, OFF_K12) + (size_t)(l * 2 + (hh & 1)) * 16384;
    f32x16 acc[2];
#pragma unroll
    for (int i = 0; i < 2; ++i)
#pragma unroll
      for (int r = 0; r < 16; ++r) acc[i][r] = 0.f;
#pragma unroll
    for (int ks = 0; ks < 8; ++ks) {
      const bf16x8 bq = *(const bf16x8*)&kb[(w * 32 + l32) * 128 + ks * 16 + h * 8];
      const bf16x8 a0 = *(const bf16x8*)&qs[(l32) * 136 + ks * 16 + h * 8];
      const bf16x8 a1 = *(const bf16x8*)&qs[(32 + l32) * 136 + ks * 16 + h * 8];
      acc[0] = __builtin_amdgcn_mfma_f32_32x32x16_bf16(a0, bq, acc[0], 0, 0, 0);
      acc[1] = __builtin_amdgcn_mfma_f32_32x32x16_bf16(a1, bq, acc[1], 0, 0, 0);
    }
#pragma unroll
    for (int mt = 0; mt < 2; ++mt)
#pragma unroll
      for (int i = 0; i < 16; ++i) {
        const int r = mt * 32 + (i & 3) + 8 * (i >> 2) + 4 * h;
        sc[r * 133 + w * 33 + l32] = acc[mt][i];
      }
    __syncthreads();
    {
      const int r = tid >> 2, part = tid & 3;
      u32 key[32];
#pragma unroll
      for (int j = 0; j < 32; ++j) {
        const u32 u = __float_as_uint(sc[r * 133 + part * 33 + j]);
        const u32 ord = (u & 0x80000000u) ? ~u : (u | 0x80000000u);
        key[j] = (ord & ~127u) | (u32)(127 - (part * 32 + j));
      }
      float* tv = TV + ((size_t)(row0 + r) * 16 + hh) * 16;
      int* ti = TI + ((size_t)(row0 + r) * 16 + hh) * 16;
      u32 prev = 0xFFFFFFFFu;
#pragma unroll
      for (int rd = 0; rd < 16; ++rd) {
        u32 m = 0u;
#pragma unroll
        for (int j = 0; j < 32; ++j) { const u32 d = key[j] - prev; m = d > m ? d : m; }
        { const u32 o = (u32)__shfl_xor((int)m, 1); m = o > m ? o : m; }
        { const u32 o = (u32)__shfl_xor((int)m, 2); m = o > m ? o : m; }
        const u32 best = prev + m;
        prev = best;
        if (part == 0) {
          const u32 ordv = best & ~127u;
          const u32 uu = (ordv & 0x80000000u) ? (ordv & 0x7FFFFFFFu) : ~ordv;
          tv[rd] = __uint_as_float(uu);
          ti[rd] = 127 - (int)(best & 127u);
        }
      }
    }
    __syncthreads();
  }
}

DI int cand_a(int c) {
  const u32 T[7] = {0x00000000u, 0x00000000u, 0x11111111u, 0x33322222u, 0x66554443u, 0xDCBA9877u, 0x000000FEu};
  u32 wv = T[0];
#pragma unroll
  for (int s = 1; s < 7; ++s) wv = ((c >> 3) == s) ? T[s] : wv;
  return (int)((wv >> ((c & 7) * 4)) & 15u);
}
DI int cand_b(int c) {
  const u32 T[7] = {0x76543210u, 0xFEDCBA98u, 0x76543210u, 0x21043210u, 0x10102103u, 0x00000010u, 0x00000000u};
  u32 wv = T[0];
#pragma unroll
  for (int s = 1; s < 7; ++s) wv = ((c >> 3) == s) ? T[s] : wv;
  return (int)((wv >> ((c & 7) * 4)) & 15u);
}
DI void phase_peer(const Params& p, int l, int bid, int nblk) {
  const int w = TID() >> 6;
  const float* TV = WSP(const float, OFF_TV);
  const int* TI = WSP(const int, OFF_TI);
  const u16* H2 = WSP(const u16, OFF_ACT);
  const unsigned char* UB = WSP(const unsigned char, OFF_XBCA);
  const unsigned char* VB = UB + (size_t)16384 * 1024;
  const float* gfin = p.in[I_GF];
  for (int row = bid * 4 + w; row < ROWS; row += nblk * 4) {
    const int b = row / TPB, pos = row % TPB;
    if (l == 1 && pos < CTXL) continue;
    const int lane = TID() & 63;
    const int head = lane >> 3, sub = lane & 7;
    const float* tv1 = TV + ((size_t)row * 16 + head * 2) * 16;
    const float* tv2 = tv1 + 16;
    const int* ti1 = TI + ((size_t)row * 16 + head * 2) * 16;
    const int* ti2 = ti1 + 16;
    const int t1lo = ti1[sub], t1hi = ti1[sub + 8], t2lo = ti2[sub], t2hi = ti2[sub + 8];
    u32 ck[7];
#pragma unroll
    for (int s = 0; s < 7; ++s) {
      const int c = sub + 8 * s;
      if (c < 50) {
        const u32 u = __float_as_uint(tv1[cand_a(c)] + tv2[cand_b(c)]);
        const u32 ord = (u & 0x80000000u) ? ~u : (u | 0x80000000u);
        ck[s] = (ord & ~63u) | (u32)(63 - c);
      } else ck[s] = 0u;
    }
    float w0v = 0.f, w1v = 0.f, mx = 0.f;
    int w0c = 0, w1c = 0;
    u32 prevk = 0xFFFFFFFFu;
#pragma unroll
    for (int r = 0; r < 16; ++r) {
      u32 m = 0u;
#pragma unroll
      for (int s = 0; s < 7; ++s) { const u32 d = ck[s] - prevk; m = d > m ? d : m; }
      { const u32 ov = (u32)dpp_i<DPP_XOR1>((int)m); m = ov > m ? ov : m; }
      { const u32 ov = (u32)dpp_i<DPP_XOR2>((int)m); m = ov > m ? ov : m; }
      { const u32 ov = (u32)dpp_i<DPP_MIRROR8>((int)m); m = ov > m ? ov : m; }
      const u32 best = prevk + m;
      prevk = best;
      const u32 ordv = best & ~63u;
      const float bv = __uint_as_float((ordv & 0x80000000u) ? (ordv & 0x7FFFFFFFu) : ~ordv);
      const int bc = 63 - (int)(best & 63u);
      if (r == 0) mx = bv;
      if (sub == (r & 7)) {
        if (r < 8) { w0v = bv; w0c = bc; } else { w1v = bv; w1c = bc; }
      }
    }
    const float e0 = expf(w0v - mx), e1 = expf(w1v - mx);
    float es = e0 + e1;
    es += dpp_f<DPP_XOR1>(es);
    es += dpp_f<DPP_XOR2>(es);
    es += dpp_f<DPP_MIRROR8>(es);
    const float g0 = e0 / es, g1 = e1 / es;
    int idx0, idx1;
    {
      const int gb = lane & ~7;
      const int a0 = cand_a(w0c), c0 = cand_b(w0c), a1 = cand_a(w1c), c1 = cand_b(w1c);
      const int p0l = __shfl(t1lo, gb + (a0 & 7)), p0h = __shfl(t1hi, gb + (a0 & 7));
      const int q0l = __shfl(t2lo, gb + (c0 & 7)), q0h = __shfl(t2hi, gb + (c0 & 7));
      const int p1l = __shfl(t1lo, gb + (a1 & 7)), p1h = __shfl(t1hi, gb + (a1 & 7));
      const int q1l = __shfl(t2lo, gb + (c1 & 7)), q1h = __shfl(t2hi, gb + (c1 & 7));
      idx0 = ((a0 & 8) ? p0h : p0l) * 128 + ((c0 & 8) ? q0h : q0l);
      idx1 = ((a1 & 8) ? p1h : p1l) * 128 + ((c1 & 8) ? q1h : q1l);
    }
    const u16* hrow = H2 + (size_t)row * 1024;
    float hv[16];
    {
      const uint4 ha = *(const uint4*)(hrow + lane * 16), hb = *(const uint4*)(hrow + lane * 16 + 8);
      hv[0] = bflo(ha.x); hv[1] = bfhi(ha.x); hv[2] = bflo(ha.y); hv[3] = bfhi(ha.y);
      hv[4] = bflo(ha.z); hv[5] = bfhi(ha.z); hv[6] = bflo(ha.w); hv[7] = bfhi(ha.w);
      hv[8] = bflo(hb.x); hv[9] = bfhi(hb.x); hv[10] = bflo(hb.y); hv[11] = bfhi(hb.y);
      hv[12] = bflo(hb.z); hv[13] = bfhi(hb.z); hv[14] = bflo(hb.w); hv[15] = bfhi(hb.w);
    }
    float acc[16];
#pragma unroll 1
    for (int prep_ = 0; prep_ < PEER_REPS; ++prep_) {
    f32x2 hv2[8];
#pragma unroll
    for (int i = 0; i < 8; ++i) hv2[i] = (f32x2){hv[2 * i], hv[2 * i + 1]};
    const bool b0 = lane & 1, b1 = lane & 2, b2 = lane & 4;
    float act0 = 0.f, act1 = 0.f;
    u32x4 rb[2][8];
#define PEER_LOAD(buf, k, TAB)                                                                     \
  _Pragma("unroll") for (int j = 0; j < 8; ++j) {                                                  \
    const int e = (k) * 8 + j;                                                                     \
    const int id = __builtin_amdgcn_readlane(((k) < 8) ? idx0 : idx1, e & 63);                     \
    rb[buf][j] = *(const u32x4*)(TAB + (size_t)id * 1024 + lane * 16);                             \
  }
#define PEER_DOT(buf, k)                                                                           \
  {                                                                                                \
    float d[8];                                                                                    \
    _Pragma("unroll") for (int j = 0; j < 8; ++j) {                                                \
      const u32 uw[4] = {rb[buf][j][0], rb[buf][j][1], rb[buf][j][2], rb[buf][j][3]};              \
      f32x2 sa = {0.f, 0.f}, sb = {0.f, 0.f};                   \
      _Pragma("unroll") for (int q = 0; q < 4; ++q) {                                              \
        const f32x2 lo = __builtin_amdgcn_cvt_pk_f32_fp8((int)uw[q], false);                       \
        const f32x2 hi = __builtin_amdgcn_cvt_pk_f32_fp8((int)uw[q], true);                        \
        sa = __builtin_elementwise_fma(hv2[2 * q], lo, sa);                                        \
        sb = __builtin_elementwise_fma(hv2[2 * q + 1], hi, sb);                                    \
      }                                                                                            \
      sa += sb;                                                                                    \
      d[j] = sa.x + sa.y;                                                                          \
    }                                                                                              \
    float a4[4];                                                                                   \
    _Pragma("unroll") for (int q = 0; q < 4; ++q) {                                                \
      const float keep = b0 ? d[2 * q + 1] : d[2 * q], send = b0 ? d[2 * q] : d[2 * q + 1];        \
      a4[q] = keep + __shfl_xor(send, 1);                                                          \
    }                                                                                              \
    float a2[2];                                                                                   \
    _Pragma("unroll") for (int q = 0; q < 2; ++q) {                                                \
      const float keep = b1 ? a4[2 * q + 1] : a4[2 * q], send = b1 ? a4[2 * q] : a4[2 * q + 1];    \
      a2[q] = keep + __shfl_xor(send, 2);                                                          \
    }                                                                                              \
    const float keep = b2 ? a2[1] : a2[0], send = b2 ? a2[0] : a2[1];                              \
    float c1 = keep + __shfl_xor(send, 4);                                                         \
    c1 += __shfl_xor(c1, 8);                                                                       \
    c1 += __shfl_xor(c1, 16);                                                                      \
    c1 += __shfl_xor(c1, 32);                                                                      \
    if ((lane >> 3) == ((k) & 7)) { if ((k) < 8) act0 = c1; else act1 = c1; }                      \
  }
    PEER_LOAD(0, 0, UB)
#pragma unroll 1
    for (int k = 0; k < 16; k += 2) {
      PEER_LOAD(1, k + 1, UB)
      __builtin_amdgcn_sched_barrier(0);
      PEER_DOT(0, k)
      { const int kn = (k + 2 < 16) ? k + 2 : 15; PEER_LOAD(0, kn, UB) }
      __builtin_amdgcn_sched_barrier(0);
      PEER_DOT(1, k + 1)
    }
    const float ga0 = gelu_tanh(act0 * (1.f / U_SCALE)) * g0 * (1.f / V_SCALE);
    const float ga1 = gelu_tanh(act1 * (1.f / U_SCALE)) * g1 * (1.f / V_SCALE);
#pragma unroll
    for (int i = 0; i < 16; ++i) acc[i] = 0.f;
#define PEER_ACC(buf, k)                                                                           \
  _Pragma("unroll") for (int j = 0; j < 8; ++j) {                                                  \
    const int e = (k) * 8 + j;                                                                     \
    const int ai = __builtin_amdgcn_readlane(__builtin_bit_cast(int, ((k) < 8) ? ga0 : ga1), e & 63); \
    const float a = __builtin_bit_cast(float, ai);                                                 \
    const u32 vw[4] = {rb[buf][j][0], rb[buf][j][1], rb[buf][j][2], rb[buf][j][3]};                \
    _Pragma("unroll") for (int q = 0; q < 4; ++q) {                                                \
      const f32x2 lo = __builtin_amdgcn_cvt_pk_f32_fp8((int)vw[q], false);                         \
      const f32x2 hi = __builtin_amdgcn_cvt_pk_f32_fp8((int)vw[q], true);                          \
      acc[q * 4 + 0] += a * lo.x; acc[q * 4 + 1] += a * lo.y; acc[q * 4 + 2] += a * hi.x; acc[q * 4 + 3] += a * hi.y; \
    }                                                                                              \
  }
    PEER_LOAD(0, 0, VB)
#pragma unroll 1
    for (int k = 0; k < 16; k += 2) {
      PEER_LOAD(1, k + 1, VB)
      __builtin_amdgcn_sched_barrier(0);
      PEER_ACC(0, k)
      { const int kn = (k + 2 < 16) ? k + 2 : 15; PEER_LOAD(0, kn, VB) }
      __builtin_amdgcn_sched_barrier(0);
      PEER_ACC(1, k + 1)
    }
#undef PEER_LOAD
#undef PEER_DOT
#undef PEER_ACC
      if (prep_ + 1 < PEER_REPS) { _Pragma("unroll") for (int i = 0; i < 16; ++i) asm volatile("" :: "v"(acc[i])); }
    }
    int row2 = row;
    asm volatile("" : "+v"(row2));
    const int lane2 = TID() & 63;
    const int b2 = row2 / TPB, pos2 = row2 % TPB;
    const float* xr = xrow_ptr(p, false, b2, pos2);
    float* xw = xrow_wptr(p, b2, pos2);
    const float* ga = WSP(const float, OFF_MOD) + (size_t)(l * 17 + (pos2 < CTXL ? 16 : b2)) * 6144 + 5120;
    float xn[16];
    float ss = 0.f;
#pragma unroll
    for (int q = 0; q < 4; ++q) {
      const float4 xv = *(const float4*)(xr + lane2 * 16 + q * 4);
      const float4 gv = *(const float4*)(ga + lane2 * 16 + q * 4);
      xn[q * 4 + 0] = xv.x + gv.x * acc[q * 4 + 0];
      xn[q * 4 + 1] = xv.y + gv.y * acc[q * 4 + 1];
      xn[q * 4 + 2] = xv.z + gv.z * acc[q * 4 + 2];
      xn[q * 4 + 3] = xv.w + gv.w * acc[q * 4 + 3];
    }
    if (l == 1) {
#pragma unroll
      for (int i = 0; i < 16; ++i) ss += xn[i] * xn[i];
      ss = wave_sum(ss);
      const float rs = rsqrtf(ss * (1.f / 1024.f) + EPSF);
#pragma unroll
      for (int i = 0; i < 16; ++i) xn[i] = xn[i] * rs * gfin[lane2 * 16 + i];
    }
#pragma unroll
    for (int q = 0; q < 4; ++q) {
      float4 o = {xn[q * 4 + 0], xn[q * 4 + 1], xn[q * 4 + 2], xn[q * 4 + 3]};
      *(float4*)(xw + lane2 * 16 + q * 4) = o;
    }
  }
}

template <int S>
DI void run_stage(const Params& p, int l, int bid, int nblk, char* smem) {
  for (int rep = 0; rep < 1 + ((REP_MASK >> (S + 1)) & 1); ++rep) {
  if (S == 0) { if (PH_MASK & 2) phase_norm(p, l, 0, bid, nblk); }
  else if (S == 1) { if (PH_MASK & 4) phase_inproj(p, l, bid, nblk, smem); }
  else if (S == 2) { if (PH_MASK & 8) phase_prep(p, l, bid, nblk, smem); }
  else if (S == 3) { if (PH_MASK & 16) phase_mixers(p, l, bid, nblk, smem, rep); }
  else if (S == 4) { if (PH_MASK & 32) phase_ssd_combine(p, l, bid, nblk); }
  else if (S == 5) { if (PH_MASK & 64) phase_outproj(p, l, bid, nblk, smem); }
  else if (S == 6) { if (PH_MASK & 128) { phase_norm(p, l, 1, bid, nblk); phase_tables(p, l, bid, nblk); } }
  else if (S == 7) { if (PH_MASK & 256) phase_q(p, l, bid, nblk, smem); }
  else if (S == 8) { if (PH_MASK & 512) phase_topk(p, l, bid, nblk, smem); }
  else { if (PH_MASK & 1024) phase_peer(p, l, bid, nblk); }
  }
}

#if ONE_LAUNCH
__global__ void __launch_bounds__(NTHR, 2) mega(Params p) {
  extern __shared__ __attribute__((aligned(16))) char smem[];
  const int bid = blockIdx.x, nblk = gridDim.x;
  cg::grid_group grid = cg::this_grid();
  volatile LAS unsigned* bst = (volatile LAS unsigned*)(smem + LDS_BYTES - 32);
  if (threadIdx.x == 0) { bst[0] = 0u; bst[1] = 0u; }
  __syncthreads();
  const XcdBarrier bar = xcd_barrier_post(WSP(unsigned, OFF_BAR), bst);
  for (int rep = 0; rep < 1 + (REP_MASK & 1); ++rep) { if (PH_MASK & 1) phase_prologue(p, bid, nblk, smem); }
  grid.sync();
#define GBAR() xcd_barrier(bar)
#pragma nounroll
  for (int l = 0; l < 2; ++l) {
    for (int xs = 0; xs < EXTRA_SYNCS; ++xs) GBAR();
    run_stage<0>(p, l, bid, nblk, smem); GBAR();
    run_stage<1>(p, l, bid, nblk, smem); GBAR();
    run_stage<2>(p, l, bid, nblk, smem); GBAR();
    run_stage<3>(p, l, bid, nblk, smem); GBAR();
    run_stage<4>(p, l, bid, nblk, smem); GBAR();
    run_stage<5>(p, l, bid, nblk, smem); GBAR();
    run_stage<6>(p, l, bid, nblk, smem); GBAR();
    run_stage<7>(p, l, bid, nblk, smem); GBAR();
    run_stage<8>(p, l, bid, nblk, smem); GBAR();
    run_stage<9>(p, l, bid, nblk, smem);
    if (l == 0) GBAR();
  }
}
#else
template <int S>
__global__ void __launch_bounds__(NTHR, 2) stage_kernel(Params p, int l) {
  extern __shared__ __attribute__((aligned(16))) char smem[];
  if (S < 0) phase_prologue(p, blockIdx.x, gridDim.x, smem);
  else run_stage<(S < 0 ? 0 : S)>(p, l, blockIdx.x, gridDim.x, smem);
}

template <int S>
static void launch_stage(const Params& p, int l, int grid, hipStream_t stream) {
  (void)hipFuncSetAttribute((const void*)stage_kernel<S>, hipFuncAttributeMaxDynamicSharedMemorySize, LDS_BYTES);
  hipLaunchKernelGGL(stage_kernel<S>, dim3(grid), dim3(NTHR), LDS_BYTES, stream, p, l);
}

#endif

extern "C" void kernel_launch(void* const* d_in, const int* in_sizes, int n_in, void* d_out, int out_size, void* d_ws,
                              size_t ws_size, hipStream_t stream) {
  static int grid = 0;
  if (grid == 0) {
    if (ws_size < WS_END || n_in != 31) { fprintf(stderr, "kernel_launch: ws %zu < %zu or n_in %d\n", ws_size, (size_t)WS_END, n_in); grid = -1; return; }
    int dev = 0, cus = 0, per_cu = 0;
    (void)hipGetDevice(&dev);
    (void)hipDeviceGetAttribute(&cus, hipDeviceAttributeMultiprocessorCount, dev);
#if ONE_LAUNCH
    (void)hipFuncSetAttribute((const void*)mega, hipFuncAttributeMaxDynamicSharedMemorySize, LDS_BYTES);
    (void)hipOccupancyMaxActiveBlocksPerMultiprocessor(&per_cu, (const void*)mega, NTHR, LDS_BYTES);
#else
    (void)hipFuncSetAttribute((const void*)stage_kernel<3>, hipFuncAttributeMaxDynamicSharedMemorySize, LDS_BYTES);
    (void)hipOccupancyMaxActiveBlocksPerMultiprocessor(&per_cu, (const void*)stage_kernel<3>, NTHR, LDS_BYTES);
#endif
    if (per_cu < 1) per_cu = 1;
    if (per_cu > 2) per_cu = 2;
    grid = cus * per_cu;
  }
  if (grid < 0) return;
  (void)hipMemsetAsync((char*)d_ws + OFF_CTR, 0, 256 + 3456 * 4, stream);
  Params p{};
  for (int i = 0; i < 31; ++i) p.in[i] = (const float*)d_in[i];
  p.out = (float*)d_out;
  p.ws = (unsigned char*)d_ws;
#if ONE_LAUNCH
  void* args[] = {&p};
  hipError_t e = hipLaunchCooperativeKernel((const void*)mega, dim3(grid), dim3(NTHR), args, LDS_BYTES, stream);
  if (e != hipSuccess) fprintf(stderr, "cooperative launch failed: %s (grid %d)\n", hipGetErrorString(e), grid);
#else
  launch_stage<-1>(p, 0, grid, stream);
  for (int l = 0; l < 2; ++l) {
    launch_stage<0>(p, l, grid, stream);
    launch_stage<1>(p, l, grid, stream);
    launch_stage<2>(p, l, grid, stream);
    launch_stage<3>(p, l, grid, stream);
    launch_stage<4>(p, l, grid, stream);
    launch_stage<5>(p, l, grid, stream);
    launch_stage<6>(p, l, grid, stream);
    launch_stage<7>(p, l, grid, stream);
    launch_stage<8>(p, l, grid, stream);
    launch_stage<9>(p, l, grid, stream);
  }
#endif
}
```

```cpp
#include <hip/hip_runtime.h>
#include <hip/hip_cooperative_groups.h>
#include <cstdio>
namespace cg = cooperative_groups;

#ifndef PH_MASK
#define PH_MASK 0xFFFF
#endif
#ifndef PEER_REPS
#define PEER_REPS 1
#endif
#ifndef EXTRA_SYNCS
#define EXTRA_SYNCS 0
#endif
#ifndef REP_MASK
#define REP_MASK 0
#endif
#ifndef ONE_LAUNCH
#define ONE_LAUNCH 1
#endif

typedef unsigned short u16;
typedef unsigned int u32;
typedef __attribute__((ext_vector_type(8))) short bf16x8;
typedef __attribute__((ext_vector_type(16))) float f32x16;
typedef __attribute__((ext_vector_type(4))) float f32x4;
typedef __attribute__((ext_vector_type(2))) float f32x2;
typedef __attribute__((ext_vector_type(4))) unsigned int u32x4;
#define DI __device__ __forceinline__
DI int TID() { int t = threadIdx.x; asm volatile("" : "+v"(t)); return t; }

DI u16 f2bf(float x) { u32 u = __float_as_uint(x); u += 0x7fffu + ((u >> 16) & 1u); return (u16)(u >> 16); }
DI float bf2f(u16 v) { return __uint_as_float(((u32)v) << 16); }
DI u32 pack2(float a, float b) { return (u32)f2bf(a) | ((u32)f2bf(b) << 16); }
DI float bflo(u32 v) { return __uint_as_float(v << 16); }
DI float bfhi(u32 v) { return __uint_as_float(v & 0xffff0000u); }

constexpr int D = 1024, NB = 16, SEQ = 2048, CTXL = 256, TPB = 2304, ROWS = NB * TPB;
constexpr int NIN = 2944;
constexpr int RSTR = 4112;
constexpr int NTHR = 256;
constexpr int LDS_BYTES = 73728;
constexpr float EPSF = 1e-6f;

constexpr size_t SZ_PHY = (size_t)ROWS * 768 * 2, SZ_PZ = (size_t)ROWS * 512 * 2, SZ_PXBC = (size_t)ROWS * 1024 * 2;
constexpr size_t OFF_PHY = 0;
constexpr size_t OFF_PZ = OFF_PHY + SZ_PHY;
constexpr size_t OFF_PXBC = OFF_PZ + SZ_PZ;
constexpr size_t OFF_Q = OFF_PHY;
constexpr size_t OFF_ACT = OFF_PXBC + SZ_PXBC;
constexpr size_t OFF_XBCA = OFF_ACT + (size_t)ROWS * 1024 * 2;
constexpr size_t OFF_DREG = OFF_XBCA + (size_t)ROWS * 1024 * 2;
constexpr size_t OFF_PQT = OFF_DREG;
constexpr size_t OFF_UT = OFF_PQT + (size_t)NB * 512 * TPB * 2;
constexpr size_t OFF_X1C = OFF_UT + (size_t)256 * 16 * TPB * 2;
constexpr size_t OFF_TV = OFF_DREG;
constexpr size_t OFF_TI = OFF_TV + (size_t)ROWS * 256 * 4;
constexpr size_t OFF_XC = OFF_DREG + (size_t)ROWS * 256 * 8;
constexpr size_t OFF_WIN = OFF_XC + (size_t)NB * CTXL * D * 4;
constexpr size_t OFF_WOUT = OFF_WIN + (size_t)2 * NIN * 1024 * 2;
constexpr size_t OFF_WQ = OFF_WOUT + (size_t)2 * 1024 * 1024 * 2;
constexpr size_t OFF_K12 = OFF_WQ + (size_t)2 * 2048 * 1024 * 2;
constexpr size_t OFF_DFT = OFF_K12 + (size_t)2 * 2 * 128 * 128 * 2;
constexpr size_t OFF_DFTC = OFF_DFT + (size_t)2048 * 4096 * 2;
constexpr size_t OFF_RF = OFF_DFTC + (size_t)256 * 512 * 2;
constexpr size_t OFF_PART = OFF_RF + (size_t)3 * 256 * 2 * RSTR * 2;
constexpr size_t OFF_MOD = OFF_PART + (size_t)3 * 32 * 256 * 4;
constexpr size_t OFF_DT = OFF_MOD + (size_t)2 * 17 * 6144 * 4;
constexpr size_t OFF_CTR = OFF_DT + (size_t)ROWS * 16 * 4;
constexpr size_t OFF_BAR = OFF_CTR + 256;
constexpr size_t OFF_TX = OFF_BAR + 3456 * 4;
constexpr size_t WS_END = OFF_TX + (size_t)NB * 768 * TPB * 2;

struct Params {
  const float* in[31];
  float* out;
  unsigned char* ws;
  int pad0, pad1;
};

enum { I_X = 0, I_C, I_CTX, I_CCTX, I_WADA, I_BADA, I_G1, I_G2, I_WIN, I_HYCW, I_HYCB, I_HFW1, I_HFB1, I_HFW2, I_HFB2,
       I_HFW3, I_HFFREQ, I_HYBIAS, I_SCW, I_SCB, I_SDTB, I_SALOG, I_SD, I_SNG, I_WOUT, I_WQ, I_K1, I_K2, I_PU, I_PV, I_GF };

__device__ const unsigned char CAND_A[56] = {0, 0, 0, 0, 0, 0, 0, 0, 0, 0, 0, 0, 0, 0, 0, 0, 1, 1, 1, 1, 1, 1, 1, 1, 2, 2, 2, 2, 2, 3, 3, 3, 3, 4, 4, 4, 5, 5, 6, 6, 7, 7, 8, 9, 10, 11, 12, 13, 14, 15, 0, 0, 0, 0, 0, 0};
__device__ const unsigned char CAND_B[56] = {0, 1, 2, 3, 4, 5, 6, 7, 8, 9, 10, 11, 12, 13, 14, 15, 0, 1, 2, 3, 4, 5, 6, 7, 0, 1, 2, 3, 4, 0, 1, 2, 3, 0, 1, 2, 0, 1, 0, 1, 0, 1, 0, 0, 0, 0, 0, 0, 0, 0, 0, 0, 0, 0, 0, 0};

#define WSP(T, off) ((T*)(p.ws + (off)))

#define XB_TMO      128
#define XB_XCNT(j)  (256  + 64 * (j))
#define XB_XSUB(j)  (1280 + 64 * (j))
#define XB_XGEN(j)  (2304 + 64 * (j))
#define XB_TOP      3328
#define XB_TOPGEN   3392
#define XCD_BAR_WORDS 3456
#define XB_SPIN_CAP (1u << 18)
#define LAS __attribute__((address_space(3)))
DI unsigned xb_ld(unsigned* p) { return __hip_atomic_load(p, __ATOMIC_RELAXED, __HIP_MEMORY_SCOPE_AGENT); }
DI unsigned xb_add(unsigned* p, unsigned v) { return __hip_atomic_fetch_add(p, v, __ATOMIC_RELAXED, __HIP_MEMORY_SCOPE_AGENT); }
DI unsigned xb_xcc_id() { return (unsigned)__builtin_amdgcn_s_getreg((3 << 11) | 20) & 0xFu; }
#define XB_SPIN(cond, bar) do { unsigned _sp = 0; while (cond) { __builtin_amdgcn_s_sleep(1); \
    if ((++_sp & 255u) == 0u) { if (xb_ld(&(bar)[XB_TMO])) break; if (_sp > XB_SPIN_CAP) { atomicAdd(&(bar)[XB_TMO], 1u); break; } } } } while (0)
struct XcdBarrier { unsigned* bar; unsigned x; volatile LAS unsigned* st; };
DI XcdBarrier xcd_barrier_post(unsigned* bar, volatile LAS unsigned* st) {
  XcdBarrier b; b.bar = bar; b.x = xb_xcc_id(); b.st = st;
  if (threadIdx.x == 0) (void)xb_add(&bar[XB_XCNT(b.x)], 1u);
  return b;
}
DI void xcd_barrier_complete(unsigned* bar, unsigned x, unsigned& nloc, unsigned& nx) {
  const unsigned G = gridDim.x * gridDim.y * gridDim.z;
  unsigned sum, cnt, mine, sp = 0u;
  for (;;) {
    sum = 0u; cnt = 0u; mine = 0u;
#pragma unroll
    for (unsigned j = 0; j < 16; ++j) { const unsigned c = xb_ld(&bar[XB_XCNT(j)]); sum += c; cnt += (c > 0u) ? 1u : 0u; mine = (j == x) ? c : mine; }
    if (sum == G) break;
    __builtin_amdgcn_s_sleep(1);
    if ((++sp & 255u) == 0u) { if (xb_ld(&bar[XB_TMO])) break; if (sp > XB_SPIN_CAP) { atomicAdd(&bar[XB_TMO], 1u); break; } }
  }
  nloc = mine > 0u ? mine : 1u; nx = cnt > 0u ? cnt : 1u;
}
DI void xcd_barrier(const XcdBarrier& b) {
  asm volatile("s_waitcnt vmcnt(0)" ::: "memory");
  __syncthreads();
  if (threadIdx.x == 0) {
    unsigned* bar = b.bar;
    __builtin_amdgcn_s_waitcnt(0);
    unsigned nloc = b.st[0], nx = b.st[1];
    if (nloc == 0u) { xcd_barrier_complete(bar, b.x, nloc, nx); b.st[0] = nloc; b.st[1] = nx; }
    const unsigned old = xb_add(&bar[XB_XSUB(b.x)], 1u);
    const unsigned gen = old / nloc;
    if (old + 1u == (gen + 1u) * nloc) {
      __builtin_amdgcn_fence(__ATOMIC_RELEASE, "agent");
      asm volatile("s_waitcnt vmcnt(0)" ::: "memory");
      const unsigned og = xb_add(&bar[XB_TOP], 1u);
      const unsigned tg = og / nx;
      if (og + 1u == (tg + 1u) * nx) xb_add(&bar[XB_TOPGEN], 1u);
      else XB_SPIN(xb_ld(&bar[XB_TOPGEN]) == tg, bar);
      __builtin_amdgcn_fence(__ATOMIC_ACQUIRE, "agent");
      xb_add(&bar[XB_XGEN(b.x)], 1u);
      asm volatile("s_waitcnt vmcnt(0)" ::: "memory");
    } else {
      XB_SPIN(xb_ld(&bar[XB_XGEN(b.x)]) == gen, bar);
      __builtin_amdgcn_fence(__ATOMIC_ACQUIRE, "agent");
      asm volatile("s_waitcnt vmcnt(0)" ::: "memory");
    }
  }
  __syncthreads();
}


template <bool SWAP, int MI, class AF, class BF, class EF>
DI void gemm_tile(const AF& af, const BF& bfn, const EF& ef, int m0, int n0, int K, char* smem) {
  constexpr int AROWS = MI * 64;
  u16* As = (u16*)smem;
  u16* Bs = As + 2 * AROWS * 40;
  const int tid = TID(), lane = tid & 63, w = tid >> 6;
  const int wm = w >> 1, wn = w & 1, l32 = lane & 31, h = lane >> 5;
  const int lrow = (tid >> 6) * 16 + ((tid >> 5) & 1) * 8 + ((tid >> 2) & 1) * 4 + ((tid >> 3) & 3), lk = (tid & 3) * 8;
  f32x16 acc[MI][2];
#pragma unroll
  for (int i = 0; i < MI; ++i)
#pragma unroll
    for (int j = 0; j < 2; ++j)
#pragma unroll
      for (int r = 0; r < 16; ++r) acc[i][j][r] = 0.f;
  u32x4 ra[MI], rb[2];
  const int nk = K >> 5;
#pragma unroll
  for (int i = 0; i < MI; ++i) ra[i] = *(const u32x4*)af(m0 + lrow + 64 * i, lk);
#pragma unroll
  for (int i = 0; i < 2; ++i) rb[i] = *(const u32x4*)bfn(n0 + lrow + 64 * i, lk);
#pragma unroll
  for (int i = 0; i < MI; ++i) *(u32x4*)&As[(lrow + 64 * i) * 40 + lk] = ra[i];
#pragma unroll
  for (int i = 0; i < 2; ++i) *(u32x4*)&Bs[(lrow + 64 * i) * 40 + lk] = rb[i];
  {
    const int k1 = (nk > 1) ? 32 + lk : lk;
#pragma unroll
    for (int i = 0; i < MI; ++i) ra[i] = *(const u32x4*)af(m0 + lrow + 64 * i, k1);
#pragma unroll
    for (int i = 0; i < 2; ++i) rb[i] = *(const u32x4*)bfn(n0 + lrow + 64 * i, k1);
  }
  __syncthreads();
  for (int kt = 0; kt < nk; ++kt) {
    const int cur = kt & 1;
    const u16* Ab = As + cur * AROWS * 40;
    const u16* Bb = Bs + cur * 128 * 40;
#pragma unroll
    for (int ks = 0; ks < 2; ++ks) {
      bf16x8 a[MI], b[2];
#pragma unroll
      for (int i = 0; i < MI; ++i) a[i] = *(const bf16x8*)&Ab[(wm * (MI * 32) + i * 32 + l32) * 40 + ks * 16 + h * 8];
#pragma unroll
      for (int i = 0; i < 2; ++i) b[i] = *(const bf16x8*)&Bb[(wn * 64 + i * 32 + l32) * 40 + ks * 16 + h * 8];
#pragma unroll
      for (int i = 0; i < MI; ++i)
#pragma unroll
        for (int j = 0; j < 2; ++j)
          acc[i][j] = SWAP ? __builtin_amdgcn_mfma_f32_32x32x16_bf16(b[j], a[i], acc[i][j], 0, 0, 0)
                           : __builtin_amdgcn_mfma_f32_32x32x16_bf16(a[i], b[j], acc[i][j], 0, 0, 0);
    }
    {
      u16* An = As + (cur ^ 1) * AROWS * 40;
      u16* Bn = Bs + (cur ^ 1) * 128 * 40;
#pragma unroll
      for (int i = 0; i < MI; ++i) *(u32x4*)&An[(lrow + 64 * i) * 40 + lk] = ra[i];
#pragma unroll
      for (int i = 0; i < 2; ++i) *(u32x4*)&Bn[(lrow + 64 * i) * 40 + lk] = rb[i];
      const int kn = (kt + 2 < nk) ? kt + 2 : nk - 1;
      const int k0 = kn * 32 + lk;
#pragma unroll
      for (int i = 0; i < MI; ++i) ra[i] = *(const u32x4*)af(m0 + lrow + 64 * i, k0);
#pragma unroll
      for (int i = 0; i < 2; ++i) rb[i] = *(const u32x4*)bfn(n0 + lrow + 64 * i, k0);
    }
    __syncthreads();
  }
#pragma unroll
  for (int i = 0; i < MI; ++i)
#pragma unroll
    for (int j = 0; j < 2; ++j)
#pragma unroll
      for (int rg = 0; rg < 4; ++rg) {
        const int m = SWAP ? (m0 + wm * (MI * 32) + i * 32 + l32) : (m0 + wm * (MI * 32) + i * 32 + rg * 8 + h * 4);
        const int n = SWAP ? (n0 + wn * 64 + j * 32 + rg * 8 + h * 4) : (n0 + wn * 64 + j * 32 + l32);
        ef(m, n, acc[i][j][rg * 4 + 0], acc[i][j][rg * 4 + 1], acc[i][j][rg * 4 + 2], acc[i][j][rg * 4 + 3]);
      }
}

template <int CTRL> DI int dpp_i(int v) { return __builtin_amdgcn_mov_dpp(v, CTRL, 0xF, 0xF, true); }
template <int CTRL> DI float dpp_f(float v) { return __builtin_bit_cast(float, __builtin_amdgcn_mov_dpp(__builtin_bit_cast(int, v), CTRL, 0xF, 0xF, true)); }
#define DPP_XOR1 0xB1
#define DPP_XOR2 0x4E
#define DPP_MIRROR8 0x141
DI float wave_sum(float v) {
#pragma unroll
  for (int o = 32; o >= 1; o >>= 1) v += __shfl_xor(v, o);
  return v;
}
DI float silu_f(float x) { return x / (1.f + __expf(-x)); }
DI float gelu_tanh(float x) {
  const float u = 0.7978845608028654f * (x + 0.044715f * x * x * x);
  return 0.5f * x * (1.f + tanhf(u));
}

DI const float* xrow_ptr(const Params& p, bool from_input, int b, int pos) {
  if (pos < CTXL) return (from_input ? p.in[I_CTX] : WSP(const float, OFF_XC)) + ((size_t)b * CTXL + pos) * D;
  return (from_input ? p.in[I_X] : (const float*)p.out) + ((size_t)b * SEQ + (pos - CTXL)) * D;
}
DI float* xrow_wptr(const Params& p, int b, int pos) {
  if (pos < CTXL) return WSP(float, OFF_XC) + ((size_t)b * CTXL + pos) * D;
  return p.out + ((size_t)b * SEQ + (pos - CTXL)) * D;
}

DI void phase_prologue(const Params& p, int bid, int nblk, char* smem) {
  const int tid = TID();
  const int gtid = bid * NTHR + tid, gn = nblk * NTHR;
  {
    float* scs = (float*)smem;
    for (int it = bid; it < 192; it += nblk) {
      const int l = it / 96, col0 = (it % 96) * 64;
      for (int e = tid; e < 17 * 1024; e += NTHR) {
        const int j = e >> 10, k = e & 1023;
        const float v = (j < 16) ? p.in[I_C][j * 1024 + k] : p.in[I_CCTX][k];
        scs[e] = v / (1.f + expf(-v));
      }
      __syncthreads();
      const int col = tid & 63, kq = tid >> 6;
      float acc[17];
#pragma unroll
      for (int j = 0; j < 17; ++j) acc[j] = 0.f;
      const float* wa = p.in[I_WADA] + (size_t)l * 1024 * 6144 + col0 + col;
      for (int k0 = kq * 256; k0 < kq * 256 + 256; k0 += 8) {
        float wv[8];
#pragma unroll
        for (int kk = 0; kk < 8; ++kk) wv[kk] = wa[(size_t)(k0 + kk) * 6144];
#pragma unroll
        for (int kk = 0; kk < 8; ++kk)
#pragma unroll
          for (int j = 0; j < 17; ++j) acc[j] += scs[j * 1024 + k0 + kk] * wv[kk];
      }
      __syncthreads();
#pragma unroll
      for (int j = 0; j < 17; ++j) scs[(kq * 17 + j) * 64 + col] = acc[j];
      __syncthreads();
      for (int e = tid; e < 17 * 64; e += NTHR) {
        const int j = e >> 6, cc = e & 63;
        float s = p.in[I_BADA][l * 6144 + col0 + cc];
#pragma unroll
        for (int q = 0; q < 4; ++q) s += scs[(q * 17 + j) * 64 + cc];
        WSP(float, OFF_MOD)[(size_t)(l * 17 + j) * 6144 + col0 + cc] = s;
      }
      __syncthreads();
    }
  }
  {
    float* zs = (float*)smem;
    float* h1s = zs + 64 * 33;
    float* h2s = h1s + 64 * 64;
    for (int it = (nblk >= 260 ? (bid >= 192 ? bid - 192 : 1 << 20) : bid); it < 68; it += nblk) {
      const int f = it < 32 ? 0 : (it < 64 ? 1 : 2);
      const int tile = it - (f == 0 ? 0 : (f == 1 ? 32 : 64));
      const int L = (f == 2) ? 256 : 2048;
      const int lyr = (f == 1) ? 1 : 0;
      const int pos0 = tile * 64;
      const float* w1 = p.in[I_HFW1] + lyr * 33 * 64;
      const float* b1 = p.in[I_HFB1] + lyr * 64;
      const float* w2 = p.in[I_HFW2] + lyr * 64 * 64;
      const float* b2 = p.in[I_HFB2] + lyr * 64;
      const float* w3 = p.in[I_HFW3] + lyr * 64 * 512;
      const float* fq = p.in[I_HFFREQ] + lyr * 64;
      for (int e = tid; e < 64 * 33; e += NTHR) {
        const int pi = e / 33, q = e % 33;
        const int pos = pos0 + pi;
        const float tt = (float)pos / (float)(L - 1);
        const float wv = 6.283185307179586f * (float)pos / (float)L;
        float z;
        if (q == 0) z = tt;
        else if (q <= 16) { const float fi = 1e-4f + (float)(q - 1) * ((15.f - 1e-4f) / 15.f); z = cosf(fi * wv); }
        else { const float fi = 1e-4f + (float)(q - 17) * ((15.f - 1e-4f) / 15.f); z = -sinf(fi * wv); }
        zs[e] = z;
      }
      __syncthreads();
      for (int e = tid; e < 64 * 64; e += NTHR) {
        const int pi = e >> 6, j = e & 63;
        float s = b1[j];
        for (int q = 0; q < 33; ++q) s += zs[pi * 33 + q] * w1[q * 64 + j];
        h1s[e] = sinf(fq[j] * s);
      }
      __syncthreads();
      for (int e = tid; e < 64 * 64; e += NTHR) {
        const int pi = e >> 6, j = e & 63;
        float s = b2[j];
        for (int k = 0; k < 64; ++k) s += h1s[pi * 64 + k] * w2[k * 64 + j];
        h2s[e] = sinf(fq[j] * s);
      }
      __syncthreads();
      {
        const int c = tid;
        const float mind = logf(1e-2f) / 1.5f, maxd = logf(1e-2f) / 0.3f;
        const float delta = fabsf(mind + (float)c * ((maxd - mind) / 255.f));
        u16* R0 = WSP(u16, OFF_RF) + ((size_t)(f * 256 + c) * 2 + 0) * RSTR;
        u16* R1 = R0 + RSTR;
        float ssq = 0.f;
        for (int pb = 0; pb < 4; ++pb) {
          float af_[16], ab_[16];
#pragma unroll
          for (int i = 0; i < 16; ++i) { af_[i] = 0.f; ab_[i] = 0.f; }
          for (int k = 0; k < 64; ++k) {
            const float wf = w3[k * 512 + c], wb = w3[k * 512 + 256 + c];
#pragma unroll
            for (int i = 0; i < 16; ++i) {
              const float hv = h2s[(pb * 16 + i) * 64 + k];
              af_[i] += hv * wf;
              ab_[i] += hv * wb;
            }
          }
#pragma unroll
          for (int i = 0; i < 16; ++i) {
            const int pos = pos0 + pb * 16 + i;
            const float tt = (float)pos / (float)(L - 1);
            const float win = expf(-tt * delta);
            const float vf = af_[i] * win, vb = ab_[i] * win;
            const u16 bfv = f2bf(vf), bbv = f2bf(vb);
            R0[L - pos] = bfv;
            R1[L - pos - 1] = bfv;
            ssq += vf * vf;
            if (pos >= 1) {
              R0[L + pos] = bbv;
              R1[L + pos - 1] = bbv;
              ssq += vb * vb;
            }
          }
        }
        WSP(float, OFF_PART)[(size_t)(f * 32 + tile) * 256 + c] = ssq;
      }
      __syncthreads();
    }
  }
  for (int e = gtid; e < 2 * NIN * 128; e += gn) {
    const int l = e / (NIN * 128);
    const int r = e % (NIN * 128);
    const int kc = r / NIN, n = r % NIN;
    const int k0 = kc * 8;
    const float* wsrc = p.in[I_WIN] + (size_t)l * 1024 * 2576;
    float v[8];
    if (n < 2304) {
#pragma unroll
      for (int j = 0; j < 8; ++j) v[j] = wsrc[(size_t)(k0 + j) * 2576 + n];
    } else if (n < 2816) {
      const int np = n - 2304, g = np >> 7, rr = np & 127, pq = rr >> 6, kk = rr & 63;
#pragma unroll
      for (int j = 0; j < 8; ++j) v[j] = 0.f;
      for (int jj = 0; jj < 64; ++jj) {
        const float ang = 6.283185307179586f * (float)((jj * kk) & 63) / 64.f;
        const float tr = pq ? sinf(ang) : cosf(ang);
#pragma unroll
        for (int j = 0; j < 8; ++j) v[j] += wsrc[(size_t)(k0 + j) * 2576 + 2320 + g * 64 + jj] * tr;
      }
    } else if (n < 2832) {
#pragma unroll
      for (int j = 0; j < 8; ++j) v[j] = wsrc[(size_t)(k0 + j) * 2576 + 2304 + (n - 2816)];
    } else {
#pragma unroll
      for (int j = 0; j < 8; ++j) v[j] = 0.f;
    }
    uint4 o = {pack2(v[0], v[1]), pack2(v[2], v[3]), pack2(v[4], v[5]), pack2(v[6], v[7])};
    *(uint4*)&WSP(u16, OFF_WIN)[((size_t)l * NIN + n) * 1024 + k0] = o;
  }
  for (int e = gtid; e < 2 * 1024 * 128; e += gn) {
    const int l = e / (1024 * 128), r = e % (1024 * 128), kc = r / 1024, n = r % 1024, k0 = kc * 8;
    const float* wsrc = p.in[I_WOUT] + (size_t)l * 1024 * 1024;
    float v[8];
#pragma unroll
    for (int j = 0; j < 8; ++j) v[j] = wsrc[(size_t)(k0 + j) * 1024 + n];
    uint4 o = {pack2(v[0], v[1]), pack2(v[2], v[3]), pack2(v[4], v[5]), pack2(v[6], v[7])};
    *(uint4*)&WSP(u16, OFF_WOUT)[((size_t)l * 1024 + n) * 1024 + k0] = o;
  }
  for (int e = gtid; e < 2 * 2048 * 128; e += gn) {
    const int l = e / (2048 * 128), r = e % (2048 * 128), kc = r / 2048, n = r % 2048, k0 = kc * 8;
    const float* wsrc = p.in[I_WQ] + (size_t)l * 1024 * 2048;
    float v[8];
#pragma unroll
    for (int j = 0; j < 8; ++j) v[j] = wsrc[(size_t)(k0 + j) * 2048 + n];
    uint4 o = {pack2(v[0], v[1]), pack2(v[2], v[3]), pack2(v[4], v[5]), pack2(v[6], v[7])};
    *(uint4*)&WSP(u16, OFF_WQ)[((size_t)l * 2048 + n) * 1024 + k0] = o;
  }
  for (int e = gtid; e < 2 * 2 * 128 * 128; e += gn) {
    const int l = e / (2 * 16384), r = e % (2 * 16384), which = r / 16384, i = r % 16384;
    const float v = (which ? p.in[I_K2] : p.in[I_K1])[l * 16384 + i];
    WSP(u16, OFF_K12)[e] = f2bf(v);
  }
  for (int e = gtid; e < 2048 * 512; e += gn) {
    const int tp = e >> 9, k0 = (e & 511) * 8;
    const float s = 1.f / sqrtf(2048.f * 64.f);
    float v[8];
#pragma unroll
    for (int j = 0; j < 8; ++j) {
      const int k = k0 + j, t = k & 2047;
      const float ang = 6.283185307179586f * (float)((tp * t) & 2047) / 2048.f;
      v[j] = (k < 2048) ? cosf(ang) * s : -sinf(ang) * s;
    }
    uint4 o = {pack2(v[0], v[1]), pack2(v[2], v[3]), pack2(v[4], v[5]), pack2(v[6], v[7])};
    *(uint4*)&WSP(u16, OFF_DFT)[(size_t)tp * 4096 + k0] = o;
  }
  for (int e = gtid; e < 256 * 64; e += gn) {
    const int tp = e >> 6, k0 = (e & 63) * 8;
    const float s = 1.f / sqrtf(256.f * 64.f);
    float v[8];
#pragma unroll
    for (int j = 0; j < 8; ++j) {
      const int k = k0 + j, t = k & 255;
      const float ang = 6.283185307179586f * (float)((tp * t) & 255) / 256.f;
      v[j] = (k < 256) ? cosf(ang) * s : -sinf(ang) * s;
    }
    uint4 o = {pack2(v[0], v[1]), pack2(v[2], v[3]), pack2(v[4], v[5]), pack2(v[6], v[7])};
    *(uint4*)&WSP(u16, OFF_DFTC)[(size_t)tp * 512 + k0] = o;
  }
}

DI void phase_norm(const Params& p, int l, int which, int bid, int nblk) {
  const int lane = TID() & 63, w = TID() >> 6;
  const float* g = (which ? p.in[I_G2] : p.in[I_G1]) + l * 1024;
  const bool from_input = (which == 0 && l == 0);
  for (int row = bid * 4 + w; row < ROWS; row += nblk * 4) {
    const int b = row / TPB, pos = row % TPB;
    if (which == 1 && l == 1 && pos < CTXL) continue;
    const float* xr = xrow_ptr(p, from_input, b, pos);
    const float* mod = WSP(const float, OFF_MOD) + (size_t)(l * 17 + (pos < CTXL ? 16 : b)) * 6144 + which * 3072;
    float x[16];
#pragma unroll
    for (int hh = 0; hh < 2; ++hh) {
      const float4 a = *(const float4*)(xr + hh * 512 + lane * 8);
      const float4 c = *(const float4*)(xr + hh * 512 + lane * 8 + 4);
      x[hh * 8 + 0] = a.x; x[hh * 8 + 1] = a.y; x[hh * 8 + 2] = a.z; x[hh * 8 + 3] = a.w;
      x[hh * 8 + 4] = c.x; x[hh * 8 + 5] = c.y; x[hh * 8 + 6] = c.z; x[hh * 8 + 7] = c.w;
    }
    float ss = 0.f;
#pragma unroll
    for (int i = 0; i < 16; ++i) ss += x[i] * x[i];
    ss = wave_sum(ss);
    const float rs = rsqrtf(ss * (1.f / 1024.f) + EPSF);
#pragma unroll
    for (int hh = 0; hh < 2; ++hh) {
      const int c0 = hh * 512 + lane * 8;
      float y[8];
#pragma unroll
      for (int i = 0; i < 8; ++i) {
        const float yn = x[hh * 8 + i] * rs * g[c0 + i];
        y[i] = yn * (1.f + mod[1024 + c0 + i]) + mod[c0 + i];
      }
      uint4 o = {pack2(y[0], y[1]), pack2(y[2], y[3]), pack2(y[4], y[5]), pack2(y[6], y[7])};
      *(uint4*)&WSP(u16, OFF_ACT)[(size_t)row * 1024 + c0] = o;
    }
  }
}

constexpr float U_SCALE = 64.f, V_SCALE = 4.f;
DI void phase_tables(const Params& p, int l, int bid, int nblk) {
  const int gtid = bid * NTHR + TID(), gn = nblk * NTHR;
  unsigned char* dst = WSP(unsigned char, OFF_XBCA);
  for (int e = gtid; e < 2 * 16384 * 64; e += gn) {
    const int which = e / (16384 * 64), r = e % (16384 * 64);
    const float sc = which ? V_SCALE : U_SCALE;
    const float* src = (which ? p.in[I_PV] : p.in[I_PU]) + (size_t)l * 16384 * 1024 + (size_t)r * 16;
    u32 o[4];
#pragma unroll
    for (int q = 0; q < 4; ++q) {
      const float4 a = *(const float4*)(src + q * 4);
      int v = __builtin_amdgcn_cvt_pk_fp8_f32(a.x * sc, a.y * sc, 0, false);
      v = __builtin_amdgcn_cvt_pk_fp8_f32(a.z * sc, a.w * sc, v, true);
      o[q] = (u32)v;
    }
    uint4 ov = {o[0], o[1], o[2], o[3]};
    *(uint4*)&dst[(size_t)e * 16] = ov;
  }
}

DI void phase_inproj(const Params& p, int l, int bid, int nblk, char* smem) {
  const u16* A = WSP(const u16, OFF_ACT);
  const u16* B = WSP(const u16, OFF_WIN) + (size_t)l * NIN * 1024;
  u16* PHY = WSP(u16, OFF_PHY);
  u16* PZ = WSP(u16, OFF_PZ);
  u16* PXBC = WSP(u16, OFF_PXBC);
  u16* PQT = WSP(u16, OFF_PQT);
  float* DT = WSP(float, OFF_DT);
  auto af = [=](int m, int k) { return A + (size_t)m * 1024 + k; };
  auto bfn = [=](int n, int k) { return B + (size_t)n * 1024 + k; };
  auto efT = [=](int m, int n, float v0, float v1, float v2, float v3) {
    const uint2 o = {pack2(v0, v1), pack2(v2, v3)};
    if (n < 768) *(uint2*)&PHY[(size_t)m * 768 + n] = o;
    else if (n < 1280) *(uint2*)&PZ[(size_t)m * 512 + (n - 768)] = o;
    else if (n < 2304) *(uint2*)&PXBC[(size_t)m * 1024 + (n - 1280)] = o;
    else if (n >= 2816 && n < 2832) { float4 f = {v0, v1, v2, v3}; *(float4*)&DT[(size_t)m * 16 + (n - 2816)] = f; }
  };
  auto efN = [=](int m, int n, float v0, float v1, float v2, float v3) {
    const int b = m / TPB, pos = m % TPB, np = n - 2304;
    uint2 o = {pack2(v0, v1), pack2(v2, v3)};
    *(uint2*)&PQT[((size_t)(b * 512 + np)) * TPB + pos] = o;
  };
  const int ntile = (ROWS / 256) * (NIN / 128);
  const int vb = (nblk % 8 == 0) ? (bid & 7) * (nblk >> 3) + (bid >> 3) : bid;
  for (int t = vb; t < ntile; t += nblk) {
    const int mt = t / (NIN / 128), nt = t % (NIN / 128);
    if (nt >= 18 && nt < 22) gemm_tile<false, 4>(af, bfn, efN, mt * 256, nt * 128, 1024, smem);
    else gemm_tile<true, 4>(af, bfn, efT, mt * 256, nt * 128, 1024, smem);
  }
}

DI void unpack8(const uint4& v, float* f) {
  f[0] = bflo(v.x); f[1] = bfhi(v.x); f[2] = bflo(v.y); f[3] = bfhi(v.y);
  f[4] = bflo(v.z); f[5] = bfhi(v.z); f[6] = bflo(v.w); f[7] = bfhi(v.w);
}
DI void phase_prep(const Params& p, int l, int bid, int nblk, char* smem) {
  const int tid = TID();
  u16* tile = (u16*)smem;
  const u16* PHY = WSP(const u16, OFF_PHY);
  const u16* PXBC = WSP(const u16, OFF_PXBC);
  u16* UT = WSP(u16, OFF_UT);
  u16* X1C = WSP(u16, OFF_X1C);
  u16* XBCA = WSP(u16, OFF_XBCA);
  u16* TX = WSP(u16, OFF_TX);
  const float* hw = p.in[I_HYCW] + l * 3 * 768;
  const float* hb = p.in[I_HYCB] + l * 768;
  const float* sw = p.in[I_SCW] + l * 3 * 1024;
  const float* sb = p.in[I_SCB] + l * 1024;
  const int cg8 = (tid & 31) * 8, pg = tid >> 5;
  for (int it = bid; it < NB * 36 * 6; it += nblk) {
    const int pass = it % 6, bt = it / 6;
    const int b = bt / 36, pt = bt % 36, pos0 = pt * 64;
    const int seg_lo = (pos0 < CTXL) ? 0 : CTXL, seg_hi = (pos0 < CTXL) ? CTXL : TPB;
    const size_t rbase = (size_t)b * TPB;
    const int pfirst = pos0 + pg * 8;
    bool transposed = false;
    if (pass <= 1) {
      if (l == 1 && pos0 < CTXL) continue;
      float cv0[8][8];
#pragma unroll
      for (int sg = 0; sg < 2; ++sg) {
        if (pass == 0 && sg == 1) break;
        const int sgrp = (pass == 0) ? 1 : (sg == 0 ? 0 : 2);
        const int col = sgrp * 256 + cg8;
        float w0[8], w1[8], w2[8], bb[8];
#pragma unroll
        for (int e = 0; e < 8; ++e) { w0[e] = hw[col + e]; w1[e] = hw[768 + col + e]; w2[e] = hw[1536 + col + e]; bb[e] = hb[col + e]; }
        uint4 raw[10];
#pragma unroll
        for (int k = 0; k < 10; ++k) {
          const int pn = pfirst + k - 1;
          raw[k] = (pn >= seg_lo && pn < seg_hi) ? *(const uint4*)&PHY[(rbase + pn) * 768 + col] : make_uint4(0u, 0u, 0u, 0u);
        }
        float xm[8], x0[8], xp[8];
        unpack8(raw[0], xm);
        unpack8(raw[1], x0);
#pragma unroll
        for (int k = 0; k < 8; ++k) {
          unpack8(raw[k + 2], xp);
          float o[8];
#pragma unroll
          for (int e = 0; e < 8; ++e) {
            o[e] = w0[e] * xm[e] + w1[e] * x0[e] + w2[e] * xp[e] + bb[e];
            xm[e] = x0[e]; x0[e] = xp[e];
          }
          if (pass == 0) {
            uint4 o1 = {pack2(o[0], o[1]), pack2(o[2], o[3]), pack2(o[4], o[5]), pack2(o[6], o[7])};
            *(uint4*)&X1C[(rbase + pfirst + k) * 256 + cg8] = o1;
          } else if (sg == 0) {
#pragma unroll
            for (int e = 0; e < 8; ++e) cv0[k][e] = o[e];
          } else {
            uint4 ou = {pack2(o[0] * cv0[k][0], o[1] * cv0[k][1]), pack2(o[2] * cv0[k][2], o[3] * cv0[k][3]),
                        pack2(o[4] * cv0[k][4], o[5] * cv0[k][5]), pack2(o[6] * cv0[k][6], o[7] * cv0[k][7])};
            *(uint4*)&tile[(pg * 8 + k) * 264 + cg8] = ou;
          }
        }
      }
      transposed = (pass == 1);
    } else {
      const int col = (pass - 2) * 256 + cg8;
      float w0[8], w1[8], w2[8], bb[8];
#pragma unroll
      for (int e = 0; e < 8; ++e) { w0[e] = sw[col + e]; w1[e] = sw[1024 + col + e]; w2[e] = sw[2048 + col + e]; bb[e] = sb[col + e]; }
      uint4 raw[10];
#pragma unroll
      for (int k = 0; k < 10; ++k) {
        const int pn = pfirst + k - 1;
        raw[k] = (pn >= seg_lo && pn < seg_hi) ? *(const uint4*)&PXBC[(rbase + pn) * 1024 + col] : make_uint4(0u, 0u, 0u, 0u);
      }
      float xm[8], x0[8], xp[8];
      unpack8(raw[0], xm);
      unpack8(raw[1], x0);
#pragma unroll
      for (int k = 0; k < 8; ++k) {
        unpack8(raw[k + 2], xp);
        float o[8];
#pragma unroll
        for (int e = 0; e < 8; ++e) {
          o[e] = silu_f(w0[e] * xm[e] + w1[e] * x0[e] + w2[e] * xp[e] + bb[e]);
          xm[e] = x0[e]; x0[e] = xp[e];
        }
        uint4 ov = {pack2(o[0], o[1]), pack2(o[2], o[3]), pack2(o[4], o[5]), pack2(o[6], o[7])};
        *(uint4*)&XBCA[(rbase + pfirst + k) * 1024 + col] = ov;
        if (pass < 5) *(uint4*)&tile[(pg * 8 + k) * 264 + cg8] = ov;
      }
      transposed = pass < 5;
    }
    if (transposed) {
      __syncthreads();
      u16* dst = (pass == 1) ? (UT + ((size_t)(tid * 16 + b)) * TPB + pos0) : (TX + ((size_t)(b * 768 + (pass - 2) * 256 + tid)) * TPB + pos0);
#pragma unroll
      for (int pc = 0; pc < 8; ++pc) {
        u32 wv[4];
#pragma unroll
        for (int e = 0; e < 4; ++e)
          wv[e] = (u32)tile[(pc * 8 + 2 * e) * 264 + tid] | ((u32)tile[(pc * 8 + 2 * e + 1) * 264 + tid] << 16);
        uint4 o = {wv[0], wv[1], wv[2], wv[3]};
        *(uint4*)&dst[pc * 8] = o;
      }
      __syncthreads();
    }
  }
}

DI void ssd_item(const Params& p, int l, int it, char* smem) {
  const int tid = TID(), lane = tid & 63, w = tid >> 6, l32 = lane & 31, h = lane >> 5;
  const int b = it >> 4, hd = (it >> 1) & 7, dir = it & 1, g = hd >> 2;
  u16* BG = (u16*)smem;
  u16* HL = BG + 128 * 136;
  float* fa = (float*)(HL + 64 * 136);
  float* fdt = fa + 128;
  float* fsw = fdt + 128;
  float* fea = fsw + 128;
  float* ftot = fea + 128;
  const u16* XBCA = WSP(const u16, OFF_XBCA);
  const u16* TX = WSP(const u16, OFF_TX);
  const float* DT = WSP(const float, OFF_DT);
  u16* Y = WSP(u16, OFF_PXBC) + (dir ? (size_t)ROWS * 512 : 0);
  const float dtb = p.in[I_SDTB][l * 16 + dir * 8 + hd];
  const float a = -expf(p.in[I_SALOG][l * 16 + dir * 8 + hd]);
  const size_t rbase = (size_t)b * TPB;
  f32x16 Hacc[2];
#pragma unroll
  for (int i = 0; i < 2; ++i)
#pragma unroll
    for (int r = 0; r < 16; ++r) Hacc[i][r] = 0.f;
  for (int e = tid; e < 64 * 136; e += NTHR) HL[e] = 0;
  for (int ci = 0; ci < 18; ++ci) {
    const int pos0 = dir ? ((ci < 2) ? (1 - ci) * 128 : (CTXL + (17 - ci) * 128)) : ci * 128;
    asm volatile("s_waitcnt vmcnt(0)" ::: "memory");
    bf16x8 creg[8];
    const u16* cr = XBCA + (rbase + pos0 + w * 32 + l32) * 1024 + 768 + g * 128 + h * 8;
#pragma unroll
    for (int ks = 0; ks < 4; ++ks) creg[ks] = *(const bf16x8*)(cr + ks * 16);
    __builtin_amdgcn_sched_barrier(0);
#pragma unroll
    for (int i = 0; i < 8; ++i) {
      const int q = tid + 256 * i, j = q >> 4, ch = q & 15;
      *(uint4*)&BG[j * 136 + ch * 8] = *(const uint4*)&XBCA[(rbase + pos0 + j) * 1024 + 512 + g * 128 + ch * 8];
    }
    if (w == 0) {
      const float r0 = DT[(rbase + pos0 + 2 * lane) * 16 + dir * 8 + hd] + dtb;
      const float r1 = DT[(rbase + pos0 + 2 * lane + 1) * 16 + dir * 8 + hd] + dtb;
      const float dt0 = (r0 > 20.f) ? r0 : log1pf(expf(r0));
      const float dt1 = (r1 > 20.f) ? r1 : log1pf(expf(r1));
      const float a0 = dt0 * a, a1 = dt1 * a;
      const float sm = a0 + a1;
      float incl = sm;
#pragma unroll
      for (int o = 1; o < 64; o <<= 1) {
        const float t = __shfl_up(incl, o);
        if (lane >= o) incl += t;
      }
      const float excl = incl - sm;
      const float total = __shfl(incl, 63);
      float ac0, ac1;
      if (!dir) { ac0 = excl + a0; ac1 = excl + sm; }
      else { ac0 = total - excl; ac1 = total - excl - a0; }
      fa[2 * lane] = ac0; fa[2 * lane + 1] = ac1;
      fdt[2 * lane] = dt0; fdt[2 * lane + 1] = dt1;
      fsw[2 * lane] = dt0 * __expf(total - ac0); fsw[2 * lane + 1] = dt1 * __expf(total - ac1);
      fea[2 * lane] = __expf(ac0); fea[2 * lane + 1] = __expf(ac1);
      if (lane == 0) ftot[0] = __expf(total);
    }
    __syncthreads();
#pragma unroll
    for (int ks = 4; ks < 8; ++ks) creg[ks] = *(const bf16x8*)(cr + ks * 16);
    f32x16 acc[4], yd[2];
#pragma unroll
    for (int i = 0; i < 4; ++i)
#pragma unroll
      for (int r = 0; r < 16; ++r) acc[i][r] = 0.f;
#pragma unroll
    for (int i = 0; i < 2; ++i)
#pragma unroll
      for (int r = 0; r < 16; ++r) yd[i][r] = 0.f;
#pragma unroll
    for (int ks = 0; ks < 8; ++ks) {
      const bf16x8 areg = creg[ks];
#pragma unroll
      for (int jb = 0; jb < 4; ++jb) {
        const bf16x8 bb = *(const bf16x8*)&BG[(jb * 32 + l32) * 136 + ks * 16 + h * 8];
        acc[jb] = __builtin_amdgcn_mfma_f32_32x32x16_bf16(areg, bb, acc[jb], 0, 0, 0);
      }
    }
    {
      const float eai = fea[w * 32 + l32];
#pragma unroll
      for (int ks = 0; ks < 8; ++ks) {
        union { u32 u[4]; bf16x8 v; } t;
        t.v = creg[ks];
#pragma unroll
        for (int q = 0; q < 4; ++q) t.u[q] = pack2(bflo(t.u[q]) * eai, bfhi(t.u[q]) * eai);
#pragma unroll
        for (int pb = 0; pb < 2; ++pb) {
          const bf16x8 bb = *(const bf16x8*)&HL[(pb * 32 + l32) * 136 + ks * 16 + h * 8];
          yd[pb] = __builtin_amdgcn_mfma_f32_32x32x16_bf16(t.v, bb, yd[pb], 0, 0, 0);
        }
      }
    }
    __syncthreads();
    int l32v = l32, hv_ = h;
    asm volatile("" : "+v"(l32v), "+v"(hv_));
    bf16x8 xf[2][8];
    const u16* xt = TX + ((size_t)(b * 768 + hd * 64 + l32v)) * TPB + pos0 + hv_ * 8;
#pragma unroll
    for (int jb = 0; jb < 4; ++jb) {
      const int j = jb * 32 + l32v;
      const float aj = fa[j], dtj = fdt[j];
#pragma unroll
      for (int r = 0; r < 16; ++r) {
        const int i = w * 32 + (r & 3) + 8 * (r >> 2) + 4 * hv_;
        const float ai = fa[i];
        const bool valid = dir ? (j >= i) : (j <= i);
        const float v = valid ? acc[jb][r] * __expf(ai - aj) * dtj : 0.f;
        BG[i * 136 + j] = f2bf(v);
      }
      __builtin_amdgcn_sched_barrier(0);
      if (jb == 1) {
#pragma unroll
        for (int ks = 0; ks < 8; ++ks) xf[0][ks] = *(const bf16x8*)(xt + ks * 16);
        __builtin_amdgcn_sched_barrier(0);
      }
    }
#pragma unroll
    for (int ks = 0; ks < 8; ++ks) xf[1][ks] = *(const bf16x8*)(xt + (size_t)32 * TPB + ks * 16);
    __builtin_amdgcn_sched_barrier(0);
#pragma unroll
    for (int pb = 0; pb < 2; ++pb)
#pragma unroll
      for (int ks = 0; ks < 8; ++ks) {
        const bf16x8 aa = *(const bf16x8*)&BG[(w * 32 + l32v) * 136 + ks * 16 + hv_ * 8];
        yd[pb] = __builtin_amdgcn_mfma_f32_32x32x16_bf16(aa, xf[pb][ks], yd[pb], 0, 0, 0);
      }
#pragma unroll
    for (int pb = 0; pb < 2; ++pb)
#pragma unroll
      for (int r = 0; r < 16; ++r) {
        const int i = w * 32 + (r & 3) + 8 * (r >> 2) + 4 * hv_;
        Y[(rbase + pos0 + i) * 512 + hd * 64 + pb * 32 + l32v] = f2bf(yd[pb][r]);
      }
    {
      u32x4 braw[8];
      {
        const u16* bt = TX + ((size_t)(b * 768 + 512 + g * 128 + w * 32 + l32v)) * TPB + pos0 + hv_ * 8;
#pragma unroll
        for (int ks = 0; ks < 8; ++ks) braw[ks] = *(const u32x4*)(bt + ks * 16);
      }
      const float eend = ftot[0];
#pragma unroll
      for (int pm = 0; pm < 2; ++pm)
#pragma unroll
        for (int r = 0; r < 16; ++r) Hacc[pm][r] *= eend;
#pragma unroll
      for (int ks = 0; ks < 8; ++ks) {
        const u32x4 raw = braw[ks];
        const float4 s0 = *(const float4*)&fsw[ks * 16 + hv_ * 8];
        const float4 s1 = *(const float4*)&fsw[ks * 16 + hv_ * 8 + 4];
        union { u32 u[4]; bf16x8 v; } bs;
        bs.u[0] = pack2(bflo(raw[0]) * s0.x, bfhi(raw[0]) * s0.y);
        bs.u[1] = pack2(bflo(raw[1]) * s0.z, bfhi(raw[1]) * s0.w);
        bs.u[2] = pack2(bflo(raw[2]) * s1.x, bfhi(raw[2]) * s1.y);
        bs.u[3] = pack2(bflo(raw[3]) * s1.z, bfhi(raw[3]) * s1.w);
#pragma unroll
        for (int pm = 0; pm < 2; ++pm) Hacc[pm] = __builtin_amdgcn_mfma_f32_32x32x16_bf16(xf[pm][ks], bs.v, Hacc[pm], 0, 0, 0);
      }
#pragma unroll
      for (int pm = 0; pm < 2; ++pm)
#pragma unroll
        for (int r = 0; r < 16; ++r) {
          const int pp = pm * 32 + (r & 3) + 8 * (r >> 2) + 4 * hv_;
          HL[pp * 136 + w * 32 + l32v] = f2bf(Hacc[pm][r]);
        }
    }
    __syncthreads();
  }
}

DI void hyena_item(const Params& p, int l, int it) {
  const int lane = TID() & 63, w = TID() >> 6;
  int c, f, L, posoff, tt0, ntile;
  if (it < 2048) { c = it >> 3; f = l; L = 2048; posoff = CTXL; tt0 = (it & 7) * 256 + w * 64; ntile = 32; }
  else { c = it - 2048; f = 2; L = 256; posoff = 0; tt0 = w * 64; ntile = 4; }
  const u16* R0 = WSP(const u16, OFF_RF) + ((size_t)(f * 256 + c) * 2) * RSTR;
  const u16* R1 = R0 + RSTR;
  const u16* UT = WSP(const u16, OFF_UT);
  const int l16 = lane & 15, kg = lane >> 4;
  f32x4 acc[4];
#pragma unroll
  for (int i = 0; i < 4; ++i) acc[i] = (f32x4){0.f, 0.f, 0.f, 0.f};
  const u16* ub = UT + ((size_t)(c * 16 + l16)) * TPB + posoff + kg * 8;
  const u16* rsel = (l16 & 1) ? (R1 - 1) : R0;
  const int nb = L - (tt0 + l16) + kg * 8;
  for (int s0 = 0; s0 < L; s0 += 32) {
    const bf16x8 bfrag = *(const bf16x8*)(ub + s0);
#pragma unroll
    for (int i = 0; i < 4; ++i) {
      const u32* ap = (const u32*)(rsel + (nb - 16 * i + s0));
      union { u32 u[4]; bf16x8 v; } au;
      au.u[0] = ap[0]; au.u[1] = ap[1]; au.u[2] = ap[2]; au.u[3] = ap[3];
      acc[i] = __builtin_amdgcn_mfma_f32_16x16x32_bf16(au.v, bfrag, acc[i], 0, 0, 0);
    }
  }
  float ssq = 0.f;
  for (int t = 0; t < ntile; ++t) ssq += WSP(const float, OFF_PART)[(size_t)(f * 32 + t) * 256 + c];
  const float scale = rsqrtf(ssq + EPSF);
  const float bias = p.in[I_HYBIAS][l * 256 + c];
  const u16* X1C = WSP(const u16, OFF_X1C);
  u16* YM = WSP(u16, OFF_ACT);
  const int b = l16;
#pragma unroll
  for (int i = 0; i < 4; ++i)
#pragma unroll
    for (int r = 0; r < 4; ++r) {
      const int t = tt0 + 16 * i + kg * 4 + r;
      const size_t row = (size_t)b * TPB + posoff + t;
      const float u = bf2f(UT[((size_t)(c * 16 + b)) * TPB + posoff + t]);
      const float x1 = bf2f(X1C[row * 256 + c]);
      YM[row * 1024 + c] = f2bf(x1 * (scale * acc[i][r] + bias * u));
    }
}

DI void hyena_item_lat(const Params& p, int l, int it) {
  const int lane = TID() & 63, w = TID() >> 6;
  const int c = it >> 2, f = l, L = 2048, posoff = CTXL;
  const int tt0 = (it & 3) * 512 + w * 128;
  const u16* R0 = WSP(const u16, OFF_RF) + ((size_t)(f * 256 + c) * 2) * RSTR;
  const u16* R1 = R0 + RSTR;
  const u16* UT = WSP(const u16, OFF_UT);
  const int l16 = lane & 15, kg = lane >> 4;
  f32x4 acc[8];
#pragma unroll
  for (int i = 0; i < 8; ++i) acc[i] = (f32x4){0.f, 0.f, 0.f, 0.f};
  const u16* ub = UT + ((size_t)(c * 16 + l16)) * TPB + posoff + kg * 8;
  const u16* rsel = (l16 & 1) ? (R1 - 1) : R0;
  const int nb = L - (tt0 + l16) + kg * 8;
  union AF { u32 u[4]; bf16x8 v; };
  AF a[8];
#define HY_LOADA(dst, off) { const u32* ap_ = (const u32*)(rsel + (off)); dst.u[0] = ap_[0]; dst.u[1] = ap_[1]; dst.u[2] = ap_[2]; dst.u[3] = ap_[3]; }
#pragma unroll
  for (int i = 2; i < 8; ++i) HY_LOADA(a[i], nb - 16 * i)
#pragma unroll 1
  for (int sb = 0; sb < L; sb += 128) {
#pragma unroll
    for (int u = 0; u < 4; ++u) {
      const int s0 = sb + 32 * u;
      HY_LOADA(a[(0 - 2 * u) & 7], nb + s0)
      HY_LOADA(a[(1 - 2 * u) & 7], nb - 16 + s0)
      const bf16x8 bfrag = *(const bf16x8*)(ub + s0);
#pragma unroll
      for (int i = 0; i < 8; ++i) acc[i] = __builtin_amdgcn_mfma_f32_16x16x32_bf16(a[(i - 2 * u) & 7].v, bfrag, acc[i], 0, 0, 0);
    }
  }
#undef HY_LOADA
  float ssq = 0.f;
  for (int t = 0; t < 32; ++t) ssq += WSP(const float, OFF_PART)[(size_t)(f * 32 + t) * 256 + c];
  const float scale = rsqrtf(ssq + EPSF);
  const float bias = p.in[I_HYBIAS][l * 256 + c];
  const u16* X1C = WSP(const u16, OFF_X1C);
  u16* YM = WSP(u16, OFF_ACT);
  const int b = l16;
#pragma unroll
  for (int i = 0; i < 8; ++i)
#pragma unroll
    for (int r = 0; r < 4; ++r) {
      const int t = tt0 + 16 * i + kg * 4 + r;
      const size_t row = (size_t)b * TPB + posoff + t;
      const float uu = bf2f(UT[((size_t)(c * 16 + b)) * TPB + posoff + t]);
      const float x1 = bf2f(X1C[row * 256 + c]);
      YM[row * 1024 + c] = f2bf(x1 * (scale * acc[i][r] + bias * uu));
    }
}

DI void fnet_item(const Params& p, int it, char* smem) {
  const u16* PQT = WSP(const u16, OFF_PQT);
  u16* YM = WSP(u16, OFF_ACT);
  if (it < 256) {
    const int mt = it >> 5, nt = it & 31;
    const u16* A = WSP(const u16, OFF_DFT);
    auto af = [=](int m, int k) { return A + (size_t)m * 4096 + k; };
    auto bfn = [=](int n, int k) {
      const int b = n >> 8, n2 = n & 255, g = n2 >> 6, kk = n2 & 63, pq = k >> 11, t = k & 2047;
      return PQT + ((size_t)(b * 512 + g * 128 + pq * 64 + kk)) * TPB + CTXL + t;
    };
    auto ef = [=](int m, int n, float v0, float v1, float v2, float v3) {
      const int b = n >> 8, n2 = n & 255;
      const uint2 o = {pack2(v0, v1), pack2(v2, v3)};
      *(uint2*)&YM[((size_t)b * TPB + CTXL + m) * 1024 + 768 + n2] = o;
    };
    gemm_tile<true, 4>(af, bfn, ef, mt * 256, nt * 128, 4096, smem);
  } else {
    const int i2 = it - 256, mt = i2 >> 5, nt = i2 & 31;
    const u16* A = WSP(const u16, OFF_DFTC);
    auto af = [=](int m, int k) { return A + (size_t)m * 512 + k; };
    auto bfn = [=](int n, int k) {
      const int b = n >> 8, n2 = n & 255, g = n2 >> 6, kk = n2 & 63, pq = k >> 8, t = k & 255;
      return PQT + ((size_t)(b * 512 + g * 128 + pq * 64 + kk)) * TPB + t;
    };
    auto ef = [=](int m, int n, float v0, float v1, float v2, float v3) {
      const int b = n >> 8, n2 = n & 255;
      const uint2 o = {pack2(v0, v1), pack2(v2, v3)};
      *(uint2*)&YM[((size_t)b * TPB + m) * 1024 + 768 + n2] = o;
    };
    gemm_tile<true, 4>(af, bfn, ef, mt * 256, nt * 128, 512, smem);
  }
}

DI void phase_mixers(const Params& p, int l, int bid, int nblk, char* smem, int rep = 0) {
  for (int it = bid; it < 256; it += nblk) ssd_item(p, l, it, smem);
  const int nf = (l == 0) ? 288 : 256;
  const int nh = (l == 0) ? 1280 : 1024;
  int* ctr = WSP(int, OFF_CTR) + l + 2 * rep;
  int* sitem = (int*)(smem + LDS_BYTES - 16);
  for (;;) {
    if (TID() == 0) *sitem = atomicAdd(ctr, 1);
    __syncthreads();
    const int it = *sitem;
    __syncthreads();
    if (it >= nf + nh) break;
    if (it < nf) fnet_item(p, it, smem);
    else if (it - nf < 1024) hyena_item_lat(p, l, it - nf);
    else hyena_item(p, l, it - nf + 1024);
  }
}

DI void phase_ssd_combine(const Params& p, int l, int bid, int nblk) {
  const int lane = TID() & 63, w = TID() >> 6;
  const u16* YF = WSP(const u16, OFF_PXBC);
  const u16* YB = YF + (size_t)ROWS * 512;
  const u16* XBCA = WSP(const u16, OFF_XBCA);
  const u16* PZ = WSP(const u16, OFF_PZ);
  u16* YM = WSP(u16, OFF_ACT);
  const float* ng = p.in[I_SNG] + l * 512;
  const int c0 = lane * 8;
  const float dsk = p.in[I_SD][l * 8 + (c0 >> 6)];
  for (int row = bid * 4 + w; row < ROWS; row += nblk * 4) {
    const int pos = row % TPB;
    if (l == 1 && pos < CTXL) continue;
    const uint4 vf = *(const uint4*)(YF + (size_t)row * 512 + c0);
    const uint4 vb = *(const uint4*)(YB + (size_t)row * 512 + c0);
    const uint4 vx = *(const uint4*)(XBCA + (size_t)row * 1024 + c0);
    const uint4 vz = *(const uint4*)(PZ + (size_t)row * 512 + c0);
    const u32 af_[4] = {vf.x, vf.y, vf.z, vf.w}, ab_[4] = {vb.x, vb.y, vb.z, vb.w};
    const u32 ax_[4] = {vx.x, vx.y, vx.z, vx.w}, az_[4] = {vz.x, vz.y, vz.z, vz.w};
    float y[8];
    float ss = 0.f;
#pragma unroll
    for (int i = 0; i < 4; ++i) {
      const float y0 = bflo(af_[i]) + bflo(ab_[i]) + dsk * bflo(ax_[i]);
      const float y1 = bfhi(af_[i]) + bfhi(ab_[i]) + dsk * bfhi(ax_[i]);
      y[2 * i] = y0 * silu_f(bflo(az_[i]));
      y[2 * i + 1] = y1 * silu_f(bfhi(az_[i]));
      ss += y[2 * i] * y[2 * i] + y[2 * i + 1] * y[2 * i + 1];
    }
#pragma unroll
    for (int o = 16; o >= 1; o >>= 1) ss += __shfl_xor(ss, o);
    const float rs = rsqrtf(ss * (1.f / 256.f) + EPSF);
    float o8[8];
#pragma unroll
    for (int i = 0; i < 8; ++i) o8[i] = y[i] * rs * ng[c0 + i];
    uint4 o = {pack2(o8[0], o8[1]), pack2(o8[2], o8[3]), pack2(o8[4], o8[5]), pack2(o8[6], o8[7])};
    *(uint4*)&YM[(size_t)row * 1024 + 256 + c0] = o;
  }
}

DI void phase_outproj(const Params& p, int l, int bid, int nblk, char* smem) {
  const u16* A = WSP(const u16, OFF_ACT);
  const u16* B = WSP(const u16, OFF_WOUT) + (size_t)l * 1024 * 1024;
  const float* MOD = WSP(const float, OFF_MOD);
  const Params pp = p;
  auto af = [=](int m, int k) { return A + (size_t)m * 1024 + k; };
  auto bfn = [=](int n, int k) { return B + (size_t)n * 1024 + k; };
  auto ef = [=](int m, int n, float v0, float v1, float v2, float v3) {
    const int b = m / TPB, pos = m % TPB;
    const float4 ga = *(const float4*)&MOD[(size_t)(l * 17 + (pos < CTXL ? 16 : b)) * 6144 + 2048 + n];
    const float4 xo = *(const float4*)(xrow_ptr(pp, l == 0, b, pos) + n);
    const float4 o = {xo.x + ga.x * v0, xo.y + ga.y * v1, xo.z + ga.z * v2, xo.w + ga.w * v3};
    *(float4*)(xrow_wptr(pp, b, pos) + n) = o;
  };
  const int ntile = (ROWS / 128) * 8;
  const int vb = (nblk % 8 == 0) ? (bid & 7) * (nblk >> 3) + (bid >> 3) : bid;
  for (int t = vb; t < ntile; t += nblk) {
    const int mt = t >> 3, nt = t & 7;
    if (l == 1 && (mt % 18) < 2) continue;
    gemm_tile<true, 2>(af, bfn, ef, mt * 128, nt * 128, 1024, smem);
  }
}

DI void phase_q(const Params& p, int l, int bid, int nblk, char* smem) {
  const u16* A = WSP(const u16, OFF_ACT);
  const u16* B = WSP(const u16, OFF_WQ) + (size_t)l * 2048 * 1024;
  u16* Q = WSP(u16, OFF_Q);
  auto af = [=](int m, int k) { return A + (size_t)m * 1024 + k; };
  auto bfn = [=](int n, int k) { return B + (size_t)n * 1024 + k; };
  auto ef = [=](int m, int n, float v0, float v1, float v2, float v3) {
    const uint2 o = {pack2(v0, v1), pack2(v2, v3)};
    *(uint2*)&Q[(size_t)m * 2048 + n] = o;
  };
  const int ntile = (ROWS / 256) * 16;
  const int vb = (nblk % 8 == 0) ? (bid & 7) * (nblk >> 3) + (bid >> 3) : bid;
  for (int t = vb; t < ntile; t += nblk) {
    const int mt = t >> 4, nt = t & 15;
    if (l == 1 && (mt % 9) < 1) continue;
    gemm_tile<true, 4>(af, bfn, ef, mt * 256, nt * 128, 1024, smem);
  }
}

DI void phase_topk(const Params& p, int l, int bid, int nblk, char* smem) {
  const int tid = TID(), lane = tid & 63, w = tid >> 6, l32 = lane & 31, h = lane >> 5;
  u16* qs = (u16*)smem;
  float* sc = (float*)(smem + 64 * 136 * 2);
  const u16* Q = WSP(const u16, OFF_Q);
  float* TV = WSP(float, OFF_TV);
  int* TI = WSP(int, OFF_TI);
  for (int it = bid; it < (ROWS / 64) * 16; it += nblk) {
    const int hh = it & 15, rt = it >> 4;
    if (l == 1 && (rt % 36) < 4) continue;
    const int row0 = rt * 64;
#pragma unroll
    for (int i = 0; i < 4; ++i) {
      const int q = tid + 256 * i, r = q >> 4, ch = q & 15;
      *(uint4*)&qs[r * 136 + ch * 8] = *(const uint4*)&Q[(size_t)(row0 + r) * 2048 + hh * 128 + ch * 8];
    }
    __syncthreads();
    const u16* kb = WSP(const u16, OFF_K12) + (size_t)(l * 2 + (hh & 1)) * 16384;
    f32x16 acc[2];
#pragma unroll
    for (int i = 0; i < 2; ++i)
#pragma unroll
      for (int r = 0; r < 16; ++r) acc[i][r] = 0.f;
#pragma unroll
    for (int ks = 0; ks < 8; ++ks) {
      const bf16x8 bq = *(const bf16x8*)&kb[(w * 32 + l32) * 128 + ks * 16 + h * 8];
      const bf16x8 a0 = *(const bf16x8*)&qs[(l32) * 136 + ks * 16 + h * 8];
      const bf16x8 a1 = *(const bf16x8*)&qs[(32 + l32) * 136 + ks * 16 + h * 8];
      acc[0] = __builtin_amdgcn_mfma_f32_32x32x16_bf16(a0, bq, acc[0], 0, 0, 0);
      acc[1] = __builtin_amdgcn_mfma_f32_32x32x16_bf16(a1, bq, acc[1], 0, 0, 0);
    }
#pragma unroll
    for (int mt = 0; mt < 2; ++mt)
#pragma unroll
      for (int i = 0; i < 16; ++i) {
        const int r = mt * 32 + (i & 3) + 8 * (i >> 2) + 4 * h;
        sc[r * 133 + w * 33 + l32] = acc[mt][i];
      }
    __syncthreads();
    {
      const int r = tid >> 2, part = tid & 3;
      u32 key[32];
#pragma unroll
      for (int j = 0; j < 32; ++j) {
        const u32 u = __float_as_uint(sc[r * 133 + part * 33 + j]);
        const u32 ord = (u & 0x80000000u) ? ~u : (u | 0x80000000u);
        key[j] = (ord & ~127u) | (u32)(127 - (part * 32 + j));
      }
      float* tv = TV + ((size_t)(row0 + r) * 16 + hh) * 16;
      int* ti = TI + ((size_t)(row0 + r) * 16 + hh) * 16;
#pragma unroll
      for (int k = 2; k <= 32; k <<= 1)
#pragma unroll
        for (int j = k >> 1; j > 0; j >>= 1)
#pragma unroll
          for (int i = 0; i < 32; ++i) {
            const int l2 = i ^ j;
            if (l2 > i) {
              const u32 ka = key[i], kb2 = key[l2];
              const u32 lo = ka < kb2 ? ka : kb2, hi = ka < kb2 ? kb2 : ka;
              if ((i & k) == 0) { key[i] = lo; key[l2] = hi; } else { key[i] = hi; key[l2] = lo; }
            }
          }
      u32 T[16];
#pragma unroll
      for (int t = 0; t < 16; ++t) T[t] = key[31 - t];
#define TOPK_MERGE(CTRL)                                                                      \
      {                                                                                       \
        u32 M[16];                                                                            \
        _Pragma("unroll") for (int t = 0; t < 16; ++t) {                                      \
          const u32 o = (u32)dpp_i<CTRL>((int)T[15 - t]);                                     \
          M[t] = T[t] > o ? T[t] : o;                                                         \
        }                                                                                     \
        _Pragma("unroll") for (int j = 8; j > 0; j >>= 1)                                     \
          _Pragma("unroll") for (int i = 0; i < 16; ++i) {                                    \
            const int l2 = i ^ j;                                                             \
            if (l2 > i) {                                                                     \
              const u32 ka = M[i], kb2 = M[l2];                                               \
              M[i] = ka > kb2 ? ka : kb2;                                                     \
              M[l2] = ka > kb2 ? kb2 : ka;                                                    \
            }                                                                                 \
          }                                                                                   \
        _Pragma("unroll") for (int t = 0; t < 16; ++t) T[t] = M[t];                           \
      }
      TOPK_MERGE(DPP_XOR1)
      TOPK_MERGE(DPP_XOR2)
#undef TOPK_MERGE
      if (part == 0) {
        float ov[16];
        int oi[16];
#pragma unroll
        for (int rd = 0; rd < 16; ++rd) {
          const u32 best = T[rd];
          const u32 ordv = best & ~127u;
          const u32 uu = (ordv & 0x80000000u) ? (ordv & 0x7FFFFFFFu) : ~ordv;
          ov[rd] = __uint_as_float(uu);
          oi[rd] = 127 - (int)(best & 127u);
        }
#pragma unroll
        for (int q = 0; q < 4; ++q) {
          float4 fv = {ov[q * 4 + 0], ov[q * 4 + 1], ov[q * 4 + 2], ov[q * 4 + 3]};
          int4 iv = {oi[q * 4 + 0], oi[q * 4 + 1], oi[q * 4 + 2], oi[q * 4 + 3]};
          *(float4*)(tv + q * 4) = fv;
          *(int4*)(ti + q * 4) = iv;
        }
      }
    }
    __syncthreads();
  }
}

DI int cand_a(int c) {
  const u32 T[7] = {0x00000000u, 0x00000000u, 0x11111111u, 0x33322222u, 0x66554443u, 0xDCBA9877u, 0x000000FEu};
  u32 wv = T[0];
#pragma unroll
  for (int s = 1; s < 7; ++s) wv = ((c >> 3) == s) ? T[s] : wv;
  return (int)((wv >> ((c & 7) * 4)) & 15u);
}
DI int cand_b(int c) {
  const u32 T[7] = {0x76543210u, 0xFEDCBA98u, 0x76543210u, 0x21043210u, 0x10102103u, 0x00000010u, 0x00000000u};
  u32 wv = T[0];
#pragma unroll
  for (int s = 1; s < 7; ++s) wv = ((c >> 3) == s) ? T[s] : wv;
  return (int)((wv >> ((c & 7) * 4)) & 15u);
}
DI void phase_peer(const Params& p, int l, int bid, int nblk) {
  const int w = TID() >> 6;
  const float* TV = WSP(const float, OFF_TV);
  const int* TI = WSP(const int, OFF_TI);
  const u16* H2 = WSP(const u16, OFF_ACT);
  const unsigned char* UB = WSP(const unsigned char, OFF_XBCA);
  const unsigned char* VB = UB + (size_t)16384 * 1024;
  const float* gfin = p.in[I_GF];
  for (int row = bid * 4 + w; row < ROWS; row += nblk * 4) {
    const int b = row / TPB, pos = row % TPB;
    if (l == 1 && pos < CTXL) continue;
    const int lane = TID() & 63;
    const int head = lane >> 3, sub = lane & 7;
    const float* tv1 = TV + ((size_t)row * 16 + head * 2) * 16;
    const float* tv2 = tv1 + 16;
    const int* ti1 = TI + ((size_t)row * 16 + head * 2) * 16;
    const int* ti2 = ti1 + 16;
    const int t1lo = ti1[sub], t1hi = ti1[sub + 8], t2lo = ti2[sub], t2hi = ti2[sub + 8];
    u32 ck[7];
#pragma unroll
    for (int s = 0; s < 7; ++s) {
      const int c = sub + 8 * s;
      if (c < 50) {
        const u32 u = __float_as_uint(tv1[cand_a(c)] + tv2[cand_b(c)]);
        const u32 ord = (u & 0x80000000u) ? ~u : (u | 0x80000000u);
        ck[s] = (ord & ~63u) | (u32)(63 - c);
      } else ck[s] = 0u;
    }
    float w0v = 0.f, w1v = 0.f, mx = 0.f;
    int w0c = 0, w1c = 0;
    u32 prevk = 0xFFFFFFFFu;
#pragma unroll
    for (int r = 0; r < 16; ++r) {
      u32 m = 0u;
#pragma unroll
      for (int s = 0; s < 7; ++s) { const u32 d = ck[s] - prevk; m = d > m ? d : m; }
      { const u32 ov = (u32)dpp_i<DPP_XOR1>((int)m); m = ov > m ? ov : m; }
      { const u32 ov = (u32)dpp_i<DPP_XOR2>((int)m); m = ov > m ? ov : m; }
      { const u32 ov = (u32)dpp_i<DPP_MIRROR8>((int)m); m = ov > m ? ov : m; }
      const u32 best = prevk + m;
      prevk = best;
      const u32 ordv = best & ~63u;
      const float bv = __uint_as_float((ordv & 0x80000000u) ? (ordv & 0x7FFFFFFFu) : ~ordv);
      const int bc = 63 - (int)(best & 63u);
      if (r == 0) mx = bv;
      if (sub == (r & 7)) {
        if (r < 8) { w0v = bv; w0c = bc; } else { w1v = bv; w1c = bc; }
      }
    }
    const float e0 = expf(w0v - mx), e1 = expf(w1v - mx);
    float es = e0 + e1;
    es += dpp_f<DPP_XOR1>(es);
    es += dpp_f<DPP_XOR2>(es);
    es += dpp_f<DPP_MIRROR8>(es);
    const float g0 = e0 / es, g1 = e1 / es;
    int idx0, idx1;
    {
      const int gb = lane & ~7;
      const int a0 = cand_a(w0c), c0 = cand_b(w0c), a1 = cand_a(w1c), c1 = cand_b(w1c);
      const int p0l = __shfl(t1lo, gb + (a0 & 7)), p0h = __shfl(t1hi, gb + (a0 & 7));
      const int q0l = __shfl(t2lo, gb + (c0 & 7)), q0h = __shfl(t2hi, gb + (c0 & 7));
      const int p1l = __shfl(t1lo, gb + (a1 & 7)), p1h = __shfl(t1hi, gb + (a1 & 7));
      const int q1l = __shfl(t2lo, gb + (c1 & 7)), q1h = __shfl(t2hi, gb + (c1 & 7));
      idx0 = ((a0 & 8) ? p0h : p0l) * 128 + ((c0 & 8) ? q0h : q0l);
      idx1 = ((a1 & 8) ? p1h : p1l) * 128 + ((c1 & 8) ? q1h : q1l);
    }
    const u16* hrow = H2 + (size_t)row * 1024;
    float hv[16];
    {
      const uint4 ha = *(const uint4*)(hrow + lane * 16), hb = *(const uint4*)(hrow + lane * 16 + 8);
      hv[0] = bflo(ha.x); hv[1] = bfhi(ha.x); hv[2] = bflo(ha.y); hv[3] = bfhi(ha.y);
      hv[4] = bflo(ha.z); hv[5] = bfhi(ha.z); hv[6] = bflo(ha.w); hv[7] = bfhi(ha.w);
      hv[8] = bflo(hb.x); hv[9] = bfhi(hb.x); hv[10] = bflo(hb.y); hv[11] = bfhi(hb.y);
      hv[12] = bflo(hb.z); hv[13] = bfhi(hb.z); hv[14] = bflo(hb.w); hv[15] = bfhi(hb.w);
    }
    float acc[16];
#pragma unroll 1
    for (int prep_ = 0; prep_ < PEER_REPS; ++prep_) {
    f32x2 hv2[8];
#pragma unroll
    for (int i = 0; i < 8; ++i) hv2[i] = (f32x2){hv[2 * i], hv[2 * i + 1]};
    const bool b0 = lane & 1, b1 = lane & 2, b2 = lane & 4;
    float act0 = 0.f, act1 = 0.f;
    u32x4 rb[2][8];
#define PEER_LOAD(buf, k, TAB)                                                                     \
  _Pragma("unroll") for (int j = 0; j < 8; ++j) {                                                  \
    const int e = (k) * 8 + j;                                                                     \
    const int id = __builtin_amdgcn_readlane(((k) < 8) ? idx0 : idx1, e & 63);                     \
    rb[buf][j] = *(const u32x4*)(TAB + (size_t)id * 1024 + lane * 16);                             \
  }
#define PEER_DOT(buf, k)                                                                           \
  {                                                                                                \
    float d[8];                                                                                    \
    _Pragma("unroll") for (int j = 0; j < 8; ++j) {                                                \
      const u32 uw[4] = {rb[buf][j][0], rb[buf][j][1], rb[buf][j][2], rb[buf][j][3]};              \
      f32x2 sa = {0.f, 0.f}, sb = {0.f, 0.f};                   \
      _Pragma("unroll") for (int q = 0; q < 4; ++q) {                                              \
        const f32x2 lo = __builtin_amdgcn_cvt_pk_f32_fp8((int)uw[q], false);                       \
        const f32x2 hi = __builtin_amdgcn_cvt_pk_f32_fp8((int)uw[q], true);                        \
        sa = __builtin_elementwise_fma(hv2[2 * q], lo, sa);                                        \
        sb = __builtin_elementwise_fma(hv2[2 * q + 1], hi, sb);                                    \
      }                                                                                            \
      sa += sb;                                                                                    \
      d[j] = sa.x + sa.y;                                                                          \
    }                                                                                              \
    float a4[4];                                                                                   \
    _Pragma("unroll") for (int q = 0; q < 4; ++q) {                                                \
      const float keep = b0 ? d[2 * q + 1] : d[2 * q], send = b0 ? d[2 * q] : d[2 * q + 1];        \
      a4[q] = keep + __shfl_xor(send, 1);                                                          \
    }                                                                                              \
    float a2[2];                                                                                   \
    _Pragma("unroll") for (int q = 0; q < 2; ++q) {                                                \
      const float keep = b1 ? a4[2 * q + 1] : a4[2 * q], send = b1 ? a4[2 * q] : a4[2 * q + 1];    \
      a2[q] = keep + __shfl_xor(send, 2);                                                          \
    }                                                                                              \
    const float keep = b2 ? a2[1] : a2[0], send = b2 ? a2[0] : a2[1];                              \
    float c1 = keep + __shfl_xor(send, 4);                                                         \
    c1 += __shfl_xor(c1, 8);                                                                       \
    c1 += __shfl_xor(c1, 16);                                                                      \
    c1 += __shfl_xor(c1, 32);                                                                      \
    if ((lane >> 3) == ((k) & 7)) { if ((k) < 8) act0 = c1; else act1 = c1; }                      \
  }
    PEER_LOAD(0, 0, UB)
#pragma unroll 1
    for (int k = 0; k < 16; k += 2) {
      PEER_LOAD(1, k + 1, UB)
      __builtin_amdgcn_sched_barrier(0);
      PEER_DOT(0, k)
      { const int kn = (k + 2 < 16) ? k + 2 : 15; PEER_LOAD(0, kn, UB) }
      __builtin_amdgcn_sched_barrier(0);
      PEER_DOT(1, k + 1)
    }
    const float ga0 = gelu_tanh(act0 * (1.f / U_SCALE)) * g0 * (1.f / V_SCALE);
    const float ga1 = gelu_tanh(act1 * (1.f / U_SCALE)) * g1 * (1.f / V_SCALE);
#pragma unroll
    for (int i = 0; i < 16; ++i) acc[i] = 0.f;
#define PEER_ACC(buf, k)                                                                           \
  _Pragma("unroll") for (int j = 0; j < 8; ++j) {                                                  \
    const int e = (k) * 8 + j;                                                                     \
    const int ai = __builtin_amdgcn_readlane(__builtin_bit_cast(int, ((k) < 8) ? ga0 : ga1), e & 63); \
    const float a = __builtin_bit_cast(float, ai);                                                 \
    const u32 vw[4] = {rb[buf][j][0], rb[buf][j][1], rb[buf][j][2], rb[buf][j][3]};                \
    _Pragma("unroll") for (int q = 0; q < 4; ++q) {                                                \
      const f32x2 lo = __builtin_amdgcn_cvt_pk_f32_fp8((int)vw[q], false);                         \
      const f32x2 hi = __builtin_amdgcn_cvt_pk_f32_fp8((int)vw[q], true);                          \
      acc[q * 4 + 0] += a * lo.x; acc[q * 4 + 1] += a * lo.y; acc[q * 4 + 2] += a * hi.x; acc[q * 4 + 3] += a * hi.y; \
    }                                                                                              \
  }
    PEER_LOAD(0, 0, VB)
#pragma unroll 1
    for (int k = 0; k < 16; k += 2) {
      PEER_LOAD(1, k + 1, VB)
      __builtin_amdgcn_sched_barrier(0);
      PEER_ACC(0, k)
      { const int kn = (k + 2 < 16) ? k + 2 : 15; PEER_LOAD(0, kn, VB) }
      __builtin_amdgcn_sched_barrier(0);
      PEER_ACC(1, k + 1)
    }
#undef PEER_LOAD
#undef PEER_DOT
#undef PEER_ACC
      if (prep_ + 1 < PEER_REPS) { _Pragma("unroll") for (int i = 0; i < 16; ++i) asm volatile("" :: "v"(acc[i])); }
    }
    int row2 = row;
    asm volatile("" : "+v"(row2));
    const int lane2 = TID() & 63;
    const int b2 = row2 / TPB, pos2 = row2 % TPB;
    const float* xr = xrow_ptr(p, false, b2, pos2);
    float* xw = xrow_wptr(p, b2, pos2);
    const float* ga = WSP(const float, OFF_MOD) + (size_t)(l * 17 + (pos2 < CTXL ? 16 : b2)) * 6144 + 5120;
    float xn[16];
    float ss = 0.f;
#pragma unroll
    for (int q = 0; q < 4; ++q) {
      const float4 xv = *(const float4*)(xr + lane2 * 16 + q * 4);
      const float4 gv = *(const float4*)(ga + lane2 * 16 + q * 4);
      xn[q * 4 + 0] = xv.x + gv.x * acc[q * 4 + 0];
      xn[q * 4 + 1] = xv.y + gv.y * acc[q * 4 + 1];
      xn[q * 4 + 2] = xv.z + gv.z * acc[q * 4 + 2];
      xn[q * 4 + 3] = xv.w + gv.w * acc[q * 4 + 3];
    }
    if (l == 1) {
#pragma unroll
      for (int i = 0; i < 16; ++i) ss += xn[i] * xn[i];
      ss = wave_sum(ss);
      const float rs = rsqrtf(ss * (1.f / 1024.f) + EPSF);
#pragma unroll
      for (int i = 0; i < 16; ++i) xn[i] = xn[i] * rs * gfin[lane2 * 16 + i];
    }
#pragma unroll
    for (int q = 0; q < 4; ++q) {
      float4 o = {xn[q * 4 + 0], xn[q * 4 + 1], xn[q * 4 + 2], xn[q * 4 + 3]};
      *(float4*)(xw + lane2 * 16 + q * 4) = o;
    }
  }
}

template <int S>
DI void run_stage(const Params& p, int l, int bid, int nblk, char* smem) {
  for (int rep = 0; rep < 1 + ((REP_MASK >> (S + 1)) & 1); ++rep) {
  if (S == 0) { if (PH_MASK & 2) phase_norm(p, l, 0, bid, nblk); }
  else if (S == 1) { if (PH_MASK & 4) phase_inproj(p, l, bid, nblk, smem); }
  else if (S == 2) { if (PH_MASK & 8) phase_prep(p, l, bid, nblk, smem); }
  else if (S == 3) { if (PH_MASK & 16) phase_mixers(p, l, bid, nblk, smem, rep); }
  else if (S == 4) { if (PH_MASK & 32) phase_ssd_combine(p, l, bid, nblk); }
  else if (S == 5) { if (PH_MASK & 64) phase_outproj(p, l, bid, nblk, smem); }
  else if (S == 6) { if (PH_MASK & 128) { phase_norm(p, l, 1, bid, nblk); phase_tables(p, l, bid, nblk); } }
  else if (S == 7) { if (PH_MASK & 256) phase_q(p, l, bid, nblk, smem); }
  else if (S == 8) { if (PH_MASK & 512) phase_topk(p, l, bid, nblk, smem); }
  else { if (PH_MASK & 1024) phase_peer(p, l, bid, nblk); }
  }
}

#if ONE_LAUNCH
__global__ void __launch_bounds__(NTHR, 2) mega(Params p) {
  extern __shared__ __attribute__((aligned(16))) char smem[];
  const int bid = blockIdx.x, nblk = gridDim.x;
  cg::grid_group grid = cg::this_grid();
  volatile LAS unsigned* bst = (volatile LAS unsigned*)(smem + LDS_BYTES - 32);
  if (threadIdx.x == 0) { bst[0] = 0u; bst[1] = 0u; }
  __syncthreads();
  const XcdBarrier bar = xcd_barrier_post(WSP(unsigned, OFF_BAR), bst);
  for (int rep = 0; rep < 1 + (REP_MASK & 1); ++rep) { if (PH_MASK & 1) phase_prologue(p, bid, nblk, smem); }
  grid.sync();
#define GBAR() xcd_barrier(bar)
#pragma nounroll
  for (int l = 0; l < 2; ++l) {
    for (int xs = 0; xs < EXTRA_SYNCS; ++xs) GBAR();
    run_stage<0>(p, l, bid, nblk, smem); GBAR();
    run_stage<1>(p, l, bid, nblk, smem); GBAR();
    run_stage<2>(p, l, bid, nblk, smem); GBAR();
    run_stage<3>(p, l, bid, nblk, smem); GBAR();
    run_stage<4>(p, l, bid, nblk, smem); GBAR();
    run_stage<5>(p, l, bid, nblk, smem); GBAR();
    run_stage<6>(p, l, bid, nblk, smem); GBAR();
    run_stage<7>(p, l, bid, nblk, smem); GBAR();
    run_stage<8>(p, l, bid, nblk, smem); GBAR();
    run_stage<9>(p, l, bid, nblk, smem);
    if (l == 0) GBAR();
  }
}
#else
template <int S>
__global__ void __launch_bounds__(NTHR, 2) stage_kernel(Params p, int l) {
  extern __shared__ __attribute__((aligned(16))) char smem[];
  if (S < 0) phase_prologue(p, blockIdx.x, gridDim.x, smem);
  else run_stage<(S < 0 ? 0 : S)>(p, l, blockIdx.x, gridDim.x, smem);
}

template <int S>
static void launch_stage(const Params& p, int l, int grid, hipStream_t stream) {
  (void)hipFuncSetAttribute((const void*)stage_kernel<S>, hipFuncAttributeMaxDynamicSharedMemorySize, LDS_BYTES);
  hipLaunchKernelGGL(stage_kernel<S>, dim3(grid), dim3(NTHR), LDS_BYTES, stream, p, l);
}

#endif

extern "C" void kernel_launch(void* const* d_in, const int* in_sizes, int n_in, void* d_out, int out_size, void* d_ws,
                              size_t ws_size, hipStream_t stream) {
  static int grid = 0;
  if (grid == 0) {
    if (ws_size < WS_END || n_in != 31) { fprintf(stderr, "kernel_launch: ws %zu < %zu or n_in %d\n", ws_size, (size_t)WS_END, n_in); grid = -1; return; }
    int dev = 0, cus = 0, per_cu = 0;
    (void)hipGetDevice(&dev);
    (void)hipDeviceGetAttribute(&cus, hipDeviceAttributeMultiprocessorCount, dev);
#if ONE_LAUNCH
    (void)hipFuncSetAttribute((const void*)mega, hipFuncAttributeMaxDynamicSharedMemorySize, LDS_BYTES);
    (void)hipOccupancyMaxActiveBlocksPerMultiprocessor(&per_cu, (const void*)mega, NTHR, LDS_BYTES);
#else
    (void)hipFuncSetAttribute((const void*)stage_kernel<3>, hipFuncAttributeMaxDynamicSharedMemorySize, LDS_BYTES);
    (void)hipOccupancyMaxActiveBlocksPerMultiprocessor(&per_cu, (const void*)stage_kernel<3>, NTHR, LDS_BYTES);
#endif
    if (per_cu < 1) per_cu = 1;
    if (per_cu > 2) per_cu = 2;
    grid = cus * per_cu;
  }
  if (grid < 0) return;
  (void)hipMemsetAsync((char*)d_ws + OFF_CTR, 0, 256 + 3456 * 4, stream);
  Params p{};
  for (int i = 0; i < 31; ++i) p.in[i] = (const float*)d_in[i];
  p.out = (float*)d_out;
  p.ws = (unsigned char*)d_ws;
#if ONE_LAUNCH
  void* args[] = {&p};
  hipError_t e = hipLaunchCooperativeKernel((const void*)mega, dim3(grid), dim3(NTHR), args, LDS_BYTES, stream);
  if (e != hipSuccess) fprintf(stderr, "cooperative launch failed: %s (grid %d)\n", hipGetErrorString(e), grid);
#else
  launch_stage<-1>(p, 0, grid, stream);
  for (int l = 0; l < 2; ++l) {
    launch_stage<0>(p, l, grid, stream);
    launch_stage<1>(p, l, grid, stream);
    launch_stage<2>(p, l, grid, stream);
    launch_stage<3>(p, l, grid, stream);
    launch_stage<4>(p, l, grid, stream);
    launch_stage<5>(p, l, grid, stream);
    launch_stage<6>(p, l, grid, stream);
    launch_stage<7>(p, l, grid, stream);
    launch_stage<8>(p, l, grid, stream);
    launch_stage<9>(p, l, grid, stream);
  }
#endif
}
```

```cpp
#include <hip/hip_runtime.h>
#include <hip/hip_cooperative_groups.h>
#include <cstdio>
namespace cg = cooperative_groups;

#ifndef PH_MASK
#define PH_MASK 0xFFFF
#endif
#ifndef PEER_REPS
#define PEER_REPS 1
#endif
#ifndef EXTRA_SYNCS
#define EXTRA_SYNCS 0
#endif
#ifndef REP_MASK
#define REP_MASK 0
#endif
#ifndef ONE_LAUNCH
#define ONE_LAUNCH 1
#endif

typedef unsigned short u16;
typedef unsigned int u32;
typedef __attribute__((ext_vector_type(8))) short bf16x8;
typedef __attribute__((ext_vector_type(16))) float f32x16;
typedef __attribute__((ext_vector_type(4))) float f32x4;
typedef __attribute__((ext_vector_type(2))) float f32x2;
typedef __attribute__((ext_vector_type(4))) unsigned int u32x4;
#define DI __device__ __forceinline__
DI int TID() { int t = threadIdx.x; asm volatile("" : "+v"(t)); return t; }

DI u16 f2bf(float x) { u32 u = __float_as_uint(x); u += 0x7fffu + ((u >> 16) & 1u); return (u16)(u >> 16); }
DI float bf2f(u16 v) { return __uint_as_float(((u32)v) << 16); }
DI u32 pack2(float a, float b) { return (u32)f2bf(a) | ((u32)f2bf(b) << 16); }
DI float bflo(u32 v) { return __uint_as_float(v << 16); }
DI float bfhi(u32 v) { return __uint_as_float(v & 0xffff0000u); }

constexpr int D = 1024, NB = 16, SEQ = 2048, CTXL = 256, TPB = 2304, ROWS = NB * TPB;
constexpr int NIN = 2944;
constexpr int RSTR = 4112;
constexpr int NTHR = 256;
constexpr int LDS_BYTES = 73728;
constexpr float EPSF = 1e-6f;

constexpr size_t SZ_PHY = (size_t)ROWS * 768 * 2, SZ_PZ = (size_t)ROWS * 512 * 2, SZ_PXBC = (size_t)ROWS * 1024 * 2;
constexpr size_t OFF_PHY = 0;
constexpr size_t OFF_PZ = OFF_PHY + SZ_PHY;
constexpr size_t OFF_PXBC = OFF_PZ + SZ_PZ;
constexpr size_t OFF_Q = OFF_PHY;
constexpr size_t OFF_ACT = OFF_PXBC + SZ_PXBC;
constexpr size_t OFF_XBCA = OFF_ACT + (size_t)ROWS * 1024 * 2;
constexpr size_t OFF_DREG = OFF_XBCA + (size_t)ROWS * 1024 * 2;
constexpr size_t OFF_PQT = OFF_DREG;
constexpr size_t OFF_UT = OFF_PQT + (size_t)NB * 512 * TPB * 2;
constexpr size_t OFF_X1C = OFF_UT + (size_t)256 * 16 * TPB * 2;
constexpr size_t OFF_TV = OFF_DREG;
constexpr size_t OFF_TI = OFF_TV + (size_t)ROWS * 256 * 4;
constexpr size_t OFF_XC = OFF_DREG + (size_t)ROWS * 256 * 8;
constexpr size_t OFF_WIN = OFF_XC + (size_t)NB * CTXL * D * 4;
constexpr size_t OFF_WOUT = OFF_WIN + (size_t)2 * NIN * 1024 * 2;
constexpr size_t OFF_WQ = OFF_WOUT + (size_t)2 * 1024 * 1024 * 2;
constexpr size_t OFF_K12 = OFF_WQ + (size_t)2 * 2048 * 1024 * 2;
constexpr size_t OFF_DFT = OFF_K12 + (size_t)2 * 2 * 128 * 128 * 2;
constexpr size_t OFF_DFTC = OFF_DFT + (size_t)2048 * 4096 * 2;
constexpr size_t OFF_RF = OFF_DFTC + (size_t)256 * 512 * 2;
constexpr size_t OFF_PART = OFF_RF + (size_t)3 * 256 * 2 * RSTR * 2;
constexpr size_t OFF_MOD = OFF_PART + (size_t)3 * 32 * 256 * 4;
constexpr size_t OFF_DT = OFF_MOD + (size_t)2 * 17 * 6144 * 4;
constexpr size_t OFF_CTR = OFF_DT + (size_t)ROWS * 16 * 4;
constexpr size_t OFF_BAR = OFF_CTR + 256;
constexpr size_t OFF_TX = OFF_BAR + 3456 * 4;
constexpr size_t WS_END = OFF_TX + (size_t)NB * 768 * TPB * 2;

struct Params {
  const float* in[31];
  float* out;
  unsigned char* ws;
  int pad0, pad1;
};

enum { I_X = 0, I_C, I_CTX, I_CCTX, I_WADA, I_BADA, I_G1, I_G2, I_WIN, I_HYCW, I_HYCB, I_HFW1, I_HFB1, I_HFW2, I_HFB2,
       I_HFW3, I_HFFREQ, I_HYBIAS, I_SCW, I_SCB, I_SDTB, I_SALOG, I_SD, I_SNG, I_WOUT, I_WQ, I_K1, I_K2, I_PU, I_PV, I_GF };

__device__ const unsigned char CAND_A[56] = {0, 0, 0, 0, 0, 0, 0, 0, 0, 0, 0, 0, 0, 0, 0, 0, 1, 1, 1, 1, 1, 1, 1, 1, 2, 2, 2, 2, 2, 3, 3, 3, 3, 4, 4, 4, 5, 5, 6, 6, 7, 7, 8, 9, 10, 11, 12, 13, 14, 15, 0, 0, 0, 0, 0, 0};
__device__ const unsigned char CAND_B[56] = {0, 1, 2, 3, 4, 5, 6, 7, 8, 9, 10, 11, 12, 13, 14, 15, 0, 1, 2, 3, 4, 5, 6, 7, 0, 1, 2, 3, 4, 0, 1, 2, 3, 0, 1, 2, 0, 1, 0, 1, 0, 1, 0, 0, 0, 0, 0, 0, 0, 0, 0, 0, 0, 0, 0, 0};

#define WSP(T, off) ((T*)(p.ws + (off)))

#define XB_TMO      128
#define XB_XCNT(j)  (256  + 64 * (j))
#define XB_XSUB(j)  (1280 + 64 * (j))
#define XB_XGEN(j)  (2304 + 64 * (j))
#define XB_TOP      3328
#define XB_TOPGEN   3392
#define XCD_BAR_WORDS 3456
#define XB_SPIN_CAP (1u << 18)
#define LAS __attribute__((address_space(3)))
DI unsigned xb_ld(unsigned* p) { return __hip_atomic_load(p, __ATOMIC_RELAXED, __HIP_MEMORY_SCOPE_AGENT); }
DI unsigned xb_add(unsigned* p, unsigned v) { return __hip_atomic_fetch_add(p, v, __ATOMIC_RELAXED, __HIP_MEMORY_SCOPE_AGENT); }
DI unsigned xb_xcc_id() { return (unsigned)__builtin_amdgcn_s_getreg((3 << 11) | 20) & 0xFu; }
#define XB_SPIN(cond, bar) do { unsigned _sp = 0; while (cond) { __builtin_amdgcn_s_sleep(1); \
    if ((++_sp & 255u) == 0u) { if (xb_ld(&(bar)[XB_TMO])) break; if (_sp > XB_SPIN_CAP) { atomicAdd(&(bar)[XB_TMO], 1u); break; } } } } while (0)
struct XcdBarrier { unsigned* bar; unsigned x; volatile LAS unsigned* st; };
DI XcdBarrier xcd_barrier_post(unsigned* bar, volatile LAS unsigned* st) {
  XcdBarrier b; b.bar = bar; b.x = xb_xcc_id(); b.st = st;
  if (threadIdx.x == 0) (void)xb_add(&bar[XB_XCNT(b.x)], 1u);
  return b;
}
DI void xcd_barrier_complete(unsigned* bar, unsigned x, unsigned& nloc, unsigned& nx) {
  const unsigned G = gridDim.x * gridDim.y * gridDim.z;
  unsigned sum, cnt, mine, sp = 0u;
  for (;;) {
    sum = 0u; cnt = 0u; mine = 0u;
#pragma unroll
    for (unsigned j = 0; j < 16; ++j) { const unsigned c = xb_ld(&bar[XB_XCNT(j)]); sum += c; cnt += (c > 0u) ? 1u : 0u; mine = (j == x) ? c : mine; }
    if (sum == G) break;
    __builtin_amdgcn_s_sleep(1);
    if ((++sp & 255u) == 0u) { if (xb_ld(&bar[XB_TMO])) break; if (sp > XB_SPIN_CAP) { atomicAdd(&bar[XB_TMO], 1u); break; } }
  }
  nloc = mine > 0u ? mine : 1u; nx = cnt > 0u ? cnt : 1u;
}
DI void xcd_barrier(const XcdBarrier& b) {
  asm volatile("s_waitcnt vmcnt(0)" ::: "memory");
  __syncthreads();
  if (threadIdx.x == 0) {
    unsigned* bar = b.bar;
    __builtin_amdgcn_s_waitcnt(0);
    unsigned nloc = b.st[0], nx = b.st[1];
    if (nloc == 0u) { xcd_barrier_complete(bar, b.x, nloc, nx); b.st[0] = nloc; b.st[1] = nx; }
    const unsigned old = xb_add(&bar[XB_XSUB(b.x)], 1u);
    const unsigned gen = old / nloc;
    if (old + 1u == (gen + 1u) * nloc) {
      __builtin_amdgcn_fence(__ATOMIC_RELEASE, "agent");
      asm volatile("s_waitcnt vmcnt(0)" ::: "memory");
      const unsigned og = xb_add(&bar[XB_TOP], 1u);
      const unsigned tg = og / nx;
      if (og + 1u == (tg + 1u) * nx) xb_add(&bar[XB_TOPGEN], 1u);
      else XB_SPIN(xb_ld(&bar[XB_TOPGEN]) == tg, bar);
      __builtin_amdgcn_fence(__ATOMIC_ACQUIRE, "agent");
      xb_add(&bar[XB_XGEN(b.x)], 1u);
      asm volatile("s_waitcnt vmcnt(0)" ::: "memory");
    } else {
      XB_SPIN(xb_ld(&bar[XB_XGEN(b.x)]) == gen, bar);
      __builtin_amdgcn_fence(__ATOMIC_ACQUIRE, "agent");
      asm volatile("s_waitcnt vmcnt(0)" ::: "memory");
    }
  }
  __syncthreads();
}


template <bool SWAP, int MI, class AF, class BF, class EF>
DI void gemm_tile(const AF& af, const BF& bfn, const EF& ef, int m0, int n0, int K, char* smem) {
  constexpr int AROWS = MI * 64;
  u16* As = (u16*)smem;
  u16* Bs = As + 2 * AROWS * 40;
  const int tid = TID(), lane = tid & 63, w = tid >> 6;
  const int wm = w >> 1, wn = w & 1, l32 = lane & 31, h = lane >> 5;
  const int lrow = (tid >> 6) * 16 + ((tid >> 5) & 1) * 8 + ((tid >> 2) & 1) * 4 + ((tid >> 3) & 3), lk = (tid & 3) * 8;
  f32x16 acc[MI][2];
#pragma unroll
  for (int i = 0; i < MI; ++i)
#pragma unroll
    for (int j = 0; j < 2; ++j)
#pragma unroll
      for (int r = 0; r < 16; ++r) acc[i][j][r] = 0.f;
  u32x4 ra[MI], rb[2];
  const int nk = K >> 5;
#pragma unroll
  for (int i = 0; i < MI; ++i) ra[i] = *(const u32x4*)af(m0 + lrow + 64 * i, lk);
#pragma unroll
  for (int i = 0; i < 2; ++i) rb[i] = *(const u32x4*)bfn(n0 + lrow + 64 * i, lk);
#pragma unroll
  for (int i = 0; i < MI; ++i) *(u32x4*)&As[(lrow + 64 * i) * 40 + lk] = ra[i];
#pragma unroll
  for (int i = 0; i < 2; ++i) *(u32x4*)&Bs[(lrow + 64 * i) * 40 + lk] = rb[i];
  {
    const int k1 = (nk > 1) ? 32 + lk : lk;
#pragma unroll
    for (int i = 0; i < MI; ++i) ra[i] = *(const u32x4*)af(m0 + lrow + 64 * i, k1);
#pragma unroll
    for (int i = 0; i < 2; ++i) rb[i] = *(const u32x4*)bfn(n0 + lrow + 64 * i, k1);
  }
  __syncthreads();
  for (int kt = 0; kt < nk; ++kt) {
    const int cur = kt & 1;
    const u16* Ab = As + cur * AROWS * 40;
    const u16* Bb = Bs + cur * 128 * 40;
#pragma unroll
    for (int ks = 0; ks < 2; ++ks) {
      bf16x8 a[MI], b[2];
#pragma unroll
      for (int i = 0; i < MI; ++i) a[i] = *(const bf16x8*)&Ab[(wm * (MI * 32) + i * 32 + l32) * 40 + ks * 16 + h * 8];
#pragma unroll
      for (int i = 0; i < 2; ++i) b[i] = *(const bf16x8*)&Bb[(wn * 64 + i * 32 + l32) * 40 + ks * 16 + h * 8];
#pragma unroll
      for (int i = 0; i < MI; ++i)
#pragma unroll
        for (int j = 0; j < 2; ++j)
          acc[i][j] = SWAP ? __builtin_amdgcn_mfma_f32_32x32x16_bf16(b[j], a[i], acc[i][j], 0, 0, 0)
                           : __builtin_amdgcn_mfma_f32_32x32x16_bf16(a[i], b[j], acc[i][j], 0, 0, 0);
    }
    {
      u16* An = As + (cur ^ 1) * AROWS * 40;
      u16* Bn = Bs + (cur ^ 1) * 128 * 40;
#pragma unroll
      for (int i = 0; i < MI; ++i) *(u32x4*)&An[(lrow + 64 * i) * 40 + lk] = ra[i];
#pragma unroll
      for (int i = 0; i < 2; ++i) *(u32x4*)&Bn[(lrow + 64 * i) * 40 + lk] = rb[i];
      const int kn = (kt + 2 < nk) ? kt + 2 : nk - 1;
      const int k0 = kn * 32 + lk;
#pragma unroll
      for (int i = 0; i < MI; ++i) ra[i] = *(const u32x4*)af(m0 + lrow + 64 * i, k0);
#pragma unroll
      for (int i = 0; i < 2; ++i) rb[i] = *(const u32x4*)bfn(n0 + lrow + 64 * i, k0);
    }
    __syncthreads();
  }
#pragma unroll
  for (int i = 0; i < MI; ++i)
#pragma unroll
    for (int j = 0; j < 2; ++j)
#pragma unroll
      for (int rg = 0; rg < 4; ++rg) {
        const int m = SWAP ? (m0 + wm * (MI * 32) + i * 32 + l32) : (m0 + wm * (MI * 32) + i * 32 + rg * 8 + h * 4);
        const int n = SWAP ? (n0 + wn * 64 + j * 32 + rg * 8 + h * 4) : (n0 + wn * 64 + j * 32 + l32);
        ef(m, n, acc[i][j][rg * 4 + 0], acc[i][j][rg * 4 + 1], acc[i][j][rg * 4 + 2], acc[i][j][rg * 4 + 3]);
      }
}

template <int CTRL> DI int dpp_i(int v) { return __builtin_amdgcn_mov_dpp(v, CTRL, 0xF, 0xF, true); }
template <int CTRL> DI float dpp_f(float v) { return __builtin_bit_cast(float, __builtin_amdgcn_mov_dpp(__builtin_bit_cast(int, v), CTRL, 0xF, 0xF, true)); }
#define DPP_XOR1 0xB1
#define DPP_XOR2 0x4E
#define DPP_MIRROR8 0x141
DI float wave_sum(float v) {
#pragma unroll
  for (int o = 32; o >= 1; o >>= 1) v += __shfl_xor(v, o);
  return v;
}
DI float silu_f(float x) { return x / (1.f + __expf(-x)); }
DI float gelu_tanh(float x) {
  const float u = 0.7978845608028654f * (x + 0.044715f * x * x * x);
  return 0.5f * x * (1.f + tanhf(u));
}

DI const float* xrow_ptr(const Params& p, bool from_input, int b, int pos) {
  if (pos < CTXL) return (from_input ? p.in[I_CTX] : WSP(const float, OFF_XC)) + ((size_t)b * CTXL + pos) * D;
  return (from_input ? p.in[I_X] : (const float*)p.out) + ((size_t)b * SEQ + (pos - CTXL)) * D;
}
DI float* xrow_wptr(const Params& p, int b, int pos) {
  if (pos < CTXL) return WSP(float, OFF_XC) + ((size_t)b * CTXL + pos) * D;
  return p.out + ((size_t)b * SEQ + (pos - CTXL)) * D;
}

DI void phase_prologue(const Params& p, int bid, int nblk, char* smem) {
  const int tid = TID();
  const int gtid = bid * NTHR + tid, gn = nblk * NTHR;
  {
    float* scs = (float*)smem;
    for (int it = bid; it < 192; it += nblk) {
      const int l = it / 96, col0 = (it % 96) * 64;
      for (int e = tid; e < 17 * 1024; e += NTHR) {
        const int j = e >> 10, k = e & 1023;
        const float v = (j < 16) ? p.in[I_C][j * 1024 + k] : p.in[I_CCTX][k];
        scs[e] = v / (1.f + expf(-v));
      }
      __syncthreads();
      const int col = tid & 63, kq = tid >> 6;
      float acc[17];
#pragma unroll
      for (int j = 0; j < 17; ++j) acc[j] = 0.f;
      const float* wa = p.in[I_WADA] + (size_t)l * 1024 * 6144 + col0 + col;
      for (int k0 = kq * 256; k0 < kq * 256 + 256; k0 += 8) {
        float wv[8];
#pragma unroll
        for (int kk = 0; kk < 8; ++kk) wv[kk] = wa[(size_t)(k0 + kk) * 6144];
#pragma unroll
        for (int kk = 0; kk < 8; ++kk)
#pragma unroll
          for (int j = 0; j < 17; ++j) acc[j] += scs[j * 1024 + k0 + kk] * wv[kk];
      }
      __syncthreads();
#pragma unroll
      for (int j = 0; j < 17; ++j) scs[(kq * 17 + j) * 64 + col] = acc[j];
      __syncthreads();
      for (int e = tid; e < 17 * 64; e += NTHR) {
        const int j = e >> 6, cc = e & 63;
        float s = p.in[I_BADA][l * 6144 + col0 + cc];
#pragma unroll
        for (int q = 0; q < 4; ++q) s += scs[(q * 17 + j) * 64 + cc];
        WSP(float, OFF_MOD)[(size_t)(l * 17 + j) * 6144 + col0 + cc] = s;
      }
      __syncthreads();
    }
  }
  {
    float* zs = (float*)smem;
    float* h1s = zs + 64 * 33;
    float* h2s = h1s + 64 * 64;
    for (int it = (nblk >= 260 ? (bid >= 192 ? bid - 192 : 1 << 20) : bid); it < 68; it += nblk) {
      const int f = it < 32 ? 0 : (it < 64 ? 1 : 2);
      const int tile = it - (f == 0 ? 0 : (f == 1 ? 32 : 64));
      const int L = (f == 2) ? 256 : 2048;
      const int lyr = (f == 1) ? 1 : 0;
      const int pos0 = tile * 64;
      const float* w1 = p.in[I_HFW1] + lyr * 33 * 64;
      const float* b1 = p.in[I_HFB1] + lyr * 64;
      const float* w2 = p.in[I_HFW2] + lyr * 64 * 64;
      const float* b2 = p.in[I_HFB2] + lyr * 64;
      const float* w3 = p.in[I_HFW3] + lyr * 64 * 512;
      const float* fq = p.in[I_HFFREQ] + lyr * 64;
      for (int e = tid; e < 64 * 33; e += NTHR) {
        const int pi = e / 33, q = e % 33;
        const int pos = pos0 + pi;
        const float tt = (float)pos / (float)(L - 1);
        const float wv = 6.283185307179586f * (float)pos / (float)L;
        float z;
        if (q == 0) z = tt;
        else if (q <= 16) { const float fi = 1e-4f + (float)(q - 1) * ((15.f - 1e-4f) / 15.f); z = cosf(fi * wv); }
        else { const float fi = 1e-4f + (float)(q - 17) * ((15.f - 1e-4f) / 15.f); z = -sinf(fi * wv); }
        zs[e] = z;
      }
      __syncthreads();
      for (int e = tid; e < 64 * 64; e += NTHR) {
        const int pi = e >> 6, j = e & 63;
        float s = b1[j];
        for (int q = 0; q < 33; ++q) s += zs[pi * 33 + q] * w1[q * 64 + j];
        h1s[e] = sinf(fq[j] * s);
      }
      __syncthreads();
      for (int e = tid; e < 64 * 64; e += NTHR) {
        const int pi = e >> 6, j = e & 63;
        float s = b2[j];
        for (int k = 0; k < 64; ++k) s += h1s[pi * 64 + k] * w2[k * 64 + j];
        h2s[e] = sinf(fq[j] * s);
      }
      __syncthreads();
      {
        const int c = tid;
        const float mind = logf(1e-2f) / 1.5f, maxd = logf(1e-2f) / 0.3f;
        const float delta = fabsf(mind + (float)c * ((maxd - mind) / 255.f));
        u16* R0 = WSP(u16, OFF_RF) + ((size_t)(f * 256 + c) * 2 + 0) * RSTR;
        u16* R1 = R0 + RSTR;
        float ssq = 0.f;
        for (int pb = 0; pb < 4; ++pb) {
          float af_[16], ab_[16];
#pragma unroll
          for (int i = 0; i < 16; ++i) { af_[i] = 0.f; ab_[i] = 0.f; }
          for (int k = 0; k < 64; ++k) {
            const float wf = w3[k * 512 + c], wb = w3[k * 512 + 256 + c];
#pragma unroll
            for (int i = 0; i < 16; ++i) {
              const float hv = h2s[(pb * 16 + i) * 64 + k];
              af_[i] += hv * wf;
              ab_[i] += hv * wb;
            }
          }
#pragma unroll
          for (int i = 0; i < 16; ++i) {
            const int pos = pos0 + pb * 16 + i;
            const float tt = (float)pos / (float)(L - 1);
            const float win = expf(-tt * delta);
            const float vf = af_[i] * win, vb = ab_[i] * win;
            const u16 bfv = f2bf(vf), bbv = f2bf(vb);
            R0[L - pos] = bfv;
            R1[L - pos - 1] = bfv;
            ssq += vf * vf;
            if (pos >= 1) {
              R0[L + pos] = bbv;
              R1[L + pos - 1] = bbv;
              ssq += vb * vb;
            }
          }
        }
        WSP(float, OFF_PART)[(size_t)(f * 32 + tile) * 256 + c] = ssq;
      }
      __syncthreads();
    }
  }
  for (int e = gtid; e < 2 * NIN * 128; e += gn) {
    const int l = e / (NIN * 128);
    const int r = e % (NIN * 128);
    const int kc = r / NIN, n = r % NIN;
    const int k0 = kc * 8;
    const float* wsrc = p.in[I_WIN] + (size_t)l * 1024 * 2576;
    float v[8];
    if (n < 2304) {
#pragma unroll
      for (int j = 0; j < 8; ++j) v[j] = wsrc[(size_t)(k0 + j) * 2576 + n];
    } else if (n < 2816) {
      const int np = n - 2304, g = np >> 7, rr = np & 127, pq = rr >> 6, kk = rr & 63;
#pragma unroll
      for (int j = 0; j < 8; ++j) v[j] = 0.f;
      for (int jj = 0; jj < 64; ++jj) {
        const float ang = 6.283185307179586f * (float)((jj * kk) & 63) / 64.f;
        const float tr = pq ? sinf(ang) : cosf(ang);
#pragma unroll
        for (int j = 0; j < 8; ++j) v[j] += wsrc[(size_t)(k0 + j) * 2576 + 2320 + g * 64 + jj] * tr;
      }
    } else if (n < 2832) {
#pragma unroll
      for (int j = 0; j < 8; ++j) v[j] = wsrc[(size_t)(k0 + j) * 2576 + 2304 + (n - 2816)];
    } else {
#pragma unroll
      for (int j = 0; j < 8; ++j) v[j] = 0.f;
    }
    uint4 o = {pack2(v[0], v[1]), pack2(v[2], v[3]), pack2(v[4], v[5]), pack2(v[6], v[7])};
    *(uint4*)&WSP(u16, OFF_WIN)[((size_t)l * NIN + n) * 1024 + k0] = o;
  }
  for (int e = gtid; e < 2 * 1024 * 128; e += gn) {
    const int l = e / (1024 * 128), r = e % (1024 * 128), kc = r / 1024, n = r % 1024, k0 = kc * 8;
    const float* wsrc = p.in[I_WOUT] + (size_t)l * 1024 * 1024;
    float v[8];
#pragma unroll
    for (int j = 0; j < 8; ++j) v[j] = wsrc[(size_t)(k0 + j) * 1024 + n];
    uint4 o = {pack2(v[0], v[1]), pack2(v[2], v[3]), pack2(v[4], v[5]), pack2(v[6], v[7])};
    *(uint4*)&WSP(u16, OFF_WOUT)[((size_t)l * 1024 + n) * 1024 + k0] = o;
  }
  for (int e = gtid; e < 2 * 2048 * 128; e += gn) {
    const int l = e / (2048 * 128), r = e % (2048 * 128), kc = r / 2048, n = r % 2048, k0 = kc * 8;
    const float* wsrc = p.in[I_WQ] + (size_t)l * 1024 * 2048;
    float v[8];
#pragma unroll
    for (int j = 0; j < 8; ++j) v[j] = wsrc[(size_t)(k0 + j) * 2048 + n];
    uint4 o = {pack2(v[0], v[1]), pack2(v[2], v[3]), pack2(v[4], v[5]), pack2(v[6], v[7])};
    *(uint4*)&WSP(u16, OFF_WQ)[((size_t)l * 2048 + n) * 1024 + k0] = o;
  }
  for (int e = gtid; e < 2 * 2 * 128 * 128; e += gn) {
    const int l = e / (2 * 16384), r = e % (2 * 16384), which = r / 16384, i = r % 16384;
    const float v = (which ? p.in[I_K2] : p.in[I_K1])[l * 16384 + i];
    WSP(u16, OFF_K12)[e] = f2bf(v);
  }
  for (int e = gtid; e < 2048 * 512; e += gn) {
    const int tp = e >> 9, k0 = (e & 511) * 8;
    const float s = 1.f / sqrtf(2048.f * 64.f);
    float v[8];
#pragma unroll
    for (int j = 0; j < 8; ++j) {
      const int k = k0 + j, t = k & 2047;
      const float ang = 6.283185307179586f * (float)((tp * t) & 2047) / 2048.f;
      v[j] = (k < 2048) ? cosf(ang) * s : -sinf(ang) * s;
    }
    uint4 o = {pack2(v[0], v[1]), pack2(v[2], v[3]), pack2(v[4], v[5]), pack2(v[6], v[7])};
    *(uint4*)&WSP(u16, OFF_DFT)[(size_t)tp * 4096 + k0] = o;
  }
  for (int e = gtid; e < 256 * 64; e += gn) {
    const int tp = e >> 6, k0 = (e & 63) * 8;
    const float s = 1.f / sqrtf(256.f * 64.f);
    float v[8];
#pragma unroll
    for (int j = 0; j < 8; ++j) {
      const int k = k0 + j, t = k & 255;
      const float ang = 6.283185307179586f * (float)((tp * t) & 255) / 256.f;
      v[j] = (k < 256) ? cosf(ang) * s : -sinf(ang) * s;
    }
    uint4 o = {pack2(v[0], v[1]), pack2(v[2], v[3]), pack2(v[4], v[5]), pack2(v[6], v[7])};
    *(uint4*)&WSP(u16, OFF_DFTC)[(size_t)tp * 512 + k0] = o;
  }
}

DI void phase_norm(const Params& p, int l, int which, int bid, int nblk) {
  const int lane = TID() & 63, w = TID() >> 6;
  const float* g = (which ? p.in[I_G2] : p.in[I_G1]) + l * 1024;
  const bool from_input = (which == 0 && l == 0);
  for (int row = bid * 4 + w; row < ROWS; row += nblk * 4) {
    const int b = row / TPB, pos = row % TPB;
    if (which == 1 && l == 1 && pos < CTXL) continue;
    const float* xr = xrow_ptr(p, from_input, b, pos);
    const float* mod = WSP(const float, OFF_MOD) + (size_t)(l * 17 + (pos < CTXL ? 16 : b)) * 6144 + which * 3072;
    float x[16];
#pragma unroll
    for (int hh = 0; hh < 2; ++hh) {
      const float4 a = *(const float4*)(xr + hh * 512 + lane * 8);
      const float4 c = *(const float4*)(xr + hh * 512 + lane * 8 + 4);
      x[hh * 8 + 0] = a.x; x[hh * 8 + 1] = a.y; x[hh * 8 + 2] = a.z; x[hh * 8 + 3] = a.w;
      x[hh * 8 + 4] = c.x; x[hh * 8 + 5] = c.y; x[hh * 8 + 6] = c.z; x[hh * 8 + 7] = c.w;
    }
    float ss = 0.f;
#pragma unroll
    for (int i = 0; i < 16; ++i) ss += x[i] * x[i];
    ss = wave_sum(ss);
    const float rs = rsqrtf(ss * (1.f / 1024.f) + EPSF);
#pragma unroll
    for (int hh = 0; hh < 2; ++hh) {
      const int c0 = hh * 512 + lane * 8;
      float y[8];
#pragma unroll
      for (int i = 0; i < 8; ++i) {
        const float yn = x[hh * 8 + i] * rs * g[c0 + i];
        y[i] = yn * (1.f + mod[1024 + c0 + i]) + mod[c0 + i];
      }
      uint4 o = {pack2(y[0], y[1]), pack2(y[2], y[3]), pack2(y[4], y[5]), pack2(y[6], y[7])};
      *(uint4*)&WSP(u16, OFF_ACT)[(size_t)row * 1024 + c0] = o;
    }
  }
}

constexpr float U_SCALE = 64.f, V_SCALE = 4.f;
DI void phase_tables(const Params& p, int l, int bid, int nblk) {
  const int gtid = bid * NTHR + TID(), gn = nblk * NTHR;
  unsigned char* dst = WSP(unsigned char, OFF_XBCA);
  for (int e = gtid; e < 2 * 16384 * 64; e += gn) {
    const int which = e / (16384 * 64), r = e % (16384 * 64);
    const float sc = which ? V_SCALE : U_SCALE;
    const float* src = (which ? p.in[I_PV] : p.in[I_PU]) + (size_t)l * 16384 * 1024 + (size_t)r * 16;
    u32 o[4];
#pragma unroll
    for (int q = 0; q < 4; ++q) {
      const float4 a = *(const float4*)(src + q * 4);
      int v = __builtin_amdgcn_cvt_pk_fp8_f32(a.x * sc, a.y * sc, 0, false);
      v = __builtin_amdgcn_cvt_pk_fp8_f32(a.z * sc, a.w * sc, v, true);
      o[q] = (u32)v;
    }
    uint4 ov = {o[0], o[1], o[2], o[3]};
    *(uint4*)&dst[(size_t)e * 16] = ov;
  }
}

DI void phase_inproj(const Params& p, int l, int bid, int nblk, char* smem) {
  const u16* A = WSP(const u16, OFF_ACT);
  const u16* B = WSP(const u16, OFF_WIN) + (size_t)l * NIN * 1024;
  u16* PHY = WSP(u16, OFF_PHY);
  u16* PZ = WSP(u16, OFF_PZ);
  u16* PXBC = WSP(u16, OFF_PXBC);
  u16* PQT = WSP(u16, OFF_PQT);
  float* DT = WSP(float, OFF_DT);
  auto af = [=](int m, int k) { return A + (size_t)m * 1024 + k; };
  auto bfn = [=](int n, int k) { return B + (size_t)n * 1024 + k; };
  auto efT = [=](int m, int n, float v0, float v1, float v2, float v3) {
    const uint2 o = {pack2(v0, v1), pack2(v2, v3)};
    if (n < 768) *(uint2*)&PHY[(size_t)m * 768 + n] = o;
    else if (n < 1280) *(uint2*)&PZ[(size_t)m * 512 + (n - 768)] = o;
    else if (n < 2304) *(uint2*)&PXBC[(size_t)m * 1024 + (n - 1280)] = o;
    else if (n >= 2816 && n < 2832) { float4 f = {v0, v1, v2, v3}; *(float4*)&DT[(size_t)m * 16 + (n - 2816)] = f; }
  };
  auto efN = [=](int m, int n, float v0, float v1, float v2, float v3) {
    const int b = m / TPB, pos = m % TPB, np = n - 2304;
    uint2 o = {pack2(v0, v1), pack2(v2, v3)};
    *(uint2*)&PQT[((size_t)(b * 512 + np)) * TPB + pos] = o;
  };
  const int ntile = (ROWS / 256) * (NIN / 128);
  const int vb = (nblk % 8 == 0) ? (bid & 7) * (nblk >> 3) + (bid >> 3) : bid;
  for (int t = vb; t < ntile; t += nblk) {
    const int mt = t / (NIN / 128), nt = t % (NIN / 128);
    if (nt >= 18 && nt < 22) gemm_tile<false, 4>(af, bfn, efN, mt * 256, nt * 128, 1024, smem);
    else gemm_tile<true, 4>(af, bfn, efT, mt * 256, nt * 128, 1024, smem);
  }
}

DI void unpack8(const uint4& v, float* f) {
  f[0] = bflo(v.x); f[1] = bfhi(v.x); f[2] = bflo(v.y); f[3] = bfhi(v.y);
  f[4] = bflo(v.z); f[5] = bfhi(v.z); f[6] = bflo(v.w); f[7] = bfhi(v.w);
}
DI void phase_prep(const Params& p, int l, int bid, int nblk, char* smem) {
  const int tid = TID();
  u16* tile = (u16*)smem;
  const u16* PHY = WSP(const u16, OFF_PHY);
  const u16* PXBC = WSP(const u16, OFF_PXBC);
  u16* UT = WSP(u16, OFF_UT);
  u16* X1C = WSP(u16, OFF_X1C);
  u16* XBCA = WSP(u16, OFF_XBCA);
  u16* TX = WSP(u16, OFF_TX);
  const float* hw = p.in[I_HYCW] + l * 3 * 768;
  const float* hb = p.in[I_HYCB] + l * 768;
  const float* sw = p.in[I_SCW] + l * 3 * 1024;
  const float* sb = p.in[I_SCB] + l * 1024;
  const int cg8 = (tid & 31) * 8, pg = tid >> 5;
  for (int it = bid; it < NB * 36 * 6; it += nblk) {
    const int pass = it % 6, bt = it / 6;
    const int b = bt / 36, pt = bt % 36, pos0 = pt * 64;
    const int seg_lo = (pos0 < CTXL) ? 0 : CTXL, seg_hi = (pos0 < CTXL) ? CTXL : TPB;
    const size_t rbase = (size_t)b * TPB;
    const int pfirst = pos0 + pg * 8;
    bool transposed = false;
    if (pass <= 1) {
      if (l == 1 && pos0 < CTXL) continue;
      float cv0[8][8];
#pragma unroll
      for (int sg = 0; sg < 2; ++sg) {
        if (pass == 0 && sg == 1) break;
        const int sgrp = (pass == 0) ? 1 : (sg == 0 ? 0 : 2);
        const int col = sgrp * 256 + cg8;
        float w0[8], w1[8], w2[8], bb[8];
#pragma unroll
        for (int e = 0; e < 8; ++e) { w0[e] = hw[col + e]; w1[e] = hw[768 + col + e]; w2[e] = hw[1536 + col + e]; bb[e] = hb[col + e]; }
        uint4 raw[10];
#pragma unroll
        for (int k = 0; k < 10; ++k) {
          const int pn = pfirst + k - 1;
          raw[k] = (pn >= seg_lo && pn < seg_hi) ? *(const uint4*)&PHY[(rbase + pn) * 768 + col] : make_uint4(0u, 0u, 0u, 0u);
        }
        float xm[8], x0[8], xp[8];
        unpack8(raw[0], xm);
        unpack8(raw[1], x0);
#pragma unroll
        for (int k = 0; k < 8; ++k) {
          unpack8(raw[k + 2], xp);
          float o[8];
#pragma unroll
          for (int e = 0; e < 8; ++e) {
            o[e] = w0[e] * xm[e] + w1[e] * x0[e] + w2[e] * xp[e] + bb[e];
            xm[e] = x0[e]; x0[e] = xp[e];
          }
          if (pass == 0) {
            uint4 o1 = {pack2(o[0], o[1]), pack2(o[2], o[3]), pack2(o[4], o[5]), pack2(o[6], o[7])};
            *(uint4*)&X1C[(rbase + pfirst + k) * 256 + cg8] = o1;
          } else if (sg == 0) {
#pragma unroll
            for (int e = 0; e < 8; ++e) cv0[k][e] = o[e];
          } else {
            uint4 ou = {pack2(o[0] * cv0[k][0], o[1] * cv0[k][1]), pack2(o[2] * cv0[k][2], o[3] * cv0[k][3]),
                        pack2(o[4] * cv0[k][4], o[5] * cv0[k][5]), pack2(o[6] * cv0[k][6], o[7] * cv0[k][7])};
            *(uint4*)&tile[(pg * 8 + k) * 264 + cg8] = ou;
          }
        }
      }
      transposed = (pass == 1);
    } else {
      const int col = (pass - 2) * 256 + cg8;
      float w0[8], w1[8], w2[8], bb[8];
#pragma unroll
      for (int e = 0; e < 8; ++e) { w0[e] = sw[col + e]; w1[e] = sw[1024 + col + e]; w2[e] = sw[2048 + col + e]; bb[e] = sb[col + e]; }
      uint4 raw[10];
#pragma unroll
      for (int k = 0; k < 10; ++k) {
        const int pn = pfirst + k - 1;
        raw[k] = (pn >= seg_lo && pn < seg_hi) ? *(const uint4*)&PXBC[(rbase + pn) * 1024 + col] : make_uint4(0u, 0u, 0u, 0u);
      }
      float xm[8], x0[8], xp[8];
      unpack8(raw[0], xm);
      unpack8(raw[1], x0);
#pragma unroll
      for (int k = 0; k < 8; ++k) {
        unpack8(raw[k + 2], xp);
        float o[8];
#pragma unroll
        for (int e = 0; e < 8; ++e) {
          o[e] = silu_f(w0[e] * xm[e] + w1[e] * x0[e] + w2[e] * xp[e] + bb[e]);
          xm[e] = x0[e]; x0[e] = xp[e];
        }
        uint4 ov = {pack2(o[0], o[1]), pack2(o[2], o[3]), pack2(o[4], o[5]), pack2(o[6], o[7])};
        *(uint4*)&XBCA[(rbase + pfirst + k) * 1024 + col] = ov;
        if (pass < 5) *(uint4*)&tile[(pg * 8 + k) * 264 + cg8] = ov;
      }
      transposed = pass < 5;
    }
    if (transposed) {
      __syncthreads();
      u16* dst = (pass == 1) ? (UT + ((size_t)(tid * 16 + b)) * TPB + pos0) : (TX + ((size_t)(b * 768 + (pass - 2) * 256 + tid)) * TPB + pos0);
#pragma unroll
      for (int pc = 0; pc < 8; ++pc) {
        u32 wv[4];
#pragma unroll
        for (int e = 0; e < 4; ++e)
          wv[e] = (u32)tile[(pc * 8 + 2 * e) * 264 + tid] | ((u32)tile[(pc * 8 + 2 * e + 1) * 264 + tid] << 16);
        uint4 o = {wv[0], wv[1], wv[2], wv[3]};
        *(uint4*)&dst[pc * 8] = o;
      }
      __syncthreads();
    }
  }
}

DI void ssd_item(const Params& p, int l, int it, char* smem) {
  const int tid = TID(), lane = tid & 63, w = tid >> 6, l32 = lane & 31, h = lane >> 5;
  const int b = it >> 4, hd = (it >> 1) & 7, dir = it & 1, g = hd >> 2;
  u16* BG = (u16*)smem;
  u16* HL = BG + 128 * 136;
  float* fa = (float*)(HL + 64 * 136);
  float* fdt = fa + 128;
  float* fsw = fdt + 128;
  float* fea = fsw + 128;
  float* ftot = fea + 128;
  const u16* XBCA = WSP(const u16, OFF_XBCA);
  const u16* TX = WSP(const u16, OFF_TX);
  const float* DT = WSP(const float, OFF_DT);
  u16* Y = WSP(u16, OFF_PXBC) + (dir ? (size_t)ROWS * 512 : 0);
  const float dtb = p.in[I_SDTB][l * 16 + dir * 8 + hd];
  const float a = -expf(p.in[I_SALOG][l * 16 + dir * 8 + hd]);
  const size_t rbase = (size_t)b * TPB;
  f32x16 Hacc[2];
#pragma unroll
  for (int i = 0; i < 2; ++i)
#pragma unroll
    for (int r = 0; r < 16; ++r) Hacc[i][r] = 0.f;
  for (int e = tid; e < 64 * 136; e += NTHR) HL[e] = 0;
  for (int ci = 0; ci < 18; ++ci) {
    const int pos0 = dir ? ((ci < 2) ? (1 - ci) * 128 : (CTXL + (17 - ci) * 128)) : ci * 128;
    asm volatile("s_waitcnt vmcnt(0)" ::: "memory");
    bf16x8 creg[8];
    const u16* cr = XBCA + (rbase + pos0 + w * 32 + l32) * 1024 + 768 + g * 128 + h * 8;
#pragma unroll
    for (int ks = 0; ks < 4; ++ks) creg[ks] = *(const bf16x8*)(cr + ks * 16);
    __builtin_amdgcn_sched_barrier(0);
#pragma unroll
    for (int i = 0; i < 8; ++i) {
      const int q = tid + 256 * i, j = q >> 4, ch = q & 15;
      *(uint4*)&BG[j * 136 + ch * 8] = *(const uint4*)&XBCA[(rbase + pos0 + j) * 1024 + 512 + g * 128 + ch * 8];
    }
    if (w == 0) {
      const float r0 = DT[(rbase + pos0 + 2 * lane) * 16 + dir * 8 + hd] + dtb;
      const float r1 = DT[(rbase + pos0 + 2 * lane + 1) * 16 + dir * 8 + hd] + dtb;
      const float dt0 = (r0 > 20.f) ? r0 : log1pf(expf(r0));
      const float dt1 = (r1 > 20.f) ? r1 : log1pf(expf(r1));
      const float a0 = dt0 * a, a1 = dt1 * a;
      const float sm = a0 + a1;
      float incl = sm;
#pragma unroll
      for (int o = 1; o < 64; o <<= 1) {
        const float t = __shfl_up(incl, o);
        if (lane >= o) incl += t;
      }
      const float excl = incl - sm;
      const float total = __shfl(incl, 63);
      float ac0, ac1;
      if (!dir) { ac0 = excl + a0; ac1 = excl + sm; }
      else { ac0 = total - excl; ac1 = total - excl - a0; }
      fa[2 * lane] = ac0; fa[2 * lane + 1] = ac1;
      fdt[2 * lane] = dt0; fdt[2 * lane + 1] = dt1;
      fsw[2 * lane] = dt0 * __expf(total - ac0); fsw[2 * lane + 1] = dt1 * __expf(total - ac1);
      fea[2 * lane] = __expf(ac0); fea[2 * lane + 1] = __expf(ac1);
      if (lane == 0) ftot[0] = __expf(total);
    }
    __syncthreads();
#pragma unroll
    for (int ks = 4; ks < 8; ++ks) creg[ks] = *(const bf16x8*)(cr + ks * 16);
    f32x16 acc[4], yd[2];
#pragma unroll
    for (int i = 0; i < 4; ++i)
#pragma unroll
      for (int r = 0; r < 16; ++r) acc[i][r] = 0.f;
#pragma unroll
    for (int i = 0; i < 2; ++i)
#pragma unroll
      for (int r = 0; r < 16; ++r) yd[i][r] = 0.f;
#pragma unroll
    for (int ks = 0; ks < 8; ++ks) {
      const bf16x8 areg = creg[ks];
#pragma unroll
      for (int jb = 0; jb < 4; ++jb) {
        const bf16x8 bb = *(const bf16x8*)&BG[(jb * 32 + l32) * 136 + ks * 16 + h * 8];
        acc[jb] = __builtin_amdgcn_mfma_f32_32x32x16_bf16(areg, bb, acc[jb], 0, 0, 0);
      }
    }
    {
      const float eai = fea[w * 32 + l32];
#pragma unroll
      for (int ks = 0; ks < 8; ++ks) {
        union { u32 u[4]; bf16x8 v; } t;
        t.v = creg[ks];
#pragma unroll
        for (int q = 0; q < 4; ++q) t.u[q] = pack2(bflo(t.u[q]) * eai, bfhi(t.u[q]) * eai);
#pragma unroll
        for (int pb = 0; pb < 2; ++pb) {
          const bf16x8 bb = *(const bf16x8*)&HL[(pb * 32 + l32) * 136 + ks * 16 + h * 8];
          yd[pb] = __builtin_amdgcn_mfma_f32_32x32x16_bf16(t.v, bb, yd[pb], 0, 0, 0);
        }
      }
    }
    __syncthreads();
    int l32v = l32, hv_ = h;
    asm volatile("" : "+v"(l32v), "+v"(hv_));
    bf16x8 xf[2][8];
    const u16* xt = TX + ((size_t)(b * 768 + hd * 64 + l32v)) * TPB + pos0 + hv_ * 8;
#pragma unroll
    for (int jb = 0; jb < 4; ++jb) {
      const int j = jb * 32 + l32v;
      const float aj = fa[j], dtj = fdt[j];
#pragma unroll
      for (int r = 0; r < 16; ++r) {
        const int i = w * 32 + (r & 3) + 8 * (r >> 2) + 4 * hv_;
        const float ai = fa[i];
        const bool valid = dir ? (j >= i) : (j <= i);
        const float v = valid ? acc[jb][r] * __expf(ai - aj) * dtj : 0.f;
        BG[i * 136 + j] = f2bf(v);
      }
      __builtin_amdgcn_sched_barrier(0);
      if (jb == 1) {
#pragma unroll
        for (int ks = 0; ks < 8; ++ks) xf[0][ks] = *(const bf16x8*)(xt + ks * 16);
        __builtin_amdgcn_sched_barrier(0);
      }
    }
#pragma unroll
    for (int ks = 0; ks < 8; ++ks) xf[1][ks] = *(const bf16x8*)(xt + (size_t)32 * TPB + ks * 16);
    __builtin_amdgcn_sched_barrier(0);
#pragma unroll
    for (int pb = 0; pb < 2; ++pb)
#pragma unroll
      for (int ks = 0; ks < 8; ++ks) {
        const bf16x8 aa = *(const bf16x8*)&BG[(w * 32 + l32v) * 136 + ks * 16 + hv_ * 8];
        yd[pb] = __builtin_amdgcn_mfma_f32_32x32x16_bf16(aa, xf[pb][ks], yd[pb], 0, 0, 0);
      }
#pragma unroll
    for (int pb = 0; pb < 2; ++pb)
#pragma unroll
      for (int r = 0; r < 16; ++r) {
        const int i = w * 32 + (r & 3) + 8 * (r >> 2) + 4 * hv_;
        Y[(rbase + pos0 + i) * 512 + hd * 64 + pb * 32 + l32v] = f2bf(yd[pb][r]);
      }
    {
      u32x4 braw[8];
      {
        const u16* bt = TX + ((size_t)(b * 768 + 512 + g * 128 + w * 32 + l32v)) * TPB + pos0 + hv_ * 8;
#pragma unroll
        for (int ks = 0; ks < 8; ++ks) braw[ks] = *(const u32x4*)(bt + ks * 16);
      }
      const float eend = ftot[0];
#pragma unroll
      for (int pm = 0; pm < 2; ++pm)
#pragma unroll
        for (int r = 0; r < 16; ++r) Hacc[pm][r] *= eend;
#pragma unroll
      for (int ks = 0; ks < 8; ++ks) {
        const u32x4 raw = braw[ks];
        const float4 s0 = *(const float4*)&fsw[ks * 16 + hv_ * 8];
        const float4 s1 = *(const float4*)&fsw[ks * 16 + hv_ * 8 + 4];
        union { u32 u[4]; bf16x8 v; } bs;
        bs.u[0] = pack2(bflo(raw[0]) * s0.x, bfhi(raw[0]) * s0.y);
        bs.u[1] = pack2(bflo(raw[1]) * s0.z, bfhi(raw[1]) * s0.w);
        bs.u[2] = pack2(bflo(raw[2]) * s1.x, bfhi(raw[2]) * s1.y);
        bs.u[3] = pack2(bflo(raw[3]) * s1.z, bfhi(raw[3]) * s1.w);
#pragma unroll
        for (int pm = 0; pm < 2; ++pm) Hacc[pm] = __builtin_amdgcn_mfma_f32_32x32x16_bf16(xf[pm][ks], bs.v, Hacc[pm], 0, 0, 0);
      }
#pragma unroll
      for (int pm = 0; pm < 2; ++pm)
#pragma unroll
        for (int r = 0; r < 16; ++r) {
          const int pp = pm * 32 + (r & 3) + 8 * (r >> 2) + 4 * hv_;
          HL[pp * 136 + w * 32 + l32v] = f2bf(Hacc[pm][r]);
        }
    }
    __syncthreads();
  }
}

DI void hyena_item(const Params& p, int l, int it) {
  const int lane = TID() & 63, w = TID() >> 6;
  int c, f, L, posoff, tt0, ntile;
  if (it < 2048) { c = it >> 3; f = l; L = 2048; posoff = CTXL; tt0 = (it & 7) * 256 + w * 64; ntile = 32; }
  else { c = it - 2048; f = 2; L = 256; posoff = 0; tt0 = w * 64; ntile = 4; }
  const u16* R0 = WSP(const u16, OFF_RF) + ((size_t)(f * 256 + c) * 2) * RSTR;
  const u16* R1 = R0 + RSTR;
  const u16* UT = WSP(const u16, OFF_UT);
  const int l16 = lane & 15, kg = lane >> 4;
  f32x4 acc[4];
#pragma unroll
  for (int i = 0; i < 4; ++i) acc[i] = (f32x4){0.f, 0.f, 0.f, 0.f};
  const u16* ub = UT + ((size_t)(c * 16 + l16)) * TPB + posoff + kg * 8;
  const u16* rsel = (l16 & 1) ? (R1 - 1) : R0;
  const int nb = L - (tt0 + l16) + kg * 8;
  for (int s0 = 0; s0 < L; s0 += 32) {
    const bf16x8 bfrag = *(const bf16x8*)(ub + s0);
#pragma unroll
    for (int i = 0; i < 4; ++i) {
      const u32* ap = (const u32*)(rsel + (nb - 16 * i + s0));
      union { u32 u[4]; bf16x8 v; } au;
      au.u[0] = ap[0]; au.u[1] = ap[1]; au.u[2] = ap[2]; au.u[3] = ap[3];
      acc[i] = __builtin_amdgcn_mfma_f32_16x16x32_bf16(au.v, bfrag, acc[i], 0, 0, 0);
    }
  }
  float ssq = 0.f;
  for (int t = 0; t < ntile; ++t) ssq += WSP(const float, OFF_PART)[(size_t)(f * 32 + t) * 256 + c];
  const float scale = rsqrtf(ssq + EPSF);
  const float bias = p.in[I_HYBIAS][l * 256 + c];
  const u16* X1C = WSP(const u16, OFF_X1C);
  u16* YM = WSP(u16, OFF_ACT);
  const int b = l16;
#pragma unroll
  for (int i = 0; i < 4; ++i)
#pragma unroll
    for (int r = 0; r < 4; ++r) {
      const int t = tt0 + 16 * i + kg * 4 + r;
      const size_t row = (size_t)b * TPB + posoff + t;
      const float u = bf2f(UT[((size_t)(c * 16 + b)) * TPB + posoff + t]);
      const float x1 = bf2f(X1C[row * 256 + c]);
      YM[row * 1024 + c] = f2bf(x1 * (scale * acc[i][r] + bias * u));
    }
}

DI void hyena_item_lat(const Params& p, int l, int it) {
  const int lane = TID() & 63, w = TID() >> 6;
  const int c = it >> 2, f = l, L = 2048, posoff = CTXL;
  const int tt0 = (it & 3) * 512 + w * 128;
  const u16* R0 = WSP(const u16, OFF_RF) + ((size_t)(f * 256 + c) * 2) * RSTR;
  const u16* R1 = R0 + RSTR;
  const u16* UT = WSP(const u16, OFF_UT);
  const int l16 = lane & 15, kg = lane >> 4;
  f32x4 acc[8];
#pragma unroll
  for (int i = 0; i < 8; ++i) acc[i] = (f32x4){0.f, 0.f, 0.f, 0.f};
  const u16* ub = UT + ((size_t)(c * 16 + l16)) * TPB + posoff + kg * 8;
  const u16* rsel = (l16 & 1) ? (R1 - 1) : R0;
  const int nb = L - (tt0 + l16) + kg * 8;
  union AF { u32 u[4]; bf16x8 v; };
  AF a[8];
#define HY_LOADA(dst, off) { const u32* ap_ = (const u32*)(rsel + (off)); dst.u[0] = ap_[0]; dst.u[1] = ap_[1]; dst.u[2] = ap_[2]; dst.u[3] = ap_[3]; }
#pragma unroll
  for (int i = 2; i < 8; ++i) HY_LOADA(a[i], nb - 16 * i)
#pragma unroll 1
  for (int sb = 0; sb < L; sb += 128) {
#pragma unroll
    for (int u = 0; u < 4; ++u) {
      const int s0 = sb + 32 * u;
      HY_LOADA(a[(0 - 2 * u) & 7], nb + s0)
      HY_LOADA(a[(1 - 2 * u) & 7], nb - 16 + s0)
      const bf16x8 bfrag = *(const bf16x8*)(ub + s0);
#pragma unroll
      for (int i = 0; i < 8; ++i) acc[i] = __builtin_amdgcn_mfma_f32_16x16x32_bf16(a[(i - 2 * u) & 7].v, bfrag, acc[i], 0, 0, 0);
    }
  }
#undef HY_LOADA
  float ssq = 0.f;
  for (int t = 0; t < 32; ++t) ssq += WSP(const float, OFF_PART)[(size_t)(f * 32 + t) * 256 + c];
  const float scale = rsqrtf(ssq + EPSF);
  const float bias = p.in[I_HYBIAS][l * 256 + c];
  const u16* X1C = WSP(const u16, OFF_X1C);
  u16* YM = WSP(u16, OFF_ACT);
  const int b = l16;
#pragma unroll
  for (int i = 0; i < 8; ++i)
#pragma unroll
    for (int r = 0; r < 4; ++r) {
      const int t = tt0 + 16 * i + kg * 4 + r;
      const size_t row = (size_t)b * TPB + posoff + t;
      const float uu = bf2f(UT[((size_t)(c * 16 + b)) * TPB + posoff + t]);
      const float x1 = bf2f(X1C[row * 256 + c]);
      YM[row * 1024 + c] = f2bf(x1 * (scale * acc[i][r] + bias * uu));
    }
}

DI void fnet_item(const Params& p, int it, char* smem) {
  const u16* PQT = WSP(const u16, OFF_PQT);
  u16* YM = WSP(u16, OFF_ACT);
  if (it < 256) {
    const int mt = it >> 5, nt = it & 31;
    const u16* A = WSP(const u16, OFF_DFT);
    auto af = [=](int m, int k) { return A + (size_t)m * 4096 + k; };
    auto bfn = [=](int n, int k) {
      const int b = n >> 8, n2 = n & 255, g = n2 >> 6, kk = n2 & 63, pq = k >> 11, t = k & 2047;
      return PQT + ((size_t)(b * 512 + g * 128 + pq * 64 + kk)) * TPB + CTXL + t;
    };
    auto ef = [=](int m, int n, float v0, float v1, float v2, float v3) {
      const int b = n >> 8, n2 = n & 255;
      const uint2 o = {pack2(v0, v1), pack2(v2, v3)};
      *(uint2*)&YM[((size_t)b * TPB + CTXL + m) * 1024 + 768 + n2] = o;
    };
    gemm_tile<true, 4>(af, bfn, ef, mt * 256, nt * 128, 4096, smem);
  } else {
    const int i2 = it - 256, mt = i2 >> 5, nt = i2 & 31;
    const u16* A = WSP(const u16, OFF_DFTC);
    auto af = [=](int m, int k) { return A + (size_t)m * 512 + k; };
    auto bfn = [=](int n, int k) {
      const int b = n >> 8, n2 = n & 255, g = n2 >> 6, kk = n2 & 63, pq = k >> 8, t = k & 255;
      return PQT + ((size_t)(b * 512 + g * 128 + pq * 64 + kk)) * TPB + t;
    };
    auto ef = [=](int m, int n, float v0, float v1, float v2, float v3) {
      const int b = n >> 8, n2 = n & 255;
      const uint2 o = {pack2(v0, v1), pack2(v2, v3)};
      *(uint2*)&YM[((size_t)b * TPB + m) * 1024 + 768 + n2] = o;
    };
    gemm_tile<true, 4>(af, bfn, ef, mt * 256, nt * 128, 512, smem);
  }
}

DI void phase_mixers(const Params& p, int l, int bid, int nblk, char* smem, int rep = 0) {
  for (int it = bid; it < 256; it += nblk) ssd_item(p, l, it, smem);
  const int nf = (l == 0) ? 288 : 256;
  const int nh = (l == 0) ? 1280 : 1024;
  int* ctr = WSP(int, OFF_CTR) + l + 2 * rep;
  int* sitem = (int*)(smem + LDS_BYTES - 16);
  for (;;) {
    if (TID() == 0) *sitem = atomicAdd(ctr, 1);
    __syncthreads();
    const int it = *sitem;
    __syncthreads();
    if (it >= nf + nh) break;
    if (it < nf) fnet_item(p, it, smem);
    else if (it - nf < 1024) hyena_item_lat(p, l, it - nf);
    else hyena_item(p, l, it - nf + 1024);
  }
}

DI void phase_ssd_combine(const Params& p, int l, int bid, int nblk) {
  const int lane = TID() & 63, w = TID() >> 6;
  const u16* YF = WSP(const u16, OFF_PXBC);
  const u16* YB = YF + (size_t)ROWS * 512;
  const u16* XBCA = WSP(const u16, OFF_XBCA);
  const u16* PZ = WSP(const u16, OFF_PZ);
  u16* YM = WSP(u16, OFF_ACT);
  const float* ng = p.in[I_SNG] + l * 512;
  const int c0 = lane * 8;
  const float dsk = p.in[I_SD][l * 8 + (c0 >> 6)];
  for (int row = bid * 4 + w; row < ROWS; row += nblk * 4) {
    const int pos = row % TPB;
    if (l == 1 && pos < CTXL) continue;
    const uint4 vf = *(const uint4*)(YF + (size_t)row * 512 + c0);
    const uint4 vb = *(const uint4*)(YB + (size_t)row * 512 + c0);
    const uint4 vx = *(const uint4*)(XBCA + (size_t)row * 1024 + c0);
    const uint4 vz = *(const uint4*)(PZ + (size_t)row * 512 + c0);
    const u32 af_[4] = {vf.x, vf.y, vf.z, vf.w}, ab_[4] = {vb.x, vb.y, vb.z, vb.w};
    const u32 ax_[4] = {vx.x, vx.y, vx.z, vx.w}, az_[4] = {vz.x, vz.y, vz.z, vz.w};
    float y[8];
    float ss = 0.f;
#pragma unroll
    for (int i = 0; i < 4; ++i) {
      const float y0 = bflo(af_[i]) + bflo(ab_[i]) + dsk * bflo(ax_[i]);
      const float y1 = bfhi(af_[i]) + bfhi(ab_[i]) + dsk * bfhi(ax_[i]);
      y[2 * i] = y0 * silu_f(bflo(az_[i]));
      y[2 * i + 1] = y1 * silu_f(bfhi(az_[i]));
      ss += y[2 * i] * y[2 * i] + y[2 * i + 1] * y[2 * i + 1];
    }
#pragma unroll
    for (int o = 16; o >= 1; o >>= 1) ss += __shfl_xor(ss, o);
    const float rs = rsqrtf(ss * (1.f / 256.f) + EPSF);
    float o8[8];
#pragma unroll
    for (int i = 0; i < 8; ++i) o8[i] = y[i] * rs * ng[c0 + i];
    uint4 o = {pack2(o8[0], o8[1]), pack2(o8[2], o8[3]), pack2(o8[4], o8[5]), pack2(o8[6], o8[7])};
    *(uint4*)&YM[(size_t)row * 1024 + 256 + c0] = o;
  }
}

DI void phase_outproj(const Params& p, int l, int bid, int nblk, char* smem) {
  const u16* A = WSP(const u16, OFF_ACT);
  const u16* B = WSP(const u16, OFF_WOUT) + (size_t)l * 1024 * 1024;
  const float* MOD = WSP(const float, OFF_MOD);
  const Params pp = p;
  auto af = [=](int m, int k) { return A + (size_t)m * 1024 + k; };
  auto bfn = [=](int n, int k) { return B + (size_t)n * 1024 + k; };
  auto ef = [=](int m, int n, float v0, float v1, float v2, float v3) {
    const int b = m / TPB, pos = m % TPB;
    const float4 ga = *(const float4*)&MOD[(size_t)(l * 17 + (pos < CTXL ? 16 : b)) * 6144 + 2048 + n];
    const float4 xo = *(const float4*)(xrow_ptr(pp, l == 0, b, pos) + n);
    const float4 o = {xo.x + ga.x * v0, xo.y + ga.y * v1, xo.z + ga.z * v2, xo.w + ga.w * v3};
    *(float4*)(xrow_wptr(pp, b, pos) + n) = o;
  };
  const int ntile = (ROWS / 128) * 8;
  const int vb = (nblk % 8 == 0) ? (bid & 7) * (nblk >> 3) + (bid >> 3) : bid;
  for (int t = vb; t < ntile; t += nblk) {
    const int mt = t >> 3, nt = t & 7;
    if (l == 1 && (mt % 18) < 2) continue;
    gemm_tile<true, 2>(af, bfn, ef, mt * 128, nt * 128, 1024, smem);
  }
}

DI void phase_q(const Params& p, int l, int bid, int nblk, char* smem) {
  const u16* A = WSP(const u16, OFF_ACT);
  const u16* B = WSP(const u16, OFF_WQ) + (size_t)l * 2048 * 1024;
  u16* Q = WSP(u16, OFF_Q);
  auto af = [=](int m, int k) { return A + (size_t)m * 1024 + k; };
  auto bfn = [=](int n, int k) { return B + (size_t)n * 1024 + k; };
  auto ef = [=](int m, int n, float v0, float v1, float v2, float v3) {
    const uint2 o = {pack2(v0, v1), pack2(v2, v3)};
    *(uint2*)&Q[(size_t)m * 2048 + n] = o;
  };
  const int ntile = (ROWS / 256) * 16;
  const int vb = (nblk % 8 == 0) ? (bid & 7) * (nblk >> 3) + (bid >> 3) : bid;
  for (int t = vb; t < ntile; t += nblk) {
    const int mt = t >> 4, nt = t & 15;
    if (l == 1 && (mt % 9) < 1) continue;
    gemm_tile<true, 4>(af, bfn, ef, mt * 256, nt * 128, 1024, smem);
  }
}

DI void phase_topk(const Params& p, int l, int bid, int nblk, char* smem) {
  const int tid = TID(), lane = tid & 63, w = tid >> 6, l32 = lane & 31, h = lane >> 5;
  u16* qs = (u16*)smem;
  float* sc = (float*)(smem + 64 * 136 * 2);
  const u16* Q = WSP(const u16, OFF_Q);
  float* TV = WSP(float, OFF_TV);
  int* TI = WSP(int, OFF_TI);
  for (int it = bid; it < (ROWS / 64) * 16; it += nblk) {
    const int hh = it & 15, rt = it >> 4;
    if (l == 1 && (rt % 36) < 4) continue;
    const int row0 = rt * 64;
    const u16* kb = WSP(const u16, OFF_K12) + (size_t)(l * 2 + (hh & 1)) * 16384;
    bf16x8 kfr[8];
#pragma unroll
    for (int ks = 0; ks < 8; ++ks) kfr[ks] = *(const bf16x8*)&kb[(w * 32 + l32) * 128 + ks * 16 + h * 8];
    __builtin_amdgcn_sched_barrier(0);
#pragma unroll
    for (int i = 0; i < 4; ++i) {
      const int q = tid + 256 * i, r = q >> 4, ch = q & 15;
      *(uint4*)&qs[r * 136 + ch * 8] = *(const uint4*)&Q[(size_t)(row0 + r) * 2048 + hh * 128 + ch * 8];
    }
    __syncthreads();
    f32x16 acc[2];
#pragma unroll
    for (int i = 0; i < 2; ++i)
#pragma unroll
      for (int r = 0; r < 16; ++r) acc[i][r] = 0.f;
#pragma unroll
    for (int ks = 0; ks < 8; ++ks) {
      const bf16x8 bq = kfr[ks];
      const bf16x8 a0 = *(const bf16x8*)&qs[(l32) * 136 + ks * 16 + h * 8];
      const bf16x8 a1 = *(const bf16x8*)&qs[(32 + l32) * 136 + ks * 16 + h * 8];
      acc[0] = __builtin_amdgcn_mfma_f32_32x32x16_bf16(a0, bq, acc[0], 0, 0, 0);
      acc[1] = __builtin_amdgcn_mfma_f32_32x32x16_bf16(a1, bq, acc[1], 0, 0, 0);
    }
#pragma unroll
    for (int mt = 0; mt < 2; ++mt)
#pragma unroll
      for (int i = 0; i < 16; ++i) {
        const int r = mt * 32 + (i & 3) + 8 * (i >> 2) + 4 * h;
        sc[r * 133 + w * 33 + l32] = acc[mt][i];
      }
    __syncthreads();
    {
      const int r = tid >> 2, part = tid & 3;
      u32 key[32];
#pragma unroll
      for (int j = 0; j < 32; ++j) {
        const u32 u = __float_as_uint(sc[r * 133 + part * 33 + j]);
        const u32 ord = (u & 0x80000000u) ? ~u : (u | 0x80000000u);
        key[j] = (ord & ~127u) | (u32)(127 - (part * 32 + j));
      }
      float* tv = TV + ((size_t)(row0 + r) * 16 + hh) * 16;
      int* ti = TI + ((size_t)(row0 + r) * 16 + hh) * 16;
#pragma unroll
      for (int k = 2; k <= 32; k <<= 1)
#pragma unroll
        for (int j = k >> 1; j > 0; j >>= 1)
#pragma unroll
          for (int i = 0; i < 32; ++i) {
            const int l2 = i ^ j;
            if (l2 > i) {
              const u32 ka = key[i], kb2 = key[l2];
              const u32 lo = ka < kb2 ? ka : kb2, hi = ka < kb2 ? kb2 : ka;
              if ((i & k) == 0) { key[i] = lo; key[l2] = hi; } else { key[i] = hi; key[l2] = lo; }
            }
          }
      u32 T[16];
#pragma unroll
      for (int t = 0; t < 16; ++t) T[t] = key[31 - t];
#define TOPK_MERGE(CTRL)                                                                      \
      {                                                                                       \
        u32 M[16];                                                                            \
        _Pragma("unroll") for (int t = 0; t < 16; ++t) {                                      \
          const u32 o = (u32)dpp_i<CTRL>((int)T[15 - t]);                                     \
          M[t] = T[t] > o ? T[t] : o;                                                         \
        }                                                                                     \
        _Pragma("unroll") for (int j = 8; j > 0; j >>= 1)                                     \
          _Pragma("unroll") for (int i = 0; i < 16; ++i) {                                    \
            const int l2 = i ^ j;                                                             \
            if (l2 > i) {                                                                     \
              const u32 ka = M[i], kb2 = M[l2];                                               \
              M[i] = ka > kb2 ? ka : kb2;                                                     \
              M[l2] = ka > kb2 ? kb2 : ka;                                                    \
            }                                                                                 \
          }                                                                                   \
        _Pragma("unroll") for (int t = 0; t < 16; ++t) T[t] = M[t];                           \
      }
      TOPK_MERGE(DPP_XOR1)
      TOPK_MERGE(DPP_XOR2)
#undef TOPK_MERGE
      if (part == 0) {
        float ov[16];
        int oi[16];
#pragma unroll
        for (int rd = 0; rd < 16; ++rd) {
          const u32 best = T[rd];
          const u32 ordv = best & ~127u;
          const u32 uu = (ordv & 0x80000000u) ? (ordv & 0x7FFFFFFFu) : ~ordv;
          ov[rd] = __uint_as_float(uu);
          oi[rd] = 127 - (int)(best & 127u);
        }
#pragma unroll
        for (int q = 0; q < 4; ++q) {
          float4 fv = {ov[q * 4 + 0], ov[q * 4 + 1], ov[q * 4 + 2], ov[q * 4 + 3]};
          int4 iv = {oi[q * 4 + 0], oi[q * 4 + 1], oi[q * 4 + 2], oi[q * 4 + 3]};
          *(float4*)(tv + q * 4) = fv;
          *(int4*)(ti + q * 4) = iv;
        }
      }
    }
    __syncthreads();
  }
}

DI int cand_a(int c) {
  const u32 T[7] = {0x00000000u, 0x00000000u, 0x11111111u, 0x33322222u, 0x66554443u, 0xDCBA9877u, 0x000000FEu};
  u32 wv = T[0];
#pragma unroll
  for (int s = 1; s < 7; ++s) wv = ((c >> 3) == s) ? T[s] : wv;
  return (int)((wv >> ((c & 7) * 4)) & 15u);
}
DI int cand_b(int c) {
  const u32 T[7] = {0x76543210u, 0xFEDCBA98u, 0x76543210u, 0x21043210u, 0x10102103u, 0x00000010u, 0x00000000u};
  u32 wv = T[0];
#pragma unroll
  for (int s = 1; s < 7; ++s) wv = ((c >> 3) == s) ? T[s] : wv;
  return (int)((wv >> ((c & 7) * 4)) & 15u);
}
DI void phase_peer(const Params& p, int l, int bid, int nblk) {
  const int w = TID() >> 6;
  const float* TV = WSP(const float, OFF_TV);
  const int* TI = WSP(const int, OFF_TI);
  const u16* H2 = WSP(const u16, OFF_ACT);
  const unsigned char* UB = WSP(const unsigned char, OFF_XBCA);
  const unsigned char* VB = UB + (size_t)16384 * 1024;
  const float* gfin = p.in[I_GF];
  for (int row = bid * 4 + w; row < ROWS; row += nblk * 4) {
    const int b = row / TPB, pos = row % TPB;
    if (l == 1 && pos < CTXL) continue;
    const int lane = TID() & 63;
    const int head = lane >> 3, sub = lane & 7;
    const float* tv1 = TV + ((size_t)row * 16 + head * 2) * 16;
    const float* tv2 = tv1 + 16;
    const int* ti1 = TI + ((size_t)row * 16 + head * 2) * 16;
    const int* ti2 = ti1 + 16;
    const int t1lo = ti1[sub], t1hi = ti1[sub + 8], t2lo = ti2[sub], t2hi = ti2[sub + 8];
    u32 ck[7];
#pragma unroll
    for (int s = 0; s < 7; ++s) {
      const int c = sub + 8 * s;
      if (c < 50) {
        const u32 u = __float_as_uint(tv1[cand_a(c)] + tv2[cand_b(c)]);
        const u32 ord = (u & 0x80000000u) ? ~u : (u | 0x80000000u);
        ck[s] = (ord & ~63u) | (u32)(63 - c);
      } else ck[s] = 0u;
    }
    float w0v = 0.f, w1v = 0.f, mx = 0.f;
    int w0c = 0, w1c = 0;
    u32 prevk = 0xFFFFFFFFu;
#pragma unroll
    for (int r = 0; r < 16; ++r) {
      u32 m = 0u;
#pragma unroll
      for (int s = 0; s < 7; ++s) { const u32 d = ck[s] - prevk; m = d > m ? d : m; }
      { const u32 ov = (u32)dpp_i<DPP_XOR1>((int)m); m = ov > m ? ov : m; }
      { const u32 ov = (u32)dpp_i<DPP_XOR2>((int)m); m = ov > m ? ov : m; }
      { const u32 ov = (u32)dpp_i<DPP_MIRROR8>((int)m); m = ov > m ? ov : m; }
      const u32 best = prevk + m;
      prevk = best;
      const u32 ordv = best & ~63u;
      const float bv = __uint_as_float((ordv & 0x80000000u) ? (ordv & 0x7FFFFFFFu) : ~ordv);
      const int bc = 63 - (int)(best & 63u);
      if (r == 0) mx = bv;
      if (sub == (r & 7)) {
        if (r < 8) { w0v = bv; w0c = bc; } else { w1v = bv; w1c = bc; }
      }
    }
    const float e0 = expf(w0v - mx), e1 = expf(w1v - mx);
    float es = e0 + e1;
    es += dpp_f<DPP_XOR1>(es);
    es += dpp_f<DPP_XOR2>(es);
    es += dpp_f<DPP_MIRROR8>(es);
    const float g0 = e0 / es, g1 = e1 / es;
    int idx0, idx1;
    {
      const int gb = lane & ~7;
      const int a0 = cand_a(w0c), c0 = cand_b(w0c), a1 = cand_a(w1c), c1 = cand_b(w1c);
      const int p0l = __shfl(t1lo, gb + (a0 & 7)), p0h = __shfl(t1hi, gb + (a0 & 7));
      const int q0l = __shfl(t2lo, gb + (c0 & 7)), q0h = __shfl(t2hi, gb + (c0 & 7));
      const int p1l = __shfl(t1lo, gb + (a1 & 7)), p1h = __shfl(t1hi, gb + (a1 & 7));
      const int q1l = __shfl(t2lo, gb + (c1 & 7)), q1h = __shfl(t2hi, gb + (c1 & 7));
      idx0 = ((a0 & 8) ? p0h : p0l) * 128 + ((c0 & 8) ? q0h : q0l);
      idx1 = ((a1 & 8) ? p1h : p1l) * 128 + ((c1 & 8) ? q1h : q1l);
    }
    const u16* hrow = H2 + (size_t)row * 1024;
    float hv[16];
    {
      const uint4 ha = *(const uint4*)(hrow + lane * 16), hb = *(const uint4*)(hrow + lane * 16 + 8);
      hv[0] = bflo(ha.x); hv[1] = bfhi(ha.x); hv[2] = bflo(ha.y); hv[3] = bfhi(ha.y);
      hv[4] = bflo(ha.z); hv[5] = bfhi(ha.z); hv[6] = bflo(ha.w); hv[7] = bfhi(ha.w);
      hv[8] = bflo(hb.x); hv[9] = bfhi(hb.x); hv[10] = bflo(hb.y); hv[11] = bfhi(hb.y);
      hv[12] = bflo(hb.z); hv[13] = bfhi(hb.z); hv[14] = bflo(hb.w); hv[15] = bfhi(hb.w);
    }
    float acc[16];
#pragma unroll 1
    for (int prep_ = 0; prep_ < PEER_REPS; ++prep_) {
    f32x2 hv2[8];
#pragma unroll
    for (int i = 0; i < 8; ++i) hv2[i] = (f32x2){hv[2 * i], hv[2 * i + 1]};
    const bool b0 = lane & 1, b1 = lane & 2, b2 = lane & 4;
    float act0 = 0.f, act1 = 0.f;
    u32x4 rb[2][8];
#define PEER_LOAD(buf, k, TAB)                                                                     \
  _Pragma("unroll") for (int j = 0; j < 8; ++j) {                                                  \
    const int e = (k) * 8 + j;                                                                     \
    const int id = __builtin_amdgcn_readlane(((k) < 8) ? idx0 : idx1, e & 63);                     \
    rb[buf][j] = *(const u32x4*)(TAB + (size_t)id * 1024 + lane * 16);                             \
  }
#define PEER_DOT(buf, k)                                                                           \
  {                                                                                                \
    float d[8];                                                                                    \
    _Pragma("unroll") for (int j = 0; j < 8; ++j) {                                                \
      const u32 uw[4] = {rb[buf][j][0], rb[buf][j][1], rb[buf][j][2], rb[buf][j][3]};              \
      f32x2 sa = {0.f, 0.f}, sb = {0.f, 0.f};                   \
      _Pragma("unroll") for (int q = 0; q < 4; ++q) {                                              \
        const f32x2 lo = __builtin_amdgcn_cvt_pk_f32_fp8((int)uw[q], false);                       \
        const f32x2 hi = __builtin_amdgcn_cvt_pk_f32_fp8((int)uw[q], true);                        \
        sa = __builtin_elementwise_fma(hv2[2 * q], lo, sa);                                        \
        sb = __builtin_elementwise_fma(hv2[2 * q + 1], hi, sb);                                    \
      }                                                                                            \
      sa += sb;                                                                                    \
      d[j] = sa.x + sa.y;                                                                          \
    }                                                                                              \
    float a4[4];                                                                                   \
    _Pragma("unroll") for (int q = 0; q < 4; ++q) {                                                \
      const float keep = b0 ? d[2 * q + 1] : d[2 * q], send = b0 ? d[2 * q] : d[2 * q + 1];        \
      a4[q] = keep + __shfl_xor(send, 1);                                                          \
    }                                                                                              \
    float a2[2];                                                                                   \
    _Pragma("unroll") for (int q = 0; q < 2; ++q) {                                                \
      const float keep = b1 ? a4[2 * q + 1] : a4[2 * q], send = b1 ? a4[2 * q] : a4[2 * q + 1];    \
      a2[q] = keep + __shfl_xor(send, 2);                                                          \
    }                                                                                              \
    const float keep = b2 ? a2[1] : a2[0], send = b2 ? a2[0] : a2[1];                              \
    float c1 = keep + __shfl_xor(send, 4);                                                         \
    c1 += __shfl_xor(c1, 8);                                                                       \
    c1 += __shfl_xor(c1, 16);                                                                      \
    c1 += __shfl_xor(c1, 32);                                                                      \
    if ((lane >> 3) == ((k) & 7)) { if ((k) < 8) act0 = c1; else act1 = c1; }                      \
  }
    PEER_LOAD(0, 0, UB)
#pragma unroll 1
    for (int k = 0; k < 16; k += 2) {
      PEER_LOAD(1, k + 1, UB)
      __builtin_amdgcn_sched_barrier(0);
      PEER_DOT(0, k)
      { const int kn = (k + 2 < 16) ? k + 2 : 15; PEER_LOAD(0, kn, UB) }
      __builtin_amdgcn_sched_barrier(0);
      PEER_DOT(1, k + 1)
    }
    const float ga0 = gelu_tanh(act0 * (1.f / U_SCALE)) * g0 * (1.f / V_SCALE);
    const float ga1 = gelu_tanh(act1 * (1.f / U_SCALE)) * g1 * (1.f / V_SCALE);
#pragma unroll
    for (int i = 0; i < 16; ++i) acc[i] = 0.f;
#define PEER_ACC(buf, k)                                                                           \
  _Pragma("unroll") for (int j = 0; j < 8; ++j) {                                                  \
    const int e = (k) * 8 + j;                                                                     \
    const int ai = __builtin_amdgcn_readlane(__builtin_bit_cast(int, ((k) < 8) ? ga0 : ga1), e & 63); \
    const float a = __builtin_bit_cast(float, ai);                                                 \
    const u32 vw[4] = {rb[buf][j][0], rb[buf][j][1], rb[buf][j][2], rb[buf][j][3]};                \
    _Pragma("unroll") for (int q = 0; q < 4; ++q) {                                                \
      const f32x2 lo = __builtin_amdgcn_cvt_pk_f32_fp8((int)vw[q], false);                         \
      const f32x2 hi = __builtin_amdgcn_cvt_pk_f32_fp8((int)vw[q], true);                          \
      acc[q * 4 + 0] += a * lo.x; acc[q * 4 + 1] += a * lo.y; acc[q * 4 + 2] += a * hi.x; acc[q * 4 + 3] += a * hi.y; \
    }                                                                                              \
  }
    PEER_LOAD(0, 0, VB)
#pragma unroll 1
    for (int k = 0; k < 16; k += 2) {
      PEER_LOAD(1, k + 1, VB)
      __builtin_amdgcn_sched_barrier(0);
      PEER_ACC(0, k)
      { const int kn = (k + 2 < 16) ? k + 2 : 15; PEER_LOAD(0, kn, VB) }
      __builtin_amdgcn_sched_barrier(0);
      PEER_ACC(1, k + 1)
    }
#undef PEER_LOAD
#undef PEER_DOT
#undef PEER_ACC
      if (prep_ + 1 < PEER_REPS) { _Pragma("unroll") for (int i = 0; i < 16; ++i) asm volatile("" :: "v"(acc[i])); }
    }
    int row2 = row;
    asm volatile("" : "+v"(row2));
    const int lane2 = TID() & 63;
    const int b2 = row2 / TPB, pos2 = row2 % TPB;
    const float* xr = xrow_ptr(p, false, b2, pos2);
    float* xw = xrow_wptr(p, b2, pos2);
    const float* ga = WSP(const float, OFF_MOD) + (size_t)(l * 17 + (pos2 < CTXL ? 16 : b2)) * 6144 + 5120;
    float xn[16];
    float ss = 0.f;
#pragma unroll
    for (int q = 0; q < 4; ++q) {
      const float4 xv = *(const float4*)(xr + lane2 * 16 + q * 4);
      const float4 gv = *(const float4*)(ga + lane2 * 16 + q * 4);
      xn[q * 4 + 0] = xv.x + gv.x * acc[q * 4 + 0];
      xn[q * 4 + 1] = xv.y + gv.y * acc[q * 4 + 1];
      xn[q * 4 + 2] = xv.z + gv.z * acc[q * 4 + 2];
      xn[q * 4 + 3] = xv.w + gv.w * acc[q * 4 + 3];
    }
    if (l == 1) {
#pragma unroll
      for (int i = 0; i < 16; ++i) ss += xn[i] * xn[i];
      ss = wave_sum(ss);
      const float rs = rsqrtf(ss * (1.f / 1024.f) + EPSF);
#pragma unroll
      for (int i = 0; i < 16; ++i) xn[i] = xn[i] * rs * gfin[lane2 * 16 + i];
    }
#pragma unroll
    for (int q = 0; q < 4; ++q) {
      float4 o = {xn[q * 4 + 0], xn[q * 4 + 1], xn[q * 4 + 2], xn[q * 4 + 3]};
      *(float4*)(xw + lane2 * 16 + q * 4) = o;
    }
  }
}

template <int S>
DI void run_stage(const Params& p, int l, int bid, int nblk, char* smem) {
  for (int rep = 0; rep < 1 + ((REP_MASK >> (S + 1)) & 1); ++rep) {
  if (S == 0) { if (PH_MASK & 2) phase_norm(p, l, 0, bid, nblk); }
  else if (S == 1) { if (PH_MASK & 4) phase_inproj(p, l, bid, nblk, smem); }
  else if (S == 2) { if (PH_MASK & 8) phase_prep(p, l, bid, nblk, smem); }
  else if (S == 3) { if (PH_MASK & 16) phase_mixers(p, l, bid, nblk, smem, rep); }
  else if (S == 4) { if (PH_MASK & 32) phase_ssd_combine(p, l, bid, nblk); }
  else if (S == 5) { if (PH_MASK & 64) phase_outproj(p, l, bid, nblk, smem); }
  else if (S == 6) { if (PH_MASK & 128) { phase_norm(p, l, 1, bid, nblk); phase_tables(p, l, bid, nblk); } }
  else if (S == 7) { if (PH_MASK & 256) phase_q(p, l, bid, nblk, smem); }
  else if (S == 8) { if (PH_MASK & 512) phase_topk(p, l, bid, nblk, smem); }
  else { if (PH_MASK & 1024) phase_peer(p, l, bid, nblk); }
  }
}

#if ONE_LAUNCH
__global__ void __launch_bounds__(NTHR, 2) mega(Params p) {
  extern __shared__ __attribute__((aligned(16))) char smem[];
  const int bid = blockIdx.x, nblk = gridDim.x;
  cg::grid_group grid = cg::this_grid();
  volatile LAS unsigned* bst = (volatile LAS unsigned*)(smem + LDS_BYTES - 32);
  if (threadIdx.x == 0) { bst[0] = 0u; bst[1] = 0u; }
  __syncthreads();
  const XcdBarrier bar = xcd_barrier_post(WSP(unsigned, OFF_BAR), bst);
  for (int rep = 0; rep < 1 + (REP_MASK & 1); ++rep) { if (PH_MASK & 1) phase_prologue(p, bid, nblk, smem); }
  grid.sync();
#define GBAR() xcd_barrier(bar)
#pragma nounroll
  for (int l = 0; l < 2; ++l) {
    for (int xs = 0; xs < EXTRA_SYNCS; ++xs) GBAR();
    run_stage<0>(p, l, bid, nblk, smem); GBAR();
    run_stage<1>(p, l, bid, nblk, smem); GBAR();
    run_stage<2>(p, l, bid, nblk, smem); GBAR();
    run_stage<3>(p, l, bid, nblk, smem); GBAR();
    run_stage<4>(p, l, bid, nblk, smem); GBAR();
    run_stage<5>(p, l, bid, nblk, smem); GBAR();
    run_stage<6>(p, l, bid, nblk, smem); GBAR();
    run_stage<7>(p, l, bid, nblk, smem); GBAR();
    run_stage<8>(p, l, bid, nblk, smem); GBAR();
    run_stage<9>(p, l, bid, nblk, smem);
    if (l == 0) GBAR();
  }
}
#else
template <int S>
__global__ void __launch_bounds__(NTHR, 2) stage_kernel(Params p, int l) {
  extern __shared__ __attribute__((aligned(16))) char smem[];
  if (S < 0) phase_prologue(p, blockIdx.x, gridDim.x, smem);
  else run_stage<(S < 0 ? 0 : S)>(p, l, blockIdx.x, gridDim.x, smem);
}

template <int S>
static void launch_stage(const Params& p, int l, int grid, hipStream_t stream) {
  (void)hipFuncSetAttribute((const void*)stage_kernel<S>, hipFuncAttributeMaxDynamicSharedMemorySize, LDS_BYTES);
  hipLaunchKernelGGL(stage_kernel<S>, dim3(grid), dim3(NTHR), LDS_BYTES, stream, p, l);
}

#endif

extern "C" void kernel_launch(void* const* d_in, const int* in_sizes, int n_in, void* d_out, int out_size, void* d_ws,
                              size_t ws_size, hipStream_t stream) {
  static int grid = 0;
  if (grid == 0) {
    if (ws_size < WS_END || n_in != 31) { fprintf(stderr, "kernel_launch: ws %zu < %zu or n_in %d\n", ws_size, (size_t)WS_END, n_in); grid = -1; return; }
    int dev = 0, cus = 0, per_cu = 0;
    (void)hipGetDevice(&dev);
    (void)hipDeviceGetAttribute(&cus, hipDeviceAttributeMultiprocessorCount, dev);
#if ONE_LAUNCH
    (void)hipFuncSetAttribute((const void*)mega, hipFuncAttributeMaxDynamicSharedMemorySize, LDS_BYTES);
    (void)hipOccupancyMaxActiveBlocksPerMultiprocessor(&per_cu, (const void*)mega, NTHR, LDS_BYTES);
#else
    (void)hipFuncSetAttribute((const void*)stage_kernel<3>, hipFuncAttributeMaxDynamicSharedMemorySize, LDS_BYTES);
    (void)hipOccupancyMaxActiveBlocksPerMultiprocessor(&per_cu, (const void*)stage_kernel<3>, NTHR, LDS_BYTES);
#endif
    if (per_cu < 1) per_cu = 1;
    if (per_cu > 2) per_cu = 2;
    grid = cus * per_cu;
  }
  if (grid < 0) return;
  (void)hipMemsetAsync((char*)d_ws + OFF_CTR, 0, 256 + 3456 * 4, stream);
  Params p{};
  for (int i = 0; i < 31; ++i) p.in[i] = (const float*)d_in[i];
  p.out = (float*)d_out;
  p.ws = (unsigned char*)d_ws;
#if ONE_LAUNCH
  void* args[] = {&p};
  hipError_t e = hipLaunchCooperativeKernel((const void*)mega, dim3(grid), dim3(NTHR), args, LDS_BYTES, stream);
  if (e != hipSuccess) fprintf(stderr, "cooperative launch failed: %s (grid %d)\n", hipGetErrorString(e), grid);
#else
  launch_stage<-1>(p, 0, grid, stream);
  for (int l = 0; l < 2; ++l) {
    launch_stage<0>(p, l, grid, stream);
    launch_stage<1>(p, l, grid, stream);
    launch_stage<2>(p, l, grid, stream);
    launch_stage<3>(p, l, grid, stream);
    launch_stage<4>(p, l, grid, stream);
    launch_stage<5>(p, l, grid, stream);
    launch_stage<6>(p, l, grid, stream);
    launch_stage<7>(p, l, grid, stream);
    launch_stage<8>(p, l, grid, stream);
    launch_stage<9>(p, l, grid, stream);
  }
#endif
}
```

```cpp
#include <hip/hip_runtime.h>
#include <hip/hip_cooperative_groups.h>
#include <cstdio>
namespace cg = cooperative_groups;

#ifndef PH_MASK
#define PH_MASK 0xFFFF
#endif
#ifndef PEER_REPS
#define PEER_REPS 1
#endif
#ifndef EXTRA_SYNCS
#define EXTRA_SYNCS 0
#endif
#ifndef REP_MASK
#define REP_MASK 0
#endif
#ifndef ONE_LAUNCH
#define ONE_LAUNCH 1
#endif

typedef unsigned short u16;
typedef unsigned int u32;
typedef __attribute__((ext_vector_type(8))) short bf16x8;
typedef __attribute__((ext_vector_type(16))) float f32x16;
typedef __attribute__((ext_vector_type(4))) float f32x4;
typedef __attribute__((ext_vector_type(2))) float f32x2;
typedef __attribute__((ext_vector_type(4))) unsigned int u32x4;
#define DI __device__ __forceinline__
DI int TID() { int t = threadIdx.x; asm volatile("" : "+v"(t)); return t; }

DI u16 f2bf(float x) { u32 u = __float_as_uint(x); u += 0x7fffu + ((u >> 16) & 1u); return (u16)(u >> 16); }
DI float bf2f(u16 v) { return __uint_as_float(((u32)v) << 16); }
DI u32 pack2(float a, float b) { return (u32)f2bf(a) | ((u32)f2bf(b) << 16); }
DI float bflo(u32 v) { return __uint_as_float(v << 16); }
DI float bfhi(u32 v) { return __uint_as_float(v & 0xffff0000u); }

constexpr int D = 1024, NB = 16, SEQ = 2048, CTXL = 256, TPB = 2304, ROWS = NB * TPB;
constexpr int NIN = 2944;
constexpr int RSTR = 4112;
constexpr int NTHR = 256;
constexpr int LDS_BYTES = 73728;
constexpr float EPSF = 1e-6f;

constexpr size_t SZ_PHY = (size_t)ROWS * 768 * 2, SZ_PZ = (size_t)ROWS * 512 * 2, SZ_PXBC = (size_t)ROWS * 1024 * 2;
constexpr size_t OFF_PHY = 0;
constexpr size_t OFF_PZ = OFF_PHY + SZ_PHY;
constexpr size_t OFF_PXBC = OFF_PZ + SZ_PZ;
constexpr size_t OFF_Q = OFF_PHY;
constexpr size_t OFF_ACT = OFF_PXBC + SZ_PXBC;
constexpr size_t OFF_XBCA = OFF_ACT + (size_t)ROWS * 1024 * 2;
constexpr size_t OFF_DREG = OFF_XBCA + (size_t)ROWS * 1024 * 2;
constexpr size_t OFF_PQT = OFF_DREG;
constexpr size_t OFF_UT = OFF_PQT + (size_t)NB * 512 * TPB * 2;
constexpr size_t OFF_X1C = OFF_UT + (size_t)256 * 16 * TPB * 2;
constexpr size_t OFF_TV = OFF_DREG;
constexpr size_t OFF_TI = OFF_TV + (size_t)ROWS * 256 * 4;
constexpr size_t OFF_XC = OFF_DREG + (size_t)ROWS * 256 * 8;
constexpr size_t OFF_WIN = OFF_XC + (size_t)NB * CTXL * D * 4;
constexpr size_t OFF_WOUT = OFF_WIN + (size_t)2 * NIN * 1024 * 2;
constexpr size_t OFF_WQ = OFF_WOUT + (size_t)2 * 1024 * 1024 * 2;
constexpr size_t OFF_K12 = OFF_WQ + (size_t)2 * 2048 * 1024 * 2;
constexpr size_t OFF_DFT = OFF_K12 + (size_t)2 * 2 * 128 * 128 * 2;
constexpr size_t OFF_DFTC = OFF_DFT + (size_t)2048 * 4096 * 2;
constexpr size_t OFF_RF = OFF_DFTC + (size_t)256 * 512 * 2;
constexpr size_t OFF_PART = OFF_RF + (size_t)3 * 256 * 2 * RSTR * 2;
constexpr size_t OFF_MOD = OFF_PART + (size_t)3 * 32 * 256 * 4;
constexpr size_t OFF_DT = OFF_MOD + (size_t)2 * 17 * 6144 * 4;
constexpr size_t OFF_CTR = OFF_DT + (size_t)ROWS * 16 * 4;
constexpr size_t OFF_BAR = OFF_CTR + 256;
constexpr size_t OFF_TX = OFF_BAR + 3456 * 4;
constexpr size_t WS_END = OFF_TX + (size_t)NB * 768 * TPB * 2;

struct Params {
  const float* in[31];
  float* out;
  unsigned char* ws;
  int pad0, pad1;
};

enum { I_X = 0, I_C, I_CTX, I_CCTX, I_WADA, I_BADA, I_G1, I_G2, I_WIN, I_HYCW, I_HYCB, I_HFW1, I_HFB1, I_HFW2, I_HFB2,
       I_HFW3, I_HFFREQ, I_HYBIAS, I_SCW, I_SCB, I_SDTB, I_SALOG, I_SD, I_SNG, I_WOUT, I_WQ, I_K1, I_K2, I_PU, I_PV, I_GF };

__device__ const unsigned char CAND_A[56] = {0, 0, 0, 0, 0, 0, 0, 0, 0, 0, 0, 0, 0, 0, 0, 0, 1, 1, 1, 1, 1, 1, 1, 1, 2, 2, 2, 2, 2, 3, 3, 3, 3, 4, 4, 4, 5, 5, 6, 6, 7, 7, 8, 9, 10, 11, 12, 13, 14, 15, 0, 0, 0, 0, 0, 0};
__device__ const unsigned char CAND_B[56] = {0, 1, 2, 3, 4, 5, 6, 7, 8, 9, 10, 11, 12, 13, 14, 15, 0, 1, 2, 3, 4, 5, 6, 7, 0, 1, 2, 3, 4, 0, 1, 2, 3, 0, 1, 2, 0, 1, 0, 1, 0, 1, 0, 0, 0, 0, 0, 0, 0, 0, 0, 0, 0, 0, 0, 0};

#define WSP(T, off) ((T*)(p.ws + (off)))

#define XB_TMO      128
#define XB_XCNT(j)  (256  + 64 * (j))
#define XB_XSUB(j)  (1280 + 64 * (j))
#define XB_XGEN(j)  (2304 + 64 * (j))
#define XB_TOP      3328
#define XB_TOPGEN   3392
#define XCD_BAR_WORDS 3456
#define XB_SPIN_CAP (1u << 18)
#define LAS __attribute__((address_space(3)))
DI unsigned xb_ld(unsigned* p) { return __hip_atomic_load(p, __ATOMIC_RELAXED, __HIP_MEMORY_SCOPE_AGENT); }
DI unsigned xb_add(unsigned* p, unsigned v) { return __hip_atomic_fetch_add(p, v, __ATOMIC_RELAXED, __HIP_MEMORY_SCOPE_AGENT); }
DI unsigned xb_xcc_id() { return (unsigned)__builtin_amdgcn_s_getreg((3 << 11) | 20) & 0xFu; }
#define XB_SPIN(cond, bar) do { unsigned _sp = 0; while (cond) { __builtin_amdgcn_s_sleep(1); \
    if ((++_sp & 255u) == 0u) { if (xb_ld(&(bar)[XB_TMO])) break; if (_sp > XB_SPIN_CAP) { atomicAdd(&(bar)[XB_TMO], 1u); break; } } } } while (0)
struct XcdBarrier { unsigned* bar; unsigned x; volatile LAS unsigned* st; };
DI XcdBarrier xcd_barrier_post(unsigned* bar, volatile LAS unsigned* st) {
  XcdBarrier b; b.bar = bar; b.x = xb_xcc_id(); b.st = st;
  if (threadIdx.x == 0) (void)xb_add(&bar[XB_XCNT(b.x)], 1u);
  return b;
}
DI void xcd_barrier_complete(unsigned* bar, unsigned x, unsigned& nloc, unsigned& nx) {
  const unsigned G = gridDim.x * gridDim.y * gridDim.z;
  unsigned sum, cnt, mine, sp = 0u;
  for (;;) {
    sum = 0u; cnt = 0u; mine = 0u;
#pragma unroll
    for (unsigned j = 0; j < 16; ++j) { const unsigned c = xb_ld(&bar[XB_XCNT(j)]); sum += c; cnt += (c > 0u) ? 1u : 0u; mine = (j == x) ? c : mine; }
    if (sum == G) break;
    __builtin_amdgcn_s_sleep(1);
    if ((++sp & 255u) == 0u) { if (xb_ld(&bar[XB_TMO])) break; if (sp > XB_SPIN_CAP) { atomicAdd(&bar[XB_TMO], 1u); break; } }
  }
  nloc = mine > 0u ? mine : 1u; nx = cnt > 0u ? cnt : 1u;
}
DI void xcd_barrier(const XcdBarrier& b) {
  asm volatile("s_waitcnt vmcnt(0)" ::: "memory");
  __syncthreads();
  if (threadIdx.x == 0) {
    unsigned* bar = b.bar;
    __builtin_amdgcn_s_waitcnt(0);
    unsigned nloc = b.st[0], nx = b.st[1];
    if (nloc == 0u) { xcd_barrier_complete(bar, b.x, nloc, nx); b.st[0] = nloc; b.st[1] = nx; }
    const unsigned old = xb_add(&bar[XB_XSUB(b.x)], 1u);
    const unsigned gen = old / nloc;
    if (old + 1u == (gen + 1u) * nloc) {
      __builtin_amdgcn_fence(__ATOMIC_RELEASE, "agent");
      asm volatile("s_waitcnt vmcnt(0)" ::: "memory");
      const unsigned og = xb_add(&bar[XB_TOP], 1u);
      const unsigned tg = og / nx;
      if (og + 1u == (tg + 1u) * nx) xb_add(&bar[XB_TOPGEN], 1u);
      else XB_SPIN(xb_ld(&bar[XB_TOPGEN]) == tg, bar);
      __builtin_amdgcn_fence(__ATOMIC_ACQUIRE, "agent");
      xb_add(&bar[XB_XGEN(b.x)], 1u);
      asm volatile("s_waitcnt vmcnt(0)" ::: "memory");
    } else {
      XB_SPIN(xb_ld(&bar[XB_XGEN(b.x)]) == gen, bar);
      __builtin_amdgcn_fence(__ATOMIC_ACQUIRE, "agent");
      asm volatile("s_waitcnt vmcnt(0)" ::: "memory");
    }
  }
  __syncthreads();
}


template <bool SWAP, int MI, class AF, class BF, class EF>
DI void gemm_tile(const AF& af, const BF& bfn, const EF& ef, int m0, int n0, int K, char* smem) {
  constexpr int AROWS = MI * 64;
  u16* As = (u16*)smem;
  u16* Bs = As + 2 * AROWS * 40;
  const int tid = TID(), lane = tid & 63, w = tid >> 6;
  const int wm = w >> 1, wn = w & 1, l32 = lane & 31, h = lane >> 5;
  const int lrow = (tid >> 6) * 16 + ((tid >> 5) & 1) * 8 + ((tid >> 2) & 1) * 4 + ((tid >> 3) & 3), lk = (tid & 3) * 8;
  f32x16 acc[MI][2];
#pragma unroll
  for (int i = 0; i < MI; ++i)
#pragma unroll
    for (int j = 0; j < 2; ++j)
#pragma unroll
      for (int r = 0; r < 16; ++r) acc[i][j][r] = 0.f;
  u32x4 ra[MI], rb[2];
  const int nk = K >> 5;
#pragma unroll
  for (int i = 0; i < MI; ++i) ra[i] = *(const u32x4*)af(m0 + lrow + 64 * i, lk);
#pragma unroll
  for (int i = 0; i < 2; ++i) rb[i] = *(const u32x4*)bfn(n0 + lrow + 64 * i, lk);
#pragma unroll
  for (int i = 0; i < MI; ++i) *(u32x4*)&As[(lrow + 64 * i) * 40 + lk] = ra[i];
#pragma unroll
  for (int i = 0; i < 2; ++i) *(u32x4*)&Bs[(lrow + 64 * i) * 40 + lk] = rb[i];
  {
    const int k1 = (nk > 1) ? 32 + lk : lk;
#pragma unroll
    for (int i = 0; i < MI; ++i) ra[i] = *(const u32x4*)af(m0 + lrow + 64 * i, k1);
#pragma unroll
    for (int i = 0; i < 2; ++i) rb[i] = *(const u32x4*)bfn(n0 + lrow + 64 * i, k1);
  }
  __syncthreads();
  for (int kt = 0; kt < nk; ++kt) {
    const int cur = kt & 1;
    const u16* Ab = As + cur * AROWS * 40;
    const u16* Bb = Bs + cur * 128 * 40;
#pragma unroll
    for (int ks = 0; ks < 2; ++ks) {
      bf16x8 a[MI], b[2];
#pragma unroll
      for (int i = 0; i < MI; ++i) a[i] = *(const bf16x8*)&Ab[(wm * (MI * 32) + i * 32 + l32) * 40 + ks * 16 + h * 8];
#pragma unroll
      for (int i = 0; i < 2; ++i) b[i] = *(const bf16x8*)&Bb[(wn * 64 + i * 32 + l32) * 40 + ks * 16 + h * 8];
#pragma unroll
      for (int i = 0; i < MI; ++i)
#pragma unroll
        for (int j = 0; j < 2; ++j)
          acc[i][j] = SWAP ? __builtin_amdgcn_mfma_f32_32x32x16_bf16(b[j], a[i], acc[i][j], 0, 0, 0)
                           : __builtin_amdgcn_mfma_f32_32x32x16_bf16(a[i], b[j], acc[i][j], 0, 0, 0);
    }
    {
      u16* An = As + (cur ^ 1) * AROWS * 40;
      u16* Bn = Bs + (cur ^ 1) * 128 * 40;
#pragma unroll
      for (int i = 0; i < MI; ++i) *(u32x4*)&An[(lrow + 64 * i) * 40 + lk] = ra[i];
#pragma unroll
      for (int i = 0; i < 2; ++i) *(u32x4*)&Bn[(lrow + 64 * i) * 40 + lk] = rb[i];
      const int kn = (kt + 2 < nk) ? kt + 2 : nk - 1;
      const int k0 = kn * 32 + lk;
#pragma unroll
      for (int i = 0; i < MI; ++i) ra[i] = *(const u32x4*)af(m0 + lrow + 64 * i, k0);
#pragma unroll
      for (int i = 0; i < 2; ++i) rb[i] = *(const u32x4*)bfn(n0 + lrow + 64 * i, k0);
    }
    __syncthreads();
  }
#pragma unroll
  for (int i = 0; i < MI; ++i)
#pragma unroll
    for (int j = 0; j < 2; ++j)
#pragma unroll
      for (int rg = 0; rg < 4; ++rg) {
        const int m = SWAP ? (m0 + wm * (MI * 32) + i * 32 + l32) : (m0 + wm * (MI * 32) + i * 32 + rg * 8 + h * 4);
        const int n = SWAP ? (n0 + wn * 64 + j * 32 + rg * 8 + h * 4) : (n0 + wn * 64 + j * 32 + l32);
        ef(m, n, acc[i][j][rg * 4 + 0], acc[i][j][rg * 4 + 1], acc[i][j][rg * 4 + 2], acc[i][j][rg * 4 + 3]);
      }
}

template <int CTRL> DI int dpp_i(int v) { return __builtin_amdgcn_mov_dpp(v, CTRL, 0xF, 0xF, true); }
template <int CTRL> DI float dpp_f(float v) { return __builtin_bit_cast(float, __builtin_amdgcn_mov_dpp(__builtin_bit_cast(int, v), CTRL, 0xF, 0xF, true)); }
#define DPP_XOR1 0xB1
#define DPP_XOR2 0x4E
#define DPP_MIRROR8 0x141
DI float wave_sum(float v) {
#pragma unroll
  for (int o = 32; o >= 1; o >>= 1) v += __shfl_xor(v, o);
  return v;
}
DI float silu_f(float x) { return x / (1.f + __expf(-x)); }
DI float gelu_tanh(float x) {
  const float u = 0.7978845608028654f * (x + 0.044715f * x * x * x);
  return 0.5f * x * (1.f + tanhf(u));
}

DI const float* xrow_ptr(const Params& p, bool from_input, int b, int pos) {
  if (pos < CTXL) return (from_input ? p.in[I_CTX] : WSP(const float, OFF_XC)) + ((size_t)b * CTXL + pos) * D;
  return (from_input ? p.in[I_X] : (const float*)p.out) + ((size_t)b * SEQ + (pos - CTXL)) * D;
}
DI float* xrow_wptr(const Params& p, int b, int pos) {
  if (pos < CTXL) return WSP(float, OFF_XC) + ((size_t)b * CTXL + pos) * D;
  return p.out + ((size_t)b * SEQ + (pos - CTXL)) * D;
}

DI void phase_prologue(const Params& p, int bid, int nblk, char* smem) {
  const int tid = TID();
  const int gtid = bid * NTHR + tid, gn = nblk * NTHR;
  {
    float* scs = (float*)smem;
    for (int it = bid; it < 192; it += nblk) {
      const int l = it / 96, col0 = (it % 96) * 64;
      for (int e = tid; e < 17 * 1024; e += NTHR) {
        const int j = e >> 10, k = e & 1023;
        const float v = (j < 16) ? p.in[I_C][j * 1024 + k] : p.in[I_CCTX][k];
        scs[e] = v / (1.f + expf(-v));
      }
      __syncthreads();
      const int col = tid & 63, kq = tid >> 6;
      float acc[17];
#pragma unroll
      for (int j = 0; j < 17; ++j) acc[j] = 0.f;
      const float* wa = p.in[I_WADA] + (size_t)l * 1024 * 6144 + col0 + col;
      for (int k0 = kq * 256; k0 < kq * 256 + 256; k0 += 8) {
        float wv[8];
#pragma unroll
        for (int kk = 0; kk < 8; ++kk) wv[kk] = wa[(size_t)(k0 + kk) * 6144];
#pragma unroll
        for (int kk = 0; kk < 8; ++kk)
#pragma unroll
          for (int j = 0; j < 17; ++j) acc[j] += scs[j * 1024 + k0 + kk] * wv[kk];
      }
      __syncthreads();
#pragma unroll
      for (int j = 0; j < 17; ++j) scs[(kq * 17 + j) * 64 + col] = acc[j];
      __syncthreads();
      for (int e = tid; e < 17 * 64; e += NTHR) {
        const int j = e >> 6, cc = e & 63;
        float s = p.in[I_BADA][l * 6144 + col0 + cc];
#pragma unroll
        for (int q = 0; q < 4; ++q) s += scs[(q * 17 + j) * 64 + cc];
        WSP(float, OFF_MOD)[(size_t)(l * 17 + j) * 6144 + col0 + cc] = s;
      }
      __syncthreads();
    }
  }
  {
    float* zs = (float*)smem;
    float* h1s = zs + 64 * 33;
    float* h2s = h1s + 64 * 64;
    for (int it = (nblk >= 260 ? (bid >= 192 ? bid - 192 : 1 << 20) : bid); it < 68; it += nblk) {
      const int f = it < 32 ? 0 : (it < 64 ? 1 : 2);
      const int tile = it - (f == 0 ? 0 : (f == 1 ? 32 : 64));
      const int L = (f == 2) ? 256 : 2048;
      const int lyr = (f == 1) ? 1 : 0;
      const int pos0 = tile * 64;
      const float* w1 = p.in[I_HFW1] + lyr * 33 * 64;
      const float* b1 = p.in[I_HFB1] + lyr * 64;
      const float* w2 = p.in[I_HFW2] + lyr * 64 * 64;
      const float* b2 = p.in[I_HFB2] + lyr * 64;
      const float* w3 = p.in[I_HFW3] + lyr * 64 * 512;
      const float* fq = p.in[I_HFFREQ] + lyr * 64;
      for (int e = tid; e < 64 * 33; e += NTHR) {
        const int pi = e / 33, q = e % 33;
        const int pos = pos0 + pi;
        const float tt = (float)pos / (float)(L - 1);
        const float wv = 6.283185307179586f * (float)pos / (float)L;
        float z;
        if (q == 0) z = tt;
        else if (q <= 16) { const float fi = 1e-4f + (float)(q - 1) * ((15.f - 1e-4f) / 15.f); z = cosf(fi * wv); }
        else { const float fi = 1e-4f + (float)(q - 17) * ((15.f - 1e-4f) / 15.f); z = -sinf(fi * wv); }
        zs[e] = z;
      }
      __syncthreads();
      for (int e = tid; e < 64 * 64; e += NTHR) {
        const int pi = e >> 6, j = e & 63;
        float s = b1[j];
        for (int q = 0; q < 33; ++q) s += zs[pi * 33 + q] * w1[q * 64 + j];
        h1s[e] = sinf(fq[j] * s);
      }
      __syncthreads();
      for (int e = tid; e < 64 * 64; e += NTHR) {
        const int pi = e >> 6, j = e & 63;
        float s = b2[j];
        for (int k = 0; k < 64; ++k) s += h1s[pi * 64 + k] * w2[k * 64 + j];
        h2s[e] = sinf(fq[j] * s);
      }
      __syncthreads();
      {
        const int c = tid;
        const float mind = logf(1e-2f) / 1.5f, maxd = logf(1e-2f) / 0.3f;
        const float delta = fabsf(mind + (float)c * ((maxd - mind) / 255.f));
        u16* R0 = WSP(u16, OFF_RF) + ((size_t)(f * 256 + c) * 2 + 0) * RSTR;
        u16* R1 = R0 + RSTR;
        float ssq = 0.f;
        for (int pb = 0; pb < 4; ++pb) {
          float af_[16], ab_[16];
#pragma unroll
          for (int i = 0; i < 16; ++i) { af_[i] = 0.f; ab_[i] = 0.f; }
          for (int k = 0; k < 64; ++k) {
            const float wf = w3[k * 512 + c], wb = w3[k * 512 + 256 + c];
#pragma unroll
            for (int i = 0; i < 16; ++i) {
              const float hv = h2s[(pb * 16 + i) * 64 + k];
              af_[i] += hv * wf;
              ab_[i] += hv * wb;
            }
          }
#pragma unroll
          for (int i = 0; i < 16; ++i) {
            const int pos = pos0 + pb * 16 + i;
            const float tt = (float)pos / (float)(L - 1);
            const float win = expf(-tt * delta);
            const float vf = af_[i] * win, vb = ab_[i] * win;
            const u16 bfv = f2bf(vf), bbv = f2bf(vb);
            R0[L - pos] = bfv;
            R1[L - pos - 1] = bfv;
            ssq += vf * vf;
            if (pos >= 1) {
              R0[L + pos] = bbv;
              R1[L + pos - 1] = bbv;
              ssq += vb * vb;
            }
          }
        }
        WSP(float, OFF_PART)[(size_t)(f * 32 + tile) * 256 + c] = ssq;
      }
      __syncthreads();
    }
  }
  for (int e = gtid; e < 2 * NIN * 128; e += gn) {
    const int l = e / (NIN * 128);
    const int r = e % (NIN * 128);
    const int kc = r / NIN, n = r % NIN;
    const int k0 = kc * 8;
    const float* wsrc = p.in[I_WIN] + (size_t)l * 1024 * 2576;
    float v[8];
    if (n < 2304) {
#pragma unroll
      for (int j = 0; j < 8; ++j) v[j] = wsrc[(size_t)(k0 + j) * 2576 + n];
    } else if (n < 2816) {
      const int np = n - 2304, g = np >> 7, rr = np & 127, pq = rr >> 6, kk = rr & 63;
#pragma unroll
      for (int j = 0; j < 8; ++j) v[j] = 0.f;
      for (int jj = 0; jj < 64; ++jj) {
        const float ang = 6.283185307179586f * (float)((jj * kk) & 63) / 64.f;
        const float tr = pq ? sinf(ang) : cosf(ang);
#pragma unroll
        for (int j = 0; j < 8; ++j) v[j] += wsrc[(size_t)(k0 + j) * 2576 + 2320 + g * 64 + jj] * tr;
      }
    } else if (n < 2832) {
#pragma unroll
      for (int j = 0; j < 8; ++j) v[j] = wsrc[(size_t)(k0 + j) * 2576 + 2304 + (n - 2816)];
    } else {
#pragma unroll
      for (int j = 0; j < 8; ++j) v[j] = 0.f;
    }
    uint4 o = {pack2(v[0], v[1]), pack2(v[2], v[3]), pack2(v[4], v[5]), pack2(v[6], v[7])};
    *(uint4*)&WSP(u16, OFF_WIN)[((size_t)l * NIN + n) * 1024 + k0] = o;
  }
  for (int e = gtid; e < 2 * 1024 * 128; e += gn) {
    const int l = e / (1024 * 128), r = e % (1024 * 128), kc = r / 1024, n = r % 1024, k0 = kc * 8;
    const float* wsrc = p.in[I_WOUT] + (size_t)l * 1024 * 1024;
    float v[8];
#pragma unroll
    for (int j = 0; j < 8; ++j) v[j] = wsrc[(size_t)(k0 + j) * 1024 + n];
    uint4 o = {pack2(v[0], v[1]), pack2(v[2], v[3]), pack2(v[4], v[5]), pack2(v[6], v[7])};
    *(uint4*)&WSP(u16, OFF_WOUT)[((size_t)l * 1024 + n) * 1024 + k0] = o;
  }
  for (int e = gtid; e < 2 * 2048 * 128; e += gn) {
    const int l = e / (2048 * 128), r = e % (2048 * 128), kc = r / 2048, n = r % 2048, k0 = kc * 8;
    const float* wsrc = p.in[I_WQ] + (size_t)l * 1024 * 2048;
    float v[8];
#pragma unroll
    for (int j = 0; j < 8; ++j) v[j] = wsrc[(size_t)(k0 + j) * 2048 + n];
    uint4 o = {pack2(v[0], v[1]), pack2(v[2], v[3]), pack2(v[4], v[5]), pack2(v[6], v[7])};
    *(uint4*)&WSP(u16, OFF_WQ)[((size_t)l * 2048 + n) * 1024 + k0] = o;
  }
  for (int e = gtid; e < 2 * 2 * 128 * 128; e += gn) {
    const int l = e / (2 * 16384), r = e % (2 * 16384), which = r / 16384, i = r % 16384;
    const float v = (which ? p.in[I_K2] : p.in[I_K1])[l * 16384 + i];
    WSP(u16, OFF_K12)[e] = f2bf(v);
  }
  for (int e = gtid; e < 2048 * 512; e += gn) {
    const int tp = e >> 9, k0 = (e & 511) * 8;
    const float s = 1.f / sqrtf(2048.f * 64.f);
    float v[8];
#pragma unroll
    for (int j = 0; j < 8; ++j) {
      const int k = k0 + j, t = k & 2047;
      const float ang = 6.283185307179586f * (float)((tp * t) & 2047) / 2048.f;
      v[j] = (k < 2048) ? cosf(ang) * s : -sinf(ang) * s;
    }
    uint4 o = {pack2(v[0], v[1]), pack2(v[2], v[3]), pack2(v[4], v[5]), pack2(v[6], v[7])};
    *(uint4*)&WSP(u16, OFF_DFT)[(size_t)tp * 4096 + k0] = o;
  }
  for (int e = gtid; e < 256 * 64; e += gn) {
    const int tp = e >> 6, k0 = (e & 63) * 8;
    const float s = 1.f / sqrtf(256.f * 64.f);
    float v[8];
#pragma unroll
    for (int j = 0; j < 8; ++j) {
      const int k = k0 + j, t = k & 255;
      const float ang = 6.283185307179586f * (float)((tp * t) & 255) / 256.f;
      v[j] = (k < 256) ? cosf(ang) * s : -sinf(ang) * s;
    }
    uint4 o = {pack2(v[0], v[1]), pack2(v[2], v[3]), pack2(v[4], v[5]), pack2(v[6], v[7])};
    *(uint4*)&WSP(u16, OFF_DFTC)[(size_t)tp * 512 + k0] = o;
  }
}

DI void phase_norm(const Params& p, int l, int which, int bid, int nblk) {
  const int lane = TID() & 63, w = TID() >> 6;
  const float* g = (which ? p.in[I_G2] : p.in[I_G1]) + l * 1024;
  const bool from_input = (which == 0 && l == 0);
  for (int row = bid * 4 + w; row < ROWS; row += nblk * 4) {
    const int b = row / TPB, pos = row % TPB;
    if (which == 1 && l == 1 && pos < CTXL) continue;
    const float* xr = xrow_ptr(p, from_input, b, pos);
    const float* mod = WSP(const float, OFF_MOD) + (size_t)(l * 17 + (pos < CTXL ? 16 : b)) * 6144 + which * 3072;
    float x[16];
#pragma unroll
    for (int hh = 0; hh < 2; ++hh) {
      const float4 a = *(const float4*)(xr + hh * 512 + lane * 8);
      const float4 c = *(const float4*)(xr + hh * 512 + lane * 8 + 4);
      x[hh * 8 + 0] = a.x; x[hh * 8 + 1] = a.y; x[hh * 8 + 2] = a.z; x[hh * 8 + 3] = a.w;
      x[hh * 8 + 4] = c.x; x[hh * 8 + 5] = c.y; x[hh * 8 + 6] = c.z; x[hh * 8 + 7] = c.w;
    }
    float ss = 0.f;
#pragma unroll
    for (int i = 0; i < 16; ++i) ss += x[i] * x[i];
    ss = wave_sum(ss);
    const float rs = rsqrtf(ss * (1.f / 1024.f) + EPSF);
#pragma unroll
    for (int hh = 0; hh < 2; ++hh) {
      const int c0 = hh * 512 + lane * 8;
      float y[8];
#pragma unroll
      for (int i = 0; i < 8; ++i) {
        const float yn = x[hh * 8 + i] * rs * g[c0 + i];
        y[i] = yn * (1.f + mod[1024 + c0 + i]) + mod[c0 + i];
      }
      uint4 o = {pack2(y[0], y[1]), pack2(y[2], y[3]), pack2(y[4], y[5]), pack2(y[6], y[7])};
      *(uint4*)&WSP(u16, OFF_ACT)[(size_t)row * 1024 + c0] = o;
    }
  }
}

constexpr float U_SCALE = 64.f, V_SCALE = 4.f;
DI void phase_tables(const Params& p, int l, int bid, int nblk) {
  const int gtid = bid * NTHR + TID(), gn = nblk * NTHR;
  unsigned char* dst = WSP(unsigned char, OFF_XBCA);
  for (int e = gtid; e < 2 * 16384 * 64; e += gn) {
    const int which = e / (16384 * 64), r = e % (16384 * 64);
    const float sc = which ? V_SCALE : U_SCALE;
    const float* src = (which ? p.in[I_PV] : p.in[I_PU]) + (size_t)l * 16384 * 1024 + (size_t)r * 16;
    u32 o[4];
#pragma unroll
    for (int q = 0; q < 4; ++q) {
      const float4 a = *(const float4*)(src + q * 4);
      int v = __builtin_amdgcn_cvt_pk_fp8_f32(a.x * sc, a.y * sc, 0, false);
      v = __builtin_amdgcn_cvt_pk_fp8_f32(a.z * sc, a.w * sc, v, true);
      o[q] = (u32)v;
    }
    uint4 ov = {o[0], o[1], o[2], o[3]};
    *(uint4*)&dst[(size_t)e * 16] = ov;
  }
}

DI void phase_inproj(const Params& p, int l, int bid, int nblk, char* smem) {
  const u16* A = WSP(const u16, OFF_ACT);
  const u16* B = WSP(const u16, OFF_WIN) + (size_t)l * NIN * 1024;
  u16* PHY = WSP(u16, OFF_PHY);
  u16* PZ = WSP(u16, OFF_PZ);
  u16* PXBC = WSP(u16, OFF_PXBC);
  u16* PQT = WSP(u16, OFF_PQT);
  float* DT = WSP(float, OFF_DT);
  auto af = [=](int m, int k) { return A + (size_t)m * 1024 + k; };
  auto bfn = [=](int n, int k) { return B + (size_t)n * 1024 + k; };
  auto efT = [=](int m, int n, float v0, float v1, float v2, float v3) {
    const uint2 o = {pack2(v0, v1), pack2(v2, v3)};
    if (n < 768) *(uint2*)&PHY[(size_t)m * 768 + n] = o;
    else if (n < 1280) *(uint2*)&PZ[(size_t)m * 512 + (n - 768)] = o;
    else if (n < 2304) *(uint2*)&PXBC[(size_t)m * 1024 + (n - 1280)] = o;
    else if (n >= 2816 && n < 2832) { float4 f = {v0, v1, v2, v3}; *(float4*)&DT[(size_t)m * 16 + (n - 2816)] = f; }
  };
  auto efN = [=](int m, int n, float v0, float v1, float v2, float v3) {
    const int b = m / TPB, pos = m % TPB, np = n - 2304;
    uint2 o = {pack2(v0, v1), pack2(v2, v3)};
    *(uint2*)&PQT[((size_t)(b * 512 + np)) * TPB + pos] = o;
  };
  const int nlat = (l == 1) ? 128 * 23 : (ROWS / 256) * 23;
  const int ntile = (l == 1) ? nlat + NB * 9 : nlat;
  const int vb = (nblk % 8 == 0) ? (bid & 7) * (nblk >> 3) + (bid >> 3) : bid;
  for (int t = vb; t < ntile; t += nblk) {
    int mt, nt;
    if (t < nlat) {
      const int mi = t / 23;
      nt = t % 23;
      mt = (l == 1) ? (mi >> 3) * 9 + (mi & 7) + 1 : mi;
    } else {
      const int u = t - nlat, q = u % 9;
      mt = (u / 9) * 9;
      nt = (q < 8) ? 10 + q : 22;
    }
    if (nt >= 18 && nt < 22) gemm_tile<false, 4>(af, bfn, efN, mt * 256, nt * 128, 1024, smem);
    else gemm_tile<true, 4>(af, bfn, efT, mt * 256, nt * 128, 1024, smem);
  }
}

DI void unpack8(const uint4& v, float* f) {
  f[0] = bflo(v.x); f[1] = bfhi(v.x); f[2] = bflo(v.y); f[3] = bfhi(v.y);
  f[4] = bflo(v.z); f[5] = bfhi(v.z); f[6] = bflo(v.w); f[7] = bfhi(v.w);
}
DI void phase_prep(const Params& p, int l, int bid, int nblk, char* smem) {
  const int tid = TID();
  u16* tile = (u16*)smem;
  const u16* PHY = WSP(const u16, OFF_PHY);
  const u16* PXBC = WSP(const u16, OFF_PXBC);
  u16* UT = WSP(u16, OFF_UT);
  u16* X1C = WSP(u16, OFF_X1C);
  u16* XBCA = WSP(u16, OFF_XBCA);
  u16* TX = WSP(u16, OFF_TX);
  const float* hw = p.in[I_HYCW] + l * 3 * 768;
  const float* hb = p.in[I_HYCB] + l * 768;
  const float* sw = p.in[I_SCW] + l * 3 * 1024;
  const float* sb = p.in[I_SCB] + l * 1024;
  const int cg8 = (tid & 31) * 8, pg = tid >> 5;
  for (int it = bid; it < NB * 36 * 6; it += nblk) {
    const int pass = it % 6, bt = it / 6;
    const int b = bt / 36, pt = bt % 36, pos0 = pt * 64;
    const int seg_lo = (pos0 < CTXL) ? 0 : CTXL, seg_hi = (pos0 < CTXL) ? CTXL : TPB;
    const size_t rbase = (size_t)b * TPB;
    const int pfirst = pos0 + pg * 8;
    bool transposed = false;
    if (pass <= 1) {
      if (l == 1 && pos0 < CTXL) continue;
      float cv0[8][8];
#pragma unroll
      for (int sg = 0; sg < 2; ++sg) {
        if (pass == 0 && sg == 1) break;
        const int sgrp = (pass == 0) ? 1 : (sg == 0 ? 0 : 2);
        const int col = sgrp * 256 + cg8;
        float w0[8], w1[8], w2[8], bb[8];
#pragma unroll
        for (int e = 0; e < 8; ++e) { w0[e] = hw[col + e]; w1[e] = hw[768 + col + e]; w2[e] = hw[1536 + col + e]; bb[e] = hb[col + e]; }
        uint4 raw[10];
#pragma unroll
        for (int k = 0; k < 10; ++k) {
          const int pn = pfirst + k - 1;
          raw[k] = (pn >= seg_lo && pn < seg_hi) ? *(const uint4*)&PHY[(rbase + pn) * 768 + col] : make_uint4(0u, 0u, 0u, 0u);
        }
        float xm[8], x0[8], xp[8];
        unpack8(raw[0], xm);
        unpack8(raw[1], x0);
#pragma unroll
        for (int k = 0; k < 8; ++k) {
          unpack8(raw[k + 2], xp);
          float o[8];
#pragma unroll
          for (int e = 0; e < 8; ++e) {
            o[e] = w0[e] * xm[e] + w1[e] * x0[e] + w2[e] * xp[e] + bb[e];
            xm[e] = x0[e]; x0[e] = xp[e];
          }
          if (pass == 0) {
            uint4 o1 = {pack2(o[0], o[1]), pack2(o[2], o[3]), pack2(o[4], o[5]), pack2(o[6], o[7])};
            *(uint4*)&X1C[(rbase + pfirst + k) * 256 + cg8] = o1;
          } else if (sg == 0) {
#pragma unroll
            for (int e = 0; e < 8; ++e) cv0[k][e] = o[e];
          } else {
            uint4 ou = {pack2(o[0] * cv0[k][0], o[1] * cv0[k][1]), pack2(o[2] * cv0[k][2], o[3] * cv0[k][3]),
                        pack2(o[4] * cv0[k][4], o[5] * cv0[k][5]), pack2(o[6] * cv0[k][6], o[7] * cv0[k][7])};
            *(uint4*)&tile[(pg * 8 + k) * 264 + cg8] = ou;
          }
        }
      }
      transposed = (pass == 1);
    } else {
      const int col = (pass - 2) * 256 + cg8;
      float w0[8], w1[8], w2[8], bb[8];
#pragma unroll
      for (int e = 0; e < 8; ++e) { w0[e] = sw[col + e]; w1[e] = sw[1024 + col + e]; w2[e] = sw[2048 + col + e]; bb[e] = sb[col + e]; }
      uint4 raw[10];
#pragma unroll
      for (int k = 0; k < 10; ++k) {
        const int pn = pfirst + k - 1;
        raw[k] = (pn >= seg_lo && pn < seg_hi) ? *(const uint4*)&PXBC[(rbase + pn) * 1024 + col] : make_uint4(0u, 0u, 0u, 0u);
      }
      float xm[8], x0[8], xp[8];
      unpack8(raw[0], xm);
      unpack8(raw[1], x0);
#pragma unroll
      for (int k = 0; k < 8; ++k) {
        unpack8(raw[k + 2], xp);
        float o[8];
#pragma unroll
        for (int e = 0; e < 8; ++e) {
          o[e] = silu_f(w0[e] * xm[e] + w1[e] * x0[e] + w2[e] * xp[e] + bb[e]);
          xm[e] = x0[e]; x0[e] = xp[e];
        }
        uint4 ov = {pack2(o[0], o[1]), pack2(o[2], o[3]), pack2(o[4], o[5]), pack2(o[6], o[7])};
        *(uint4*)&XBCA[(rbase + pfirst + k) * 1024 + col] = ov;
        if (pass < 5) *(uint4*)&tile[(pg * 8 + k) * 264 + cg8] = ov;
      }
      transposed = pass < 5;
    }
    if (transposed) {
      __syncthreads();
      u16* dst = (pass == 1) ? (UT + ((size_t)(tid * 16 + b)) * TPB + pos0) : (TX + ((size_t)(b * 768 + (pass - 2) * 256 + tid)) * TPB + pos0);
#pragma unroll
      for (int pc = 0; pc < 8; ++pc) {
        u32 wv[4];
#pragma unroll
        for (int e = 0; e < 4; ++e)
          wv[e] = (u32)tile[(pc * 8 + 2 * e) * 264 + tid] | ((u32)tile[(pc * 8 + 2 * e + 1) * 264 + tid] << 16);
        uint4 o = {wv[0], wv[1], wv[2], wv[3]};
        *(uint4*)&dst[pc * 8] = o;
      }
      __syncthreads();
    }
  }
}

DI void ssd_item(const Params& p, int l, int it, char* smem) {
  const int tid = TID(), lane = tid & 63, w = tid >> 6, l32 = lane & 31, h = lane >> 5;
  const int b = it >> 4, hd = (it >> 1) & 7, dir = it & 1, g = hd >> 2;
  u16* BG = (u16*)smem;
  u16* HL = BG + 128 * 136;
  float* fa = (float*)(HL + 64 * 136);
  float* fdt = fa + 128;
  float* fsw = fdt + 128;
  float* fea = fsw + 128;
  float* ftot = fea + 128;
  const u16* XBCA = WSP(const u16, OFF_XBCA);
  const u16* TX = WSP(const u16, OFF_TX);
  const float* DT = WSP(const float, OFF_DT);
  u16* Y = WSP(u16, OFF_PXBC) + (dir ? (size_t)ROWS * 512 : 0);
  const float dtb = p.in[I_SDTB][l * 16 + dir * 8 + hd];
  const float a = -expf(p.in[I_SALOG][l * 16 + dir * 8 + hd]);
  const size_t rbase = (size_t)b * TPB;
  f32x16 Hacc[2];
#pragma unroll
  for (int i = 0; i < 2; ++i)
#pragma unroll
    for (int r = 0; r < 16; ++r) Hacc[i][r] = 0.f;
  for (int e = tid; e < 64 * 136; e += NTHR) HL[e] = 0;
  for (int ci = 0; ci < 18; ++ci) {
    const int pos0 = dir ? ((ci < 2) ? (1 - ci) * 128 : (CTXL + (17 - ci) * 128)) : ci * 128;
    asm volatile("s_waitcnt vmcnt(0)" ::: "memory");
    bf16x8 creg[8];
    const u16* cr = XBCA + (rbase + pos0 + w * 32 + l32) * 1024 + 768 + g * 128 + h * 8;
#pragma unroll
    for (int ks = 0; ks < 4; ++ks) creg[ks] = *(const bf16x8*)(cr + ks * 16);
    __builtin_amdgcn_sched_barrier(0);
#pragma unroll
    for (int i = 0; i < 8; ++i) {
      const int q = tid + 256 * i, j = q >> 4, ch = q & 15;
      *(uint4*)&BG[j * 136 + ch * 8] = *(const uint4*)&XBCA[(rbase + pos0 + j) * 1024 + 512 + g * 128 + ch * 8];
    }
    if (w == 0) {
      const float r0 = DT[(rbase + pos0 + 2 * lane) * 16 + dir * 8 + hd] + dtb;
      const float r1 = DT[(rbase + pos0 + 2 * lane + 1) * 16 + dir * 8 + hd] + dtb;
      const float dt0 = (r0 > 20.f) ? r0 : log1pf(expf(r0));
      const float dt1 = (r1 > 20.f) ? r1 : log1pf(expf(r1));
      const float a0 = dt0 * a, a1 = dt1 * a;
      const float sm = a0 + a1;
      float incl = sm;
#pragma unroll
      for (int o = 1; o < 64; o <<= 1) {
        const float t = __shfl_up(incl, o);
        if (lane >= o) incl += t;
      }
      const float excl = incl - sm;
      const float total = __shfl(incl, 63);
      float ac0, ac1;
      if (!dir) { ac0 = excl + a0; ac1 = excl + sm; }
      else { ac0 = total - excl; ac1 = total - excl - a0; }
      fa[2 * lane] = ac0; fa[2 * lane + 1] = ac1;
      fdt[2 * lane] = dt0; fdt[2 * lane + 1] = dt1;
      fsw[2 * lane] = dt0 * __expf(total - ac0); fsw[2 * lane + 1] = dt1 * __expf(total - ac1);
      fea[2 * lane] = __expf(ac0); fea[2 * lane + 1] = __expf(ac1);
      if (lane == 0) ftot[0] = __expf(total);
    }
    __syncthreads();
#pragma unroll
    for (int ks = 4; ks < 8; ++ks) creg[ks] = *(const bf16x8*)(cr + ks * 16);
    f32x16 acc[4], yd[2];
#pragma unroll
    for (int i = 0; i < 4; ++i)
#pragma unroll
      for (int r = 0; r < 16; ++r) acc[i][r] = 0.f;
#pragma unroll
    for (int i = 0; i < 2; ++i)
#pragma unroll
      for (int r = 0; r < 16; ++r) yd[i][r] = 0.f;
#pragma unroll
    for (int ks = 0; ks < 8; ++ks) {
      const bf16x8 areg = creg[ks];
#pragma unroll
      for (int jb = 0; jb < 4; ++jb) {
        const bf16x8 bb = *(const bf16x8*)&BG[(jb * 32 + l32) * 136 + ks * 16 + h * 8];
        acc[jb] = __builtin_amdgcn_mfma_f32_32x32x16_bf16(areg, bb, acc[jb], 0, 0, 0);
      }
    }
    {
      const float eai = fea[w * 32 + l32];
#pragma unroll
      for (int ks = 0; ks < 8; ++ks) {
        union { u32 u[4]; bf16x8 v; } t;
        t.v = creg[ks];
#pragma unroll
        for (int q = 0; q < 4; ++q) t.u[q] = pack2(bflo(t.u[q]) * eai, bfhi(t.u[q]) * eai);
#pragma unroll
        for (int pb = 0; pb < 2; ++pb) {
          const bf16x8 bb = *(const bf16x8*)&HL[(pb * 32 + l32) * 136 + ks * 16 + h * 8];
          yd[pb] = __builtin_amdgcn_mfma_f32_32x32x16_bf16(t.v, bb, yd[pb], 0, 0, 0);
        }
      }
    }
    __syncthreads();
    int l32v = l32, hv_ = h;
    asm volatile("" : "+v"(l32v), "+v"(hv_));
    bf16x8 xf[2][8];
    const u16* xt = TX + ((size_t)(b * 768 + hd * 64 + l32v)) * TPB + pos0 + hv_ * 8;
#pragma unroll
    for (int jb = 0; jb < 4; ++jb) {
      const int j = jb * 32 + l32v;
      const float aj = fa[j], dtj = fdt[j];
#pragma unroll
      for (int r = 0; r < 16; ++r) {
        const int i = w * 32 + (r & 3) + 8 * (r >> 2) + 4 * hv_;
        const float ai = fa[i];
        const bool valid = dir ? (j >= i) : (j <= i);
        const float v = valid ? acc[jb][r] * __expf(ai - aj) * dtj : 0.f;
        BG[i * 136 + j] = f2bf(v);
      }
      __builtin_amdgcn_sched_barrier(0);
      if (jb == 1) {
#pragma unroll
        for (int ks = 0; ks < 8; ++ks) xf[0][ks] = *(const bf16x8*)(xt + ks * 16);
        __builtin_amdgcn_sched_barrier(0);
      }
    }
#pragma unroll
    for (int ks = 0; ks < 8; ++ks) xf[1][ks] = *(const bf16x8*)(xt + (size_t)32 * TPB + ks * 16);
    __builtin_amdgcn_sched_barrier(0);
#pragma unroll
    for (int pb = 0; pb < 2; ++pb)
#pragma unroll
      for (int ks = 0; ks < 8; ++ks) {
        const bf16x8 aa = *(const bf16x8*)&BG[(w * 32 + l32v) * 136 + ks * 16 + hv_ * 8];
        yd[pb] = __builtin_amdgcn_mfma_f32_32x32x16_bf16(aa, xf[pb][ks], yd[pb], 0, 0, 0);
      }
#pragma unroll
    for (int pb = 0; pb < 2; ++pb)
#pragma unroll
      for (int r = 0; r < 16; ++r) {
        const int i = w * 32 + (r & 3) + 8 * (r >> 2) + 4 * hv_;
        Y[(rbase + pos0 + i) * 512 + hd * 64 + pb * 32 + l32v] = f2bf(yd[pb][r]);
      }
    {
      u32x4 braw[8];
      {
        const u16* bt = TX + ((size_t)(b * 768 + 512 + g * 128 + w * 32 + l32v)) * TPB + pos0 + hv_ * 8;
#pragma unroll
        for (int ks = 0; ks < 8; ++ks) braw[ks] = *(const u32x4*)(bt + ks * 16);
      }
      const float eend = ftot[0];
#pragma unroll
      for (int pm = 0; pm < 2; ++pm)
#pragma unroll
        for (int r = 0; r < 16; ++r) Hacc[pm][r] *= eend;
#pragma unroll
      for (int ks = 0; ks < 8; ++ks) {
        const u32x4 raw = braw[ks];
        const float4 s0 = *(const float4*)&fsw[ks * 16 + hv_ * 8];
        const float4 s1 = *(const float4*)&fsw[ks * 16 + hv_ * 8 + 4];
        union { u32 u[4]; bf16x8 v; } bs;
        bs.u[0] = pack2(bflo(raw[0]) * s0.x, bfhi(raw[0]) * s0.y);
        bs.u[1] = pack2(bflo(raw[1]) * s0.z, bfhi(raw[1]) * s0.w);
        bs.u[2] = pack2(bflo(raw[2]) * s1.x, bfhi(raw[2]) * s1.y);
        bs.u[3] = pack2(bflo(raw[3]) * s1.z, bfhi(raw[3]) * s1.w);
#pragma unroll
        for (int pm = 0; pm < 2; ++pm) Hacc[pm] = __builtin_amdgcn_mfma_f32_32x32x16_bf16(xf[pm][ks], bs.v, Hacc[pm], 0, 0, 0);
      }
#pragma unroll
      for (int pm = 0; pm < 2; ++pm)
#pragma unroll
        for (int r = 0; r < 16; ++r) {
          const int pp = pm * 32 + (r & 3) + 8 * (r >> 2) + 4 * hv_;
          HL[pp * 136 + w * 32 + l32v] = f2bf(Hacc[pm][r]);
        }
    }
    __syncthreads();
  }
}

DI void hyena_item(const Params& p, int l, int it) {
  const int lane = TID() & 63, w = TID() >> 6;
  int c, f, L, posoff, tt0, ntile;
  if (it < 2048) { c = it >> 3; f = l; L = 2048; posoff = CTXL; tt0 = (it & 7) * 256 + w * 64; ntile = 32; }
  else { c = it - 2048; f = 2; L = 256; posoff = 0; tt0 = w * 64; ntile = 4; }
  const u16* R0 = WSP(const u16, OFF_RF) + ((size_t)(f * 256 + c) * 2) * RSTR;
  const u16* R1 = R0 + RSTR;
  const u16* UT = WSP(const u16, OFF_UT);
  const int l16 = lane & 15, kg = lane >> 4;
  f32x4 acc[4];
#pragma unroll
  for (int i = 0; i < 4; ++i) acc[i] = (f32x4){0.f, 0.f, 0.f, 0.f};
  const u16* ub = UT + ((size_t)(c * 16 + l16)) * TPB + posoff + kg * 8;
  const u16* rsel = (l16 & 1) ? (R1 - 1) : R0;
  const int nb = L - (tt0 + l16) + kg * 8;
  for (int s0 = 0; s0 < L; s0 += 32) {
    const bf16x8 bfrag = *(const bf16x8*)(ub + s0);
#pragma unroll
    for (int i = 0; i < 4; ++i) {
      const u32* ap = (const u32*)(rsel + (nb - 16 * i + s0));
      union { u32 u[4]; bf16x8 v; } au;
      au.u[0] = ap[0]; au.u[1] = ap[1]; au.u[2] = ap[2]; au.u[3] = ap[3];
      acc[i] = __builtin_amdgcn_mfma_f32_16x16x32_bf16(au.v, bfrag, acc[i], 0, 0, 0);
    }
  }
  float ssq = 0.f;
  for (int t = 0; t < ntile; ++t) ssq += WSP(const float, OFF_PART)[(size_t)(f * 32 + t) * 256 + c];
  const float scale = rsqrtf(ssq + EPSF);
  const float bias = p.in[I_HYBIAS][l * 256 + c];
  const u16* X1C = WSP(const u16, OFF_X1C);
  u16* YM = WSP(u16, OFF_ACT);
  const int b = l16;
#pragma unroll
  for (int i = 0; i < 4; ++i)
#pragma unroll
    for (int r = 0; r < 4; ++r) {
      const int t = tt0 + 16 * i + kg * 4 + r;
      const size_t row = (size_t)b * TPB + posoff + t;
      const float u = bf2f(UT[((size_t)(c * 16 + b)) * TPB + posoff + t]);
      const float x1 = bf2f(X1C[row * 256 + c]);
      YM[row * 1024 + c] = f2bf(x1 * (scale * acc[i][r] + bias * u));
    }
}

DI void hyena_item_lat(const Params& p, int l, int it) {
  const int lane = TID() & 63, w = TID() >> 6;
  const int c = it >> 2, f = l, L = 2048, posoff = CTXL;
  const int tt0 = (it & 3) * 512 + w * 128;
  const u16* R0 = WSP(const u16, OFF_RF) + ((size_t)(f * 256 + c) * 2) * RSTR;
  const u16* R1 = R0 + RSTR;
  const u16* UT = WSP(const u16, OFF_UT);
  const int l16 = lane & 15, kg = lane >> 4;
  f32x4 acc[8];
#pragma unroll
  for (int i = 0; i < 8; ++i) acc[i] = (f32x4){0.f, 0.f, 0.f, 0.f};
  const u16* ub = UT + ((size_t)(c * 16 + l16)) * TPB + posoff + kg * 8;
  const u16* rsel = (l16 & 1) ? (R1 - 1) : R0;
  const int nb = L - (tt0 + l16) + kg * 8;
  union AF { u32 u[4]; bf16x8 v; };
  AF a[8];
#define HY_LOADA(dst, off) { const u32* ap_ = (const u32*)(rsel + (off)); dst.u[0] = ap_[0]; dst.u[1] = ap_[1]; dst.u[2] = ap_[2]; dst.u[3] = ap_[3]; }
#pragma unroll
  for (int i = 2; i < 8; ++i) HY_LOADA(a[i], nb - 16 * i)
#pragma unroll 1
  for (int sb = 0; sb < L; sb += 128) {
#pragma unroll
    for (int u = 0; u < 4; ++u) {
      const int s0 = sb + 32 * u;
      HY_LOADA(a[(0 - 2 * u) & 7], nb + s0)
      HY_LOADA(a[(1 - 2 * u) & 7], nb - 16 + s0)
      const bf16x8 bfrag = *(const bf16x8*)(ub + s0);
#pragma unroll
      for (int i = 0; i < 8; ++i) acc[i] = __builtin_amdgcn_mfma_f32_16x16x32_bf16(a[(i - 2 * u) & 7].v, bfrag, acc[i], 0, 0, 0);
    }
  }
#undef HY_LOADA
  float ssq = 0.f;
  for (int t = 0; t < 32; ++t) ssq += WSP(const float, OFF_PART)[(size_t)(f * 32 + t) * 256 + c];
  const float scale = rsqrtf(ssq + EPSF);
  const float bias = p.in[I_HYBIAS][l * 256 + c];
  const u16* X1C = WSP(const u16, OFF_X1C);
  u16* YM = WSP(u16, OFF_ACT);
  const int b = l16;
#pragma unroll
  for (int i = 0; i < 8; ++i)
#pragma unroll
    for (int r = 0; r < 4; ++r) {
      const int t = tt0 + 16 * i + kg * 4 + r;
      const size_t row = (size_t)b * TPB + posoff + t;
      const float uu = bf2f(UT[((size_t)(c * 16 + b)) * TPB + posoff + t]);
      const float x1 = bf2f(X1C[row * 256 + c]);
      YM[row * 1024 + c] = f2bf(x1 * (scale * acc[i][r] + bias * uu));
    }
}

DI void fnet_item(const Params& p, int it, char* smem) {
  const u16* PQT = WSP(const u16, OFF_PQT);
  u16* YM = WSP(u16, OFF_ACT);
  if (it < 256) {
    const int mt = it >> 5, nt = it & 31;
    const u16* A = WSP(const u16, OFF_DFT);
    auto af = [=](int m, int k) { return A + (size_t)m * 4096 + k; };
    auto bfn = [=](int n, int k) {
      const int b = n >> 8, n2 = n & 255, g = n2 >> 6, kk = n2 & 63, pq = k >> 11, t = k & 2047;
      return PQT + ((size_t)(b * 512 + g * 128 + pq * 64 + kk)) * TPB + CTXL + t;
    };
    auto ef = [=](int m, int n, float v0, float v1, float v2, float v3) {
      const int b = n >> 8, n2 = n & 255;
      const uint2 o = {pack2(v0, v1), pack2(v2, v3)};
      *(uint2*)&YM[((size_t)b * TPB + CTXL + m) * 1024 + 768 + n2] = o;
    };
    gemm_tile<true, 4>(af, bfn, ef, mt * 256, nt * 128, 4096, smem);
  } else {
    const int i2 = it - 256, mt = i2 >> 5, nt = i2 & 31;
    const u16* A = WSP(const u16, OFF_DFTC);
    auto af = [=](int m, int k) { return A + (size_t)m * 512 + k; };
    auto bfn = [=](int n, int k) {
      const int b = n >> 8, n2 = n & 255, g = n2 >> 6, kk = n2 & 63, pq = k >> 8, t = k & 255;
      return PQT + ((size_t)(b * 512 + g * 128 + pq * 64 + kk)) * TPB + t;
    };
    auto ef = [=](int m, int n, float v0, float v1, float v2, float v3) {
      const int b = n >> 8, n2 = n & 255;
      const uint2 o = {pack2(v0, v1), pack2(v2, v3)};
      *(uint2*)&YM[((size_t)b * TPB + m) * 1024 + 768 + n2] = o;
    };
    gemm_tile<true, 4>(af, bfn, ef, mt * 256, nt * 128, 512, smem);
  }
}

DI void phase_mixers(const Params& p, int l, int bid, int nblk, char* smem, int rep = 0) {
  for (int it = bid; it < 256; it += nblk) ssd_item(p, l, it, smem);
  const int nf = (l == 0) ? 288 : 256;
  const int nh = (l == 0) ? 1280 : 1024;
  int* ctr = WSP(int, OFF_CTR) + l + 2 * rep;
  int* sitem = (int*)(smem + LDS_BYTES - 16);
  for (;;) {
    if (TID() == 0) *sitem = atomicAdd(ctr, 1);
    __syncthreads();
    const int it = *sitem;
    __syncthreads();
    if (it >= nf + nh) break;
    if (it < nf) fnet_item(p, it, smem);
    else if (it - nf < 1024) hyena_item_lat(p, l, it - nf);
    else hyena_item(p, l, it - nf + 1024);
  }
}

DI void phase_ssd_combine(const Params& p, int l, int bid, int nblk) {
  const int lane = TID() & 63, w = TID() >> 6;
  const u16* YF = WSP(const u16, OFF_PXBC);
  const u16* YB = YF + (size_t)ROWS * 512;
  const u16* XBCA = WSP(const u16, OFF_XBCA);
  const u16* PZ = WSP(const u16, OFF_PZ);
  u16* YM = WSP(u16, OFF_ACT);
  const float* ng = p.in[I_SNG] + l * 512;
  const int c0 = lane * 8;
  const float dsk = p.in[I_SD][l * 8 + (c0 >> 6)];
  for (int row = bid * 4 + w; row < ROWS; row += nblk * 4) {
    const int pos = row % TPB;
    if (l == 1 && pos < CTXL) continue;
    const uint4 vf = *(const uint4*)(YF + (size_t)row * 512 + c0);
    const uint4 vb = *(const uint4*)(YB + (size_t)row * 512 + c0);
    const uint4 vx = *(const uint4*)(XBCA + (size_t)row * 1024 + c0);
    const uint4 vz = *(const uint4*)(PZ + (size_t)row * 512 + c0);
    const u32 af_[4] = {vf.x, vf.y, vf.z, vf.w}, ab_[4] = {vb.x, vb.y, vb.z, vb.w};
    const u32 ax_[4] = {vx.x, vx.y, vx.z, vx.w}, az_[4] = {vz.x, vz.y, vz.z, vz.w};
    float y[8];
    float ss = 0.f;
#pragma unroll
    for (int i = 0; i < 4; ++i) {
      const float y0 = bflo(af_[i]) + bflo(ab_[i]) + dsk * bflo(ax_[i]);
      const float y1 = bfhi(af_[i]) + bfhi(ab_[i]) + dsk * bfhi(ax_[i]);
      y[2 * i] = y0 * silu_f(bflo(az_[i]));
      y[2 * i + 1] = y1 * silu_f(bfhi(az_[i]));
      ss += y[2 * i] * y[2 * i] + y[2 * i + 1] * y[2 * i + 1];
    }
#pragma unroll
    for (int o = 16; o >= 1; o >>= 1) ss += __shfl_xor(ss, o);
    const float rs = rsqrtf(ss * (1.f / 256.f) + EPSF);
    float o8[8];
#pragma unroll
    for (int i = 0; i < 8; ++i) o8[i] = y[i] * rs * ng[c0 + i];
    uint4 o = {pack2(o8[0], o8[1]), pack2(o8[2], o8[3]), pack2(o8[4], o8[5]), pack2(o8[6], o8[7])};
    *(uint4*)&YM[(size_t)row * 1024 + 256 + c0] = o;
  }
}

DI void phase_outproj(const Params& p, int l, int bid, int nblk, char* smem) {
  const u16* A = WSP(const u16, OFF_ACT);
  const u16* B = WSP(const u16, OFF_WOUT) + (size_t)l * 1024 * 1024;
  const float* MOD = WSP(const float, OFF_MOD);
  const Params pp = p;
  auto af = [=](int m, int k) { return A + (size_t)m * 1024 + k; };
  auto bfn = [=](int n, int k) { return B + (size_t)n * 1024 + k; };
  auto ef = [=](int m, int n, float v0, float v1, float v2, float v3) {
    const int b = m / TPB, pos = m % TPB;
    const float4 ga = *(const float4*)&MOD[(size_t)(l * 17 + (pos < CTXL ? 16 : b)) * 6144 + 2048 + n];
    const float4 xo = *(const float4*)(xrow_ptr(pp, l == 0, b, pos) + n);
    const float4 o = {xo.x + ga.x * v0, xo.y + ga.y * v1, xo.z + ga.z * v2, xo.w + ga.w * v3};
    *(float4*)(xrow_wptr(pp, b, pos) + n) = o;
  };
  const int ntile = (ROWS / 128) * 8;
  const int vb = (nblk % 8 == 0) ? (bid & 7) * (nblk >> 3) + (bid >> 3) : bid;
  for (int t = vb; t < ntile; t += nblk) {
    const int mt = t >> 3, nt = t & 7;
    if (l == 1 && (mt % 18) < 2) continue;
    gemm_tile<true, 2>(af, bfn, ef, mt * 128, nt * 128, 1024, smem);
  }
}

DI void phase_q(const Params& p, int l, int bid, int nblk, char* smem) {
  const u16* A = WSP(const u16, OFF_ACT);
  const u16* B = WSP(const u16, OFF_WQ) + (size_t)l * 2048 * 1024;
  u16* Q = WSP(u16, OFF_Q);
  auto af = [=](int m, int k) { return A + (size_t)m * 1024 + k; };
  auto bfn = [=](int n, int k) { return B + (size_t)n * 1024 + k; };
  auto ef = [=](int m, int n, float v0, float v1, float v2, float v3) {
    const uint2 o = {pack2(v0, v1), pack2(v2, v3)};
    *(uint2*)&Q[(size_t)m * 2048 + n] = o;
  };
  const int ntile = (ROWS / 256) * 16;
  const int vb = (nblk % 8 == 0) ? (bid & 7) * (nblk >> 3) + (bid >> 3) : bid;
  for (int t = vb; t < ntile; t += nblk) {
    const int mt = t >> 4, nt = t & 15;
    if (l == 1 && (mt % 9) < 1) continue;
    gemm_tile<true, 4>(af, bfn, ef, mt * 256, nt * 128, 1024, smem);
  }
}

DI void phase_topk(const Params& p, int l, int bid, int nblk, char* smem) {
  const int tid = TID(), lane = tid & 63, w = tid >> 6, l32 = lane & 31, h = lane >> 5;
  u16* qs = (u16*)smem;
  float* sc = (float*)(smem + 64 * 136 * 2);
  const u16* Q = WSP(const u16, OFF_Q);
  float* TV = WSP(float, OFF_TV);
  int* TI = WSP(int, OFF_TI);
  for (int it = bid; it < (ROWS / 64) * 16; it += nblk) {
    const int hh = it & 15, rt = it >> 4;
    if (l == 1 && (rt % 36) < 4) continue;
    const int row0 = rt * 64;
    const u16* kb = WSP(const u16, OFF_K12) + (size_t)(l * 2 + (hh & 1)) * 16384;
    bf16x8 kfr[8];
#pragma unroll
    for (int ks = 0; ks < 8; ++ks) kfr[ks] = *(const bf16x8*)&kb[(w * 32 + l32) * 128 + ks * 16 + h * 8];
    __builtin_amdgcn_sched_barrier(0);
#pragma unroll
    for (int i = 0; i < 4; ++i) {
      const int q = tid + 256 * i, r = q >> 4, ch = q & 15;
      *(uint4*)&qs[r * 136 + ch * 8] = *(const uint4*)&Q[(size_t)(row0 + r) * 2048 + hh * 128 + ch * 8];
    }
    __syncthreads();
    f32x16 acc[2];
#pragma unroll
    for (int i = 0; i < 2; ++i)
#pragma unroll
      for (int r = 0; r < 16; ++r) acc[i][r] = 0.f;
#pragma unroll
    for (int ks = 0; ks < 8; ++ks) {
      const bf16x8 bq = kfr[ks];
      const bf16x8 a0 = *(const bf16x8*)&qs[(l32) * 136 + ks * 16 + h * 8];
      const bf16x8 a1 = *(const bf16x8*)&qs[(32 + l32) * 136 + ks * 16 + h * 8];
      acc[0] = __builtin_amdgcn_mfma_f32_32x32x16_bf16(a0, bq, acc[0], 0, 0, 0);
      acc[1] = __builtin_amdgcn_mfma_f32_32x32x16_bf16(a1, bq, acc[1], 0, 0, 0);
    }
#pragma unroll
    for (int mt = 0; mt < 2; ++mt)
#pragma unroll
      for (int i = 0; i < 16; ++i) {
        const int r = mt * 32 + (i & 3) + 8 * (i >> 2) + 4 * h;
        sc[r * 133 + w * 33 + l32] = acc[mt][i];
      }
    __syncthreads();
    {
      const int r = tid >> 2, part = tid & 3;
      u32 key[32];
#pragma unroll
      for (int j = 0; j < 32; ++j) {
        const u32 u = __float_as_uint(sc[r * 133 + part * 33 + j]);
        const u32 ord = (u & 0x80000000u) ? ~u : (u | 0x80000000u);
        key[j] = (ord & ~127u) | (u32)(127 - (part * 32 + j));
      }
      float* tv = TV + ((size_t)(row0 + r) * 16 + hh) * 16;
      int* ti = TI + ((size_t)(row0 + r) * 16 + hh) * 16;
#pragma unroll
      for (int k = 2; k <= 32; k <<= 1)
#pragma unroll
        for (int j = k >> 1; j > 0; j >>= 1)
#pragma unroll
          for (int i = 0; i < 32; ++i) {
            const int l2 = i ^ j;
            if (l2 > i) {
              const u32 ka = key[i], kb2 = key[l2];
              const u32 lo = ka < kb2 ? ka : kb2, hi = ka < kb2 ? kb2 : ka;
              if ((i & k) == 0) { key[i] = lo; key[l2] = hi; } else { key[i] = hi; key[l2] = lo; }
            }
          }
      u32 T[16];
#pragma unroll
      for (int t = 0; t < 16; ++t) T[t] = key[31 - t];
#define TOPK_MERGE(CTRL)                                                                      \
      {                                                                                       \
        u32 M[16];                                                                            \
        _Pragma("unroll") for (int t = 0; t < 16; ++t) {                                      \
          const u32 o = (u32)dpp_i<CTRL>((int)T[15 - t]);                                     \
          M[t] = T[t] > o ? T[t] : o;                                                         \
        }                                                                                     \
        _Pragma("unroll") for (int j = 8; j > 0; j >>= 1)                                     \
          _Pragma("unroll") for (int i = 0; i < 16; ++i) {                                    \
            const int l2 = i ^ j;                                                             \
            if (l2 > i) {                                                                     \
              const u32 ka = M[i], kb2 = M[l2];                                               \
              M[i] = ka > kb2 ? ka : kb2;                                                     \
              M[l2] = ka > kb2 ? kb2 : ka;                                                    \
            }                                                                                 \
          }                                                                                   \
        _Pragma("unroll") for (int t = 0; t < 16; ++t) T[t] = M[t];                           \
      }
      TOPK_MERGE(DPP_XOR1)
      TOPK_MERGE(DPP_XOR2)
#undef TOPK_MERGE
      if (part == 0) {
        float ov[16];
        int oi[16];
#pragma unroll
        for (int rd = 0; rd < 16; ++rd) {
          const u32 best = T[rd];
          const u32 ordv = best & ~127u;
          const u32 uu = (ordv & 0x80000000u) ? (ordv & 0x7FFFFFFFu) : ~ordv;
          ov[rd] = __uint_as_float(uu);
          oi[rd] = 127 - (int)(best & 127u);
        }
#pragma unroll
        for (int q = 0; q < 4; ++q) {
          float4 fv = {ov[q * 4 + 0], ov[q * 4 + 1], ov[q * 4 + 2], ov[q * 4 + 3]};
          int4 iv = {oi[q * 4 + 0], oi[q * 4 + 1], oi[q * 4 + 2], oi[q * 4 + 3]};
          *(float4*)(tv + q * 4) = fv;
          *(int4*)(ti + q * 4) = iv;
        }
      }
    }
    __syncthreads();
  }
}

DI int cand_a(int c) {
  const u32 T[7] = {0x00000000u, 0x00000000u, 0x11111111u, 0x33322222u, 0x66554443u, 0xDCBA9877u, 0x000000FEu};
  u32 wv = T[0];
#pragma unroll
  for (int s = 1; s < 7; ++s) wv = ((c >> 3) == s) ? T[s] : wv;
  return (int)((wv >> ((c & 7) * 4)) & 15u);
}
DI int cand_b(int c) {
  const u32 T[7] = {0x76543210u, 0xFEDCBA98u, 0x76543210u, 0x21043210u, 0x10102103u, 0x00000010u, 0x00000000u};
  u32 wv = T[0];
#pragma unroll
  for (int s = 1; s < 7; ++s) wv = ((c >> 3) == s) ? T[s] : wv;
  return (int)((wv >> ((c & 7) * 4)) & 15u);
}
DI void phase_peer(const Params& p, int l, int bid, int nblk) {
  const int w = TID() >> 6;
  const float* TV = WSP(const float, OFF_TV);
  const int* TI = WSP(const int, OFF_TI);
  const u16* H2 = WSP(const u16, OFF_ACT);
  const unsigned char* UB = WSP(const unsigned char, OFF_XBCA);
  const unsigned char* VB = UB + (size_t)16384 * 1024;
  const float* gfin = p.in[I_GF];
  for (int row = bid * 4 + w; row < ROWS; row += nblk * 4) {
    const int b = row / TPB, pos = row % TPB;
    if (l == 1 && pos < CTXL) continue;
    const int lane = TID() & 63;
    const int head = lane >> 3, sub = lane & 7;
    const float* tv1 = TV + ((size_t)row * 16 + head * 2) * 16;
    const float* tv2 = tv1 + 16;
    const int* ti1 = TI + ((size_t)row * 16 + head * 2) * 16;
    const int* ti2 = ti1 + 16;
    const int t1lo = ti1[sub], t1hi = ti1[sub + 8], t2lo = ti2[sub], t2hi = ti2[sub + 8];
    u32 ck[7];
#pragma unroll
    for (int s = 0; s < 7; ++s) {
      const int c = sub + 8 * s;
      if (c < 50) {
        const u32 u = __float_as_uint(tv1[cand_a(c)] + tv2[cand_b(c)]);
        const u32 ord = (u & 0x80000000u) ? ~u : (u | 0x80000000u);
        ck[s] = (ord & ~63u) | (u32)(63 - c);
      } else ck[s] = 0u;
    }
    float w0v = 0.f, w1v = 0.f, mx = 0.f;
    int w0c = 0, w1c = 0;
    u32 prevk = 0xFFFFFFFFu;
#pragma unroll
    for (int r = 0; r < 16; ++r) {
      u32 m = 0u;
#pragma unroll
      for (int s = 0; s < 7; ++s) { const u32 d = ck[s] - prevk; m = d > m ? d : m; }
      { const u32 ov = (u32)dpp_i<DPP_XOR1>((int)m); m = ov > m ? ov : m; }
      { const u32 ov = (u32)dpp_i<DPP_XOR2>((int)m); m = ov > m ? ov : m; }
      { const u32 ov = (u32)dpp_i<DPP_MIRROR8>((int)m); m = ov > m ? ov : m; }
      const u32 best = prevk + m;
      prevk = best;
      const u32 ordv = best & ~63u;
      const float bv = __uint_as_float((ordv & 0x80000000u) ? (ordv & 0x7FFFFFFFu) : ~ordv);
      const int bc = 63 - (int)(best & 63u);
      if (r == 0) mx = bv;
      if (sub == (r & 7)) {
        if (r < 8) { w0v = bv; w0c = bc; } else { w1v = bv; w1c = bc; }
      }
    }
    const float e0 = expf(w0v - mx), e1 = expf(w1v - mx);
    float es = e0 + e1;
    es += dpp_f<DPP_XOR1>(es);
    es += dpp_f<DPP_XOR2>(es);
    es += dpp_f<DPP_MIRROR8>(es);
    const float g0 = e0 / es, g1 = e1 / es;
    int idx0, idx1;
    {
      const int gb = lane & ~7;
      const int a0 = cand_a(w0c), c0 = cand_b(w0c), a1 = cand_a(w1c), c1 = cand_b(w1c);
      const int p0l = __shfl(t1lo, gb + (a0 & 7)), p0h = __shfl(t1hi, gb + (a0 & 7));
      const int q0l = __shfl(t2lo, gb + (c0 & 7)), q0h = __shfl(t2hi, gb + (c0 & 7));
      const int p1l = __shfl(t1lo, gb + (a1 & 7)), p1h = __shfl(t1hi, gb + (a1 & 7));
      const int q1l = __shfl(t2lo, gb + (c1 & 7)), q1h = __shfl(t2hi, gb + (c1 & 7));
      idx0 = ((a0 & 8) ? p0h : p0l) * 128 + ((c0 & 8) ? q0h : q0l);
      idx1 = ((a1 & 8) ? p1h : p1l) * 128 + ((c1 & 8) ? q1h : q1l);
    }
    const u16* hrow = H2 + (size_t)row * 1024;
    float hv[16];
    {
      const uint4 ha = *(const uint4*)(hrow + lane * 16), hb = *(const uint4*)(hrow + lane * 16 + 8);
      hv[0] = bflo(ha.x); hv[1] = bfhi(ha.x); hv[2] = bflo(ha.y); hv[3] = bfhi(ha.y);
      hv[4] = bflo(ha.z); hv[5] = bfhi(ha.z); hv[6] = bflo(ha.w); hv[7] = bfhi(ha.w);
      hv[8] = bflo(hb.x); hv[9] = bfhi(hb.x); hv[10] = bflo(hb.y); hv[11] = bfhi(hb.y);
      hv[12] = bflo(hb.z); hv[13] = bfhi(hb.z); hv[14] = bflo(hb.w); hv[15] = bfhi(hb.w);
    }
    float acc[16];
#pragma unroll 1
    for (int prep_ = 0; prep_ < PEER_REPS; ++prep_) {
    f32x2 hv2[8];
#pragma unroll
    for (int i = 0; i < 8; ++i) hv2[i] = (f32x2){hv[2 * i], hv[2 * i + 1]};
    const bool b0 = lane & 1, b1 = lane & 2, b2 = lane & 4;
    float act0 = 0.f, act1 = 0.f;
    u32x4 rb[2][8];
#define PEER_LOAD(buf, k, TAB)                                                                     \
  _Pragma("unroll") for (int j = 0; j < 8; ++j) {                                                  \
    const int e = (k) * 8 + j;                                                                     \
    const int id = __builtin_amdgcn_readlane(((k) < 8) ? idx0 : idx1, e & 63);                     \
    rb[buf][j] = *(const u32x4*)(TAB + (size_t)id * 1024 + lane * 16);                             \
  }
#define PEER_DOT(buf, k)                                                                           \
  {                                                                                                \
    float d[8];                                                                                    \
    _Pragma("unroll") for (int j = 0; j < 8; ++j) {                                                \
      const u32 uw[4] = {rb[buf][j][0], rb[buf][j][1], rb[buf][j][2], rb[buf][j][3]};              \
      f32x2 sa = {0.f, 0.f}, sb = {0.f, 0.f};                   \
      _Pragma("unroll") for (int q = 0; q < 4; ++q) {                                              \
        const f32x2 lo = __builtin_amdgcn_cvt_pk_f32_fp8((int)uw[q], false);                       \
        const f32x2 hi = __builtin_amdgcn_cvt_pk_f32_fp8((int)uw[q], true);                        \
        sa = __builtin_elementwise_fma(hv2[2 * q], lo, sa);                                        \
        sb = __builtin_elementwise_fma(hv2[2 * q + 1], hi, sb);                                    \
      }                                                                                            \
      sa += sb;                                                                                    \
      d[j] = sa.x + sa.y;                                                                          \
    }                                                                                              \
    float a4[4];                                                                                   \
    _Pragma("unroll") for (int q = 0; q < 4; ++q) {                                                \
      const float keep = b0 ? d[2 * q + 1] : d[2 * q], send = b0 ? d[2 * q] : d[2 * q + 1];        \
      a4[q] = keep + __shfl_xor(send, 1);                                                          \
    }                                                                                              \
    float a2[2];                                                                                   \
    _Pragma("unroll") for (int q = 0; q < 2; ++q) {                                                \
      const float keep = b1 ? a4[2 * q + 1] : a4[2 * q], send = b1 ? a4[2 * q] : a4[2 * q + 1];    \
      a2[q] = keep + __shfl_xor(send, 2);                                                          \
    }                                                                                              \
    const float keep = b2 ? a2[1] : a2[0], send = b2 ? a2[0] : a2[1];                              \
    float c1 = keep + __shfl_xor(send, 4);                                                         \
    c1 += __shfl_xor(c1, 8);                                                                       \
    c1 += __shfl_xor(c1, 16);                                                                      \
    c1 += __shfl_xor(c1, 32);                                                                      \
    if ((lane >> 3) == ((k) & 7)) { if ((k) < 8) act0 = c1; else act1 = c1; }                      \
  }
    PEER_LOAD(0, 0, UB)
#pragma unroll 1
    for (int k = 0; k < 16; k += 2) {
      PEER_LOAD(1, k + 1, UB)
      __builtin_amdgcn_sched_barrier(0);
      PEER_DOT(0, k)
      { const int kn = (k + 2 < 16) ? k + 2 : 15; PEER_LOAD(0, kn, UB) }
      __builtin_amdgcn_sched_barrier(0);
      PEER_DOT(1, k + 1)
    }
    const float ga0 = gelu_tanh(act0 * (1.f / U_SCALE)) * g0 * (1.f / V_SCALE);
    const float ga1 = gelu_tanh(act1 * (1.f / U_SCALE)) * g1 * (1.f / V_SCALE);
#pragma unroll
    for (int i = 0; i < 16; ++i) acc[i] = 0.f;
#define PEER_ACC(buf, k)                                                                           \
  _Pragma("unroll") for (int j = 0; j < 8; ++j) {                                                  \
    const int e = (k) * 8 + j;                                                                     \
    const int ai = __builtin_amdgcn_readlane(__builtin_bit_cast(int, ((k) < 8) ? ga0 : ga1), e & 63); \
    const float a = __builtin_bit_cast(float, ai);                                                 \
    const u32 vw[4] = {rb[buf][j][0], rb[buf][j][1], rb[buf][j][2], rb[buf][j][3]};                \
    _Pragma("unroll") for (int q = 0; q < 4; ++q) {                                                \
      const f32x2 lo = __builtin_amdgcn_cvt_pk_f32_fp8((int)vw[q], false);                         \
      const f32x2 hi = __builtin_amdgcn_cvt_pk_f32_fp8((int)vw[q], true);                          \
      acc[q * 4 + 0] += a * lo.x; acc[q * 4 + 1] += a * lo.y; acc[q * 4 + 2] += a * hi.x; acc[q * 4 + 3] += a * hi.y; \
    }                                                                                              \
  }
    PEER_LOAD(0, 0, VB)
#pragma unroll 1
    for (int k = 0; k < 16; k += 2) {
      PEER_LOAD(1, k + 1, VB)
      __builtin_amdgcn_sched_barrier(0);
      PEER_ACC(0, k)
      { const int kn = (k + 2 < 16) ? k + 2 : 15; PEER_LOAD(0, kn, VB) }
      __builtin_amdgcn_sched_barrier(0);
      PEER_ACC(1, k + 1)
    }
#undef PEER_LOAD
#undef PEER_DOT
#undef PEER_ACC
      if (prep_ + 1 < PEER_REPS) { _Pragma("unroll") for (int i = 0; i < 16; ++i) asm volatile("" :: "v"(acc[i])); }
    }
    int row2 = row;
    asm volatile("" : "+v"(row2));
    const int lane2 = TID() & 63;
    const int b2 = row2 / TPB, pos2 = row2 % TPB;
    const float* xr = xrow_ptr(p, false, b2, pos2);
    float* xw = xrow_wptr(p, b2, pos2);
    const float* ga = WSP(const float, OFF_MOD) + (size_t)(l * 17 + (pos2 < CTXL ? 16 : b2)) * 6144 + 5120;
    float xn[16];
    float ss = 0.f;
#pragma unroll
    for (int q = 0; q < 4; ++q) {
      const float4 xv = *(const float4*)(xr + lane2 * 16 + q * 4);
      const float4 gv = *(const float4*)(ga + lane2 * 16 + q * 4);
      xn[q * 4 + 0] = xv.x + gv.x * acc[q * 4 + 0];
      xn[q * 4 + 1] = xv.y + gv.y * acc[q * 4 + 1];
      xn[q * 4 + 2] = xv.z + gv.z * acc[q * 4 + 2];
      xn[q * 4 + 3] = xv.w + gv.w * acc[q * 4 + 3];
    }
    if (l == 1) {
#pragma unroll
      for (int i = 0; i < 16; ++i) ss += xn[i] * xn[i];
      ss = wave_sum(ss);
      const float rs = rsqrtf(ss * (1.f / 1024.f) + EPSF);
#pragma unroll
      for (int i = 0; i < 16; ++i) xn[i] = xn[i] * rs * gfin[lane2 * 16 + i];
    }
#pragma unroll
    for (int q = 0; q < 4; ++q) {
      float4 o = {xn[q * 4 + 0], xn[q * 4 + 1], xn[q * 4 + 2], xn[q * 4 + 3]};
      *(float4*)(xw + lane2 * 16 + q * 4) = o;
    }
  }
}

template <int S>
DI void run_stage(const Params& p, int l, int bid, int nblk, char* smem) {
  for (int rep = 0; rep < 1 + ((REP_MASK >> (S + 1)) & 1); ++rep) {
  if (S == 0) { if (PH_MASK & 2) phase_norm(p, l, 0, bid, nblk); }
  else if (S == 1) { if (PH_MASK & 4) phase_inproj(p, l, bid, nblk, smem); }
  else if (S == 2) { if (PH_MASK & 8) phase_prep(p, l, bid, nblk, smem); }
  else if (S == 3) { if (PH_MASK & 16) phase_mixers(p, l, bid, nblk, smem, rep); }
  else if (S == 4) { if (PH_MASK & 32) phase_ssd_combine(p, l, bid, nblk); }
  else if (S == 5) { if (PH_MASK & 64) phase_outproj(p, l, bid, nblk, smem); }
  else if (S == 6) { if (PH_MASK & 128) { phase_norm(p, l, 1, bid, nblk); phase_tables(p, l, bid, nblk); } }
  else if (S == 7) { if (PH_MASK & 256) phase_q(p, l, bid, nblk, smem); }
  else if (S == 8) { if (PH_MASK & 512) phase_topk(p, l, bid, nblk, smem); }
  else { if (PH_MASK & 1024) phase_peer(p, l, bid, nblk); }
  }
}

#if ONE_LAUNCH
__global__ void __launch_bounds__(NTHR, 2) mega(Params p) {
  extern __shared__ __attribute__((aligned(16))) char smem[];
  const int bid = blockIdx.x, nblk = gridDim.x;
  cg::grid_group grid = cg::this_grid();
  volatile LAS unsigned* bst = (volatile LAS unsigned*)(smem + LDS_BYTES - 32);
  if (threadIdx.x == 0) { bst[0] = 0u; bst[1] = 0u; }
  __syncthreads();
  const XcdBarrier bar = xcd_barrier_post(WSP(unsigned, OFF_BAR), bst);
  for (int rep = 0; rep < 1 + (REP_MASK & 1); ++rep) { if (PH_MASK & 1) phase_prologue(p, bid, nblk, smem); }
  grid.sync();
#define GBAR() xcd_barrier(bar)
#pragma nounroll
  for (int l = 0; l < 2; ++l) {
    for (int xs = 0; xs < EXTRA_SYNCS; ++xs) GBAR();
    run_stage<0>(p, l, bid, nblk, smem); GBAR();
    run_stage<1>(p, l, bid, nblk, smem); GBAR();
    run_stage<2>(p, l, bid, nblk, smem); GBAR();
    run_stage<3>(p, l, bid, nblk, smem); GBAR();
    run_stage<4>(p, l, bid, nblk, smem); GBAR();
    run_stage<5>(p, l, bid, nblk, smem); GBAR();
    run_stage<6>(p, l, bid, nblk, smem); GBAR();
    run_stage<7>(p, l, bid, nblk, smem); GBAR();
    run_stage<8>(p, l, bid, nblk, smem); GBAR();
    run_stage<9>(p, l, bid, nblk, smem);
    if (l == 0) GBAR();
  }
}
#else
template <int S>
__global__ void __launch_bounds__(NTHR, 2) stage_kernel(Params p, int l) {
  extern __shared__ __attribute__((aligned(16))) char smem[];
  if (S < 0) phase_prologue(p, blockIdx.x, gridDim.x, smem);
  else run_stage<(S < 0 ? 0 : S)>(p, l, blockIdx.x, gridDim.x, smem);
}

template <int S>
static void launch_stage(const Params& p, int l, int grid, hipStream_t stream) {
  (void)hipFuncSetAttribute((const void*)stage_kernel<S>, hipFuncAttributeMaxDynamicSharedMemorySize, LDS_BYTES);
  hipLaunchKernelGGL(stage_kernel<S>, dim3(grid), dim3(NTHR), LDS_BYTES, stream, p, l);
}

#endif

extern "C" void kernel_launch(void* const* d_in, const int* in_sizes, int n_in, void* d_out, int out_size, void* d_ws,
                              size_t ws_size, hipStream_t stream) {
  static int grid = 0;
  if (grid == 0) {
    if (ws_size < WS_END || n_in != 31) { fprintf(stderr, "kernel_launch: ws %zu < %zu or n_in %d\n", ws_size, (size_t)WS_END, n_in); grid = -1; return; }
    int dev = 0, cus = 0, per_cu = 0;
    (void)hipGetDevice(&dev);
    (void)hipDeviceGetAttribute(&cus, hipDeviceAttributeMultiprocessorCount, dev);
#if ONE_LAUNCH
    (void)hipFuncSetAttribute((const void*)mega, hipFuncAttributeMaxDynamicSharedMemorySize, LDS_BYTES);
    (void)hipOccupancyMaxActiveBlocksPerMultiprocessor(&per_cu, (const void*)mega, NTHR, LDS_BYTES);
#else
    (void)hipFuncSetAttribute((const void*)stage_kernel<3>, hipFuncAttributeMaxDynamicSharedMemorySize, LDS_BYTES);
    (void)hipOccupancyMaxActiveBlocksPerMultiprocessor(&per_cu, (const void*)stage_kernel<3>, NTHR, LDS_BYTES);
#endif
    if (per_cu < 1) per_cu = 1;
    if (per_cu > 2) per_cu = 2;
    grid = cus * per_cu;
  }
  if (grid < 0) return;
  (void)hipMemsetAsync((char*)d_ws + OFF_CTR, 0, 256 + 3456 * 4, stream);
  Params p{};
  for (int i = 0; i < 31; ++i) p.in[i] = (const float*)d_in[i];
  p.out = (float*)d_out;
  p.ws = (unsigned char*)d_ws;
#if ONE_LAUNCH
  void* args[] = {&p};
  hipError_t e = hipLaunchCooperativeKernel((const void*)mega, dim3(grid), dim3(NTHR), args, LDS_BYTES, stream);
  if (e != hipSuccess) fprintf(stderr, "cooperative launch failed: %s (grid %d)\n", hipGetErrorString(e), grid);
#else
  launch_stage<-1>(p, 0, grid, stream);
  for (int l = 0; l < 2; ++l) {
    launch_stage<0>(p, l, grid, stream);
    launch_stage<1>(p, l, grid, stream);
    launch_stage<2>(p, l, grid, stream);
    launch_stage<3>(p, l, grid, stream);
    launch_stage<4>(p, l, grid, stream);
    launch_stage<5>(p, l, grid, stream);
    launch_stage<6>(p, l, grid, stream);
    launch_stage<7>(p, l, grid, stream);
    launch_stage<8>(p, l, grid, stream);
    launch_stage<9>(p, l, grid, stream);
  }
#endif
}
```

```cpp
#include <hip/hip_runtime.h>
#include <hip/hip_cooperative_groups.h>
#include <cstdio>
namespace cg = cooperative_groups;

#ifndef PH_MASK
#define PH_MASK 0xFFFF
#endif
#ifndef PEER_REPS
#define PEER_REPS 1
#endif
#ifndef EXTRA_SYNCS
#define EXTRA_SYNCS 0
#endif
#ifndef REP_MASK
#define REP_MASK 0
#endif
#ifndef ONE_LAUNCH
#define ONE_LAUNCH 1
#endif

typedef unsigned short u16;
typedef unsigned int u32;
typedef __attribute__((ext_vector_type(8))) short bf16x8;
typedef __attribute__((ext_vector_type(16))) float f32x16;
typedef __attribute__((ext_vector_type(4))) float f32x4;
typedef __attribute__((ext_vector_type(2))) float f32x2;
typedef __attribute__((ext_vector_type(4))) unsigned int u32x4;
#define DI __device__ __forceinline__
DI int TID() { int t = threadIdx.x; asm volatile("" : "+v"(t)); return t; }

DI u16 f2bf(float x) { u32 u = __float_as_uint(x); u += 0x7fffu + ((u >> 16) & 1u); return (u16)(u >> 16); }
DI float bf2f(u16 v) { return __uint_as_float(((u32)v) << 16); }
DI u32 pack2(float a, float b) { return (u32)f2bf(a) | ((u32)f2bf(b) << 16); }
DI float bflo(u32 v) { return __uint_as_float(v << 16); }
DI float bfhi(u32 v) { return __uint_as_float(v & 0xffff0000u); }

constexpr int D = 1024, NB = 16, SEQ = 2048, CTXL = 256, TPB = 2304, ROWS = NB * TPB;
constexpr int NIN = 2944;
constexpr int RSTR = 4112;
constexpr int NTHR = 256;
constexpr int LDS_BYTES = 73728;
constexpr float EPSF = 1e-6f;

constexpr size_t SZ_PHY = (size_t)ROWS * 768 * 2, SZ_PZ = (size_t)ROWS * 512 * 2, SZ_PXBC = (size_t)ROWS * 1024 * 2;
constexpr size_t OFF_PHY = 0;
constexpr size_t OFF_PZ = OFF_PHY + SZ_PHY;
constexpr size_t OFF_PXBC = OFF_PZ + SZ_PZ;
constexpr size_t OFF_Q = OFF_PHY;
constexpr size_t OFF_ACT = OFF_PXBC + SZ_PXBC;
constexpr size_t OFF_XBCA = OFF_ACT + (size_t)ROWS * 1024 * 2;
constexpr size_t OFF_DREG = OFF_XBCA + (size_t)ROWS * 1024 * 2;
constexpr size_t OFF_PQT = OFF_DREG;
constexpr size_t OFF_UT = OFF_PQT + (size_t)NB * 512 * TPB * 2;
constexpr size_t OFF_X1C = OFF_UT + (size_t)256 * 16 * TPB * 2;
constexpr size_t OFF_TV = OFF_DREG;
constexpr size_t OFF_TI = OFF_TV + (size_t)ROWS * 256 * 4;
constexpr size_t OFF_XC = OFF_DREG + (size_t)ROWS * 256 * 8;
constexpr size_t OFF_WIN = OFF_XC + (size_t)NB * CTXL * D * 4;
constexpr size_t OFF_WOUT = OFF_WIN + (size_t)2 * NIN * 1024 * 2;
constexpr size_t OFF_WQ = OFF_WOUT + (size_t)2 * 1024 * 1024 * 2;
constexpr size_t OFF_K12 = OFF_WQ + (size_t)2 * 2048 * 1024 * 2;
constexpr size_t OFF_DFT = OFF_K12 + (size_t)2 * 2 * 128 * 128 * 2;
constexpr size_t OFF_DFTC = OFF_DFT + (size_t)2048 * 4096 * 2;
constexpr size_t OFF_RF = OFF_DFTC + (size_t)256 * 512 * 2;
constexpr size_t OFF_PART = OFF_RF + (size_t)3 * 256 * 2 * RSTR * 2;
constexpr size_t OFF_MOD = OFF_PART + (size_t)3 * 32 * 256 * 4;
constexpr size_t OFF_DT = OFF_MOD + (size_t)2 * 17 * 6144 * 4;
constexpr size_t OFF_CTR = OFF_DT + (size_t)ROWS * 16 * 4;
constexpr size_t OFF_BAR = OFF_CTR + 256;
constexpr size_t OFF_TX = OFF_BAR + 3456 * 4;
constexpr size_t WS_END = OFF_TX + (size_t)NB * 768 * TPB * 2;

struct Params {
  const float* in[31];
  float* out;
  unsigned char* ws;
  int pad0, pad1;
};

enum { I_X = 0, I_C, I_CTX, I_CCTX, I_WADA, I_BADA, I_G1, I_G2, I_WIN, I_HYCW, I_HYCB, I_HFW1, I_HFB1, I_HFW2, I_HFB2,
       I_HFW3, I_HFFREQ, I_HYBIAS, I_SCW, I_SCB, I_SDTB, I_SALOG, I_SD, I_SNG, I_WOUT, I_WQ, I_K1, I_K2, I_PU, I_PV, I_GF };

__device__ const unsigned char CAND_A[56] = {0, 0, 0, 0, 0, 0, 0, 0, 0, 0, 0, 0, 0, 0, 0, 0, 1, 1, 1, 1, 1, 1, 1, 1, 2, 2, 2, 2, 2, 3, 3, 3, 3, 4, 4, 4, 5, 5, 6, 6, 7, 7, 8, 9, 10, 11, 12, 13, 14, 15, 0, 0, 0, 0, 0, 0};
__device__ const unsigned char CAND_B[56] = {0, 1, 2, 3, 4, 5, 6, 7, 8, 9, 10, 11, 12, 13, 14, 15, 0, 1, 2, 3, 4, 5, 6, 7, 0, 1, 2, 3, 4, 0, 1, 2, 3, 0, 1, 2, 0, 1, 0, 1, 0, 1, 0, 0, 0, 0, 0, 0, 0, 0, 0, 0, 0, 0, 0, 0};

#define WSP(T, off) ((T*)(p.ws + (off)))

#define XB_TMO      128
#define XB_XCNT(j)  (256  + 64 * (j))
#define XB_XSUB(j)  (1280 + 64 * (j))
#define XB_XGEN(j)  (2304 + 64 * (j))
#define XB_TOP      3328
#define XB_TOPGEN   3392
#define XCD_BAR_WORDS 3456
#define XB_SPIN_CAP (1u << 18)
#define LAS __attribute__((address_space(3)))
DI unsigned xb_ld(unsigned* p) { return __hip_atomic_load(p, __ATOMIC_RELAXED, __HIP_MEMORY_SCOPE_AGENT); }
DI unsigned xb_add(unsigned* p, unsigned v) { return __hip_atomic_fetch_add(p, v, __ATOMIC_RELAXED, __HIP_MEMORY_SCOPE_AGENT); }
DI unsigned xb_xcc_id() { return (unsigned)__builtin_amdgcn_s_getreg((3 << 11) | 20) & 0xFu; }
#define XB_SPIN(cond, bar) do { unsigned _sp = 0; while (cond) { __builtin_amdgcn_s_sleep(1); \
    if ((++_sp & 255u) == 0u) { if (xb_ld(&(bar)[XB_TMO])) break; if (_sp > XB_SPIN_CAP) { atomicAdd(&(bar)[XB_TMO], 1u); break; } } } } while (0)
struct XcdBarrier { unsigned* bar; unsigned x; volatile LAS unsigned* st; };
DI XcdBarrier xcd_barrier_post(unsigned* bar, volatile LAS unsigned* st) {
  XcdBarrier b; b.bar = bar; b.x = xb_xcc_id(); b.st = st;
  if (threadIdx.x == 0) (void)xb_add(&bar[XB_XCNT(b.x)], 1u);
  return b;
}
DI void xcd_barrier_complete(unsigned* bar, unsigned x, unsigned& nloc, unsigned& nx) {
  const unsigned G = gridDim.x * gridDim.y * gridDim.z;
  unsigned sum, cnt, mine, sp = 0u;
  for (;;) {
    sum = 0u; cnt = 0u; mine = 0u;
#pragma unroll
    for (unsigned j = 0; j < 16; ++j) { const unsigned c = xb_ld(&bar[XB_XCNT(j)]); sum += c; cnt += (c > 0u) ? 1u : 0u; mine = (j == x) ? c : mine; }
    if (sum == G) break;
    __builtin_amdgcn_s_sleep(1);
    if ((++sp & 255u) == 0u) { if (xb_ld(&bar[XB_TMO])) break; if (sp > XB_SPIN_CAP) { atomicAdd(&bar[XB_TMO], 1u); break; } }
  }
  nloc = mine > 0u ? mine : 1u; nx = cnt > 0u ? cnt : 1u;
}
DI void xcd_barrier(const XcdBarrier& b) {
  asm volatile("s_waitcnt vmcnt(0)" ::: "memory");
  __syncthreads();
  if (threadIdx.x == 0) {
    unsigned* bar = b.bar;
    __builtin_amdgcn_s_waitcnt(0);
    unsigned nloc = b.st[0], nx = b.st[1];
    if (nloc == 0u) { xcd_barrier_complete(bar, b.x, nloc, nx); b.st[0] = nloc; b.st[1] = nx; }
    const unsigned old = xb_add(&bar[XB_XSUB(b.x)], 1u);
    const unsigned gen = old / nloc;
    if (old + 1u == (gen + 1u) * nloc) {
      __builtin_amdgcn_fence(__ATOMIC_RELEASE, "agent");
      asm volatile("s_waitcnt vmcnt(0)" ::: "memory");
      const unsigned og = xb_add(&bar[XB_TOP], 1u);
      const unsigned tg = og / nx;
      if (og + 1u == (tg + 1u) * nx) xb_add(&bar[XB_TOPGEN], 1u);
      else XB_SPIN(xb_ld(&bar[XB_TOPGEN]) == tg, bar);
      __builtin_amdgcn_fence(__ATOMIC_ACQUIRE, "agent");
      xb_add(&bar[XB_XGEN(b.x)], 1u);
      asm volatile("s_waitcnt vmcnt(0)" ::: "memory");
    } else {
      XB_SPIN(xb_ld(&bar[XB_XGEN(b.x)]) == gen, bar);
      __builtin_amdgcn_fence(__ATOMIC_ACQUIRE, "agent");
      asm volatile("s_waitcnt vmcnt(0)" ::: "memory");
    }
  }
  __syncthreads();
}


template <bool SWAP, int MI, class AF, class BF, class EF>
DI void gemm_tile(const AF& af, const BF& bfn, const EF& ef, int m0, int n0, int K, char* smem) {
  constexpr int AROWS = MI * 64;
  u16* As = (u16*)smem;
  u16* Bs = As + 2 * AROWS * 40;
  const int tid = TID(), lane = tid & 63, w = tid >> 6;
  const int wm = w >> 1, wn = w & 1, l32 = lane & 31, h = lane >> 5;
  const int lrow = (tid >> 6) * 16 + ((tid >> 5) & 1) * 8 + ((tid >> 2) & 1) * 4 + ((tid >> 3) & 3), lk = (tid & 3) * 8;
  f32x16 acc[MI][2];
#pragma unroll
  for (int i = 0; i < MI; ++i)
#pragma unroll
    for (int j = 0; j < 2; ++j)
#pragma unroll
      for (int r = 0; r < 16; ++r) acc[i][j][r] = 0.f;
  u32x4 ra[MI], rb[2];
  const int nk = K >> 5;
#pragma unroll
  for (int i = 0; i < MI; ++i) ra[i] = *(const u32x4*)af(m0 + lrow + 64 * i, lk);
#pragma unroll
  for (int i = 0; i < 2; ++i) rb[i] = *(const u32x4*)bfn(n0 + lrow + 64 * i, lk);
#pragma unroll
  for (int i = 0; i < MI; ++i) *(u32x4*)&As[(lrow + 64 * i) * 40 + lk] = ra[i];
#pragma unroll
  for (int i = 0; i < 2; ++i) *(u32x4*)&Bs[(lrow + 64 * i) * 40 + lk] = rb[i];
  {
    const int k1 = (nk > 1) ? 32 + lk : lk;
#pragma unroll
    for (int i = 0; i < MI; ++i) ra[i] = *(const u32x4*)af(m0 + lrow + 64 * i, k1);
#pragma unroll
    for (int i = 0; i < 2; ++i) rb[i] = *(const u32x4*)bfn(n0 + lrow + 64 * i, k1);
  }
  __syncthreads();
  for (int kt = 0; kt < nk; ++kt) {
    const int cur = kt & 1;
    const u16* Ab = As + cur * AROWS * 40;
    const u16* Bb = Bs + cur * 128 * 40;
#pragma unroll
    for (int ks = 0; ks < 2; ++ks) {
      bf16x8 a[MI], b[2];
#pragma unroll
      for (int i = 0; i < MI; ++i) a[i] = *(const bf16x8*)&Ab[(wm * (MI * 32) + i * 32 + l32) * 40 + ks * 16 + h * 8];
#pragma unroll
      for (int i = 0; i < 2; ++i) b[i] = *(const bf16x8*)&Bb[(wn * 64 + i * 32 + l32) * 40 + ks * 16 + h * 8];
#pragma unroll
      for (int i = 0; i < MI; ++i)
#pragma unroll
        for (int j = 0; j < 2; ++j)
          acc[i][j] = SWAP ? __builtin_amdgcn_mfma_f32_32x32x16_bf16(b[j], a[i], acc[i][j], 0, 0, 0)
                           : __builtin_amdgcn_mfma_f32_32x32x16_bf16(a[i], b[j], acc[i][j], 0, 0, 0);
    }
    {
      u16* An = As + (cur ^ 1) * AROWS * 40;
      u16* Bn = Bs + (cur ^ 1) * 128 * 40;
#pragma unroll
      for (int i = 0; i < MI; ++i) *(u32x4*)&An[(lrow + 64 * i) * 40 + lk] = ra[i];
#pragma unroll
      for (int i = 0; i < 2; ++i) *(u32x4*)&Bn[(lrow + 64 * i) * 40 + lk] = rb[i];
      const int kn = (kt + 2 < nk) ? kt + 2 : nk - 1;
      const int k0 = kn * 32 + lk;
#pragma unroll
      for (int i = 0; i < MI; ++i) ra[i] = *(const u32x4*)af(m0 + lrow + 64 * i, k0);
#pragma unroll
      for (int i = 0; i < 2; ++i) rb[i] = *(const u32x4*)bfn(n0 + lrow + 64 * i, k0);
    }
    __syncthreads();
  }
#pragma unroll
  for (int i = 0; i < MI; ++i)
#pragma unroll
    for (int j = 0; j < 2; ++j)
#pragma unroll
      for (int rg = 0; rg < 4; ++rg) {
        const int m = SWAP ? (m0 + wm * (MI * 32) + i * 32 + l32) : (m0 + wm * (MI * 32) + i * 32 + rg * 8 + h * 4);
        const int n = SWAP ? (n0 + wn * 64 + j * 32 + rg * 8 + h * 4) : (n0 + wn * 64 + j * 32 + l32);
        ef(m, n, acc[i][j][rg * 4 + 0], acc[i][j][rg * 4 + 1], acc[i][j][rg * 4 + 2], acc[i][j][rg * 4 + 3]);
      }
}

template <int CTRL> DI int dpp_i(int v) { return __builtin_amdgcn_mov_dpp(v, CTRL, 0xF, 0xF, true); }
template <int CTRL> DI float dpp_f(float v) { return __builtin_bit_cast(float, __builtin_amdgcn_mov_dpp(__builtin_bit_cast(int, v), CTRL, 0xF, 0xF, true)); }
#define DPP_XOR1 0xB1
#define DPP_XOR2 0x4E
#define DPP_MIRROR8 0x141
DI float wave_sum(float v) {
#pragma unroll
  for (int o = 32; o >= 1; o >>= 1) v += __shfl_xor(v, o);
  return v;
}
DI float silu_f(float x) { return x / (1.f + __expf(-x)); }
DI float gelu_tanh(float x) {
  const float u = 0.7978845608028654f * (x + 0.044715f * x * x * x);
  return 0.5f * x * (1.f + tanhf(u));
}

DI const float* xrow_ptr(const Params& p, bool from_input, int b, int pos) {
  if (pos < CTXL) return (from_input ? p.in[I_CTX] : WSP(const float, OFF_XC)) + ((size_t)b * CTXL + pos) * D;
  return (from_input ? p.in[I_X] : (const float*)p.out) + ((size_t)b * SEQ + (pos - CTXL)) * D;
}
DI float* xrow_wptr(const Params& p, int b, int pos) {
  if (pos < CTXL) return WSP(float, OFF_XC) + ((size_t)b * CTXL + pos) * D;
  return p.out + ((size_t)b * SEQ + (pos - CTXL)) * D;
}

DI void phase_prologue(const Params& p, int bid, int nblk, char* smem) {
  const int tid = TID();
  const int gtid = bid * NTHR + tid, gn = nblk * NTHR;
  {
    float* scs = (float*)smem;
    for (int it = bid; it < 192; it += nblk) {
      const int l = it / 96, col0 = (it % 96) * 64;
      for (int e = tid; e < 17 * 1024; e += NTHR) {
        const int j = e >> 10, k = e & 1023;
        const float v = (j < 16) ? p.in[I_C][j * 1024 + k] : p.in[I_CCTX][k];
        scs[e] = v / (1.f + expf(-v));
      }
      __syncthreads();
      const int col = tid & 63, kq = tid >> 6;
      float acc[17];
#pragma unroll
      for (int j = 0; j < 17; ++j) acc[j] = 0.f;
      const float* wa = p.in[I_WADA] + (size_t)l * 1024 * 6144 + col0 + col;
      for (int k0 = kq * 256; k0 < kq * 256 + 256; k0 += 8) {
        float wv[8];
#pragma unroll
        for (int kk = 0; kk < 8; ++kk) wv[kk] = wa[(size_t)(k0 + kk) * 6144];
#pragma unroll
        for (int kk = 0; kk < 8; ++kk)
#pragma unroll
          for (int j = 0; j < 17; ++j) acc[j] += scs[j * 1024 + k0 + kk] * wv[kk];
      }
      __syncthreads();
#pragma unroll
      for (int j = 0; j < 17; ++j) scs[(kq * 17 + j) * 64 + col] = acc[j];
      __syncthreads();
      for (int e = tid; e < 17 * 64; e += NTHR) {
        const int j = e >> 6, cc = e & 63;
        float s = p.in[I_BADA][l * 6144 + col0 + cc];
#pragma unroll
        for (int q = 0; q < 4; ++q) s += scs[(q * 17 + j) * 64 + cc];
        WSP(float, OFF_MOD)[(size_t)(l * 17 + j) * 6144 + col0 + cc] = s;
      }
      __syncthreads();
    }
  }
  {
    float* zs = (float*)smem;
    float* h1s = zs + 64 * 33;
    float* h2s = h1s + 64 * 64;
    for (int it = (nblk >= 260 ? (bid >= 192 ? bid - 192 : 1 << 20) : bid); it < 68; it += nblk) {
      const int f = it < 32 ? 0 : (it < 64 ? 1 : 2);
      const int tile = it - (f == 0 ? 0 : (f == 1 ? 32 : 64));
      const int L = (f == 2) ? 256 : 2048;
      const int lyr = (f == 1) ? 1 : 0;
      const int pos0 = tile * 64;
      const float* w1 = p.in[I_HFW1] + lyr * 33 * 64;
      const float* b1 = p.in[I_HFB1] + lyr * 64;
      const float* w2 = p.in[I_HFW2] + lyr * 64 * 64;
      const float* b2 = p.in[I_HFB2] + lyr * 64;
      const float* w3 = p.in[I_HFW3] + lyr * 64 * 512;
      const float* fq = p.in[I_HFFREQ] + lyr * 64;
      for (int e = tid; e < 64 * 33; e += NTHR) {
        const int pi = e / 33, q = e % 33;
        const int pos = pos0 + pi;
        const float tt = (float)pos / (float)(L - 1);
        const float wv = 6.283185307179586f * (float)pos / (float)L;
        float z;
        if (q == 0) z = tt;
        else if (q <= 16) { const float fi = 1e-4f + (float)(q - 1) * ((15.f - 1e-4f) / 15.f); z = cosf(fi * wv); }
        else { const float fi = 1e-4f + (float)(q - 17) * ((15.f - 1e-4f) / 15.f); z = -sinf(fi * wv); }
        zs[e] = z;
      }
      __syncthreads();
      for (int e = tid; e < 64 * 64; e += NTHR) {
        const int pi = e >> 6, j = e & 63;
        float s = b1[j];
        for (int q = 0; q < 33; ++q) s += zs[pi * 33 + q] * w1[q * 64 + j];
        h1s[e] = sinf(fq[j] * s);
      }
      __syncthreads();
      for (int e = tid; e < 64 * 64; e += NTHR) {
        const int pi = e >> 6, j = e & 63;
        float s = b2[j];
        for (int k = 0; k < 64; ++k) s += h1s[pi * 64 + k] * w2[k * 64 + j];
        h2s[e] = sinf(fq[j] * s);
      }
      __syncthreads();
      {
        const int c = tid;
        const float mind = logf(1e-2f) / 1.5f, maxd = logf(1e-2f) / 0.3f;
        const float delta = fabsf(mind + (float)c * ((maxd - mind) / 255.f));
        u16* R0 = WSP(u16, OFF_RF) + ((size_t)(f * 256 + c) * 2 + 0) * RSTR;
        u16* R1 = R0 + RSTR;
        float ssq = 0.f;
        for (int pb = 0; pb < 4; ++pb) {
          float af_[16], ab_[16];
#pragma unroll
          for (int i = 0; i < 16; ++i) { af_[i] = 0.f; ab_[i] = 0.f; }
          for (int k = 0; k < 64; ++k) {
            const float wf = w3[k * 512 + c], wb = w3[k * 512 + 256 + c];
#pragma unroll
            for (int i = 0; i < 16; ++i) {
              const float hv = h2s[(pb * 16 + i) * 64 + k];
              af_[i] += hv * wf;
              ab_[i] += hv * wb;
            }
          }
#pragma unroll
          for (int i = 0; i < 16; ++i) {
            const int pos = pos0 + pb * 16 + i;
            const float tt = (float)pos / (float)(L - 1);
            const float win = expf(-tt * delta);
            const float vf = af_[i] * win, vb = ab_[i] * win;
            const u16 bfv = f2bf(vf), bbv = f2bf(vb);
            R0[L - pos] = bfv;
            R1[L - pos - 1] = bfv;
            ssq += vf * vf;
            if (pos >= 1) {
              R0[L + pos] = bbv;
              R1[L + pos - 1] = bbv;
              ssq += vb * vb;
            }
          }
        }
        WSP(float, OFF_PART)[(size_t)(f * 32 + tile) * 256 + c] = ssq;
      }
      __syncthreads();
    }
  }
  for (int e = gtid; e < 2 * NIN * 128; e += gn) {
    const int l = e / (NIN * 128);
    const int r = e % (NIN * 128);
    const int kc = r / NIN, n = r % NIN;
    const int k0 = kc * 8;
    const float* wsrc = p.in[I_WIN] + (size_t)l * 1024 * 2576;
    float v[8];
    if (n < 2304) {
#pragma unroll
      for (int j = 0; j < 8; ++j) v[j] = wsrc[(size_t)(k0 + j) * 2576 + n];
    } else if (n < 2816) {
      const int np = n - 2304, g = np >> 7, rr = np & 127, pq = rr >> 6, kk = rr & 63;
#pragma unroll
      for (int j = 0; j < 8; ++j) v[j] = 0.f;
      for (int jj = 0; jj < 64; ++jj) {
        const float ang = 6.283185307179586f * (float)((jj * kk) & 63) / 64.f;
        const float tr = pq ? sinf(ang) : cosf(ang);
#pragma unroll
        for (int j = 0; j < 8; ++j) v[j] += wsrc[(size_t)(k0 + j) * 2576 + 2320 + g * 64 + jj] * tr;
      }
    } else if (n < 2832) {
#pragma unroll
      for (int j = 0; j < 8; ++j) v[j] = wsrc[(size_t)(k0 + j) * 2576 + 2304 + (n - 2816)];
    } else {
#pragma unroll
      for (int j = 0; j < 8; ++j) v[j] = 0.f;
    }
    uint4 o = {pack2(v[0], v[1]), pack2(v[2], v[3]), pack2(v[4], v[5]), pack2(v[6], v[7])};
    *(uint4*)&WSP(u16, OFF_WIN)[((size_t)l * NIN + n) * 1024 + k0] = o;
  }
  for (int e = gtid; e < 2 * 1024 * 128; e += gn) {
    const int l = e / (1024 * 128), r = e % (1024 * 128), kc = r / 1024, n = r % 1024, k0 = kc * 8;
    const float* wsrc = p.in[I_WOUT] + (size_t)l * 1024 * 1024;
    float v[8];
#pragma unroll
    for (int j = 0; j < 8; ++j) v[j] = wsrc[(size_t)(k0 + j) * 1024 + n];
    uint4 o = {pack2(v[0], v[1]), pack2(v[2], v[3]), pack2(v[4], v[5]), pack2(v[6], v[7])};
    *(uint4*)&WSP(u16, OFF_WOUT)[((size_t)l * 1024 + n) * 1024 + k0] = o;
  }
  for (int e = gtid; e < 2 * 2048 * 128; e += gn) {
    const int l = e / (2048 * 128), r = e % (2048 * 128), kc = r / 2048, n = r % 2048, k0 = kc * 8;
    const float* wsrc = p.in[I_WQ] + (size_t)l * 1024 * 2048;
    float v[8];
#pragma unroll
    for (int j = 0; j < 8; ++j) v[j] = wsrc[(size_t)(k0 + j) * 2048 + n];
    uint4 o = {pack2(v[0], v[1]), pack2(v[2], v[3]), pack2(v[4], v[5]), pack2(v[6], v[7])};
    *(uint4*)&WSP(u16, OFF_WQ)[((size_t)l * 2048 + n) * 1024 + k0] = o;
  }
  for (int e = gtid; e < 2 * 2 * 128 * 128; e += gn) {
    const int l = e / (2 * 16384), r = e % (2 * 16384), which = r / 16384, i = r % 16384;
    const float v = (which ? p.in[I_K2] : p.in[I_K1])[l * 16384 + i];
    WSP(u16, OFF_K12)[e] = f2bf(v);
  }
  for (int e = gtid; e < 2048 * 512; e += gn) {
    const int tp = e >> 9, k0 = (e & 511) * 8;
    const float s = 1.f / sqrtf(2048.f * 64.f);
    float v[8];
#pragma unroll
    for (int j = 0; j < 8; ++j) {
      const int k = k0 + j, t = k & 2047;
      const float ang = 6.283185307179586f * (float)((tp * t) & 2047) / 2048.f;
      v[j] = (k < 2048) ? cosf(ang) * s : -sinf(ang) * s;
    }
    uint4 o = {pack2(v[0], v[1]), pack2(v[2], v[3]), pack2(v[4], v[5]), pack2(v[6], v[7])};
    *(uint4*)&WSP(u16, OFF_DFT)[(size_t)tp * 4096 + k0] = o;
  }
  for (int e = gtid; e < 256 * 64; e += gn) {
    const int tp = e >> 6, k0 = (e & 63) * 8;
    const float s = 1.f / sqrtf(256.f * 64.f);
    float v[8];
#pragma unroll
    for (int j = 0; j < 8; ++j) {
      const int k = k0 + j, t = k & 255;
      const float ang = 6.283185307179586f * (float)((tp * t) & 255) / 256.f;
      v[j] = (k < 256) ? cosf(ang) * s : -sinf(ang) * s;
    }
    uint4 o = {pack2(v[0], v[1]), pack2(v[2], v[3]), pack2(v[4], v[5]), pack2(v[6], v[7])};
    *(uint4*)&WSP(u16, OFF_DFTC)[(size_t)tp * 512 + k0] = o;
  }
}

DI void phase_norm(const Params& p, int l, int which, int bid, int nblk) {
  const int lane = TID() & 63, w = TID() >> 6;
  const float* g = (which ? p.in[I_G2] : p.in[I_G1]) + l * 1024;
  const bool from_input = (which == 0 && l == 0);
  for (int row = bid * 4 + w; row < ROWS; row += nblk * 4) {
    const int b = row / TPB, pos = row % TPB;
    if (which == 1 && l == 1 && pos < CTXL) continue;
    const float* xr = xrow_ptr(p, from_input, b, pos);
    const float* mod = WSP(const float, OFF_MOD) + (size_t)(l * 17 + (pos < CTXL ? 16 : b)) * 6144 + which * 3072;
    float x[16];
#pragma unroll
    for (int hh = 0; hh < 2; ++hh) {
      const float4 a = *(const float4*)(xr + hh * 512 + lane * 8);
      const float4 c = *(const float4*)(xr + hh * 512 + lane * 8 + 4);
      x[hh * 8 + 0] = a.x; x[hh * 8 + 1] = a.y; x[hh * 8 + 2] = a.z; x[hh * 8 + 3] = a.w;
      x[hh * 8 + 4] = c.x; x[hh * 8 + 5] = c.y; x[hh * 8 + 6] = c.z; x[hh * 8 + 7] = c.w;
    }
    float ss = 0.f;
#pragma unroll
    for (int i = 0; i < 16; ++i) ss += x[i] * x[i];
    ss = wave_sum(ss);
    const float rs = rsqrtf(ss * (1.f / 1024.f) + EPSF);
#pragma unroll
    for (int hh = 0; hh < 2; ++hh) {
      const int c0 = hh * 512 + lane * 8;
      float y[8];
#pragma unroll
      for (int i = 0; i < 8; ++i) {
        const float yn = x[hh * 8 + i] * rs * g[c0 + i];
        y[i] = yn * (1.f + mod[1024 + c0 + i]) + mod[c0 + i];
      }
      uint4 o = {pack2(y[0], y[1]), pack2(y[2], y[3]), pack2(y[4], y[5]), pack2(y[6], y[7])};
      *(uint4*)&WSP(u16, OFF_ACT)[(size_t)row * 1024 + c0] = o;
    }
  }
}

constexpr float U_SCALE = 64.f, V_SCALE = 4.f;
DI void phase_tables(const Params& p, int l, int bid, int nblk) {
  const int gtid = bid * NTHR + TID(), gn = nblk * NTHR;
  unsigned char* dst = WSP(unsigned char, OFF_XBCA);
  for (int e = gtid; e < 2 * 16384 * 64; e += gn) {
    const int which = e / (16384 * 64), r = e % (16384 * 64);
    const float sc = which ? V_SCALE : U_SCALE;
    const float* src = (which ? p.in[I_PV] : p.in[I_PU]) + (size_t)l * 16384 * 1024 + (size_t)r * 16;
    u32 o[4];
#pragma unroll
    for (int q = 0; q < 4; ++q) {
      const float4 a = *(const float4*)(src + q * 4);
      int v = __builtin_amdgcn_cvt_pk_fp8_f32(a.x * sc, a.y * sc, 0, false);
      v = __builtin_amdgcn_cvt_pk_fp8_f32(a.z * sc, a.w * sc, v, true);
      o[q] = (u32)v;
    }
    uint4 ov = {o[0], o[1], o[2], o[3]};
    *(uint4*)&dst[(size_t)e * 16] = ov;
  }
}

DI void phase_inproj(const Params& p, int l, int bid, int nblk, char* smem) {
  const u16* A = WSP(const u16, OFF_ACT);
  const u16* B = WSP(const u16, OFF_WIN) + (size_t)l * NIN * 1024;
  u16* PHY = WSP(u16, OFF_PHY);
  u16* PZ = WSP(u16, OFF_PZ);
  u16* PXBC = WSP(u16, OFF_PXBC);
  u16* PQT = WSP(u16, OFF_PQT);
  float* DT = WSP(float, OFF_DT);
  auto af = [=](int m, int k) { return A + (size_t)m * 1024 + k; };
  auto bfn = [=](int n, int k) { return B + (size_t)n * 1024 + k; };
  auto efT = [=](int m, int n, float v0, float v1, float v2, float v3) {
    const uint2 o = {pack2(v0, v1), pack2(v2, v3)};
    if (n < 768) *(uint2*)&PHY[(size_t)m * 768 + n] = o;
    else if (n < 1280) *(uint2*)&PZ[(size_t)m * 512 + (n - 768)] = o;
    else if (n < 2304) *(uint2*)&PXBC[(size_t)m * 1024 + (n - 1280)] = o;
    else if (n >= 2816 && n < 2832) { float4 f = {v0, v1, v2, v3}; *(float4*)&DT[(size_t)m * 16 + (n - 2816)] = f; }
  };
  auto efN = [=](int m, int n, float v0, float v1, float v2, float v3) {
    const int b = m / TPB, pos = m % TPB, np = n - 2304;
    uint2 o = {pack2(v0, v1), pack2(v2, v3)};
    *(uint2*)&PQT[((size_t)(b * 512 + np)) * TPB + pos] = o;
  };
  const int nlat = (l == 1) ? 128 * 23 : (ROWS / 256) * 23;
  const int ntile = (l == 1) ? nlat + NB * 9 : nlat;
  const int vb = (nblk % 8 == 0) ? (bid & 7) * (nblk >> 3) + (bid >> 3) : bid;
  for (int t = vb; t < ntile; t += nblk) {
    int mt, nt;
    if (t < nlat) {
      const int mi = t / 23;
      nt = t % 23;
      mt = (l == 1) ? (mi >> 3) * 9 + (mi & 7) + 1 : mi;
    } else {
      const int u = t - nlat, q = u % 9;
      mt = (u / 9) * 9;
      nt = (q < 8) ? 10 + q : 22;
    }
    if (nt >= 18 && nt < 22) gemm_tile<false, 4>(af, bfn, efN, mt * 256, nt * 128, 1024, smem);
    else gemm_tile<true, 4>(af, bfn, efT, mt * 256, nt * 128, 1024, smem);
  }
}

DI void unpack8(const uint4& v, float* f) {
  f[0] = bflo(v.x); f[1] = bfhi(v.x); f[2] = bflo(v.y); f[3] = bfhi(v.y);
  f[4] = bflo(v.z); f[5] = bfhi(v.z); f[6] = bflo(v.w); f[7] = bfhi(v.w);
}
DI void phase_prep(const Params& p, int l, int bid, int nblk, char* smem) {
  const int tid = TID();
  u16* tile = (u16*)smem;
  const u16* PHY = WSP(const u16, OFF_PHY);
  const u16* PXBC = WSP(const u16, OFF_PXBC);
  u16* UT = WSP(u16, OFF_UT);
  u16* X1C = WSP(u16, OFF_X1C);
  u16* XBCA = WSP(u16, OFF_XBCA);
  u16* TX = WSP(u16, OFF_TX);
  const float* hw = p.in[I_HYCW] + l * 3 * 768;
  const float* hb = p.in[I_HYCB] + l * 768;
  const float* sw = p.in[I_SCW] + l * 3 * 1024;
  const float* sb = p.in[I_SCB] + l * 1024;
  const int cg8 = (tid & 31) * 8, pg = tid >> 5;
  for (int it = bid; it < NB * 36 * 6; it += nblk) {
    const int pass = it % 6, bt = it / 6;
    const int b = bt / 36, pt = bt % 36, pos0 = pt * 64;
    const int seg_lo = (pos0 < CTXL) ? 0 : CTXL, seg_hi = (pos0 < CTXL) ? CTXL : TPB;
    const size_t rbase = (size_t)b * TPB;
    const int pfirst = pos0 + pg * 8;
    bool transposed = false;
    if (pass <= 1) {
      if (l == 1 && pos0 < CTXL) continue;
      float cv0[8][8];
#pragma unroll
      for (int sg = 0; sg < 2; ++sg) {
        if (pass == 0 && sg == 1) break;
        const int sgrp = (pass == 0) ? 1 : (sg == 0 ? 0 : 2);
        const int col = sgrp * 256 + cg8;
        float w0[8], w1[8], w2[8], bb[8];
#pragma unroll
        for (int e = 0; e < 8; ++e) { w0[e] = hw[col + e]; w1[e] = hw[768 + col + e]; w2[e] = hw[1536 + col + e]; bb[e] = hb[col + e]; }
        uint4 raw[10];
#pragma unroll
        for (int k = 0; k < 10; ++k) {
          const int pn = pfirst + k - 1;
          raw[k] = (pn >= seg_lo && pn < seg_hi) ? *(const uint4*)&PHY[(rbase + pn) * 768 + col] : make_uint4(0u, 0u, 0u, 0u);
        }
        float xm[8], x0[8], xp[8];
        unpack8(raw[0], xm);
        unpack8(raw[1], x0);
#pragma unroll
        for (int k = 0; k < 8; ++k) {
          unpack8(raw[k + 2], xp);
          float o[8];
#pragma unroll
          for (int e = 0; e < 8; ++e) {
            o[e] = w0[e] * xm[e] + w1[e] * x0[e] + w2[e] * xp[e] + bb[e];
            xm[e] = x0[e]; x0[e] = xp[e];
          }
          if (pass == 0) {
            uint4 o1 = {pack2(o[0], o[1]), pack2(o[2], o[3]), pack2(o[4], o[5]), pack2(o[6], o[7])};
            *(uint4*)&X1C[(rbase + pfirst + k) * 256 + cg8] = o1;
          } else if (sg == 0) {
#pragma unroll
            for (int e = 0; e < 8; ++e) cv0[k][e] = o[e];
          } else {
            uint4 ou = {pack2(o[0] * cv0[k][0], o[1] * cv0[k][1]), pack2(o[2] * cv0[k][2], o[3] * cv0[k][3]),
                        pack2(o[4] * cv0[k][4], o[5] * cv0[k][5]), pack2(o[6] * cv0[k][6], o[7] * cv0[k][7])};
            *(uint4*)&tile[(pg * 8 + k) * 264 + cg8] = ou;
          }
        }
      }
      transposed = (pass == 1);
    } else {
      const int col = (pass - 2) * 256 + cg8;
      float w0[8], w1[8], w2[8], bb[8];
#pragma unroll
      for (int e = 0; e < 8; ++e) { w0[e] = sw[col + e]; w1[e] = sw[1024 + col + e]; w2[e] = sw[2048 + col + e]; bb[e] = sb[col + e]; }
      uint4 raw[10];
#pragma unroll
      for (int k = 0; k < 10; ++k) {
        const int pn = pfirst + k - 1;
        raw[k] = (pn >= seg_lo && pn < seg_hi) ? *(const uint4*)&PXBC[(rbase + pn) * 1024 + col] : make_uint4(0u, 0u, 0u, 0u);
      }
      float xm[8], x0[8], xp[8];
      unpack8(raw[0], xm);
      unpack8(raw[1], x0);
#pragma unroll
      for (int k = 0; k < 8; ++k) {
        unpack8(raw[k + 2], xp);
        float o[8];
#pragma unroll
        for (int e = 0; e < 8; ++e) {
          o[e] = silu_f(w0[e] * xm[e] + w1[e] * x0[e] + w2[e] * xp[e] + bb[e]);
          xm[e] = x0[e]; x0[e] = xp[e];
        }
        uint4 ov = {pack2(o[0], o[1]), pack2(o[2], o[3]), pack2(o[4], o[5]), pack2(o[6], o[7])};
        *(uint4*)&XBCA[(rbase + pfirst + k) * 1024 + col] = ov;
        if (pass < 5) *(uint4*)&tile[(pg * 8 + k) * 264 + cg8] = ov;
      }
      transposed = pass < 5;
    }
    if (transposed) {
      __syncthreads();
      u16* dst = (pass == 1) ? (UT + ((size_t)(tid * 16 + b)) * TPB + pos0) : (TX + ((size_t)(b * 768 + (pass - 2) * 256 + tid)) * TPB + pos0);
#pragma unroll
      for (int pc = 0; pc < 8; ++pc) {
        u32 wv[4];
#pragma unroll
        for (int e = 0; e < 4; ++e)
          wv[e] = (u32)tile[(pc * 8 + 2 * e) * 264 + tid] | ((u32)tile[(pc * 8 + 2 * e + 1) * 264 + tid] << 16);
        uint4 o = {wv[0], wv[1], wv[2], wv[3]};
        *(uint4*)&dst[pc * 8] = o;
      }
      __syncthreads();
    }
  }
}

DI void ssd_item(const Params& p, int l, int it, char* smem) {
  const int tid = TID(), lane = tid & 63, w = tid >> 6, l32 = lane & 31, h = lane >> 5;
  const int b = it >> 4, hd = (it >> 1) & 7, dir = it & 1, g = hd >> 2;
  u16* BG = (u16*)smem;
  u16* HL = BG + 128 * 136;
  float* fa = (float*)(HL + 64 * 136);
  float* fdt = fa + 128;
  float* fsw = fdt + 128;
  float* fea = fsw + 128;
  float* ftot = fea + 128;
  const u16* XBCA = WSP(const u16, OFF_XBCA);
  const u16* TX = WSP(const u16, OFF_TX);
  const float* DT = WSP(const float, OFF_DT);
  u16* Y = WSP(u16, OFF_PXBC) + (dir ? (size_t)ROWS * 512 : 0);
  const float dtb = p.in[I_SDTB][l * 16 + dir * 8 + hd];
  const float a = -expf(p.in[I_SALOG][l * 16 + dir * 8 + hd]);
  const size_t rbase = (size_t)b * TPB;
  f32x16 Hacc[2];
#pragma unroll
  for (int i = 0; i < 2; ++i)
#pragma unroll
    for (int r = 0; r < 16; ++r) Hacc[i][r] = 0.f;
  for (int e = tid; e < 64 * 136; e += NTHR) HL[e] = 0;
  for (int ci = 0; ci < 18; ++ci) {
    const int pos0 = dir ? ((ci < 2) ? (1 - ci) * 128 : (CTXL + (17 - ci) * 128)) : ci * 128;
    asm volatile("s_waitcnt vmcnt(0)" ::: "memory");
    bf16x8 creg[8];
    const u16* cr = XBCA + (rbase + pos0 + w * 32 + l32) * 1024 + 768 + g * 128 + h * 8;
#pragma unroll
    for (int ks = 0; ks < 4; ++ks) creg[ks] = *(const bf16x8*)(cr + ks * 16);
    __builtin_amdgcn_sched_barrier(0);
#pragma unroll
    for (int i = 0; i < 8; ++i) {
      const int q = tid + 256 * i, j = q >> 4, ch = q & 15;
      *(uint4*)&BG[j * 136 + ch * 8] = *(const uint4*)&XBCA[(rbase + pos0 + j) * 1024 + 512 + g * 128 + ch * 8];
    }
    if (w == 0) {
      const float r0 = DT[(rbase + pos0 + 2 * lane) * 16 + dir * 8 + hd] + dtb;
      const float r1 = DT[(rbase + pos0 + 2 * lane + 1) * 16 + dir * 8 + hd] + dtb;
      const float dt0 = (r0 > 20.f) ? r0 : log1pf(expf(r0));
      const float dt1 = (r1 > 20.f) ? r1 : log1pf(expf(r1));
      const float a0 = dt0 * a, a1 = dt1 * a;
      const float sm = a0 + a1;
      float incl = sm;
#pragma unroll
      for (int o = 1; o < 64; o <<= 1) {
        const float t = __shfl_up(incl, o);
        if (lane >= o) incl += t;
      }
      const float excl = incl - sm;
      const float total = __shfl(incl, 63);
      float ac0, ac1;
      if (!dir) { ac0 = excl + a0; ac1 = excl + sm; }
      else { ac0 = total - excl; ac1 = total - excl - a0; }
      fa[2 * lane] = ac0; fa[2 * lane + 1] = ac1;
      fdt[2 * lane] = dt0; fdt[2 * lane + 1] = dt1;
      fsw[2 * lane] = dt0 * __expf(total - ac0); fsw[2 * lane + 1] = dt1 * __expf(total - ac1);
      fea[2 * lane] = __expf(ac0); fea[2 * lane + 1] = __expf(ac1);
      if (lane == 0) ftot[0] = __expf(total);
    }
    __syncthreads();
#pragma unroll
    for (int ks = 4; ks < 8; ++ks) creg[ks] = *(const bf16x8*)(cr + ks * 16);
    f32x16 acc[4], yd[2];
#pragma unroll
    for (int i = 0; i < 4; ++i)
#pragma unroll
      for (int r = 0; r < 16; ++r) acc[i][r] = 0.f;
#pragma unroll
    for (int i = 0; i < 2; ++i)
#pragma unroll
      for (int r = 0; r < 16; ++r) yd[i][r] = 0.f;
#pragma unroll
    for (int ks = 0; ks < 8; ++ks) {
      const bf16x8 areg = creg[ks];
#pragma unroll
      for (int jb = 0; jb < 4; ++jb) {
        const bf16x8 bb = *(const bf16x8*)&BG[(jb * 32 + l32) * 136 + ks * 16 + h * 8];
        acc[jb] = __builtin_amdgcn_mfma_f32_32x32x16_bf16(areg, bb, acc[jb], 0, 0, 0);
      }
    }
    {
      const float eai = fea[w * 32 + l32];
#pragma unroll
      for (int ks = 0; ks < 8; ++ks) {
        union { u32 u[4]; bf16x8 v; } t;
        t.v = creg[ks];
#pragma unroll
        for (int q = 0; q < 4; ++q) t.u[q] = pack2(bflo(t.u[q]) * eai, bfhi(t.u[q]) * eai);
#pragma unroll
        for (int pb = 0; pb < 2; ++pb) {
          const bf16x8 bb = *(const bf16x8*)&HL[(pb * 32 + l32) * 136 + ks * 16 + h * 8];
          yd[pb] = __builtin_amdgcn_mfma_f32_32x32x16_bf16(t.v, bb, yd[pb], 0, 0, 0);
        }
      }
    }
    __syncthreads();
    int l32v = l32, hv_ = h;
    asm volatile("" : "+v"(l32v), "+v"(hv_));
    bf16x8 xf[2][8];
    const u16* xt = TX + ((size_t)(b * 768 + hd * 64 + l32v)) * TPB + pos0 + hv_ * 8;
#pragma unroll
    for (int jb = 0; jb < 4; ++jb) {
      const int j = jb * 32 + l32v;
      const float aj = fa[j], dtj = fdt[j];
#pragma unroll
      for (int r = 0; r < 16; ++r) {
        const int i = w * 32 + (r & 3) + 8 * (r >> 2) + 4 * hv_;
        const float ai = fa[i];
        const bool valid = dir ? (j >= i) : (j <= i);
        const float v = valid ? acc[jb][r] * __expf(ai - aj) * dtj : 0.f;
        BG[i * 136 + j] = f2bf(v);
      }
      __builtin_amdgcn_sched_barrier(0);
      if (jb == 1) {
#pragma unroll
        for (int ks = 0; ks < 8; ++ks) xf[0][ks] = *(const bf16x8*)(xt + ks * 16);
        __builtin_amdgcn_sched_barrier(0);
      }
    }
#pragma unroll
    for (int ks = 0; ks < 8; ++ks) xf[1][ks] = *(const bf16x8*)(xt + (size_t)32 * TPB + ks * 16);
    __builtin_amdgcn_sched_barrier(0);
#pragma unroll
    for (int pb = 0; pb < 2; ++pb)
#pragma unroll
      for (int ks = 0; ks < 8; ++ks) {
        const bf16x8 aa = *(const bf16x8*)&BG[(w * 32 + l32v) * 136 + ks * 16 + hv_ * 8];
        yd[pb] = __builtin_amdgcn_mfma_f32_32x32x16_bf16(aa, xf[pb][ks], yd[pb], 0, 0, 0);
      }
#pragma unroll
    for (int pb = 0; pb < 2; ++pb)
#pragma unroll
      for (int r = 0; r < 16; ++r) {
        const int i = w * 32 + (r & 3) + 8 * (r >> 2) + 4 * hv_;
        Y[(rbase + pos0 + i) * 512 + hd * 64 + pb * 32 + l32v] = f2bf(yd[pb][r]);
      }
    {
      u32x4 braw[8];
      {
        const u16* bt = TX + ((size_t)(b * 768 + 512 + g * 128 + w * 32 + l32v)) * TPB + pos0 + hv_ * 8;
#pragma unroll
        for (int ks = 0; ks < 8; ++ks) braw[ks] = *(const u32x4*)(bt + ks * 16);
      }
      const float eend = ftot[0];
#pragma unroll
      for (int pm = 0; pm < 2; ++pm)
#pragma unroll
        for (int r = 0; r < 16; ++r) Hacc[pm][r] *= eend;
#pragma unroll
      for (int ks = 0; ks < 8; ++ks) {
        const u32x4 raw = braw[ks];
        const float4 s0 = *(const float4*)&fsw[ks * 16 + hv_ * 8];
        const float4 s1 = *(const float4*)&fsw[ks * 16 + hv_ * 8 + 4];
        union { u32 u[4]; bf16x8 v; } bs;
        bs.u[0] = pack2(bflo(raw[0]) * s0.x, bfhi(raw[0]) * s0.y);
        bs.u[1] = pack2(bflo(raw[1]) * s0.z, bfhi(raw[1]) * s0.w);
        bs.u[2] = pack2(bflo(raw[2]) * s1.x, bfhi(raw[2]) * s1.y);
        bs.u[3] = pack2(bflo(raw[3]) * s1.z, bfhi(raw[3]) * s1.w);
#pragma unroll
        for (int pm = 0; pm < 2; ++pm) Hacc[pm] = __builtin_amdgcn_mfma_f32_32x32x16_bf16(xf[pm][ks], bs.v, Hacc[pm], 0, 0, 0);
      }
#pragma unroll
      for (int pm = 0; pm < 2; ++pm)
#pragma unroll
        for (int r = 0; r < 16; ++r) {
          const int pp = pm * 32 + (r & 3) + 8 * (r >> 2) + 4 * hv_;
          HL[pp * 136 + w * 32 + l32v] = f2bf(Hacc[pm][r]);
        }
    }
    __syncthreads();
  }
}

DI void hyena_item(const Params& p, int l, int it) {
  const int lane = TID() & 63, w = TID() >> 6;
  int c, f, L, posoff, tt0, ntile;
  if (it < 2048) { c = it >> 3; f = l; L = 2048; posoff = CTXL; tt0 = (it & 7) * 256 + w * 64; ntile = 32; }
  else { c = it - 2048; f = 2; L = 256; posoff = 0; tt0 = w * 64; ntile = 4; }
  const u16* R0 = WSP(const u16, OFF_RF) + ((size_t)(f * 256 + c) * 2) * RSTR;
  const u16* R1 = R0 + RSTR;
  const u16* UT = WSP(const u16, OFF_UT);
  const int l16 = lane & 15, kg = lane >> 4;
  f32x4 acc[4];
#pragma unroll
  for (int i = 0; i < 4; ++i) acc[i] = (f32x4){0.f, 0.f, 0.f, 0.f};
  const u16* ub = UT + ((size_t)(c * 16 + l16)) * TPB + posoff + kg * 8;
  const u16* rsel = (l16 & 1) ? (R1 - 1) : R0;
  const int nb = L - (tt0 + l16) + kg * 8;
  for (int s0 = 0; s0 < L; s0 += 32) {
    const bf16x8 bfrag = *(const bf16x8*)(ub + s0);
#pragma unroll
    for (int i = 0; i < 4; ++i) {
      const u32* ap = (const u32*)(rsel + (nb - 16 * i + s0));
      union { u32 u[4]; bf16x8 v; } au;
      au.u[0] = ap[0]; au.u[1] = ap[1]; au.u[2] = ap[2]; au.u[3] = ap[3];
      acc[i] = __builtin_amdgcn_mfma_f32_16x16x32_bf16(au.v, bfrag, acc[i], 0, 0, 0);
    }
  }
  float ssq = 0.f;
  for (int t = 0; t < ntile; ++t) ssq += WSP(const float, OFF_PART)[(size_t)(f * 32 + t) * 256 + c];
  const float scale = rsqrtf(ssq + EPSF);
  const float bias = p.in[I_HYBIAS][l * 256 + c];
  const u16* X1C = WSP(const u16, OFF_X1C);
  u16* YM = WSP(u16, OFF_ACT);
  const int b = l16;
#pragma unroll
  for (int i = 0; i < 4; ++i)
#pragma unroll
    for (int r = 0; r < 4; ++r) {
      const int t = tt0 + 16 * i + kg * 4 + r;
      const size_t row = (size_t)b * TPB + posoff + t;
      const float u = bf2f(UT[((size_t)(c * 16 + b)) * TPB + posoff + t]);
      const float x1 = bf2f(X1C[row * 256 + c]);
      YM[row * 1024 + c] = f2bf(x1 * (scale * acc[i][r] + bias * u));
    }
}

DI void hyena_item_lat(const Params& p, int l, int it) {
  const int lane = TID() & 63, w = TID() >> 6;
  const int c = it >> 2, f = l, L = 2048, posoff = CTXL;
  const int tt0 = (it & 3) * 512 + w * 128;
  const u16* R0 = WSP(const u16, OFF_RF) + ((size_t)(f * 256 + c) * 2) * RSTR;
  const u16* R1 = R0 + RSTR;
  const u16* UT = WSP(const u16, OFF_UT);
  const int l16 = lane & 15, kg = lane >> 4;
  f32x4 acc[8];
#pragma unroll
  for (int i = 0; i < 8; ++i) acc[i] = (f32x4){0.f, 0.f, 0.f, 0.f};
  const u16* ub = UT + ((size_t)(c * 16 + l16)) * TPB + posoff + kg * 8;
  const u16* rsel = (l16 & 1) ? (R1 - 1) : R0;
  const int nb = L - (tt0 + l16) + kg * 8;
  union AF { u32 u[4]; bf16x8 v; };
  AF a[8];
#define HY_LOADA(dst, off) { const u32* ap_ = (const u32*)(rsel + (off)); dst.u[0] = ap_[0]; dst.u[1] = ap_[1]; dst.u[2] = ap_[2]; dst.u[3] = ap_[3]; }
#pragma unroll
  for (int i = 2; i < 8; ++i) HY_LOADA(a[i], nb - 16 * i)
#pragma unroll 1
  for (int sb = 0; sb < L; sb += 128) {
#pragma unroll
    for (int u = 0; u < 4; ++u) {
      const int s0 = sb + 32 * u;
      HY_LOADA(a[(0 - 2 * u) & 7], nb + s0)
      HY_LOADA(a[(1 - 2 * u) & 7], nb - 16 + s0)
      const bf16x8 bfrag = *(const bf16x8*)(ub + s0);
#pragma unroll
      for (int i = 0; i < 8; ++i) acc[i] = __builtin_amdgcn_mfma_f32_16x16x32_bf16(a[(i - 2 * u) & 7].v, bfrag, acc[i], 0, 0, 0);
    }
  }
#undef HY_LOADA
  float ssq = 0.f;
  for (int t = 0; t < 32; ++t) ssq += WSP(const float, OFF_PART)[(size_t)(f * 32 + t) * 256 + c];
  const float scale = rsqrtf(ssq + EPSF);
  const float bias = p.in[I_HYBIAS][l * 256 + c];
  const u16* X1C = WSP(const u16, OFF_X1C);
  u16* YM = WSP(u16, OFF_ACT);
  const int b = l16;
#pragma unroll
  for (int i = 0; i < 8; ++i)
#pragma unroll
    for (int r = 0; r < 4; ++r) {
      const int t = tt0 + 16 * i + kg * 4 + r;
      const size_t row = (size_t)b * TPB + posoff + t;
      const float uu = bf2f(UT[((size_t)(c * 16 + b)) * TPB + posoff + t]);
      const float x1 = bf2f(X1C[row * 256 + c]);
      YM[row * 1024 + c] = f2bf(x1 * (scale * acc[i][r] + bias * uu));
    }
}

DI void fnet_item(const Params& p, int it, char* smem) {
  const u16* PQT = WSP(const u16, OFF_PQT);
  u16* YM = WSP(u16, OFF_ACT);
  if (it < 256) {
    const int mt = it >> 5, nt = it & 31;
    const u16* A = WSP(const u16, OFF_DFT);
    auto af = [=](int m, int k) { return A + (size_t)m * 4096 + k; };
    auto bfn = [=](int n, int k) {
      const int b = n >> 8, n2 = n & 255, g = n2 >> 6, kk = n2 & 63, pq = k >> 11, t = k & 2047;
      return PQT + ((size_t)(b * 512 + g * 128 + pq * 64 + kk)) * TPB + CTXL + t;
    };
    auto ef = [=](int m, int n, float v0, float v1, float v2, float v3) {
      const int b = n >> 8, n2 = n & 255;
      const uint2 o = {pack2(v0, v1), pack2(v2, v3)};
      *(uint2*)&YM[((size_t)b * TPB + CTXL + m) * 1024 + 768 + n2] = o;
    };
    gemm_tile<true, 4>(af, bfn, ef, mt * 256, nt * 128, 4096, smem);
  } else {
    const int i2 = it - 256, mt = i2 >> 5, nt = i2 & 31;
    const u16* A = WSP(const u16, OFF_DFTC);
    auto af = [=](int m, int k) { return A + (size_t)m * 512 + k; };
    auto bfn = [=](int n, int k) {
      const int b = n >> 8, n2 = n & 255, g = n2 >> 6, kk = n2 & 63, pq = k >> 8, t = k & 255;
      return PQT + ((size_t)(b * 512 + g * 128 + pq * 64 + kk)) * TPB + t;
    };
    auto ef = [=](int m, int n, float v0, float v1, float v2, float v3) {
      const int b = n >> 8, n2 = n & 255;
      const uint2 o = {pack2(v0, v1), pack2(v2, v3)};
      *(uint2*)&YM[((size_t)b * TPB + m) * 1024 + 768 + n2] = o;
    };
    gemm_tile<true, 4>(af, bfn, ef, mt * 256, nt * 128, 512, smem);
  }
}

DI void phase_mixers(const Params& p, int l, int bid, int nblk, char* smem, int rep = 0) {
  for (int it = bid; it < 256; it += nblk) ssd_item(p, l, it, smem);
  const int nf = (l == 0) ? 288 : 256;
  const int nh = (l == 0) ? 1280 : 1024;
  int* ctr = WSP(int, OFF_CTR) + l + 2 * rep;
  int* sitem = (int*)(smem + LDS_BYTES - 16);
  for (;;) {
    if (TID() == 0) *sitem = atomicAdd(ctr, 1);
    __syncthreads();
    const int it = *sitem;
    __syncthreads();
    if (it >= nf + nh) break;
    if (it < nf) fnet_item(p, it, smem);
    else if (it - nf < 1024) hyena_item_lat(p, l, it - nf);
    else hyena_item(p, l, it - nf + 1024);
  }
}

DI void phase_ssd_combine(const Params& p, int l, int bid, int nblk) {
  const int lane = TID() & 63, w = TID() >> 6;
  const u16* YF = WSP(const u16, OFF_PXBC);
  const u16* YB = YF + (size_t)ROWS * 512;
  const u16* XBCA = WSP(const u16, OFF_XBCA);
  const u16* PZ = WSP(const u16, OFF_PZ);
  u16* YM = WSP(u16, OFF_ACT);
  const float* ng = p.in[I_SNG] + l * 512;
  const int c0 = lane * 8;
  const float dsk = p.in[I_SD][l * 8 + (c0 >> 6)];
  for (int row = bid * 4 + w; row < ROWS; row += nblk * 4) {
    const int pos = row % TPB;
    if (l == 1 && pos < CTXL) continue;
    const uint4 vf = *(const uint4*)(YF + (size_t)row * 512 + c0);
    const uint4 vb = *(const uint4*)(YB + (size_t)row * 512 + c0);
    const uint4 vx = *(const uint4*)(XBCA + (size_t)row * 1024 + c0);
    const uint4 vz = *(const uint4*)(PZ + (size_t)row * 512 + c0);
    const u32 af_[4] = {vf.x, vf.y, vf.z, vf.w}, ab_[4] = {vb.x, vb.y, vb.z, vb.w};
    const u32 ax_[4] = {vx.x, vx.y, vx.z, vx.w}, az_[4] = {vz.x, vz.y, vz.z, vz.w};
    float y[8];
    float ss = 0.f;
#pragma unroll
    for (int i = 0; i < 4; ++i) {
      const float y0 = bflo(af_[i]) + bflo(ab_[i]) + dsk * bflo(ax_[i]);
      const float y1 = bfhi(af_[i]) + bfhi(ab_[i]) + dsk * bfhi(ax_[i]);
      y[2 * i] = y0 * silu_f(bflo(az_[i]));
      y[2 * i + 1] = y1 * silu_f(bfhi(az_[i]));
      ss += y[2 * i] * y[2 * i] + y[2 * i + 1] * y[2 * i + 1];
    }
#pragma unroll
    for (int o = 16; o >= 1; o >>= 1) ss += __shfl_xor(ss, o);
    const float rs = rsqrtf(ss * (1.f / 256.f) + EPSF);
    float o8[8];
#pragma unroll
    for (int i = 0; i < 8; ++i) o8[i] = y[i] * rs * ng[c0 + i];
    uint4 o = {pack2(o8[0], o8[1]), pack2(o8[2], o8[3]), pack2(o8[4], o8[5]), pack2(o8[6], o8[7])};
    *(uint4*)&YM[(size_t)row * 1024 + 256 + c0] = o;
  }
}

DI void phase_outproj(const Params& p, int l, int bid, int nblk, char* smem) {
  const u16* A = WSP(const u16, OFF_ACT);
  const u16* B = WSP(const u16, OFF_WOUT) + (size_t)l * 1024 * 1024;
  const float* MOD = WSP(const float, OFF_MOD);
  const Params pp = p;
  auto af = [=](int m, int k) { return A + (size_t)m * 1024 + k; };
  auto bfn = [=](int n, int k) { return B + (size_t)n * 1024 + k; };
  auto ef = [=](int m, int n, float v0, float v1, float v2, float v3) {
    const int b = m / TPB, pos = m % TPB;
    const float4 ga = *(const float4*)&MOD[(size_t)(l * 17 + (pos < CTXL ? 16 : b)) * 6144 + 2048 + n];
    const float4 xo = *(const float4*)(xrow_ptr(pp, l == 0, b, pos) + n);
    const float4 o = {xo.x + ga.x * v0, xo.y + ga.y * v1, xo.z + ga.z * v2, xo.w + ga.w * v3};
    *(float4*)(xrow_wptr(pp, b, pos) + n) = o;
  };
  const int ntile = (l == 1 ? NB * 16 : ROWS / 128) * 8;
  const int vb = (nblk % 8 == 0) ? (bid & 7) * (nblk >> 3) + (bid >> 3) : bid;
  for (int t = vb; t < ntile; t += nblk) {
    const int mi = t >> 3, nt = t & 7;
    const int mt = (l == 1) ? (mi >> 4) * 18 + 2 + (mi & 15) : mi;
    gemm_tile<true, 2>(af, bfn, ef, mt * 128, nt * 128, 1024, smem);
  }
}

DI void phase_q(const Params& p, int l, int bid, int nblk, char* smem) {
  const u16* A = WSP(const u16, OFF_ACT);
  const u16* B = WSP(const u16, OFF_WQ) + (size_t)l * 2048 * 1024;
  u16* Q = WSP(u16, OFF_Q);
  auto af = [=](int m, int k) { return A + (size_t)m * 1024 + k; };
  auto bfn = [=](int n, int k) { return B + (size_t)n * 1024 + k; };
  auto ef = [=](int m, int n, float v0, float v1, float v2, float v3) {
    const uint2 o = {pack2(v0, v1), pack2(v2, v3)};
    *(uint2*)&Q[(size_t)m * 2048 + n] = o;
  };
  const int ntile = (l == 1 ? NB * 8 : ROWS / 256) * 16;
  const int vb = (nblk % 8 == 0) ? (bid & 7) * (nblk >> 3) + (bid >> 3) : bid;
  for (int t = vb; t < ntile; t += nblk) {
    const int mi = t >> 4, nt = t & 15;
    const int mt = (l == 1) ? (mi >> 3) * 9 + (mi & 7) + 1 : mi;
    gemm_tile<true, 4>(af, bfn, ef, mt * 256, nt * 128, 1024, smem);
  }
}

DI void phase_topk(const Params& p, int l, int bid, int nblk, char* smem) {
  const int tid = TID(), lane = tid & 63, w = tid >> 6, l32 = lane & 31, h = lane >> 5;
  u16* qs = (u16*)smem;
  float* sc = (float*)(smem + 64 * 136 * 2);
  const u16* Q = WSP(const u16, OFF_Q);
  float* TV = WSP(float, OFF_TV);
  int* TI = WSP(int, OFF_TI);
  const int nitem = (l == 1 ? NB * 32 : ROWS / 64) * 16;
  for (int it = bid; it < nitem; it += nblk) {
    const int hh = it & 15, ri = it >> 4;
    const int rt = (l == 1) ? (ri >> 5) * 36 + 4 + (ri & 31) : ri;
    const int row0 = rt * 64;
    const u16* kb = WSP(const u16, OFF_K12) + (size_t)(l * 2 + (hh & 1)) * 16384;
    bf16x8 kfr[8];
#pragma unroll
    for (int ks = 0; ks < 8; ++ks) kfr[ks] = *(const bf16x8*)&kb[(w * 32 + l32) * 128 + ks * 16 + h * 8];
    __builtin_amdgcn_sched_barrier(0);
#pragma unroll
    for (int i = 0; i < 4; ++i) {
      const int q = tid + 256 * i, r = q >> 4, ch = q & 15;
      *(uint4*)&qs[r * 136 + ch * 8] = *(const uint4*)&Q[(size_t)(row0 + r) * 2048 + hh * 128 + ch * 8];
    }
    __syncthreads();
    f32x16 acc[2];
#pragma unroll
    for (int i = 0; i < 2; ++i)
#pragma unroll
      for (int r = 0; r < 16; ++r) acc[i][r] = 0.f;
#pragma unroll
    for (int ks = 0; ks < 8; ++ks) {
      const bf16x8 bq = kfr[ks];
      const bf16x8 a0 = *(const bf16x8*)&qs[(l32) * 136 + ks * 16 + h * 8];
      const bf16x8 a1 = *(const bf16x8*)&qs[(32 + l32) * 136 + ks * 16 + h * 8];
      acc[0] = __builtin_amdgcn_mfma_f32_32x32x16_bf16(a0, bq, acc[0], 0, 0, 0);
      acc[1] = __builtin_amdgcn_mfma_f32_32x32x16_bf16(a1, bq, acc[1], 0, 0, 0);
    }
#pragma unroll
    for (int mt = 0; mt < 2; ++mt)
#pragma unroll
      for (int i = 0; i < 16; ++i) {
        const int r = mt * 32 + (i & 3) + 8 * (i >> 2) + 4 * h;
        sc[r * 133 + w * 33 + l32] = acc[mt][i];
      }
    __syncthreads();
    {
      const int r = tid >> 2, part = tid & 3;
      u32 key[32];
#pragma unroll
      for (int j = 0; j < 32; ++j) {
        const u32 u = __float_as_uint(sc[r * 133 + part * 33 + j]);
        const u32 ord = (u & 0x80000000u) ? ~u : (u | 0x80000000u);
        key[j] = (ord & ~127u) | (u32)(127 - (part * 32 + j));
      }
      float* tv = TV + ((size_t)(row0 + r) * 16 + hh) * 16;
      int* ti = TI + ((size_t)(row0 + r) * 16 + hh) * 16;
#pragma unroll
      for (int k = 2; k <= 32; k <<= 1)
#pragma unroll
        for (int j = k >> 1; j > 0; j >>= 1)
#pragma unroll
          for (int i = 0; i < 32; ++i) {
            const int l2 = i ^ j;
            if (l2 > i) {
              const u32 ka = key[i], kb2 = key[l2];
              const u32 lo = ka < kb2 ? ka : kb2, hi = ka < kb2 ? kb2 : ka;
              if ((i & k) == 0) { key[i] = lo; key[l2] = hi; } else { key[i] = hi; key[l2] = lo; }
            }
          }
      u32 T[16];
#pragma unroll
      for (int t = 0; t < 16; ++t) T[t] = key[31 - t];
#define TOPK_MERGE(CTRL)                                                                      \
      {                                                                                       \
        u32 M[16];                                                                            \
        _Pragma("unroll") for (int t = 0; t < 16; ++t) {                                      \
          const u32 o = (u32)dpp_i<CTRL>((int)T[15 - t]);                                     \
          M[t] = T[t] > o ? T[t] : o;                                                         \
        }                                                                                     \
        _Pragma("unroll") for (int j = 8; j > 0; j >>= 1)                                     \
          _Pragma("unroll") for (int i = 0; i < 16; ++i) {                                    \
            const int l2 = i ^ j;                                                             \
            if (l2 > i) {                                                                     \
              const u32 ka = M[i], kb2 = M[l2];                                               \
              M[i] = ka > kb2 ? ka : kb2;                                                     \
              M[l2] = ka > kb2 ? kb2 : ka;                                                    \
            }                                                                                 \
          }                                                                                   \
        _Pragma("unroll") for (int t = 0; t < 16; ++t) T[t] = M[t];                           \
      }
      TOPK_MERGE(DPP_XOR1)
      TOPK_MERGE(DPP_XOR2)
#undef TOPK_MERGE
      if (part == 0) {
        float ov[16];
        int oi[16];
#pragma unroll
        for (int rd = 0; rd < 16; ++rd) {
          const u32 best = T[rd];
          const u32 ordv = best & ~127u;
          const u32 uu = (ordv & 0x80000000u) ? (ordv & 0x7FFFFFFFu) : ~ordv;
          ov[rd] = __uint_as_float(uu);
          oi[rd] = 127 - (int)(best & 127u);
        }
#pragma unroll
        for (int q = 0; q < 4; ++q) {
          float4 fv = {ov[q * 4 + 0], ov[q * 4 + 1], ov[q * 4 + 2], ov[q * 4 + 3]};
          int4 iv = {oi[q * 4 + 0], oi[q * 4 + 1], oi[q * 4 + 2], oi[q * 4 + 3]};
          *(float4*)(tv + q * 4) = fv;
          *(int4*)(ti + q * 4) = iv;
        }
      }
    }
    __syncthreads();
  }
}

DI int cand_a(int c) {
  const u32 T[7] = {0x00000000u, 0x00000000u, 0x11111111u, 0x33322222u, 0x66554443u, 0xDCBA9877u, 0x000000FEu};
  u32 wv = T[0];
#pragma unroll
  for (int s = 1; s < 7; ++s) wv = ((c >> 3) == s) ? T[s] : wv;
  return (int)((wv >> ((c & 7) * 4)) & 15u);
}
DI int cand_b(int c) {
  const u32 T[7] = {0x76543210u, 0xFEDCBA98u, 0x76543210u, 0x21043210u, 0x10102103u, 0x00000010u, 0x00000000u};
  u32 wv = T[0];
#pragma unroll
  for (int s = 1; s < 7; ++s) wv = ((c >> 3) == s) ? T[s] : wv;
  return (int)((wv >> ((c & 7) * 4)) & 15u);
}
DI void phase_peer(const Params& p, int l, int bid, int nblk) {
  const int w = TID() >> 6;
  const float* TV = WSP(const float, OFF_TV);
  const int* TI = WSP(const int, OFF_TI);
  const u16* H2 = WSP(const u16, OFF_ACT);
  const unsigned char* UB = WSP(const unsigned char, OFF_XBCA);
  const unsigned char* VB = UB + (size_t)16384 * 1024;
  const float* gfin = p.in[I_GF];
  for (int row = bid * 4 + w; row < ROWS; row += nblk * 4) {
    const int b = row / TPB, pos = row % TPB;
    if (l == 1 && pos < CTXL) continue;
    const int lane = TID() & 63;
    const int head = lane >> 3, sub = lane & 7;
    const float* tv1 = TV + ((size_t)row * 16 + head * 2) * 16;
    const float* tv2 = tv1 + 16;
    const int* ti1 = TI + ((size_t)row * 16 + head * 2) * 16;
    const int* ti2 = ti1 + 16;
    const int t1lo = ti1[sub], t1hi = ti1[sub + 8], t2lo = ti2[sub], t2hi = ti2[sub + 8];
    u32 ck[7];
#pragma unroll
    for (int s = 0; s < 7; ++s) {
      const int c = sub + 8 * s;
      if (c < 50) {
        const u32 u = __float_as_uint(tv1[cand_a(c)] + tv2[cand_b(c)]);
        const u32 ord = (u & 0x80000000u) ? ~u : (u | 0x80000000u);
        ck[s] = (ord & ~63u) | (u32)(63 - c);
      } else ck[s] = 0u;
    }
    float w0v = 0.f, w1v = 0.f, mx = 0.f;
    int w0c = 0, w1c = 0;
    u32 prevk = 0xFFFFFFFFu;
#pragma unroll
    for (int r = 0; r < 16; ++r) {
      u32 m = 0u;
#pragma unroll
      for (int s = 0; s < 7; ++s) { const u32 d = ck[s] - prevk; m = d > m ? d : m; }
      { const u32 ov = (u32)dpp_i<DPP_XOR1>((int)m); m = ov > m ? ov : m; }
      { const u32 ov = (u32)dpp_i<DPP_XOR2>((int)m); m = ov > m ? ov : m; }
      { const u32 ov = (u32)dpp_i<DPP_MIRROR8>((int)m); m = ov > m ? ov : m; }
      const u32 best = prevk + m;
      prevk = best;
      const u32 ordv = best & ~63u;
      const float bv = __uint_as_float((ordv & 0x80000000u) ? (ordv & 0x7FFFFFFFu) : ~ordv);
      const int bc = 63 - (int)(best & 63u);
      if (r == 0) mx = bv;
      if (sub == (r & 7)) {
        if (r < 8) { w0v = bv; w0c = bc; } else { w1v = bv; w1c = bc; }
      }
    }
    const float e0 = expf(w0v - mx), e1 = expf(w1v - mx);
    float es = e0 + e1;
    es += dpp_f<DPP_XOR1>(es);
    es += dpp_f<DPP_XOR2>(es);
    es += dpp_f<DPP_MIRROR8>(es);
    const float g0 = e0 / es, g1 = e1 / es;
    int idx0, idx1;
    {
      const int gb = lane & ~7;
      const int a0 = cand_a(w0c), c0 = cand_b(w0c), a1 = cand_a(w1c), c1 = cand_b(w1c);
      const int p0l = __shfl(t1lo, gb + (a0 & 7)), p0h = __shfl(t1hi, gb + (a0 & 7));
      const int q0l = __shfl(t2lo, gb + (c0 & 7)), q0h = __shfl(t2hi, gb + (c0 & 7));
      const int p1l = __shfl(t1lo, gb + (a1 & 7)), p1h = __shfl(t1hi, gb + (a1 & 7));
      const int q1l = __shfl(t2lo, gb + (c1 & 7)), q1h = __shfl(t2hi, gb + (c1 & 7));
      idx0 = ((a0 & 8) ? p0h : p0l) * 128 + ((c0 & 8) ? q0h : q0l);
      idx1 = ((a1 & 8) ? p1h : p1l) * 128 + ((c1 & 8) ? q1h : q1l);
    }
    const u16* hrow = H2 + (size_t)row * 1024;
    float hv[16];
    {
      const uint4 ha = *(const uint4*)(hrow + lane * 16), hb = *(const uint4*)(hrow + lane * 16 + 8);
      hv[0] = bflo(ha.x); hv[1] = bfhi(ha.x); hv[2] = bflo(ha.y); hv[3] = bfhi(ha.y);
      hv[4] = bflo(ha.z); hv[5] = bfhi(ha.z); hv[6] = bflo(ha.w); hv[7] = bfhi(ha.w);
      hv[8] = bflo(hb.x); hv[9] = bfhi(hb.x); hv[10] = bflo(hb.y); hv[11] = bfhi(hb.y);
      hv[12] = bflo(hb.z); hv[13] = bfhi(hb.z); hv[14] = bflo(hb.w); hv[15] = bfhi(hb.w);
    }
    float acc[16];
#pragma unroll 1
    for (int prep_ = 0; prep_ < PEER_REPS; ++prep_) {
    f32x2 hv2[8];
#pragma unroll
    for (int i = 0; i < 8; ++i) hv2[i] = (f32x2){hv[2 * i], hv[2 * i + 1]};
    const bool b0 = lane & 1, b1 = lane & 2, b2 = lane & 4;
    float act0 = 0.f, act1 = 0.f;
    u32x4 rb[2][8];
#define PEER_LOAD(buf, k, TAB)                                                                     \
  _Pragma("unroll") for (int j = 0; j < 8; ++j) {                                                  \
    const int e = (k) * 8 + j;                                                                     \
    const int id = __builtin_amdgcn_readlane(((k) < 8) ? idx0 : idx1, e & 63);                     \
    rb[buf][j] = *(const u32x4*)(TAB + (size_t)id * 1024 + lane * 16);                             \
  }
#define PEER_DOT(buf, k)                                                                           \
  {                                                                                                \
    float d[8];                                                                                    \
    _Pragma("unroll") for (int j = 0; j < 8; ++j) {                                                \
      const u32 uw[4] = {rb[buf][j][0], rb[buf][j][1], rb[buf][j][2], rb[buf][j][3]};              \
      f32x2 sa = {0.f, 0.f}, sb = {0.f, 0.f};                   \
      _Pragma("unroll") for (int q = 0; q < 4; ++q) {                                              \
        const f32x2 lo = __builtin_amdgcn_cvt_pk_f32_fp8((int)uw[q], false);                       \
        const f32x2 hi = __builtin_amdgcn_cvt_pk_f32_fp8((int)uw[q], true);                        \
        sa = __builtin_elementwise_fma(hv2[2 * q], lo, sa);                                        \
        sb = __builtin_elementwise_fma(hv2[2 * q + 1], hi, sb);                                    \
      }                                                                                            \
      sa += sb;                                                                                    \
      d[j] = sa.x + sa.y;                                                                          \
    }                                                                                              \
    float a4[4];                                                                                   \
    _Pragma("unroll") for (int q = 0; q < 4; ++q) {                                                \
      const float keep = b0 ? d[2 * q + 1] : d[2 * q], send = b0 ? d[2 * q] : d[2 * q + 1];        \
      a4[q] = keep + __shfl_xor(send, 1);                                                          \
    }                                                                                              \
    float a2[2];                                                                                   \
    _Pragma("unroll") for (int q = 0; q < 2; ++q) {                                                \
      const float keep = b1 ? a4[2 * q + 1] : a4[2 * q], send = b1 ? a4[2 * q] : a4[2 * q + 1];    \
      a2[q] = keep + __shfl_xor(send, 2);                                                          \
    }                                                                                              \
    const float keep = b2 ? a2[1] : a2[0], send = b2 ? a2[0] : a2[1];                              \
    float c1 = keep + __shfl_xor(send, 4);                                                         \
    c1 += __shfl_xor(c1, 8);                                                                       \
    c1 += __shfl_xor(c1, 16);                                                                      \
    c1 += __shfl_xor(c1, 32);                                                                      \
    if ((lane >> 3) == ((k) & 7)) { if ((k) < 8) act0 = c1; else act1 = c1; }                      \
  }
    PEER_LOAD(0, 0, UB)
#pragma unroll 1
    for (int k = 0; k < 16; k += 2) {
      PEER_LOAD(1, k + 1, UB)
      __builtin_amdgcn_sched_barrier(0);
      PEER_DOT(0, k)
      { const int kn = (k + 2 < 16) ? k + 2 : 15; PEER_LOAD(0, kn, UB) }
      __builtin_amdgcn_sched_barrier(0);
      PEER_DOT(1, k + 1)
    }
    const float ga0 = gelu_tanh(act0 * (1.f / U_SCALE)) * g0 * (1.f / V_SCALE);
    const float ga1 = gelu_tanh(act1 * (1.f / U_SCALE)) * g1 * (1.f / V_SCALE);
#pragma unroll
    for (int i = 0; i < 16; ++i) acc[i] = 0.f;
#define PEER_ACC(buf, k)                                                                           \
  _Pragma("unroll") for (int j = 0; j < 8; ++j) {                                                  \
    const int e = (k) * 8 + j;                                                                     \
    const int ai = __builtin_amdgcn_readlane(__builtin_bit_cast(int, ((k) < 8) ? ga0 : ga1), e & 63); \
    const float a = __builtin_bit_cast(float, ai);                                                 \
    const u32 vw[4] = {rb[buf][j][0], rb[buf][j][1], rb[buf][j][2], rb[buf][j][3]};                \
    _Pragma("unroll") for (int q = 0; q < 4; ++q) {                                                \
      const f32x2 lo = __builtin_amdgcn_cvt_pk_f32_fp8((int)vw[q], false);                         \
      const f32x2 hi = __builtin_amdgcn_cvt_pk_f32_fp8((int)vw[q], true);                          \
      acc[q * 4 + 0] += a * lo.x; acc[q * 4 + 1] += a * lo.y; acc[q * 4 + 2] += a * hi.x; acc[q * 4 + 3] += a * hi.y; \
    }                                                                                              \
  }
    PEER_LOAD(0, 0, VB)
#pragma unroll 1
    for (int k = 0; k < 16; k += 2) {
      PEER_LOAD(1, k + 1, VB)
      __builtin_amdgcn_sched_barrier(0);
      PEER_ACC(0, k)
      { const int kn = (k + 2 < 16) ? k + 2 : 15; PEER_LOAD(0, kn, VB) }
      __builtin_amdgcn_sched_barrier(0);
      PEER_ACC(1, k + 1)
    }
#undef PEER_LOAD
#undef PEER_DOT
#undef PEER_ACC
      if (prep_ + 1 < PEER_REPS) { _Pragma("unroll") for (int i = 0; i < 16; ++i) asm volatile("" :: "v"(acc[i])); }
    }
    int row2 = row;
    asm volatile("" : "+v"(row2));
    const int lane2 = TID() & 63;
    const int b2 = row2 / TPB, pos2 = row2 % TPB;
    const float* xr = xrow_ptr(p, false, b2, pos2);
    float* xw = xrow_wptr(p, b2, pos2);
    const float* ga = WSP(const float, OFF_MOD) + (size_t)(l * 17 + (pos2 < CTXL ? 16 : b2)) * 6144 + 5120;
    float xn[16];
    float ss = 0.f;
#pragma unroll
    for (int q = 0; q < 4; ++q) {
      const float4 xv = *(const float4*)(xr + lane2 * 16 + q * 4);
      const float4 gv = *(const float4*)(ga + lane2 * 16 + q * 4);
      xn[q * 4 + 0] = xv.x + gv.x * acc[q * 4 + 0];
      xn[q * 4 + 1] = xv.y + gv.y * acc[q * 4 + 1];
      xn[q * 4 + 2] = xv.z + gv.z * acc[q * 4 + 2];
      xn[q * 4 + 3] = xv.w + gv.w * acc[q * 4 + 3];
    }
    if (l == 1) {
#pragma unroll
      for (int i = 0; i < 16; ++i) ss += xn[i] * xn[i];
      ss = wave_sum(ss);
      const float rs = rsqrtf(ss * (1.f / 1024.f) + EPSF);
#pragma unroll
      for (int i = 0; i < 16; ++i) xn[i] = xn[i] * rs * gfin[lane2 * 16 + i];
    }
#pragma unroll
    for (int q = 0; q < 4; ++q) {
      float4 o = {xn[q * 4 + 0], xn[q * 4 + 1], xn[q * 4 + 2], xn[q * 4 + 3]};
      *(float4*)(xw + lane2 * 16 + q * 4) = o;
    }
  }
}

template <int S>
DI void run_stage(const Params& p, int l, int bid, int nblk, char* smem) {
  for (int rep = 0; rep < 1 + ((REP_MASK >> (S + 1)) & 1); ++rep) {
  if (S == 0) { if (PH_MASK & 2) phase_norm(p, l, 0, bid, nblk); }
  else if (S == 1) { if (PH_MASK & 4) phase_inproj(p, l, bid, nblk, smem); }
  else if (S == 2) { if (PH_MASK & 8) phase_prep(p, l, bid, nblk, smem); }
  else if (S == 3) { if (PH_MASK & 16) phase_mixers(p, l, bid, nblk, smem, rep); }
  else if (S == 4) { if (PH_MASK & 32) phase_ssd_combine(p, l, bid, nblk); }
  else if (S == 5) { if (PH_MASK & 64) phase_outproj(p, l, bid, nblk, smem); }
  else if (S == 6) { if (PH_MASK & 128) { phase_norm(p, l, 1, bid, nblk); phase_tables(p, l, bid, nblk); } }
  else if (S == 7) { if (PH_MASK & 256) phase_q(p, l, bid, nblk, smem); }
  else if (S == 8) { if (PH_MASK & 512) phase_topk(p, l, bid, nblk, smem); }
  else { if (PH_MASK & 1024) phase_peer(p, l, bid, nblk); }
  }
}

#if ONE_LAUNCH
__global__ void __launch_bounds__(NTHR, 2) mega(Params p) {
  extern __shared__ __attribute__((aligned(16))) char smem[];
  const int bid = blockIdx.x, nblk = gridDim.x;
  cg::grid_group grid = cg::this_grid();
  volatile LAS unsigned* bst = (volatile LAS unsigned*)(smem + LDS_BYTES - 32);
  if (threadIdx.x == 0) { bst[0] = 0u; bst[1] = 0u; }
  __syncthreads();
  const XcdBarrier bar = xcd_barrier_post(WSP(unsigned, OFF_BAR), bst);
  for (int rep = 0; rep < 1 + (REP_MASK & 1); ++rep) { if (PH_MASK & 1) phase_prologue(p, bid, nblk, smem); }
  grid.sync();
#define GBAR() xcd_barrier(bar)
#pragma nounroll
  for (int l = 0; l < 2; ++l) {
    for (int xs = 0; xs < EXTRA_SYNCS; ++xs) GBAR();
    run_stage<0>(p, l, bid, nblk, smem); GBAR();
    run_stage<1>(p, l, bid, nblk, smem); GBAR();
    run_stage<2>(p, l, bid, nblk, smem); GBAR();
    run_stage<3>(p, l, bid, nblk, smem); GBAR();
    run_stage<4>(p, l, bid, nblk, smem); GBAR();
    run_stage<5>(p, l, bid, nblk, smem); GBAR();
    run_stage<6>(p, l, bid, nblk, smem); GBAR();
    run_stage<7>(p, l, bid, nblk, smem); GBAR();
    run_stage<8>(p, l, bid, nblk, smem); GBAR();
    run_stage<9>(p, l, bid, nblk, smem);
    if (l == 0) GBAR();
  }
}
#else
template <int S>
__global__ void __launch_bounds__(NTHR, 2) stage_kernel(Params p, int l) {
  extern __shared__ __attribute__((aligned(16))) char smem[];
  if (S < 0) phase_prologue(p, blockIdx.x, gridDim.x, smem);
  else run_stage<(S < 0 ? 0 : S)>(p, l, blockIdx.x, gridDim.x, smem);
}

template <int S>
static void launch_stage(const Params& p, int l, int grid, hipStream_t stream) {
  (void)hipFuncSetAttribute((const void*)stage_kernel<S>, hipFuncAttributeMaxDynamicSharedMemorySize, LDS_BYTES);
  hipLaunchKernelGGL(stage_kernel<S>, dim3(grid), dim3(NTHR), LDS_BYTES, stream, p, l);
}

#endif

extern "C" void kernel_launch(void* const* d_in, const int* in_sizes, int n_in, void* d_out, int out_size, void* d_ws,
                              size_t ws_size, hipStream_t stream) {
  static int grid = 0;
  if (grid == 0) {
    if (ws_size < WS_END || n_in != 31) { fprintf(stderr, "kernel_launch: ws %zu < %zu or n_in %d\n", ws_size, (size_t)WS_END, n_in); grid = -1; return; }
    int dev = 0, cus = 0, per_cu = 0;
    (void)hipGetDevice(&dev);
    (void)hipDeviceGetAttribute(&cus, hipDeviceAttributeMultiprocessorCount, dev);
#if ONE_LAUNCH
    (void)hipFuncSetAttribute((const void*)mega, hipFuncAttributeMaxDynamicSharedMemorySize, LDS_BYTES);
    (void)hipOccupancyMaxActiveBlocksPerMultiprocessor(&per_cu, (const void*)mega, NTHR, LDS_BYTES);
#else
    (void)hipFuncSetAttribute((const void*)stage_kernel<3>, hipFuncAttributeMaxDynamicSharedMemorySize, LDS_BYTES);
    (void)hipOccupancyMaxActiveBlocksPerMultiprocessor(&per_cu, (const void*)stage_kernel<3>, NTHR, LDS_BYTES);
#endif
    if (per_cu < 1) per_cu = 1;
    if (per_cu > 2) per_cu = 2;
    grid = cus * per_cu;
  }
  if (grid < 0) return;
  (void)hipMemsetAsync((char*)d_ws + OFF_CTR, 0, 256 + 3456 * 4, stream);
  Params p{};
  for (int i = 0; i < 31; ++i) p.in[i] = (const float*)d_in[i];
  p.out = (float*)d_out;
  p.ws = (unsigned char*)d_ws;
#if ONE_LAUNCH
  void* args[] = {&p};
  hipError_t e = hipLaunchCooperativeKernel((const void*)mega, dim3(grid), dim3(NTHR), args, LDS_BYTES, stream);
  if (e != hipSuccess) fprintf(stderr, "cooperative launch failed: %s (grid %d)\n", hipGetErrorString(e), grid);
#else
  launch_stage<-1>(p, 0, grid, stream);
  for (int l = 0; l < 2; ++l) {
    launch_stage<0>(p, l, grid, stream);
    launch_stage<1>(p, l, grid, stream);
    launch_stage<2>(p, l, grid, stream);
    launch_stage<3>(p, l, grid, stream);
    launch_stage<4>(p, l, grid, stream);
    launch_stage<5>(p, l, grid, stream);
    launch_stage<6>(p, l, grid, stream);
    launch_stage<7>(p, l, grid, stream);
    launch_stage<8>(p, l, grid, stream);
    launch_stage<9>(p, l, grid, stream);
  }
#endif
}
```
